# Optimizing an MI355X kernel written in HIP

```python
import math
import jax, jax.numpy as jnp
from jax import lax
import numpy as np

D_MODEL = 2048
BATCH = 2
SEQ = 16384
DEPTH = 1

EPS = 1e-6
F_GROUPS = 4
F_GROUP_DIM = D_MODEL // 8
F_WIDTH = F_GROUPS * F_GROUP_DIM
GLA_HEADS = 4
GLA_DK = D_MODEL // 16
GLA_DV = D_MODEL // 8
GLA_QK = GLA_HEADS * GLA_DK
GLA_V = GLA_HEADS * GLA_DV
GATE_RANK = 16
GATE_TAU = 16.0
GLA_CHUNK = 64
N_DIRS = 2
W_IN_COLS = F_WIDTH + 2 * GLA_QK + 2 * GLA_V + N_DIRS * GATE_RANK + 2 * D_MODEL
PEER_HEADS = 8
PEER_QDIM = 256
PEER_HALF = PEER_QDIM // 2
N_KEYS = 128
N_EXPERTS = N_KEYS * N_KEYS
PEER_TOPK = 16
PEER_TOKEN_BLOCK = 128

kernel_name = "hybrid_fnet_gla_peer_adaln_block"


def rms_norm(x, g):
    xf = x.astype(jnp.float32)
    y = xf * lax.rsqrt(jnp.mean(xf * xf, axis=-1, keepdims=True) + EPS)
    return (y * g.astype(jnp.float32)).astype(x.dtype)


def fourier_mix(z):
    B, S, _ = z.shape
    zf = z.reshape(B, S, F_GROUPS, F_GROUP_DIM).astype(jnp.float32)
    y = jnp.fft.fftn(zf, axes=(1, 3), norm="ortho").real
    return y.reshape(B, S, F_WIDTH).astype(z.dtype)


def gla_chunked(q, k, v, log_a):
    N, H, S, DK = q.shape
    DV = v.shape[-1]
    nc = S // GLA_CHUNK

    def to_chunks(t):
        t = t.reshape(N, H, nc, GLA_CHUNK, t.shape[-1])
        return jnp.moveaxis(t, 2, 0)

    mask = jnp.tril(jnp.ones((GLA_CHUNK, GLA_CHUNK), dtype=bool))[None, None, :, :, None]

    def step(state, inp):
        qc, kc, vc, ac = inp
        b = jnp.cumsum(ac, axis=-2)
        o_inter = jnp.einsum('nhcd,nhde->nhce', qc * jnp.exp(b), state)
        diff = b[:, :, :, None, :] - b[:, :, None, :, :]
        decay = jnp.exp(jnp.where(mask, diff, -jnp.inf))
        attn = jnp.einsum('nhid,nhjd,nhijd->nhij', qc, kc, decay)
        o_intra = jnp.einsum('nhij,nhje->nhie', attn, vc)
        b_last = b[:, :, -1:, :]
        k_dec = kc * jnp.exp(b_last - b)
        state = jnp.exp(b_last[:, :, 0, :])[..., None] * state + jnp.einsum('nhcd,nhce->nhde', k_dec, vc)
        return state, o_inter + o_intra

    state0 = jnp.zeros((N, H, DK, DV), jnp.float32)
    _, out = lax.scan(step, state0, (to_chunks(q), to_chunks(k), to_chunks(v), to_chunks(log_a)))
    return jnp.moveaxis(out, 0, 2).reshape(N, H, S, DV)


def gla_branch(q, k, v, r, a1, w_a2, b_a, norm_g):
    B, S, _ = q.shape
    dtype = q.dtype
    qh = q.reshape(B, S, GLA_HEADS, GLA_DK).astype(jnp.float32) * (GLA_DK ** -0.5)
    kh = k.reshape(B, S, GLA_HEADS, GLA_DK).astype(jnp.float32)
    vh = v.reshape(B, S, GLA_HEADS, GLA_DV).astype(jnp.float32)
    a1 = a1.reshape(B, S, N_DIRS, GATE_RANK)
    z = jnp.einsum('bsir,ire->ibse', a1, w_a2) + b_a[:, None, None, :]
    log_a = (jax.nn.log_sigmoid(z.astype(jnp.float32)) / GATE_TAU).reshape(N_DIRS, B, S, GLA_HEADS, GLA_DK)

    def both_dirs(t):
        t2 = jnp.stack([t, jnp.flip(t, axis=1)])
        return jnp.transpose(t2.reshape((N_DIRS * B,) + t.shape[1:]), (0, 2, 1, 3))

    la = jnp.stack([log_a[0], jnp.flip(log_a[1], axis=1)])
    la = jnp.transpose(la.reshape(N_DIRS * B, S, GLA_HEADS, GLA_DK), (0, 2, 1, 3))
    o = gla_chunked(both_dirs(qh), both_dirs(kh), both_dirs(vh), la)
    o = o.reshape(N_DIRS, B, GLA_HEADS, S, GLA_DV)
    o = o[0] + jnp.flip(o[1], axis=2)
    o = jnp.transpose(o, (0, 2, 1, 3))
    o = o * lax.rsqrt(jnp.mean(o * o, axis=-1, keepdims=True) + EPS) * norm_g.astype(jnp.float32)
    o = o * jax.nn.silu(r.reshape(B, S, GLA_HEADS, GLA_DV).astype(jnp.float32))
    return o.reshape(B, S, GLA_V).astype(dtype)


def peer_ffn(n2, w_q, keys, u, v):
    B, S, D = n2.shape
    q = (n2 @ w_q).reshape(B, S, PEER_HEADS, PEER_QDIM).astype(jnp.float32)
    s1 = jnp.einsum('bshd,hnd->bshn', q[..., :PEER_HALF], keys[:, 0].astype(jnp.float32))
    s2 = jnp.einsum('bshd,hnd->bshn', q[..., PEER_HALF:], keys[:, 1].astype(jnp.float32))
    v1, i1 = lax.top_k(s1, PEER_TOPK)
    v2, i2 = lax.top_k(s2, PEER_TOPK)
    cand = (v1[..., :, None] + v2[..., None, :]).reshape(B, S, PEER_HEADS, PEER_TOPK * PEER_TOPK)
    sv, pos = lax.top_k(cand, PEER_TOPK)
    e1 = jnp.take_along_axis(i1, pos // PEER_TOPK, axis=-1)
    e2 = jnp.take_along_axis(i2, pos % PEER_TOPK, axis=-1)
    idx = e1 * N_KEYS + e2
    g = jax.nn.softmax(sv, axis=-1)

    T = B * S
    nb = T // PEER_TOKEN_BLOCK
    xb = n2.reshape(nb, PEER_TOKEN_BLOCK, D)
    ib = idx.reshape(nb, PEER_TOKEN_BLOCK, PEER_HEADS * PEER_TOPK)
    gb = g.reshape(nb, PEER_TOKEN_BLOCK, PEER_HEADS * PEER_TOPK)

    def block(args):
        xt, it, gt = args
        U = jnp.take(u, it, axis=0)
        act = jax.nn.gelu(jnp.einsum('td,tkd->tk', xt, U).astype(jnp.float32), approximate=False)
        V = jnp.take(v, it, axis=0)
        return jnp.einsum('tk,tkd->td', (gt * act).astype(xt.dtype), V)

    out = lax.map(block, (xb, ib, gb))
    return out.reshape(B, S, D)


def setup_inputs(seed: int = 0) -> dict:
    key = jax.random.key(seed)
    ks = jax.random.split(key, 20)
    D = D_MODEL
    f32 = jnp.float32
    nrm = lambda k, shape, s: jax.random.normal(k, shape, f32) * s
    return {
        "x": nrm(ks[0], (BATCH, SEQ, D), 1.0),
        "c": nrm(ks[1], (BATCH, D), 1.0),
        "w_ada": nrm(ks[2], (DEPTH, D, 6 * D), D ** -0.5),
        "b_ada": nrm(ks[3], (DEPTH, 6 * D), 0.02),
        "norm1_g": 1.0 + nrm(ks[4], (DEPTH, D), 0.02),
        "w_in": nrm(ks[5], (DEPTH, D, W_IN_COLS), D ** -0.5),
        "w_fnet": nrm(ks[6], (DEPTH, F_WIDTH, D), F_WIDTH ** -0.5),
        "gla_w_a2": nrm(ks[7], (DEPTH, N_DIRS, GATE_RANK, GLA_QK), GATE_RANK ** -0.5),
        "gla_b_a": nrm(ks[8], (DEPTH, N_DIRS, GLA_QK), 0.1),
        "gla_norm_g": 1.0 + nrm(ks[9], (DEPTH, GLA_DV), 0.02),
        "w_gla": nrm(ks[10], (DEPTH, GLA_V, D), GLA_V ** -0.5),
        "w_out": nrm(ks[11], (DEPTH, D, D), D ** -0.5),
        "norm2_g": 1.0 + nrm(ks[12], (DEPTH, D), 0.02),
        "peer_w_q": nrm(ks[13], (DEPTH, D, PEER_HEADS * PEER_QDIM), D ** -0.5),
        "peer_keys": nrm(ks[14], (DEPTH, PEER_HEADS, 2, N_KEYS, PEER_HALF), PEER_HALF ** -0.5),
        "peer_u": nrm(ks[15], (DEPTH, N_EXPERTS, D), D ** -0.5),
        "peer_v": nrm(ks[16], (DEPTH, N_EXPERTS, D), 0.5),
        "final_norm_g": 1.0 + nrm(ks[17], (D,), 0.02),
    }


def reference(x, c, w_ada, b_ada, norm1_g, w_in, w_fnet, gla_w_a2, gla_b_a, gla_norm_g,
              w_gla, w_out, norm2_g, peer_w_q, peer_keys, peer_u, peer_v, final_norm_g):
    split_points = [F_WIDTH,
                    F_WIDTH + GLA_QK,
                    F_WIDTH + 2 * GLA_QK,
                    F_WIDTH + 2 * GLA_QK + GLA_V,
                    F_WIDTH + 2 * GLA_QK + 2 * GLA_V,
                    F_WIDTH + 2 * GLA_QK + 2 * GLA_V + N_DIRS * GATE_RANK]
    h = x
    for l in range(DEPTH):
        mod = jax.nn.silu(c) @ w_ada[l] + b_ada[l]
        sh1, sc1, g1, sh2, sc2, g2 = jnp.split(mod[:, None, :], 6, axis=-1)

        n = rms_norm(h, norm1_g[l]) * (1.0 + sc1) + sh1
        p = n @ w_in[l]
        z_f, q, k, v, r, a1, m = jnp.split(p, split_points, axis=-1)
        y_f = fourier_mix(z_f) @ w_fnet[l]
        y_g = gla_branch(q, k, v, r, a1, gla_w_a2[l], gla_b_a[l], gla_norm_g[l]) @ w_gla[l]
        gate_f, gate_g = jnp.split(jax.nn.sigmoid(m), 2, axis=-1)
        mixed = (gate_f * y_f + gate_g * y_g) @ w_out[l]
        h = h + g1 * mixed

        n2 = rms_norm(h, norm2_g[l]) * (1.0 + sc2) + sh2
        h = h + g2 * peer_ffn(n2, peer_w_q[l], peer_keys[l], peer_u[l], peer_v[l])
    return rms_norm(h, final_norm_g)
```

```cpp
#include <hip/hip_runtime.h>
#include <hip/hip_cooperative_groups.h>
#include <cstdio>
namespace cg = cooperative_groups;

#define LAS __attribute__((address_space(3)))
typedef unsigned short bf16_t;
typedef short bf16x8 __attribute__((ext_vector_type(8)));
typedef float f32x4 __attribute__((ext_vector_type(4)));
typedef float f32x2 __attribute__((ext_vector_type(2)));
typedef unsigned u32x4 __attribute__((ext_vector_type(4)));
typedef unsigned u32x2 __attribute__((ext_vector_type(2)));
typedef LAS unsigned char* ldsp_t;

#ifndef N_PHASE_LAUNCH
#define N_PHASE_LAUNCH 0
#endif

constexpr int T_ = 32768, D_ = 2048, S_ = 16384;
constexpr float EPS = 1e-6f;
constexpr int PW = 8448;
constexpr int PC_Z = 0, PC_Q = 1024, PC_K = 1536, PC_V = 2048, PC_R = 3072, PC_GF = 4096, PC_GG = 6144, PC_A1 = 8192;
constexpr int LDS_BYTES = 135168;

constexpr size_t WS_CTL  = 0;
constexpr size_t WS_MOD  = 65536;
constexpr size_t WS_TW   = WS_MOD + 98304;
constexpr size_t WS_F1   = WS_TW + 131072;
constexpr size_t WS_F2   = WS_F1 + 65536;
constexpr size_t WS_DSEG = WS_F2 + 131072;
constexpr size_t WS_WIN  = WS_DSEG + 131072;
constexpr size_t WS_WFN  = WS_WIN + (size_t)8448 * 2048 * 2;
constexpr size_t WS_WGLA = WS_WFN + (size_t)2048 * 2048 * 2;
constexpr size_t WS_WOUT = WS_WGLA + (size_t)2048 * 1024 * 2;
constexpr size_t WS_WQ   = WS_WOUT + (size_t)2048 * 2048 * 2;
constexpr size_t WS_KEYS = WS_WQ + (size_t)2048 * 2048 * 2;
constexpr size_t WS_L    = WS_KEYS + (size_t)8 * 2 * 128 * 128 * 2;
constexpr size_t WS_XN   = WS_L + (size_t)512 * 16384 * 4;
constexpr size_t WS_O    = WS_XN + (size_t)T_ * 2048 * 2;
constexpr size_t WS_P    = WS_O + (size_t)T_ * 2048 * 2;
constexpr size_t WS_QP   = WS_P;
constexpr size_t WS_IDX  = WS_QP + (size_t)T_ * 2048 * 2;
constexpr size_t WS_G    = WS_IDX + (size_t)T_ * 128 * 4;
constexpr size_t WS_UB   = WS_G + (size_t)T_ * 128 * 4;
constexpr size_t WS_VB   = WS_UB + (size_t)16384 * 2048 * 2;
constexpr size_t WS_END  = WS_P + (size_t)T_ * PW * 2;
static_assert(WS_VB + (size_t)16384 * 2048 * 2 <= WS_END, "late buffers must fit in the P region");
static_assert(WS_END <= (size_t)1000 * 1000 * 1000, "workspace budget");

struct Args { const float* in[18]; float* out; unsigned char* ws; int ph_lo, ph_hi; };
enum { I_X = 0, I_C, I_WADA, I_BADA, I_N1G, I_WIN, I_WFNET, I_WA2, I_BA, I_GNG, I_WGLA, I_WOUT, I_N2G, I_WQ, I_KEYS, I_U, I_V, I_FNG };

__device__ __forceinline__ unsigned f2bf(float f) { unsigned u = __float_as_uint(f); return (u + 0x7fffu + ((u >> 16) & 1u)) >> 16; }
__device__ __forceinline__ float bf2f(unsigned h) { return __uint_as_float(h << 16); }
__device__ __forceinline__ unsigned pk2(float lo, float hi) { return f2bf(lo) | (f2bf(hi) << 16); }
__device__ __forceinline__ float bflo(unsigned w) { return __uint_as_float(w << 16); }
__device__ __forceinline__ float bfhi(unsigned w) { return __uint_as_float(w & 0xffff0000u); }
__device__ __forceinline__ float wave_sum(float v) {
#pragma unroll
    for (int o = 32; o >= 1; o >>= 1) v += __shfl_xor(v, o);
    return v;
}
__device__ __forceinline__ float sigmoidf_(float v) { return 1.0f / (1.0f + __expf(-v)); }


namespace pg8 {
constexpr int BM = 256, BK = 64, HALF = 128, HTB = HALF * BK * 2, STAGE_BYTES = 8 * HTB, NXCD = 8, WGM = 8;
__device__ __forceinline__ int lds_byte(int r, int c) { const int st = (r >> 4) * 2 + (c >> 5), rr = r & 15, cc = c & 31, ob = rr * 64 + cc * 2; return st * 1024 + (ob ^ (((ob >> 9) & 1) << 5)); }
__device__ __forceinline__ void stage_rc(int b, int& R, int& C) { const int st = b / 1024, sb = b % 1024, swz = sb ^ (((sb >> 9) & 1) << 5); R = (st >> 1) * 16 + swz / 64; C = (st & 1) * 32 + (swz % 64) / 2; }
__device__ __forceinline__ int perm32(int rho) { const int n = rho >> 4, i = rho & 15; return 8 * (i >> 2) + 4 * n + (i & 3); }

struct Unit { int pm, pn; };
struct Gemm { const bf16_t* A; const bf16_t* Bt; int M, N, K, lda; };

struct StaticOrder {
    int nM, nN, nwg, G, c;
    __device__ void init(int M, int N, int G_, int c_) { nM = M / BM; nN = N / BM; nwg = nM * nN; G = G_; c = c_; }
    __device__ bool next(int i, Unit& u) const {
        const long L = (long)i * G + c; if (L >= nwg) return false;
        int wgid = (int)L; { const int q = nwg / NXCD, r = nwg % NXCD, xcd = wgid % NXCD, off = wgid / NXCD; wgid = (xcd < r ? xcd * (q + 1) : r * (q + 1) + (xcd - r) * q) + off; }
        const int nig = WGM * nN, gid = wgid / nig, fm = gid * WGM, gsz = (nM - fm) < WGM ? (nM - fm) : WGM;
        u.pm = fm + ((wgid % nig) % gsz); u.pn = (wgid % nig) / gsz; return true;
    }
};

template <class Epi>
__device__ __forceinline__ void gemm_phase(ldsp_t lds, const Gemm g, const StaticOrder& S, const Epi& E) {
    const int tid = threadIdx.x, wid = __builtin_amdgcn_readfirstlane(tid >> 6), lane = tid & 63, wr = wid >> 2, wc = wid & 3, fr = lane & 15, fq = lane >> 4;
    const int K = g.K, nt = K / BK, lda = g.lda;
    unsigned voffA[2], voffB[2];
#pragma unroll
    for (int i = 0; i < 2; ++i) { int R, C; stage_rc(tid * 16 + i * 8192, R, C); const int Rb = Epi::PERM ? ((R & ~31) + perm32(R & 31)) : R;
        voffA[i] = (unsigned)(R * lda + C) * 2u; voffB[i] = (unsigned)(Rb * K + C) * 2u; }
    const size_t kstep = (size_t)(BK * 2);
    const size_t hstepA = (size_t)HALF * lda * 2, hstepB = (size_t)HALF * K * 2;
    const size_t tstepA = 2 * hstepA, tstepB = 2 * hstepB;
    const unsigned ldsw = (unsigned)wid * 1024u;
    const int aoff = lds_byte(wr * 64 + fr, fq * 8), boff = lds_byte(wc * 32 + fr, fq * 8);
#define PG8_SA(b, h) (((b) * 2 + (h)) * HTB)
#define PG8_SB(b, h) ((4 + (b) * 2 + (h)) * HTB)
#define PG8_STAGE(bufoff, gbase, voff) do { _Pragma("unroll") for (int _i = 0; _i < 2; ++_i) \
        __builtin_amdgcn_global_load_lds((const unsigned*)((const char*)(gbase) + (voff)[_i]), (LAS unsigned*)(lds + (bufoff) + ldsw + _i * 8192), 16, 0, 0); } while (0)
#define PG8_LDA(dst, b, h) do { _Pragma("unroll") for (int m = 0; m < 4; ++m) _Pragma("unroll") for (int k = 0; k < 2; ++k) dst[m][k] = *(const LAS bf16x8*)(lds + PG8_SA(b, h) + aoff + m * 2048 + k * 1024); } while (0)
#define PG8_LDB(dst, b, h) do { _Pragma("unroll") for (int n = 0; n < 2; ++n) _Pragma("unroll") for (int k = 0; k < 2; ++k) dst[n][k] = *(const LAS bf16x8*)(lds + PG8_SB(b, h) + boff + n * 2048 + k * 1024); } while (0)
#define PG8_MMA(ai, bj, At, Bt) do { __builtin_amdgcn_s_setprio(1); _Pragma("unroll") for (int m = 0; m < 4; ++m) _Pragma("unroll") for (int n = 0; n < 2; ++n) _Pragma("unroll") for (int k = 0; k < 2; ++k) \
        acc[ai][bj][m][n] = __builtin_amdgcn_mfma_f32_16x16x32_bf16(Bt[n][k], At[m][k], acc[ai][bj][m][n], 0, 0, 0); __builtin_amdgcn_s_setprio(0); } while (0)
#define PG8_WAIT_V(n) asm volatile("s_waitcnt vmcnt(" #n ")" ::: "memory")
#define PG8_WAIT_L(n) asm volatile("s_waitcnt lgkmcnt(" #n ")" ::: "memory")
#define PG8_BAR __builtin_amdgcn_s_barrier()
#define PG8_SCHED __builtin_amdgcn_sched_barrier(0)
    Unit cur, nxt; int ui = 0;
    if (!S.next(0, cur)) return;
    f32x4 acc[2][2][4][2];
#pragma unroll
    for (int a = 0; a < 2; ++a)
#pragma unroll
        for (int b = 0; b < 2; ++b)
#pragma unroll
            for (int m = 0; m < 4; ++m)
#pragma unroll
                for (int n = 0; n < 2; ++n) acc[a][b][m][n] = (f32x4){0.f, 0.f, 0.f, 0.f};
    bf16x8 At[4][2], B0[2][2], B1[2][2];
    const char* cA = (const char*)g.A + (size_t)cur.pm * tstepA; const char* cB = (const char*)g.Bt + (size_t)cur.pn * tstepB;
    PG8_STAGE(PG8_SB(0, 0), cB, voffB); PG8_STAGE(PG8_SA(0, 0), cA, voffA); PG8_STAGE(PG8_SB(0, 1), cB + hstepB, voffB); PG8_STAGE(PG8_SA(0, 1), cA + hstepA, voffA);
    if (wr == 1) PG8_BAR;
    PG8_WAIT_V(4); PG8_BAR;
    PG8_STAGE(PG8_SB(1, 0), cB + kstep, voffB); PG8_STAGE(PG8_SA(1, 0), cA + kstep, voffA); PG8_STAGE(PG8_SB(1, 1), cB + hstepB + kstep, voffB);
    PG8_WAIT_V(6); PG8_BAR;
    for (;;) {
        const bool has_next = S.next(ui + 1, nxt);
        const char* nA = has_next ? (const char*)g.A + (size_t)nxt.pm * tstepA : cA; const char* nB = has_next ? (const char*)g.Bt + (size_t)nxt.pn * tstepB : cB;
        for (int t = 0; t < nt; t += 2) {
            const bool last = (t == nt - 2);
            const char* a1 = cA + (size_t)(t + 1) * kstep;
            const char* a2 = last ? nA : cA + (size_t)(t + 2) * kstep; const char* b2 = last ? nB : cB + (size_t)(t + 2) * kstep;
            const char* a3 = a2 + kstep; const char* b3 = b2 + kstep;
            PG8_LDB(B0, 0, 0); PG8_SCHED; PG8_LDA(At, 0, 0); PG8_STAGE(PG8_SA(1, 1), a1 + hstepA, voffA);
            PG8_WAIT_L(8); PG8_BAR; PG8_WAIT_L(0); PG8_MMA(0, 0, At, B0); PG8_BAR; PG8_SCHED;
            PG8_LDB(B1, 0, 1); PG8_STAGE(PG8_SB(0, 0), b2, voffB);
            PG8_BAR; PG8_WAIT_L(0); PG8_MMA(0, 1, At, B1); PG8_BAR;
            PG8_LDA(At, 0, 1); PG8_STAGE(PG8_SA(0, 0), a2, voffA);
            PG8_BAR; PG8_WAIT_L(0); PG8_MMA(1, 0, At, B0); PG8_BAR; PG8_SCHED;
            PG8_STAGE(PG8_SB(0, 1), b2 + hstepB, voffB);
            PG8_WAIT_V(6); PG8_BAR; PG8_MMA(1, 1, At, B1); PG8_BAR;
            PG8_LDB(B0, 1, 0); PG8_SCHED; PG8_LDA(At, 1, 0); PG8_STAGE(PG8_SA(0, 1), a2 + hstepA, voffA);
            PG8_WAIT_L(8); PG8_BAR; PG8_WAIT_L(0); PG8_MMA(0, 0, At, B0); PG8_BAR; PG8_SCHED;
            PG8_LDB(B1, 1, 1); PG8_STAGE(PG8_SB(1, 0), b3, voffB);
            PG8_BAR; PG8_WAIT_L(0); PG8_MMA(0, 1, At, B1); PG8_BAR;
            PG8_LDA(At, 1, 1); PG8_STAGE(PG8_SA(1, 0), a3, voffA);
            PG8_BAR; PG8_WAIT_L(0); PG8_MMA(1, 0, At, B0); PG8_BAR; PG8_SCHED;
            PG8_STAGE(PG8_SB(1, 1), b3 + hstepB, voffB);
            PG8_WAIT_V(6); PG8_BAR; PG8_MMA(1, 1, At, B1); PG8_BAR;
        }
        E(acc, cur, wr, wc, fr, fq);
        if (!has_next) break;
#pragma unroll
        for (int a = 0; a < 2; ++a)
#pragma unroll
            for (int b = 0; b < 2; ++b)
#pragma unroll
                for (int m = 0; m < 4; ++m)
#pragma unroll
                    for (int n = 0; n < 2; ++n) acc[a][b][m][n] = (f32x4){0.f, 0.f, 0.f, 0.f};
        cur = nxt; cA = nA; cB = nB; ++ui;
    }
    PG8_WAIT_V(0);
    if (wr == 0) PG8_BAR;
    PG8_BAR;
#undef PG8_SA
#undef PG8_SB
#undef PG8_STAGE
#undef PG8_LDA
#undef PG8_LDB
#undef PG8_MMA
#undef PG8_WAIT_V
#undef PG8_WAIT_L
#undef PG8_BAR
#undef PG8_SCHED
}

struct EpiIn {
    static constexpr bool PERM = true;
    bf16_t* P;
    __device__ __forceinline__ void operator()(const f32x4 (&acc)[2][2][4][2], const Unit& u, int wr, int wc, int fr, int fq) const {
        const int row0 = u.pm * BM + wr * 64 + fr, col0 = u.pn * BM + wc * 32 + 8 * fq;
        const bool sg = (u.pn >= 16 && u.pn < 32);
#pragma unroll
        for (int ai = 0; ai < 2; ++ai)
#pragma unroll
            for (int m = 0; m < 4; ++m) { bf16_t* rowp = P + (size_t)(row0 + ai * HALF + m * 16) * PW + col0;
#pragma unroll
                for (int bj = 0; bj < 2; ++bj) { f32x4 v0 = acc[ai][bj][m][0], v1 = acc[ai][bj][m][1];
                    if (sg) {
#pragma unroll
                        for (int j = 0; j < 4; ++j) { v0[j] = sigmoidf_(v0[j]); v1[j] = sigmoidf_(v1[j]); } }
                    u32x4 w; w.x = pk2(v0[0], v0[1]); w.y = pk2(v0[2], v0[3]); w.z = pk2(v1[0], v1[1]); w.w = pk2(v1[2], v1[3]);
                    *(u32x4*)(rowp + bj * HALF) = w; } }
    }
};
template <int MODE> struct EpiGate {
    static constexpr bool PERM = true;
    bf16_t* O; int ldo; const bf16_t* G; int ldg;
    __device__ __forceinline__ void operator()(const f32x4 (&acc)[2][2][4][2], const Unit& u, int wr, int wc, int fr, int fq) const {
        const int row0 = u.pm * BM + wr * 64 + fr, col0 = u.pn * BM + wc * 32 + 8 * fq;
#pragma unroll
        for (int ai = 0; ai < 2; ++ai)
#pragma unroll
            for (int m = 0; m < 4; ++m) { const size_t row = (size_t)(row0 + ai * HALF + m * 16);
#pragma unroll
                for (int bj = 0; bj < 2; ++bj) { const f32x4 v0 = acc[ai][bj][m][0], v1 = acc[ai][bj][m][1];
                    float r[8] = {v0[0], v0[1], v0[2], v0[3], v1[0], v1[1], v1[2], v1[3]};
                    bf16_t* op = O + row * ldo + col0 + bj * HALF;
                    if (MODE != 2) { const u32x4 gw = *(const u32x4*)(G + row * ldg + col0 + bj * HALF);
                        const unsigned gws[4] = {gw.x, gw.y, gw.z, gw.w};
#pragma unroll
                        for (int j = 0; j < 4; ++j) { r[2 * j] *= bflo(gws[j]); r[2 * j + 1] *= bfhi(gws[j]); } }
                    if (MODE == 1) { const u32x4 ow = *(const u32x4*)op; const unsigned ows[4] = {ow.x, ow.y, ow.z, ow.w};
#pragma unroll
                        for (int j = 0; j < 4; ++j) { r[2 * j] += bflo(ows[j]); r[2 * j + 1] += bfhi(ows[j]); } }
                    u32x4 w; w.x = pk2(r[0], r[1]); w.y = pk2(r[2], r[3]); w.z = pk2(r[4], r[5]); w.w = pk2(r[6], r[7]);
                    *(u32x4*)op = w; } }
    }
};
struct EpiRes {
    static constexpr bool PERM = false;
    const float* X; const float* gmod; float* H;
    __device__ __forceinline__ void operator()(const f32x4 (&acc)[2][2][4][2], const Unit& u, int wr, int wc, int fr, int fq) const {
        const int row0 = u.pm * BM + wr * 64 + fr, col0 = u.pn * BM + wc * 32 + 4 * fq;
        const float* gm = gmod + (size_t)((u.pm * BM) >> 14) * 12288;
        f32x4 gv[2][2];
#pragma unroll
        for (int bj = 0; bj < 2; ++bj)
#pragma unroll
            for (int n = 0; n < 2; ++n) gv[bj][n] = *(const f32x4*)(gm + col0 + bj * HALF + n * 16);
#pragma unroll
        for (int ai = 0; ai < 2; ++ai)
#pragma unroll
            for (int m = 0; m < 4; ++m) { const size_t off = (size_t)(row0 + ai * HALF + m * 16) * 2048 + col0;
#pragma unroll
                for (int bj = 0; bj < 2; ++bj)
#pragma unroll
                    for (int n = 0; n < 2; ++n) { const f32x4 xs = *(const f32x4*)(X + off + bj * HALF + n * 16);
                        *(f32x4*)(H + off + bj * HALF + n * 16) = xs + gv[bj][n] * acc[ai][bj][m][n]; } }
    }
};
}

__device__ void gemv_task(const Args& a, int task, ldsp_t lds) {
    const int tid = threadIdx.x, cq = tid & 15, rl = tid >> 4;
    const float* W = a.in[I_WADA] + 64 * task + 4 * cq;
    const float* c = a.in[I_C];
    f32x4 acc0 = {0.f, 0.f, 0.f, 0.f}, acc1 = {0.f, 0.f, 0.f, 0.f};
    for (int r = rl; r < 2048; r += 32) {
        const f32x4 w = *(const f32x4*)(W + (size_t)r * 12288);
        const float c0 = c[r], c1 = c[2048 + r];
        const float s0 = c0 / (1.f + __expf(-c0)), s1 = c1 / (1.f + __expf(-c1));
        acc0 += s0 * w; acc1 += s1 * w;
    }
    LAS float* red = (LAS float*)lds;
    __syncthreads();
#pragma unroll
    for (int j = 0; j < 4; ++j) { red[(rl * 16 + cq) * 8 + j] = acc0[j]; red[(rl * 16 + cq) * 8 + 4 + j] = acc1[j]; }
    __syncthreads();
    if (tid < 128) {
        const int b = tid >> 6, col = tid & 63; float s = 0.f;
        for (int r = 0; r < 32; ++r) s += red[(r * 16 + (col >> 2)) * 8 + b * 4 + (col & 3)];
        float* mod = (float*)(a.ws + WS_MOD);
        mod[b * 12288 + 64 * task + col] = s + a.in[I_BADA][64 * task + col];
    }
    __syncthreads();
}

template <class CMap>
__device__ __forceinline__ void tr_tile(const float* src, int src_ld, int r0, int c0, CMap cmap, bf16_t* dst, int dst_ld, ldsp_t lds) {
    LAS float* tile = (LAS float*)lds;
    const int tid = threadIdx.x, cc = tid & 63, rr0 = tid >> 6;
    const int sc = cmap(c0 + cc);
#pragma unroll
    for (int i = 0; i < 8; ++i) { const int r = rr0 + 8 * i; tile[cc * 65 + r] = sc >= 0 ? src[(size_t)(r0 + r) * src_ld + sc] : 0.f; }
    __syncthreads();
    const int rp = (tid & 31) * 2, c1 = tid >> 5;
#pragma unroll
    for (int i = 0; i < 4; ++i) { const int c = c1 + 16 * i; *(unsigned*)(dst + (size_t)(c0 + c) * dst_ld + r0 + rp) = pk2(tile[c * 65 + rp], tile[c * 65 + rp + 1]); }
    __syncthreads();
}
struct MapId { __device__ int operator()(int c) const { return c; } };
struct MapWin { __device__ int operator()(int c) const { return c < 4096 ? c : (c < 8192 ? c + 32 : (c < 8224 ? c - 4096 : -1)); } };

__device__ void fold_tile(const Args& a, int tile, ldsp_t lds) {
    LAS float* wl = (LAS float*)lds;
    LAS float* ct = (LAS float*)(lds + 65536);
    const int tid = threadIdx.x;
    const int nb = tile & 31, kb = tile >> 5;
    const int ri = kb >> 4, g = (kb >> 2) & 3, c0 = (kb & 3) * 64, n0 = nb * 64;
    const float* wf = a.in[I_WFNET] + (size_t)(g * 256) * 2048 + n0;
    __syncthreads();
#pragma unroll
    for (int j = 0; j < 8; ++j) { const int row = (tid >> 4) + 32 * j, c4 = (tid & 15) * 4;
        const f32x4 v = *(const f32x4*)(wf + (size_t)row * 2048 + c4);
        wl[row * 64 + c4] = v[0]; wl[row * 64 + c4 + 1] = v[1]; wl[row * 64 + c4 + 2] = v[2]; wl[row * 64 + c4 + 3] = v[3]; }
    if (tid < 256) ct[tid] = cospif((float)tid * (1.0f / 128.0f));
    __syncthreads();
    const int kk = tid & 63, nn0 = tid >> 6, c = c0 + kk;
    float acc[8];
#pragma unroll
    for (int i = 0; i < 8; ++i) acc[i] = 0.f;
    for (int m = 0; m < 256; ++m) {
        const int idx = (m * c) & 255;
        const float cs = ri ? ct[(idx + 192) & 255] : ct[idx];
#pragma unroll
        for (int i = 0; i < 8; ++i) acc[i] += wl[m * 64 + nn0 + 8 * i] * cs;
    }
    bf16_t* dst = (bf16_t*)(a.ws + WS_WFN);
#pragma unroll
    for (int i = 0; i < 8; ++i) dst[(size_t)(n0 + nn0 + 8 * i) * 2048 + ri * 1024 + g * 256 + c] = (bf16_t)f2bf(acc[i] * (1.0f / 2048.0f));
    __syncthreads();
}

__device__ void tables_task(const Args& a, int task) {
    const int tid = threadIdx.x;
    bf16_t* F1 = (bf16_t*)(a.ws + WS_F1); bf16_t* F2 = (bf16_t*)(a.ws + WS_F2); float* TW = (float*)(a.ws + WS_TW);
    {
        const int e = task * 512 + tid, R = e >> 7, sh = e & 127, w = R >> 5, mt = (R >> 4) & 1, r = R & 15, kf = 16 * w + r;
        float s, c; sincospif((float)((kf * sh) & 127) * (1.0f / 64.0f), &s, &c);
        F1[e] = (bf16_t)f2bf(mt ? -s : c);
    }
#pragma unroll
    for (int q = 0; q < 2; ++q) {
        const int e = task * 1024 + q * 512 + tid, R = e >> 8, K = e & 255, sl = K >> 1, ri = K & 1, w = R >> 5, mt = (R >> 4) & 1, r = R & 15, kf = 16 * w + r;
        float s, c; sincospif((float)((kf * sl) & 127) * (1.0f / 64.0f), &s, &c);
        const float v = mt ? (ri ? c : -s) : (ri ? s : c);
        F2[e] = (bf16_t)f2bf(v);
    }
    if (task < 32) {
        const int e = task * 512 + tid, kl = e >> 7, sl = e & 127;
        float s, c; sincospif((float)(kl * sl) * (1.0f / 8192.0f), &s, &c);
        TW[2 * e] = c; TW[2 * e + 1] = s;
    }
}

__device__ void cvt_flat(const float* src, bf16_t* dst, size_t n) {
    const size_t gt = (size_t)blockIdx.x * 512 + threadIdx.x, gs = (size_t)gridDim.x * 512;
    for (size_t i = gt * 8; i < n; i += gs * 8) {
        const f32x4 v0 = *(const f32x4*)(src + i), v1 = *(const f32x4*)(src + i + 4);
        u32x4 w; w.x = pk2(v0[0], v0[1]); w.y = pk2(v0[2], v0[3]); w.z = pk2(v1[0], v1[1]); w.w = pk2(v1[2], v1[3]);
        *(u32x4*)(dst + i) = w;
    }
}

__device__ void phase0(const Args& a, ldsp_t lds) {
    const int G = gridDim.x, bx = blockIdx.x;
    for (int t = bx; t < 192; t += G) gemv_task(a, t, lds);
    for (int t = bx; t < 64; t += G) tables_task(a, t);
    cvt_flat(a.in[I_KEYS], (bf16_t*)(a.ws + WS_KEYS), (size_t)8 * 2 * 128 * 128);
    for (int t = bx; t < 132 * 32; t += G) tr_tile(a.in[I_WIN], 8224, (t & 31) * 64, (t >> 5) * 64, MapWin(), (bf16_t*)(a.ws + WS_WIN), 2048, lds);
    for (int t = bx; t < 32 * 16; t += G) tr_tile(a.in[I_WGLA], 2048, (t & 15) * 64, (t >> 4) * 64, MapId(), (bf16_t*)(a.ws + WS_WGLA), 1024, lds);
    for (int t = bx; t < 32 * 32; t += G) tr_tile(a.in[I_WOUT], 2048, (t & 31) * 64, (t >> 5) * 64, MapId(), (bf16_t*)(a.ws + WS_WOUT), 2048, lds);
    for (int t = bx; t < 32 * 32; t += G) tr_tile(a.in[I_WQ], 2048, (t & 31) * 64, (t >> 5) * 64, MapId(), (bf16_t*)(a.ws + WS_WQ), 2048, lds);
    for (int t = bx; t < 1024; t += G) fold_tile(a, t, lds);
}

__device__ void norm_phase(const float* X, const float* gvec, const float* mod_sh, const float* mod_sc, bf16_t* out) {
    const int lane = threadIdx.x & 63, wave = threadIdx.x >> 6;
    const int W = gridDim.x * 8;
    for (int row = blockIdx.x * 8 + wave; row < T_; row += W) {
        const float* xr = X + (size_t)row * 2048;
        const int b = row >> 14;
        f32x4 v[8]; float ss = 0.f;
#pragma unroll
        for (int j = 0; j < 8; ++j) { v[j] = *(const f32x4*)(xr + (j * 64 + lane) * 4); ss += v[j][0] * v[j][0] + v[j][1] * v[j][1] + v[j][2] * v[j][2] + v[j][3] * v[j][3]; }
        ss = wave_sum(ss);
        const float rstd = rsqrtf(ss * (1.0f / 2048.0f) + EPS);
#pragma unroll
        for (int j = 0; j < 8; ++j) { const int d = (j * 64 + lane) * 4;
            const f32x4 gg = *(const f32x4*)(gvec + d), sc = *(const f32x4*)(mod_sc + b * 12288 + d), sh = *(const f32x4*)(mod_sh + b * 12288 + d);
            f32x4 y = v[j] * rstd * gg * (1.0f + sc) + sh;
            u32x2 w; w.x = pk2(y[0], y[1]); w.y = pk2(y[2], y[3]);
            *(u32x2*)(out + (size_t)row * 2048 + d) = w; }
    }
}

__device__ void fft1_phase(const Args& a, ldsp_t lds) {
    const int tid = threadIdx.x, lane = tid & 63, w = tid >> 6, g = lane >> 4, l15 = lane & 15;
    const bf16_t* F1 = (const bf16_t*)(a.ws + WS_F1);
    const float* TW = (const float*)(a.ws + WS_TW);
    const bf16_t* P = (const bf16_t*)(a.ws + WS_P);
    bf16_t* T1 = (bf16_t*)a.out;
    bf16x8 Af[2][4];
#pragma unroll
    for (int mt = 0; mt < 2; ++mt)
#pragma unroll
        for (int ks = 0; ks < 4; ++ks) Af[mt][ks] = *(const bf16x8*)(F1 + (32 * w + 16 * mt + l15) * 128 + 32 * ks + 8 * g);
    constexpr int ZS = 272;
    const int cp = tid & 63, sg = tid >> 6;
    unsigned buf[16];
    int tile = blockIdx.x;
    if (tile < 2048) { const int cb = tile & 7, s_lo = (tile >> 3) & 127, b = tile >> 10;
        const bf16_t* src = P + (size_t)(b * S_ + s_lo) * PW + PC_Z + cb * 128 + 2 * cp;
#pragma unroll
        for (int i = 0; i < 16; ++i) buf[i] = *(const unsigned*)(src + (size_t)(sg + 8 * i) * 128 * PW); }
    for (; tile < 2048; tile += gridDim.x) {
        const int cb = tile & 7, s_lo = (tile >> 3) & 127, b = tile >> 10;
        __syncthreads();
#pragma unroll
        for (int i = 0; i < 16; ++i) { const int sh = sg + 8 * i;
            *(LAS unsigned short*)(lds + (2 * cp) * ZS + sh * 2) = (unsigned short)(buf[i] & 0xffffu);
            *(LAS unsigned short*)(lds + (2 * cp + 1) * ZS + sh * 2) = (unsigned short)(buf[i] >> 16); }
        __syncthreads();
        { const int nt_ = tile + gridDim.x;
          if (nt_ < 2048) { const int cb2 = nt_ & 7, s2 = (nt_ >> 3) & 127, b2 = nt_ >> 10;
            const bf16_t* src = P + (size_t)(b2 * S_ + s2) * PW + PC_Z + cb2 * 128 + 2 * cp;
#pragma unroll
            for (int i = 0; i < 16; ++i) buf[i] = *(const unsigned*)(src + (size_t)(sg + 8 * i) * 128 * PW); } }
        f32x4 acc[2][8];
#pragma unroll
        for (int mt = 0; mt < 2; ++mt)
#pragma unroll
            for (int nt = 0; nt < 8; ++nt) acc[mt][nt] = (f32x4){0.f, 0.f, 0.f, 0.f};
#pragma unroll
        for (int nt = 0; nt < 8; ++nt)
#pragma unroll
            for (int ks = 0; ks < 4; ++ks) { const bf16x8 bfr = *(const LAS bf16x8*)(lds + (16 * nt + l15) * ZS + (32 * ks + 8 * g) * 2);
                acc[0][nt] = __builtin_amdgcn_mfma_f32_16x16x32_bf16(Af[0][ks], bfr, acc[0][nt], 0, 0, 0);
                acc[1][nt] = __builtin_amdgcn_mfma_f32_16x16x32_bf16(Af[1][ks], bfr, acc[1][nt], 0, 0, 0); }
#pragma unroll
        for (int r = 0; r < 4; ++r) { const int k_lo = 16 * w + 4 * g + r;
            const f32x2 cs = *(const f32x2*)(TW + 2 * (k_lo * 128 + s_lo));
            bf16_t* dst = T1 + ((size_t)((b * 128 + k_lo) * 128 + s_lo) * 2) * 1024 + cb * 128 + l15;
#pragma unroll
            for (int nt = 0; nt < 8; ++nt) { const float tr = acc[0][nt][r], ti = acc[1][nt][r];
                dst[16 * nt] = (bf16_t)f2bf(tr * cs.x + ti * cs.y);
                dst[1024 + 16 * nt] = (bf16_t)f2bf(ti * cs.x - tr * cs.y); } }
    }
}

__device__ void fft2_phase(const Args& a, ldsp_t lds) {
    const int tid = threadIdx.x, lane = tid & 63, w = tid >> 6, g = lane >> 4, l15 = lane & 15;
    const bf16_t* F2 = (const bf16_t*)(a.ws + WS_F2);
    const bf16_t* T1 = (const bf16_t*)a.out;
    bf16_t* ZA = (bf16_t*)a.out + (size_t)T_ * 2048;
    bf16x8 Af[2][8];
#pragma unroll
    for (int mt = 0; mt < 2; ++mt)
#pragma unroll
        for (int ks = 0; ks < 8; ++ks) Af[mt][ks] = *(const bf16x8*)(F2 + (32 * w + 16 * mt + l15) * 256 + 32 * ks + 8 * g);
    constexpr int ZS = 528;
    const int cp = tid & 63, kg = tid >> 6;
    for (int tile = blockIdx.x; tile < 2048; tile += gridDim.x) {
        const int cb = tile & 7, k_lo = (tile >> 3) & 127, b = tile >> 10;
        const bf16_t* src = T1 + ((size_t)(b * 128 + k_lo) * 256) * 1024 + cb * 128 + 2 * cp;
        __syncthreads();
#pragma unroll 8
        for (int i = 0; i < 32; ++i) { const int kk = kg + 8 * i; const unsigned v = *(const unsigned*)(src + (size_t)kk * 1024);
            *(LAS unsigned short*)(lds + (2 * cp) * ZS + kk * 2) = (unsigned short)(v & 0xffffu);
            *(LAS unsigned short*)(lds + (2 * cp + 1) * ZS + kk * 2) = (unsigned short)(v >> 16); }
        __syncthreads();
        f32x4 acc[2][8];
#pragma unroll
        for (int mt = 0; mt < 2; ++mt)
#pragma unroll
            for (int nt = 0; nt < 8; ++nt) acc[mt][nt] = (f32x4){0.f, 0.f, 0.f, 0.f};
#pragma unroll
        for (int nt = 0; nt < 8; ++nt)
#pragma unroll
            for (int ks = 0; ks < 8; ++ks) { const bf16x8 bfr = *(const LAS bf16x8*)(lds + (16 * nt + l15) * ZS + (32 * ks + 8 * g) * 2);
                acc[0][nt] = __builtin_amdgcn_mfma_f32_16x16x32_bf16(Af[0][ks], bfr, acc[0][nt], 0, 0, 0);
                acc[1][nt] = __builtin_amdgcn_mfma_f32_16x16x32_bf16(Af[1][ks], bfr, acc[1][nt], 0, 0, 0); }
#pragma unroll
        for (int r = 0; r < 4; ++r) { const int k_hi = 16 * w + 4 * g + r;
            bf16_t* dst = ZA + (size_t)(b * S_ + 128 * k_hi + k_lo) * 2048 + cb * 128 + l15;
#pragma unroll
            for (int nt = 0; nt < 8; ++nt) { dst[16 * nt] = (bf16_t)f2bf(acc[0][nt][r]); dst[1024 + 16 * nt] = (bf16_t)f2bf(acc[1][nt][r]); } }
    }
}

__device__ __forceinline__ void gla_task_decode(int task, int& stream, int& eh, int& sg) {
    const int u = task & 255, i = task >> 8; stream = u >> 4; eh = i; sg = i ? 15 - (u & 15) : (u & 15);
}
__device__ __forceinline__ int gla_task_encode(int stream, int eh, int sg) { return eh * 256 + stream * 16 + (eh ? 15 - sg : sg); }

template <bool PB>
__device__ void gla_phase(const Args& a, ldsp_t lds) {
    const int tid = threadIdx.x, lane = tid & 63, w = tid >> 6, g = lane >> 4, l15 = lane & 15;
    const int d = tid & 127, tg = tid >> 7;
    const bf16_t* P = (const bf16_t*)(a.ws + WS_P);
    float* Lbuf = (float*)(a.ws + WS_L);
    float* DSEG = (float*)(a.ws + WS_DSEG);
    bf16_t* O = (bf16_t*)(a.ws + WS_O);
    constexpr int QS = 272, JS = 144;
    constexpr int OFF_QS = 0, OFF_KS = OFF_QS + 64 * QS, OFF_KDT = OFF_KS + 64 * QS, OFF_VT = OFF_KDT + 128 * JS, OFF_AS = OFF_VT + 128 * JS,
                  OFF_SB = OFF_AS + 64 * JS, OFF_A1 = OFF_SB + 128 * QS, OFF_TOT = OFF_A1 + 2048, OFF_DS = OFF_TOT + 2048, OFF_END = OFF_DS + 512;
    static_assert(OFF_END <= LDS_BYTES, "GLA LDS");
    LAS float* tot = (LAS float*)(lds + OFF_TOT);
    LAS float* dSv = (LAS float*)(lds + OFF_DS);

    for (int task = blockIdx.x; task < 512; task += gridDim.x) {
        int stream, eh, sg; gla_task_decode(task, stream, eh, sg);
        const int dir = stream & 1, h = (stream >> 1) & 3, b = stream >> 3;
        float wa[16];
#pragma unroll
        for (int r = 0; r < 16; ++r) wa[r] = a.in[I_WA2][(size_t)(dir * 16 + r) * 512 + h * 128 + d];
        const float ba = a.in[I_BA][dir * 512 + h * 128 + d];
        f32x4 Sst[8];
#pragma unroll
        for (int mt = 0; mt < 8; ++mt) Sst[mt] = (f32x4){0.f, 0.f, 0.f, 0.f};
        if (PB) {
            for (int sp = 0; sp < sg; ++sp) {
                const float* Lp = Lbuf + (size_t)gla_task_encode(stream, eh, sp) * 16384;
                const float* Dp = DSEG + (stream * 16 + sp) * 128;
#pragma unroll
                for (int mt = 0; mt < 8; ++mt) { const f32x4 dl = *(const f32x4*)(Dp + 16 * mt + 4 * g);
#pragma unroll
                    for (int r = 0; r < 4; ++r) Sst[mt][r] = Sst[mt][r] * __expf(dl[r]) + Lp[(mt * 4 + r) * 512 + tid]; }
            }
            __syncthreads();
#pragma unroll
            for (int mt = 0; mt < 8; ++mt) { u32x2 pw; pw.x = pk2(Sst[mt][0], Sst[mt][1]); pw.y = pk2(Sst[mt][2], Sst[mt][3]);
                *(LAS u32x2*)(lds + OFF_SB + (16 * w + l15) * QS + (16 * mt + 4 * g) * 2) = pw; }
        }
        float logD = 0.f;
        for (int ci = 0; ci < 16; ++ci) {
            const int tau0 = sg * 1024 + ci * 64;
            if (tid < 128) { const int i = tid >> 1, hf = tid & 1, tau = tau0 + i, t = dir ? (S_ - 1 - tau) : tau;
                const u32x4 v = *(const u32x4*)(P + (size_t)(b * S_ + t) * PW + PC_A1 + dir * 16 + hf * 8);
                *(LAS u32x4*)(lds + OFF_A1 + i * 32 + hf * 16) = v; }
            __syncthreads();
            float wv[16]; float run = 0.f;
#pragma unroll
            for (int ii = 0; ii < 16; ++ii) { const int i = 16 * tg + ii;
                const u32x4 p0 = *(const LAS u32x4*)(lds + OFF_A1 + i * 32), p1 = *(const LAS u32x4*)(lds + OFF_A1 + i * 32 + 16);
                const unsigned pw[8] = {p0.x, p0.y, p0.z, p0.w, p1.x, p1.y, p1.z, p1.w};
                float z = ba;
#pragma unroll
                for (int r = 0; r < 8; ++r) z += bflo(pw[r]) * wa[2 * r] + bfhi(pw[r]) * wa[2 * r + 1];
                const float ls = fminf(z, 0.f) - log1pf(__expf(-fabsf(z)));
                run += ls * (1.0f / 16.0f); wv[ii] = run; }
            tot[tg * 128 + d] = run;
            __syncthreads();
            float pre = 0.f, blast = 0.f;
#pragma unroll
            for (int q = 0; q < 4; ++q) { const float tq = tot[q * 128 + d]; blast += tq; pre += (q < tg) ? tq : 0.f; }
            if (tg == 0) { dSv[d] = __expf(blast); logD += blast; }
#pragma unroll
            for (int ii = 0; ii < 16; ++ii) { const int i = 16 * tg + ii, tau = tau0 + i, t = dir ? (S_ - 1 - tau) : tau;
                const bf16_t* prow = P + (size_t)(b * S_ + t) * PW;
                const float bi = pre + wv[ii];
                const float kv = bf2f(prow[PC_K + h * 128 + d]);
                if (PB) { const float qv = bf2f(prow[PC_Q + h * 128 + d]);
                    *(LAS unsigned short*)(lds + OFF_QS + i * QS + d * 2) = (unsigned short)f2bf(qv * 0.08838834764831845f * __expf(bi));
                    *(LAS unsigned short*)(lds + OFF_KS + i * QS + d * 2) = (unsigned short)f2bf(kv * __expf(-bi)); }
                *(LAS unsigned short*)(lds + OFF_KDT + d * JS + i * 2) = (unsigned short)f2bf(kv * __expf(blast - bi));
                *(LAS unsigned short*)(lds + OFF_VT + d * JS + i * 2) = prow[PC_V + h * 256 + eh * 128 + d]; }
            __syncthreads();
            f32x4 oacc[4];
            if (PB) {
#pragma unroll
                for (int q = 0; q < 2; ++q) { const int mt = w >> 1, nt = 2 * (w & 1) + q;
                    f32x4 sacc = {0.f, 0.f, 0.f, 0.f};
#pragma unroll
                    for (int ks = 0; ks < 4; ++ks) { const bf16x8 af = *(const LAS bf16x8*)(lds + OFF_QS + (16 * mt + l15) * QS + (32 * ks + 8 * g) * 2);
                        const bf16x8 bf = *(const LAS bf16x8*)(lds + OFF_KS + (16 * nt + l15) * QS + (32 * ks + 8 * g) * 2);
                        sacc = __builtin_amdgcn_mfma_f32_16x16x32_bf16(af, bf, sacc, 0, 0, 0); }
#pragma unroll
                    for (int r = 0; r < 4; ++r) { const int i = 16 * mt + 4 * g + r, j = 16 * nt + l15;
                        *(LAS unsigned short*)(lds + OFF_AS + i * JS + j * 2) = (unsigned short)f2bf(j <= i ? sacc[r] : 0.f); } }
                __syncthreads();
#pragma unroll
                for (int mt = 0; mt < 4; ++mt) oacc[mt] = (f32x4){0.f, 0.f, 0.f, 0.f};
#pragma unroll
                for (int ks = 0; ks < 4; ++ks) { const bf16x8 bf = *(const LAS bf16x8*)(lds + OFF_SB + (16 * w + l15) * QS + (32 * ks + 8 * g) * 2);
#pragma unroll
                    for (int mt = 0; mt < 4; ++mt) { const bf16x8 af = *(const LAS bf16x8*)(lds + OFF_QS + (16 * mt + l15) * QS + (32 * ks + 8 * g) * 2);
                        oacc[mt] = __builtin_amdgcn_mfma_f32_16x16x32_bf16(af, bf, oacc[mt], 0, 0, 0); } }
#pragma unroll
                for (int ks = 0; ks < 2; ++ks) { const bf16x8 bf = *(const LAS bf16x8*)(lds + OFF_VT + (16 * w + l15) * JS + (32 * ks + 8 * g) * 2);
#pragma unroll
                    for (int mt = 0; mt < 4; ++mt) { const bf16x8 af = *(const LAS bf16x8*)(lds + OFF_AS + (16 * mt + l15) * JS + (32 * ks + 8 * g) * 2);
                        oacc[mt] = __builtin_amdgcn_mfma_f32_16x16x32_bf16(af, bf, oacc[mt], 0, 0, 0); } }
            }
#pragma unroll
            for (int mt = 0; mt < 8; ++mt) { const f32x4 dsc = *(const LAS f32x4*)(lds + OFF_DS + (16 * mt + 4 * g) * 4);
                Sst[mt] = Sst[mt] * dsc; }
#pragma unroll
            for (int ks = 0; ks < 2; ++ks) { const bf16x8 bf = *(const LAS bf16x8*)(lds + OFF_VT + (16 * w + l15) * JS + (32 * ks + 8 * g) * 2);
#pragma unroll
                for (int mt = 0; mt < 8; ++mt) { const bf16x8 af = *(const LAS bf16x8*)(lds + OFF_KDT + (16 * mt + l15) * JS + (32 * ks + 8 * g) * 2);
                    Sst[mt] = __builtin_amdgcn_mfma_f32_16x16x32_bf16(af, bf, Sst[mt], 0, 0, 0); } }
            if (PB) {
                __syncthreads();
#pragma unroll
                for (int mt = 0; mt < 8; ++mt) { u32x2 pw; pw.x = pk2(Sst[mt][0], Sst[mt][1]); pw.y = pk2(Sst[mt][2], Sst[mt][3]);
                    *(LAS u32x2*)(lds + OFF_SB + (16 * w + l15) * QS + (16 * mt + 4 * g) * 2) = pw; }
#pragma unroll
                for (int mt = 0; mt < 4; ++mt)
#pragma unroll
                    for (int r = 0; r < 4; ++r) { const int i = 16 * mt + 4 * g + r, tau = tau0 + i, t = dir ? (S_ - 1 - tau) : tau;
                        O[((size_t)dir * T_ + (size_t)(b * S_ + t)) * 1024 + h * 256 + eh * 128 + 16 * w + l15] = (bf16_t)f2bf(oacc[mt][r]); }
            }
        }
        if (!PB) {
            float* Lp = Lbuf + (size_t)task * 16384;
#pragma unroll
            for (int mt = 0; mt < 8; ++mt)
#pragma unroll
                for (int r = 0; r < 4; ++r) Lp[(mt * 4 + r) * 512 + tid] = Sst[mt][r];
            if (tg == 0 && eh == 0) DSEG[(stream * 16 + sg) * 128 + d] = logD;
        }
        __syncthreads();
    }
}

__device__ void gla_post_phase(const Args& a) {
    const int lane = threadIdx.x & 63, wave = threadIdx.x >> 6, W = gridDim.x * 8;
    const bf16_t* O = (const bf16_t*)(a.ws + WS_O);
    const bf16_t* P = (const bf16_t*)(a.ws + WS_P);
    bf16_t* GO = (bf16_t*)(a.ws + WS_XN);
    const float* ng = a.in[I_GNG];
    for (int row = blockIdx.x * 8 + wave; row < T_; row += W) {
        const int e0 = lane * 16;
        float v[16]; float ss = 0.f;
#pragma unroll
        for (int q = 0; q < 2; ++q) { const u32x4 f = *(const u32x4*)(O + (size_t)row * 1024 + e0 + 8 * q), bk = *(const u32x4*)(O + ((size_t)T_ + row) * 1024 + e0 + 8 * q);
            const unsigned fw[4] = {f.x, f.y, f.z, f.w}, bw[4] = {bk.x, bk.y, bk.z, bk.w};
#pragma unroll
            for (int j = 0; j < 4; ++j) { v[8 * q + 2 * j] = bflo(fw[j]) + bflo(bw[j]); v[8 * q + 2 * j + 1] = bfhi(fw[j]) + bfhi(bw[j]); } }
#pragma unroll
        for (int j = 0; j < 16; ++j) ss += v[j] * v[j];
#pragma unroll
        for (int o = 8; o >= 1; o >>= 1) ss += __shfl_xor(ss, o);
        const float rstd = rsqrtf(ss * (1.0f / 256.0f) + EPS);
        unsigned ow[8];
#pragma unroll
        for (int q = 0; q < 2; ++q) { const u32x4 rr = *(const u32x4*)(P + (size_t)row * PW + PC_R + e0 + 8 * q); const unsigned rw[4] = {rr.x, rr.y, rr.z, rr.w};
#pragma unroll
            for (int j = 0; j < 4; ++j) { const int e = (e0 + 8 * q + 2 * j) & 255;
                const float r0 = bflo(rw[j]), r1 = bfhi(rw[j]);
                const float y0 = v[8 * q + 2 * j] * rstd * ng[e] * (r0 * sigmoidf_(r0)), y1 = v[8 * q + 2 * j + 1] * rstd * ng[e + 1] * (r1 * sigmoidf_(r1));
                ow[4 * q + j] = pk2(y0, y1); } }
        *(u32x4*)(GO + (size_t)row * 1024 + e0) = (u32x4){ow[0], ow[1], ow[2], ow[3]};
        *(u32x4*)(GO + (size_t)row * 1024 + e0 + 8) = (u32x4){ow[4], ow[5], ow[6], ow[7]};
    }
}

__device__ __forceinline__ unsigned f2ord(float f) { const unsigned u = __float_as_uint(f); return (u & 0x80000000u) ? ~u : (u | 0x80000000u); }
__device__ __forceinline__ float ord2f(unsigned o) { return __uint_as_float((o & 0x80000000u) ? (o & 0x7fffffffu) : ~o); }
#define CE_DESC(x, y) do { const unsigned _hi = max((x), (y)), _lo = min((x), (y)); (x) = _hi; (y) = _lo; } while (0)
#define CE_ASC(x, y) do { const unsigned _hi = max((x), (y)), _lo = min((x), (y)); (x) = _lo; (y) = _hi; } while (0)
template <int N> __device__ __forceinline__ void bitonic_sort_desc(unsigned (&k)[N]) {
#pragma unroll
    for (int sz = 2; sz <= N; sz <<= 1)
#pragma unroll
        for (int j = sz >> 1; j > 0; j >>= 1)
#pragma unroll
            for (int i = 0; i < N; ++i) { const int l = i ^ j; if (l > i) { if ((i & sz) == 0) CE_DESC(k[i], k[l]); else CE_ASC(k[i], k[l]); } }
}
template <int N> __device__ __forceinline__ void bitonic_merge_desc(unsigned (&k)[N]) {
#pragma unroll
    for (int j = N >> 1; j > 0; j >>= 1)
#pragma unroll
        for (int i = 0; i < N; ++i) { const int l = i ^ j; if (l > i) CE_DESC(k[i], k[l]); }
}
#define CE2_DESC(kx, px, ky, py) do { const bool _sw = (ky) > (kx); const unsigned _k0 = _sw ? (ky) : (kx), _k1 = _sw ? (kx) : (ky), _p0 = _sw ? (py) : (px), _p1 = _sw ? (px) : (py); \
        (kx) = _k0; (ky) = _k1; (px) = _p0; (py) = _p1; } while (0)
template <int N> __device__ __forceinline__ void bitonic_sort_desc2(unsigned (&k)[N], unsigned (&p)[N]) {
#pragma unroll
    for (int sz = 2; sz <= N; sz <<= 1)
#pragma unroll
        for (int j = sz >> 1; j > 0; j >>= 1)
#pragma unroll
            for (int i = 0; i < N; ++i) { const int l = i ^ j; if (l > i) { if ((i & sz) == 0) CE2_DESC(k[i], p[i], k[l], p[l]); else CE2_DESC(k[l], p[l], k[i], p[i]); } }
}
template <int N> __device__ __forceinline__ void bitonic_merge_desc2(unsigned (&k)[N], unsigned (&p)[N]) {
#pragma unroll
    for (int j = N >> 1; j > 0; j >>= 1)
#pragma unroll
        for (int i = 0; i < N; ++i) { const int l = i ^ j; if (l > i) CE2_DESC(k[i], p[i], k[l], p[l]); }
}
__device__ __forceinline__ void lane_merge16(unsigned (&k)[16], int xm) {
    unsigned o[16];
#pragma unroll
    for (int i = 0; i < 16; ++i) o[i] = (unsigned)__shfl_xor((int)k[i], xm);
#pragma unroll
    for (int i = 0; i < 16; ++i) k[i] = max(k[i], o[15 - i]);
    bitonic_merge_desc<16>(k);
}
__device__ __forceinline__ void lane_merge16_2(unsigned (&k)[16], unsigned (&p)[16], int xm) {
    unsigned ok[16], op[16];
#pragma unroll
    for (int i = 0; i < 16; ++i) { ok[i] = (unsigned)__shfl_xor((int)k[i], xm); op[i] = (unsigned)__shfl_xor((int)p[i], xm); }
#pragma unroll
    for (int i = 0; i < 16; ++i) { const bool sw = ok[15 - i] > k[i]; k[i] = sw ? ok[15 - i] : k[i]; p[i] = sw ? op[15 - i] : p[i]; }
    bitonic_merge_desc2<16>(k, p);
}

__device__ void peer_select_phase(const Args& a, ldsp_t lds) {
    const int lane = threadIdx.x & 63, wave = threadIdx.x >> 6, g = lane >> 4, l15 = lane & 15, W = gridDim.x * 8;
    const bf16_t* QP = (const bf16_t*)(a.ws + WS_QP);
    const bf16_t* KB = (const bf16_t*)(a.ws + WS_KEYS);
    int* IDX = (int*)(a.ws + WS_IDX); float* GW = (float*)(a.ws + WS_G);
    for (int item = blockIdx.x * 8 + wave; item < 2048 * 8; item += W) {
        const int tok0 = (item >> 3) * 16, h = item & 7, tok = tok0 + l15;
        LAS unsigned* tl = (LAS unsigned*)(lds + wave * 8192);
#pragma unroll 1
        for (int hf = 0; hf < 2; ++hf) {
            bf16x8 bq[4];
#pragma unroll
            for (int ks = 0; ks < 4; ++ks) bq[ks] = *(const bf16x8*)(QP + (size_t)tok * 2048 + h * 256 + hf * 128 + 32 * ks + 8 * g);
            unsigned key[32];
#pragma unroll
            for (int mt = 0; mt < 8; ++mt) { f32x4 acc = {0.f, 0.f, 0.f, 0.f};
#pragma unroll
                for (int ks = 0; ks < 4; ++ks) { const bf16x8 af = *(const bf16x8*)(KB + (size_t)((h * 2 + hf) * 128 + 16 * mt + l15) * 128 + 32 * ks + 8 * g);
                    acc = __builtin_amdgcn_mfma_f32_16x16x32_bf16(af, bq[ks], acc, 0, 0, 0); }
#pragma unroll
                for (int r = 0; r < 4; ++r) { const int n = 16 * mt + 4 * g + r; key[4 * mt + r] = (f2ord(acc[r]) & ~127u) | (unsigned)(127 - n); }
                __builtin_amdgcn_sched_barrier(0); }
            unsigned lo[16], hi[16];
#pragma unroll
            for (int i = 0; i < 16; ++i) { lo[i] = key[i]; hi[i] = key[16 + i]; }
            bitonic_sort_desc<16>(lo); bitonic_sort_desc<16>(hi);
#pragma unroll
            for (int i = 0; i < 16; ++i) lo[i] = max(lo[i], hi[15 - i]);
            bitonic_merge_desc<16>(lo);
            lane_merge16(lo, 16); lane_merge16(lo, 32);
#pragma unroll
            for (int i = 0; i < 16; ++i) tl[(hf * 16 + i) * 64 + lane] = lo[i];
        }
        unsigned top[2][16];
#pragma unroll
        for (int i = 0; i < 16; ++i) { top[0][i] = tl[i * 64 + lane]; top[1][i] = tl[(16 + i) * 64 + lane]; }
        unsigned ck[16], cp[16];
#pragma unroll
        for (int i = 0; i < 16; ++i) { ck[i] = 0u; cp[i] = 0u; }
#define PEER_CAND(slot, I, J) do { const float _s = ord2f(top[0][I] & ~127u) + ord2f(top[1][J] & ~127u); ck[slot] = f2ord(_s); cp[slot] = ((127u - (top[0][I] & 127u)) << 7) | (127u - (top[1][J] & 127u)); } while (0)
        if (g == 0) { PEER_CAND(0, 0, 0); PEER_CAND(1, 0, 1); PEER_CAND(2, 0, 2); PEER_CAND(3, 0, 3); PEER_CAND(4, 0, 4); PEER_CAND(5, 0, 5); PEER_CAND(6, 0, 6); PEER_CAND(7, 0, 7);
            PEER_CAND(8, 0, 8); PEER_CAND(9, 0, 9); PEER_CAND(10, 0, 10); PEER_CAND(11, 0, 11); PEER_CAND(12, 0, 12); PEER_CAND(13, 0, 13); PEER_CAND(14, 0, 14); PEER_CAND(15, 0, 15); }
        else if (g == 1) { PEER_CAND(0, 1, 0); PEER_CAND(1, 1, 1); PEER_CAND(2, 1, 2); PEER_CAND(3, 1, 3); PEER_CAND(4, 1, 4); PEER_CAND(5, 1, 5); PEER_CAND(6, 1, 6); PEER_CAND(7, 1, 7);
            PEER_CAND(8, 2, 0); PEER_CAND(9, 2, 1); PEER_CAND(10, 2, 2); PEER_CAND(11, 2, 3); PEER_CAND(12, 2, 4); PEER_CAND(13, 3, 0); PEER_CAND(14, 3, 1); PEER_CAND(15, 3, 2); }
        else if (g == 2) { PEER_CAND(0, 3, 3); PEER_CAND(1, 4, 0); PEER_CAND(2, 4, 1); PEER_CAND(3, 4, 2); PEER_CAND(4, 5, 0); PEER_CAND(5, 5, 1); PEER_CAND(6, 6, 0); PEER_CAND(7, 6, 1);
            PEER_CAND(8, 7, 0); PEER_CAND(9, 7, 1); PEER_CAND(10, 8, 0); PEER_CAND(11, 9, 0); PEER_CAND(12, 10, 0); PEER_CAND(13, 11, 0); PEER_CAND(14, 12, 0); PEER_CAND(15, 13, 0); }
        else { PEER_CAND(0, 14, 0); PEER_CAND(1, 15, 0); }
#undef PEER_CAND
        bitonic_sort_desc2<16>(ck, cp);
        lane_merge16_2(ck, cp, 16); lane_merge16_2(ck, cp, 32);
        float ev[16]; float sum = 0.f; const float mx = ord2f(ck[0]);
#pragma unroll
        for (int i = 0; i < 16; ++i) { ev[i] = __expf(ord2f(ck[i]) - mx); sum += ev[i]; }
        const float inv = 1.0f / sum;
#pragma unroll
        for (int i = 0; i < 16; ++i) if ((i >> 2) == g) { IDX[(size_t)tok * 128 + h * 16 + i] = (int)cp[i]; GW[(size_t)tok * 128 + h * 16 + i] = ev[i] * inv; }
    }
}

__device__ __forceinline__ float gelu_erf(float x) { return 0.5f * x * (1.0f + erff(x * 0.70710678118654752f)); }
__device__ void peer_gather_phase(const Args& a) {
    const int lane = threadIdx.x & 63, wave = threadIdx.x >> 6, W = gridDim.x * 8;
    const bf16_t* XN = (const bf16_t*)(a.ws + WS_XN);
    const bf16_t* UB = (const bf16_t*)(a.ws + WS_UB);
    const bf16_t* VB = (const bf16_t*)(a.ws + WS_VB);
    const int* IDX = (const int*)(a.ws + WS_IDX); const float* GW = (const float*)(a.ws + WS_G);
    const float* mod = (const float*)(a.ws + WS_MOD);
    const float* fg = a.in[I_FNG];
    float* H = a.out;
    for (int tok = blockIdx.x * 8 + wave; tok < T_; tok += W) {
        float xf[4][8];
#pragma unroll
        for (int c = 0; c < 4; ++c) { const u32x4 xv = *(const u32x4*)(XN + (size_t)tok * 2048 + (c * 64 + lane) * 8); const unsigned xs[4] = {xv.x, xv.y, xv.z, xv.w};
#pragma unroll
            for (int j = 0; j < 4; ++j) { xf[c][2 * j] = bflo(xs[j]); xf[c][2 * j + 1] = bfhi(xs[j]); } }
        const int id0 = IDX[(size_t)tok * 128 + lane], id1 = IDX[(size_t)tok * 128 + 64 + lane];
        const float g0 = GW[(size_t)tok * 128 + lane], g1 = GW[(size_t)tok * 128 + 64 + lane];
        float o[4][8];
#pragma unroll
        for (int c = 0; c < 4; ++c)
#pragma unroll
            for (int j = 0; j < 8; ++j) o[c][j] = 0.f;
        for (int kk = 0; kk < 128; kk += 2) {
            int ex[2]; float gw[2];
#pragma unroll
            for (int e = 0; e < 2; ++e) { const int k = kk + e;
                ex[e] = (k < 64) ? __builtin_amdgcn_readlane(id0, k & 63) : __builtin_amdgcn_readlane(id1, k & 63);
                gw[e] = (k < 64) ? __uint_as_float(__builtin_amdgcn_readlane(__float_as_uint(g0), k & 63)) : __uint_as_float(__builtin_amdgcn_readlane(__float_as_uint(g1), k & 63)); }
            u32x4 ur[2][4];
#pragma unroll
            for (int e = 0; e < 2; ++e)
#pragma unroll
                for (int c = 0; c < 4; ++c) ur[e][c] = *(const u32x4*)(UB + (size_t)ex[e] * 2048 + (c * 64 + lane) * 8);
            u32x4 vr[2][4];
#pragma unroll
            for (int e = 0; e < 2; ++e)
#pragma unroll
                for (int c = 0; c < 4; ++c) vr[e][c] = *(const u32x4*)(VB + (size_t)ex[e] * 2048 + (c * 64 + lane) * 8);
            float dt[2];
#pragma unroll
            for (int e = 0; e < 2; ++e) { float s = 0.f;
#pragma unroll
                for (int c = 0; c < 4; ++c) { const unsigned us[4] = {ur[e][c].x, ur[e][c].y, ur[e][c].z, ur[e][c].w};
#pragma unroll
                    for (int j = 0; j < 4; ++j) s += bflo(us[j]) * xf[c][2 * j] + bfhi(us[j]) * xf[c][2 * j + 1]; }
                dt[e] = wave_sum(s); }
#pragma unroll
            for (int e = 0; e < 2; ++e) { const float cf = gw[e] * gelu_erf(dt[e]);
#pragma unroll
                for (int c = 0; c < 4; ++c) { const unsigned vs[4] = {vr[e][c].x, vr[e][c].y, vr[e][c].z, vr[e][c].w};
#pragma unroll
                    for (int j = 0; j < 4; ++j) { o[c][2 * j] += cf * bflo(vs[j]); o[c][2 * j + 1] += cf * bfhi(vs[j]); } } }
        }
        const int b = tok >> 14; float ss = 0.f;
#pragma unroll
        for (int c = 0; c < 4; ++c) { const int d0 = (c * 64 + lane) * 8;
            const f32x4 h0 = *(const f32x4*)(H + (size_t)tok * 2048 + d0), h1 = *(const f32x4*)(H + (size_t)tok * 2048 + d0 + 4);
            const f32x4 q0 = *(const f32x4*)(mod + b * 12288 + 5 * 2048 + d0), q1 = *(const f32x4*)(mod + b * 12288 + 5 * 2048 + d0 + 4);
#pragma unroll
            for (int j = 0; j < 4; ++j) { o[c][j] = h0[j] + q0[j] * o[c][j]; o[c][4 + j] = h1[j] + q1[j] * o[c][4 + j]; ss += o[c][j] * o[c][j] + o[c][4 + j] * o[c][4 + j]; } }
        ss = wave_sum(ss);
        const float rstd = rsqrtf(ss * (1.0f / 2048.0f) + EPS);
#pragma unroll
        for (int c = 0; c < 4; ++c) { const int d0 = (c * 64 + lane) * 8;
            const f32x4 f0 = *(const f32x4*)(fg + d0), f1 = *(const f32x4*)(fg + d0 + 4);
            f32x4 r0, r1;
#pragma unroll
            for (int j = 0; j < 4; ++j) { r0[j] = o[c][j] * rstd * f0[j]; r1[j] = o[c][4 + j] * rstd * f1[j]; }
            *(f32x4*)(H + (size_t)tok * 2048 + d0) = r0; *(f32x4*)(H + (size_t)tok * 2048 + d0 + 4) = r1; }
    }
}

__global__ void __launch_bounds__(512, 2) mega(Args a) {
    extern __shared__ __attribute__((aligned(16))) unsigned char lds_raw[];
    ldsp_t lds = (ldsp_t)lds_raw;
    cg::grid_group grid = cg::this_grid();
    const int lo = a.ph_lo, hi = a.ph_hi;
    unsigned char* ws = a.ws;
    const float* mod = (const float*)(ws + WS_MOD);
#ifdef ONLY_PHASE
#define IN(k) ((k) == ONLY_PHASE && lo <= (k) && (k) < hi)
#else
#define IN(k) (lo <= (k) && (k) < hi)
#endif
#define SEAM(k) do { if (IN(k) && IN((k) + 1)) grid.sync(); } while (0)

    if (IN(0)) phase0(a, lds);
    SEAM(0);
    if (IN(1)) norm_phase(a.in[I_X], a.in[I_N1G], mod, mod + 2048, (bf16_t*)(ws + WS_XN));
    SEAM(1);
    if (IN(2)) {
        pg8::Gemm g{(const bf16_t*)(ws + WS_XN), (const bf16_t*)(ws + WS_WIN), T_, PW, 2048, 2048};
        pg8::StaticOrder S; S.init(T_, PW, gridDim.x, blockIdx.x);
        pg8::EpiIn E{(bf16_t*)(ws + WS_P)};
        pg8::gemm_phase(lds, g, S, E);
    }
    SEAM(2);
    if (IN(3)) { fft1_phase(a, lds); __syncthreads(); gla_phase<false>(a, lds); }
    SEAM(3);
    if (IN(4)) { fft2_phase(a, lds); __syncthreads(); gla_phase<true>(a, lds); }
    SEAM(4);
    if (IN(5)) gla_post_phase(a);
    SEAM(5);
    if (IN(6)) {
        {
            pg8::Gemm g{(const bf16_t*)a.out + (size_t)T_ * 2048, (const bf16_t*)(ws + WS_WFN), T_, 2048, 2048, 2048};
            pg8::StaticOrder S; S.init(T_, 2048, gridDim.x, blockIdx.x);
            pg8::EpiGate<0> E{(bf16_t*)(ws + WS_O), 2048, (const bf16_t*)(ws + WS_P) + PC_GF, PW};
            pg8::gemm_phase(lds, g, S, E);
        }
        {
            pg8::Gemm g{(const bf16_t*)(ws + WS_XN), (const bf16_t*)(ws + WS_WGLA), T_, 2048, 1024, 1024};
            pg8::StaticOrder S; S.init(T_, 2048, gridDim.x, blockIdx.x);
            pg8::EpiGate<1> E{(bf16_t*)(ws + WS_O), 2048, (const bf16_t*)(ws + WS_P) + PC_GG, PW};
            pg8::gemm_phase(lds, g, S, E);
        }
    }
    SEAM(6);
    if (IN(7)) {
        pg8::Gemm g{(const bf16_t*)(ws + WS_O), (const bf16_t*)(ws + WS_WOUT), T_, 2048, 2048, 2048};
        pg8::StaticOrder S; S.init(T_, 2048, gridDim.x, blockIdx.x);
        pg8::EpiRes E{a.in[I_X], mod + 2 * 2048, a.out};
        pg8::gemm_phase(lds, g, S, E);
    }
    SEAM(7);
    if (IN(8)) {
        norm_phase(a.out, a.in[I_N2G], mod + 3 * 2048, mod + 4 * 2048, (bf16_t*)(ws + WS_XN));
        cvt_flat(a.in[I_U], (bf16_t*)(ws + WS_UB), (size_t)16384 * 2048);
        cvt_flat(a.in[I_V], (bf16_t*)(ws + WS_VB), (size_t)16384 * 2048);
    }
    SEAM(8);
    if (IN(9)) {
        pg8::Gemm g{(const bf16_t*)(ws + WS_XN), (const bf16_t*)(ws + WS_WQ), T_, 2048, 2048, 2048};
        pg8::StaticOrder S; S.init(T_, 2048, gridDim.x, blockIdx.x);
        pg8::EpiGate<2> E{(bf16_t*)(ws + WS_QP), 2048, nullptr, 0};
        pg8::gemm_phase(lds, g, S, E);
    }
    SEAM(9);
    if (IN(10)) peer_select_phase(a, lds);
    SEAM(10);
    if (IN(11)) peer_gather_phase(a);
#undef IN
#undef SEAM
}

constexpr int N_PHASES = 12;

extern "C" void kernel_launch(void* const* d_in, const int* in_sizes, int n_in, void* d_out, int out_size, void* d_ws, size_t ws_size, hipStream_t stream) {
    static int grid = 0;
    if (grid == 0) {
        int dev = 0, cus = 0, per_cu = 0;
        (void)hipGetDevice(&dev);
        (void)hipDeviceGetAttribute(&cus, hipDeviceAttributeMultiprocessorCount, dev);
        (void)hipFuncSetAttribute((const void*)mega, hipFuncAttributeMaxDynamicSharedMemorySize, LDS_BYTES);
        (void)hipOccupancyMaxActiveBlocksPerMultiprocessor(&per_cu, (const void*)mega, 512, LDS_BYTES);
        if (per_cu < 1 || n_in != 18 || ws_size < WS_END) { fprintf(stderr, "kernel_launch: unexpected configuration (per_cu %d, n_in %d, ws %zu)\n", per_cu, n_in, ws_size); grid = -1; return; }
        grid = cus;
    }
    if (grid < 0) return;
    Args a{};
    for (int i = 0; i < 18; ++i) a.in[i] = (const float*)d_in[i];
    a.out = (float*)d_out; a.ws = (unsigned char*)d_ws;
#if N_PHASE_LAUNCH
    for (int p = 0; p < N_PHASES; ++p) { a.ph_lo = p; a.ph_hi = p + 1;
        void* args[] = {&a};
        hipError_t e = hipLaunchCooperativeKernel((void*)mega, dim3(grid), dim3(512), args, LDS_BYTES, stream);
        if (e != hipSuccess) fprintf(stderr, "launch %d failed: %s\n", p, hipGetErrorString(e)); }
#else
    a.ph_lo = 0; a.ph_hi = N_PHASES;
    void* args[] = {&a};
    hipError_t e = hipLaunchCooperativeKernel((void*)mega, dim3(grid), dim3(512), args, LDS_BYTES, stream);
    if (e != hipSuccess) fprintf(stderr, "cooperative launch failed: %s (grid %d)\n", hipGetErrorString(e), grid);
#endif
}
```

```cpp
#include <hip/hip_runtime.h>
#include <hip/hip_cooperative_groups.h>
#include <cstdio>
namespace cg = cooperative_groups;

#define LAS __attribute__((address_space(3)))
typedef unsigned short bf16_t;
typedef short bf16x8 __attribute__((ext_vector_type(8)));
typedef float f32x4 __attribute__((ext_vector_type(4)));
typedef float f32x2 __attribute__((ext_vector_type(2)));
typedef unsigned u32x4 __attribute__((ext_vector_type(4)));
typedef unsigned u32x2 __attribute__((ext_vector_type(2)));
typedef LAS unsigned char* ldsp_t;

#ifndef N_PHASE_LAUNCH
#define N_PHASE_LAUNCH 0
#endif

constexpr int T_ = 32768, D_ = 2048, S_ = 16384;
constexpr float EPS = 1e-6f;
constexpr int PW = 8448;
constexpr int PC_Z = 0, PC_Q = 1024, PC_K = 1536, PC_V = 2048, PC_R = 3072, PC_GF = 4096, PC_GG = 6144, PC_A1 = 8192;
constexpr int LDS_BYTES = 135168;

constexpr size_t WS_CTL  = 0;
constexpr size_t WS_MOD  = 65536;
constexpr size_t WS_TW   = WS_MOD + 98304;
constexpr size_t WS_F1   = WS_TW + 131072;
constexpr size_t WS_F2   = WS_F1 + 65536;
constexpr size_t WS_DSEG = WS_F2 + 131072;
constexpr size_t WS_WIN  = WS_DSEG + 131072;
constexpr size_t WS_WFN  = WS_WIN + (size_t)8448 * 2048 * 2;
constexpr size_t WS_WGLA = WS_WFN + (size_t)2048 * 2048 * 2;
constexpr size_t WS_WOUT = WS_WGLA + (size_t)2048 * 1024 * 2;
constexpr size_t WS_WQ   = WS_WOUT + (size_t)2048 * 2048 * 2;
constexpr size_t WS_KEYS = WS_WQ + (size_t)2048 * 2048 * 2;
constexpr size_t WS_L    = WS_KEYS + (size_t)8 * 2 * 128 * 128 * 2;
constexpr size_t WS_XN   = WS_L + (size_t)512 * 16384 * 4;
constexpr size_t WS_O    = WS_XN + (size_t)T_ * 2048 * 2;
constexpr size_t WS_P    = WS_O + (size_t)T_ * 2048 * 2;
constexpr size_t WS_QP   = WS_P;
constexpr size_t WS_IDX  = WS_QP + (size_t)T_ * 2048 * 2;
constexpr size_t WS_G    = WS_IDX + (size_t)T_ * 128 * 4;
constexpr size_t WS_UB   = WS_G + (size_t)T_ * 128 * 4;
constexpr size_t WS_VB   = WS_UB + (size_t)16384 * 2048 * 2;
constexpr size_t WS_END  = WS_P + (size_t)T_ * PW * 2;
static_assert(WS_VB + (size_t)16384 * 2048 * 2 <= WS_END, "late buffers must fit in the P region");
static_assert(WS_END <= (size_t)1000 * 1000 * 1000, "workspace budget");

struct Args { const float* in[18]; float* out; unsigned char* ws; int ph_lo, ph_hi; };
enum { I_X = 0, I_C, I_WADA, I_BADA, I_N1G, I_WIN, I_WFNET, I_WA2, I_BA, I_GNG, I_WGLA, I_WOUT, I_N2G, I_WQ, I_KEYS, I_U, I_V, I_FNG };

__device__ __forceinline__ unsigned f2bf(float f) { unsigned u = __float_as_uint(f); return (u + 0x7fffu + ((u >> 16) & 1u)) >> 16; }
__device__ __forceinline__ float bf2f(unsigned h) { return __uint_as_float(h << 16); }
__device__ __forceinline__ unsigned pk2(float lo, float hi) { return f2bf(lo) | (f2bf(hi) << 16); }
__device__ __forceinline__ float bflo(unsigned w) { return __uint_as_float(w << 16); }
__device__ __forceinline__ float bfhi(unsigned w) { return __uint_as_float(w & 0xffff0000u); }
__device__ __forceinline__ float wave_sum(float v) {
#pragma unroll
    for (int o = 32; o >= 1; o >>= 1) v += __shfl_xor(v, o);
    return v;
}
__device__ __forceinline__ float sigmoidf_(float v) { return 1.0f / (1.0f + __expf(-v)); }


namespace pg8 {
constexpr int BM = 256, BK = 64, HALF = 128, HTB = HALF * BK * 2, STAGE_BYTES = 8 * HTB, NXCD = 8, WGM = 8;
__device__ __forceinline__ int lds_byte(int r, int c) { const int st = (r >> 4) * 2 + (c >> 5), rr = r & 15, cc = c & 31, ob = rr * 64 + cc * 2; return st * 1024 + (ob ^ (((ob >> 9) & 1) << 5)); }
__device__ __forceinline__ void stage_rc(int b, int& R, int& C) { const int st = b / 1024, sb = b % 1024, swz = sb ^ (((sb >> 9) & 1) << 5); R = (st >> 1) * 16 + swz / 64; C = (st & 1) * 32 + (swz % 64) / 2; }
__device__ __forceinline__ int perm32(int rho) { const int n = rho >> 4, i = rho & 15; return 8 * (i >> 2) + 4 * n + (i & 3); }

struct Unit { int pm, pn; };
struct Gemm { const bf16_t* A; const bf16_t* Bt; int M, N, K, lda; };

struct StaticOrder {
    int nM, nN, nwg, G, c;
    __device__ void init(int M, int N, int G_, int c_) { nM = M / BM; nN = N / BM; nwg = nM * nN; G = G_; c = c_; }
    __device__ bool next(int i, Unit& u) const {
        const long L = (long)i * G + c; if (L >= nwg) return false;
        int wgid = (int)L; { const int q = nwg / NXCD, r = nwg % NXCD, xcd = wgid % NXCD, off = wgid / NXCD; wgid = (xcd < r ? xcd * (q + 1) : r * (q + 1) + (xcd - r) * q) + off; }
        const int nig = WGM * nN, gid = wgid / nig, fm = gid * WGM, gsz = (nM - fm) < WGM ? (nM - fm) : WGM;
        u.pm = fm + ((wgid % nig) % gsz); u.pn = (wgid % nig) / gsz; return true;
    }
};

template <class Epi>
__device__ __forceinline__ void gemm_phase(ldsp_t lds, const Gemm g, const StaticOrder& S, const Epi& E) {
    const int tid = threadIdx.x, wid = __builtin_amdgcn_readfirstlane(tid >> 6), lane = tid & 63, wr = wid >> 2, wc = wid & 3, fr = lane & 15, fq = lane >> 4;
    const int K = g.K, nt = K / BK, lda = g.lda;
    unsigned voffA[2], voffB[2];
#pragma unroll
    for (int i = 0; i < 2; ++i) { int R, C; stage_rc(tid * 16 + i * 8192, R, C); const int Rb = Epi::PERM ? ((R & ~31) + perm32(R & 31)) : R;
        voffA[i] = (unsigned)(R * lda + C) * 2u; voffB[i] = (unsigned)(Rb * K + C) * 2u; }
    const size_t kstep = (size_t)(BK * 2);
    const size_t hstepA = (size_t)HALF * lda * 2, hstepB = (size_t)HALF * K * 2;
    const size_t tstepA = 2 * hstepA, tstepB = 2 * hstepB;
    const unsigned ldsw = (unsigned)wid * 1024u;
    const int aoff = lds_byte(wr * 64 + fr, fq * 8), boff = lds_byte(wc * 32 + fr, fq * 8);
#define PG8_SA(b, h) (((b) * 2 + (h)) * HTB)
#define PG8_SB(b, h) ((4 + (b) * 2 + (h)) * HTB)
#define PG8_STAGE(bufoff, gbase, voff) do { _Pragma("unroll") for (int _i = 0; _i < 2; ++_i) \
        __builtin_amdgcn_global_load_lds((const unsigned*)((const char*)(gbase) + (voff)[_i]), (LAS unsigned*)(lds + (bufoff) + ldsw + _i * 8192), 16, 0, 0); } while (0)
#define PG8_LDA(dst, b, h) do { _Pragma("unroll") for (int m = 0; m < 4; ++m) _Pragma("unroll") for (int k = 0; k < 2; ++k) dst[m][k] = *(const LAS bf16x8*)(lds + PG8_SA(b, h) + aoff + m * 2048 + k * 1024); } while (0)
#define PG8_LDB(dst, b, h) do { _Pragma("unroll") for (int n = 0; n < 2; ++n) _Pragma("unroll") for (int k = 0; k < 2; ++k) dst[n][k] = *(const LAS bf16x8*)(lds + PG8_SB(b, h) + boff + n * 2048 + k * 1024); } while (0)
#define PG8_MMA(ai, bj, At, Bt) do { __builtin_amdgcn_s_setprio(1); _Pragma("unroll") for (int m = 0; m < 4; ++m) _Pragma("unroll") for (int n = 0; n < 2; ++n) _Pragma("unroll") for (int k = 0; k < 2; ++k) \
        acc[ai][bj][m][n] = __builtin_amdgcn_mfma_f32_16x16x32_bf16(Bt[n][k], At[m][k], acc[ai][bj][m][n], 0, 0, 0); __builtin_amdgcn_s_setprio(0); } while (0)
#define PG8_WAIT_V(n) asm volatile("s_waitcnt vmcnt(" #n ")" ::: "memory")
#define PG8_WAIT_L(n) asm volatile("s_waitcnt lgkmcnt(" #n ")" ::: "memory")
#define PG8_BAR __builtin_amdgcn_s_barrier()
#define PG8_SCHED __builtin_amdgcn_sched_barrier(0)
    Unit cur, nxt; int ui = 0;
    if (!S.next(0, cur)) return;
    f32x4 acc[2][2][4][2];
#pragma unroll
    for (int a = 0; a < 2; ++a)
#pragma unroll
        for (int b = 0; b < 2; ++b)
#pragma unroll
            for (int m = 0; m < 4; ++m)
#pragma unroll
                for (int n = 0; n < 2; ++n) acc[a][b][m][n] = (f32x4){0.f, 0.f, 0.f, 0.f};
    bf16x8 At[4][2], B0[2][2], B1[2][2];
    const char* cA = (const char*)g.A + (size_t)cur.pm * tstepA; const char* cB = (const char*)g.Bt + (size_t)cur.pn * tstepB;
    PG8_STAGE(PG8_SB(0, 0), cB, voffB); PG8_STAGE(PG8_SA(0, 0), cA, voffA); PG8_STAGE(PG8_SB(0, 1), cB + hstepB, voffB); PG8_STAGE(PG8_SA(0, 1), cA + hstepA, voffA);
    if (wr == 1) PG8_BAR;
    PG8_WAIT_V(4); PG8_BAR;
    PG8_STAGE(PG8_SB(1, 0), cB + kstep, voffB); PG8_STAGE(PG8_SA(1, 0), cA + kstep, voffA); PG8_STAGE(PG8_SB(1, 1), cB + hstepB + kstep, voffB);
    PG8_WAIT_V(6); PG8_BAR;
    for (;;) {
        const bool has_next = S.next(ui + 1, nxt);
        const char* nA = has_next ? (const char*)g.A + (size_t)nxt.pm * tstepA : cA; const char* nB = has_next ? (const char*)g.Bt + (size_t)nxt.pn * tstepB : cB;
        for (int t = 0; t < nt; t += 2) {
            const bool last = (t == nt - 2);
            const char* a1 = cA + (size_t)(t + 1) * kstep;
            const char* a2 = last ? nA : cA + (size_t)(t + 2) * kstep; const char* b2 = last ? nB : cB + (size_t)(t + 2) * kstep;
            const char* a3 = a2 + kstep; const char* b3 = b2 + kstep;
            PG8_LDB(B0, 0, 0); PG8_SCHED; PG8_LDA(At, 0, 0); PG8_STAGE(PG8_SA(1, 1), a1 + hstepA, voffA);
            PG8_WAIT_L(8); PG8_BAR; PG8_WAIT_L(0); PG8_MMA(0, 0, At, B0); PG8_BAR; PG8_SCHED;
            PG8_LDB(B1, 0, 1); PG8_STAGE(PG8_SB(0, 0), b2, voffB);
            PG8_BAR; PG8_WAIT_L(0); PG8_MMA(0, 1, At, B1); PG8_BAR;
            PG8_LDA(At, 0, 1); PG8_STAGE(PG8_SA(0, 0), a2, voffA);
            PG8_BAR; PG8_WAIT_L(0); PG8_MMA(1, 0, At, B0); PG8_BAR; PG8_SCHED;
            PG8_STAGE(PG8_SB(0, 1), b2 + hstepB, voffB);
            PG8_WAIT_V(6); PG8_BAR; PG8_MMA(1, 1, At, B1); PG8_BAR;
            PG8_LDB(B0, 1, 0); PG8_SCHED; PG8_LDA(At, 1, 0); PG8_STAGE(PG8_SA(0, 1), a2 + hstepA, voffA);
            PG8_WAIT_L(8); PG8_BAR; PG8_WAIT_L(0); PG8_MMA(0, 0, At, B0); PG8_BAR; PG8_SCHED;
            PG8_LDB(B1, 1, 1); PG8_STAGE(PG8_SB(1, 0), b3, voffB);
            PG8_BAR; PG8_WAIT_L(0); PG8_MMA(0, 1, At, B1); PG8_BAR;
            PG8_LDA(At, 1, 1); PG8_STAGE(PG8_SA(1, 0), a3, voffA);
            PG8_BAR; PG8_WAIT_L(0); PG8_MMA(1, 0, At, B0); PG8_BAR; PG8_SCHED;
            PG8_STAGE(PG8_SB(1, 1), b3 + hstepB, voffB);
            PG8_WAIT_V(6); PG8_BAR; PG8_MMA(1, 1, At, B1); PG8_BAR;
        }
        E(acc, cur, wr, wc, fr, fq);
        if (!has_next) break;
#pragma unroll
        for (int a = 0; a < 2; ++a)
#pragma unroll
            for (int b = 0; b < 2; ++b)
#pragma unroll
                for (int m = 0; m < 4; ++m)
#pragma unroll
                    for (int n = 0; n < 2; ++n) acc[a][b][m][n] = (f32x4){0.f, 0.f, 0.f, 0.f};
        cur = nxt; cA = nA; cB = nB; ++ui;
    }
    PG8_WAIT_V(0);
    if (wr == 0) PG8_BAR;
    PG8_BAR;
#undef PG8_SA
#undef PG8_SB
#undef PG8_STAGE
#undef PG8_LDA
#undef PG8_LDB
#undef PG8_MMA
#undef PG8_WAIT_V
#undef PG8_WAIT_L
#undef PG8_BAR
#undef PG8_SCHED
}

struct EpiIn {
    static constexpr bool PERM = true;
    bf16_t* P;
    __device__ __forceinline__ void operator()(const f32x4 (&acc)[2][2][4][2], const Unit& u, int wr, int wc, int fr, int fq) const {
        const int row0 = u.pm * BM + wr * 64 + fr, col0 = u.pn * BM + wc * 32 + 8 * fq;
        const bool sg = (u.pn >= 16 && u.pn < 32);
#pragma unroll
        for (int ai = 0; ai < 2; ++ai)
#pragma unroll
            for (int m = 0; m < 4; ++m) { bf16_t* rowp = P + (size_t)(row0 + ai * HALF + m * 16) * PW + col0;
#pragma unroll
                for (int bj = 0; bj < 2; ++bj) { f32x4 v0 = acc[ai][bj][m][0], v1 = acc[ai][bj][m][1];
                    if (sg) {
#pragma unroll
                        for (int j = 0; j < 4; ++j) { v0[j] = sigmoidf_(v0[j]); v1[j] = sigmoidf_(v1[j]); } }
                    u32x4 w; w.x = pk2(v0[0], v0[1]); w.y = pk2(v0[2], v0[3]); w.z = pk2(v1[0], v1[1]); w.w = pk2(v1[2], v1[3]);
                    *(u32x4*)(rowp + bj * HALF) = w; } }
    }
};
template <int MODE> struct EpiGate {
    static constexpr bool PERM = true;
    bf16_t* O; int ldo; const bf16_t* G; int ldg;
    __device__ __forceinline__ void operator()(const f32x4 (&acc)[2][2][4][2], const Unit& u, int wr, int wc, int fr, int fq) const {
        const int row0 = u.pm * BM + wr * 64 + fr, col0 = u.pn * BM + wc * 32 + 8 * fq;
#pragma unroll
        for (int ai = 0; ai < 2; ++ai)
#pragma unroll
            for (int m = 0; m < 4; ++m) { const size_t row = (size_t)(row0 + ai * HALF + m * 16);
#pragma unroll
                for (int bj = 0; bj < 2; ++bj) { const f32x4 v0 = acc[ai][bj][m][0], v1 = acc[ai][bj][m][1];
                    float r[8] = {v0[0], v0[1], v0[2], v0[3], v1[0], v1[1], v1[2], v1[3]};
                    bf16_t* op = O + row * ldo + col0 + bj * HALF;
                    if (MODE != 2) { const u32x4 gw = *(const u32x4*)(G + row * ldg + col0 + bj * HALF);
                        const unsigned gws[4] = {gw.x, gw.y, gw.z, gw.w};
#pragma unroll
                        for (int j = 0; j < 4; ++j) { r[2 * j] *= bflo(gws[j]); r[2 * j + 1] *= bfhi(gws[j]); } }
                    if (MODE == 1) { const u32x4 ow = *(const u32x4*)op; const unsigned ows[4] = {ow.x, ow.y, ow.z, ow.w};
#pragma unroll
                        for (int j = 0; j < 4; ++j) { r[2 * j] += bflo(ows[j]); r[2 * j + 1] += bfhi(ows[j]); } }
                    u32x4 w; w.x = pk2(r[0], r[1]); w.y = pk2(r[2], r[3]); w.z = pk2(r[4], r[5]); w.w = pk2(r[6], r[7]);
                    *(u32x4*)op = w; } }
    }
};
struct EpiRes {
    static constexpr bool PERM = false;
    const float* X; const float* gmod; float* H;
    __device__ __forceinline__ void operator()(const f32x4 (&acc)[2][2][4][2], const Unit& u, int wr, int wc, int fr, int fq) const {
        const int row0 = u.pm * BM + wr * 64 + fr, col0 = u.pn * BM + wc * 32 + 4 * fq;
        const float* gm = gmod + (size_t)((u.pm * BM) >> 14) * 12288;
        f32x4 gv[2][2];
#pragma unroll
        for (int bj = 0; bj < 2; ++bj)
#pragma unroll
            for (int n = 0; n < 2; ++n) gv[bj][n] = *(const f32x4*)(gm + col0 + bj * HALF + n * 16);
#pragma unroll
        for (int ai = 0; ai < 2; ++ai)
#pragma unroll
            for (int m = 0; m < 4; ++m) { const size_t off = (size_t)(row0 + ai * HALF + m * 16) * 2048 + col0;
#pragma unroll
                for (int bj = 0; bj < 2; ++bj)
#pragma unroll
                    for (int n = 0; n < 2; ++n) { const f32x4 xs = *(const f32x4*)(X + off + bj * HALF + n * 16);
                        *(f32x4*)(H + off + bj * HALF + n * 16) = xs + gv[bj][n] * acc[ai][bj][m][n]; } }
    }
};
}

__device__ void gemv_task(const Args& a, int task, ldsp_t lds) {
    const int tid = threadIdx.x, cq = tid & 15, rl = tid >> 4;
    const float* W = a.in[I_WADA] + 64 * task + 4 * cq;
    const float* c = a.in[I_C];
    f32x4 acc0 = {0.f, 0.f, 0.f, 0.f}, acc1 = {0.f, 0.f, 0.f, 0.f};
    for (int r = rl; r < 2048; r += 32) {
        const f32x4 w = *(const f32x4*)(W + (size_t)r * 12288);
        const float c0 = c[r], c1 = c[2048 + r];
        const float s0 = c0 / (1.f + __expf(-c0)), s1 = c1 / (1.f + __expf(-c1));
        acc0 += s0 * w; acc1 += s1 * w;
    }
    LAS float* red = (LAS float*)lds;
    __syncthreads();
#pragma unroll
    for (int j = 0; j < 4; ++j) { red[(rl * 16 + cq) * 8 + j] = acc0[j]; red[(rl * 16 + cq) * 8 + 4 + j] = acc1[j]; }
    __syncthreads();
    if (tid < 128) {
        const int b = tid >> 6, col = tid & 63; float s = 0.f;
        for (int r = 0; r < 32; ++r) s += red[(r * 16 + (col >> 2)) * 8 + b * 4 + (col & 3)];
        float* mod = (float*)(a.ws + WS_MOD);
        mod[b * 12288 + 64 * task + col] = s + a.in[I_BADA][64 * task + col];
    }
    __syncthreads();
}

template <class CMap>
__device__ __forceinline__ void tr_tile(const float* src, int src_ld, int r0, int c0, CMap cmap, bf16_t* dst, int dst_ld, ldsp_t lds) {
    LAS float* tile = (LAS float*)lds;
    const int tid = threadIdx.x, cc = tid & 63, rr0 = tid >> 6;
    const int sc = cmap(c0 + cc);
#pragma unroll
    for (int i = 0; i < 8; ++i) { const int r = rr0 + 8 * i; tile[cc * 65 + r] = sc >= 0 ? src[(size_t)(r0 + r) * src_ld + sc] : 0.f; }
    __syncthreads();
    const int rp = (tid & 31) * 2, c1 = tid >> 5;
#pragma unroll
    for (int i = 0; i < 4; ++i) { const int c = c1 + 16 * i; *(unsigned*)(dst + (size_t)(c0 + c) * dst_ld + r0 + rp) = pk2(tile[c * 65 + rp], tile[c * 65 + rp + 1]); }
    __syncthreads();
}
struct MapId { __device__ int operator()(int c) const { return c; } };
struct MapWin { __device__ int operator()(int c) const { return c < 4096 ? c : (c < 8192 ? c + 32 : (c < 8224 ? c - 4096 : -1)); } };

__device__ void fold_tile(const Args& a, int tile, ldsp_t lds) {
    LAS float* wl = (LAS float*)lds;
    LAS float* ct = (LAS float*)(lds + 65536);
    const int tid = threadIdx.x;
    const int nb = tile & 31, kb = tile >> 5;
    const int ri = kb >> 4, g = (kb >> 2) & 3, c0 = (kb & 3) * 64, n0 = nb * 64;
    const float* wf = a.in[I_WFNET] + (size_t)(g * 256) * 2048 + n0;
    __syncthreads();
#pragma unroll
    for (int j = 0; j < 8; ++j) { const int row = (tid >> 4) + 32 * j, c4 = (tid & 15) * 4;
        const f32x4 v = *(const f32x4*)(wf + (size_t)row * 2048 + c4);
        wl[row * 64 + c4] = v[0]; wl[row * 64 + c4 + 1] = v[1]; wl[row * 64 + c4 + 2] = v[2]; wl[row * 64 + c4 + 3] = v[3]; }
    if (tid < 256) ct[tid] = cospif((float)tid * (1.0f / 128.0f));
    __syncthreads();
    const int kk = tid & 63, nn0 = tid >> 6, c = c0 + kk;
    float acc[8];
#pragma unroll
    for (int i = 0; i < 8; ++i) acc[i] = 0.f;
    for (int m = 0; m < 256; ++m) {
        const int idx = (m * c) & 255;
        const float cs = ri ? ct[(idx + 192) & 255] : ct[idx];
#pragma unroll
        for (int i = 0; i < 8; ++i) acc[i] += wl[m * 64 + nn0 + 8 * i] * cs;
    }
    bf16_t* dst = (bf16_t*)(a.ws + WS_WFN);
#pragma unroll
    for (int i = 0; i < 8; ++i) dst[(size_t)(n0 + nn0 + 8 * i) * 2048 + ri * 1024 + g * 256 + c] = (bf16_t)f2bf(acc[i] * (1.0f / 2048.0f));
    __syncthreads();
}

__device__ void tables_task(const Args& a, int task) {
    const int tid = threadIdx.x;
    bf16_t* F1 = (bf16_t*)(a.ws + WS_F1); bf16_t* F2 = (bf16_t*)(a.ws + WS_F2); float* TW = (float*)(a.ws + WS_TW);
    {
        const int e = task * 512 + tid, R = e >> 7, sh = e & 127, w = R >> 5, mt = (R >> 4) & 1, r = R & 15, kf = 16 * w + r;
        float s, c; sincospif((float)((kf * sh) & 127) * (1.0f / 64.0f), &s, &c);
        F1[e] = (bf16_t)f2bf(mt ? -s : c);
    }
#pragma unroll
    for (int q = 0; q < 2; ++q) {
        const int e = task * 1024 + q * 512 + tid, R = e >> 8, K = e & 255, sl = K >> 1, ri = K & 1, w = R >> 5, mt = (R >> 4) & 1, r = R & 15, kf = 16 * w + r;
        float s, c; sincospif((float)((kf * sl) & 127) * (1.0f / 64.0f), &s, &c);
        const float v = mt ? (ri ? c : -s) : (ri ? s : c);
        F2[e] = (bf16_t)f2bf(v);
    }
    if (task < 32) {
        const int e = task * 512 + tid, kl = e >> 7, sl = e & 127;
        float s, c; sincospif((float)(kl * sl) * (1.0f / 8192.0f), &s, &c);
        TW[2 * e] = c; TW[2 * e + 1] = s;
    }
}

__device__ void cvt_flat(const float* src, bf16_t* dst, size_t n) {
    const size_t gt = (size_t)blockIdx.x * 512 + threadIdx.x, gs = (size_t)gridDim.x * 512;
    for (size_t i = gt * 8; i < n; i += gs * 8) {
        const f32x4 v0 = *(const f32x4*)(src + i), v1 = *(const f32x4*)(src + i + 4);
        u32x4 w; w.x = pk2(v0[0], v0[1]); w.y = pk2(v0[2], v0[3]); w.z = pk2(v1[0], v1[1]); w.w = pk2(v1[2], v1[3]);
        *(u32x4*)(dst + i) = w;
    }
}

__device__ void phase0(const Args& a, ldsp_t lds) {
    const int G = gridDim.x, bx = blockIdx.x;
    for (int t = bx; t < 192; t += G) gemv_task(a, t, lds);
    for (int t = bx; t < 64; t += G) tables_task(a, t);
    cvt_flat(a.in[I_KEYS], (bf16_t*)(a.ws + WS_KEYS), (size_t)8 * 2 * 128 * 128);
    for (int t = bx; t < 132 * 32; t += G) tr_tile(a.in[I_WIN], 8224, (t & 31) * 64, (t >> 5) * 64, MapWin(), (bf16_t*)(a.ws + WS_WIN), 2048, lds);
    for (int t = bx; t < 32 * 16; t += G) tr_tile(a.in[I_WGLA], 2048, (t & 15) * 64, (t >> 4) * 64, MapId(), (bf16_t*)(a.ws + WS_WGLA), 1024, lds);
    for (int t = bx; t < 32 * 32; t += G) tr_tile(a.in[I_WOUT], 2048, (t & 31) * 64, (t >> 5) * 64, MapId(), (bf16_t*)(a.ws + WS_WOUT), 2048, lds);
    for (int t = bx; t < 32 * 32; t += G) tr_tile(a.in[I_WQ], 2048, (t & 31) * 64, (t >> 5) * 64, MapId(), (bf16_t*)(a.ws + WS_WQ), 2048, lds);
    for (int t = bx; t < 1024; t += G) fold_tile(a, t, lds);
}

__device__ void norm_phase(const float* X, const float* gvec, const float* mod_sh, const float* mod_sc, bf16_t* out) {
    const int lane = threadIdx.x & 63, wave = threadIdx.x >> 6;
    const int W = gridDim.x * 8;
    for (int row = blockIdx.x * 8 + wave; row < T_; row += W) {
        const float* xr = X + (size_t)row * 2048;
        const int b = row >> 14;
        f32x4 v[8]; float ss = 0.f;
#pragma unroll
        for (int j = 0; j < 8; ++j) { v[j] = *(const f32x4*)(xr + (j * 64 + lane) * 4); ss += v[j][0] * v[j][0] + v[j][1] * v[j][1] + v[j][2] * v[j][2] + v[j][3] * v[j][3]; }
        ss = wave_sum(ss);
        const float rstd = rsqrtf(ss * (1.0f / 2048.0f) + EPS);
#pragma unroll
        for (int j = 0; j < 8; ++j) { const int d = (j * 64 + lane) * 4;
            const f32x4 gg = *(const f32x4*)(gvec + d), sc = *(const f32x4*)(mod_sc + b * 12288 + d), sh = *(const f32x4*)(mod_sh + b * 12288 + d);
            f32x4 y = v[j] * rstd * gg * (1.0f + sc) + sh;
            u32x2 w; w.x = pk2(y[0], y[1]); w.y = pk2(y[2], y[3]);
            *(u32x2*)(out + (size_t)row * 2048 + d) = w; }
    }
}

__device__ void fft1_phase(const Args& a, ldsp_t lds) {
    const int tid = threadIdx.x, lane = tid & 63, w = tid >> 6, g = lane >> 4, l15 = lane & 15;
    const bf16_t* F1 = (const bf16_t*)(a.ws + WS_F1);
    const float* TW = (const float*)(a.ws + WS_TW);
    const bf16_t* P = (const bf16_t*)(a.ws + WS_P);
    bf16_t* T1 = (bf16_t*)a.out;
    bf16x8 Af[2][4];
#pragma unroll
    for (int mt = 0; mt < 2; ++mt)
#pragma unroll
        for (int ks = 0; ks < 4; ++ks) Af[mt][ks] = *(const bf16x8*)(F1 + (32 * w + 16 * mt + l15) * 128 + 32 * ks + 8 * g);
    constexpr int ZS = 272;
    const int cp = tid & 63, sg = tid >> 6;
    unsigned buf[16];
    int tile = blockIdx.x;
    if (tile < 2048) { const int cb = tile & 7, s_lo = (tile >> 3) & 127, b = tile >> 10;
        const bf16_t* src = P + (size_t)(b * S_ + s_lo) * PW + PC_Z + cb * 128 + 2 * cp;
#pragma unroll
        for (int i = 0; i < 16; ++i) buf[i] = *(const unsigned*)(src + (size_t)(sg + 8 * i) * 128 * PW); }
    for (; tile < 2048; tile += gridDim.x) {
        const int cb = tile & 7, s_lo = (tile >> 3) & 127, b = tile >> 10;
        __syncthreads();
#pragma unroll
        for (int i = 0; i < 16; ++i) { const int sh = sg + 8 * i;
            *(LAS unsigned short*)(lds + (2 * cp) * ZS + sh * 2) = (unsigned short)(buf[i] & 0xffffu);
            *(LAS unsigned short*)(lds + (2 * cp + 1) * ZS + sh * 2) = (unsigned short)(buf[i] >> 16); }
        __syncthreads();
        { const int nt_ = tile + gridDim.x;
          if (nt_ < 2048) { const int cb2 = nt_ & 7, s2 = (nt_ >> 3) & 127, b2 = nt_ >> 10;
            const bf16_t* src = P + (size_t)(b2 * S_ + s2) * PW + PC_Z + cb2 * 128 + 2 * cp;
#pragma unroll
            for (int i = 0; i < 16; ++i) buf[i] = *(const unsigned*)(src + (size_t)(sg + 8 * i) * 128 * PW); } }
        f32x4 acc[2][8];
#pragma unroll
        for (int mt = 0; mt < 2; ++mt)
#pragma unroll
            for (int nt = 0; nt < 8; ++nt) acc[mt][nt] = (f32x4){0.f, 0.f, 0.f, 0.f};
#pragma unroll
        for (int nt = 0; nt < 8; ++nt)
#pragma unroll
            for (int ks = 0; ks < 4; ++ks) { const bf16x8 bfr = *(const LAS bf16x8*)(lds + (16 * nt + l15) * ZS + (32 * ks + 8 * g) * 2);
                acc[0][nt] = __builtin_amdgcn_mfma_f32_16x16x32_bf16(Af[0][ks], bfr, acc[0][nt], 0, 0, 0);
                acc[1][nt] = __builtin_amdgcn_mfma_f32_16x16x32_bf16(Af[1][ks], bfr, acc[1][nt], 0, 0, 0); }
#pragma unroll
        for (int r = 0; r < 4; ++r) { const int k_lo = 16 * w + 4 * g + r;
            const f32x2 cs = *(const f32x2*)(TW + 2 * (k_lo * 128 + s_lo));
            bf16_t* dst = T1 + ((size_t)((b * 128 + k_lo) * 128 + s_lo) * 2) * 1024 + cb * 128 + l15;
#pragma unroll
            for (int nt = 0; nt < 8; ++nt) { const float tr = acc[0][nt][r], ti = acc[1][nt][r];
                dst[16 * nt] = (bf16_t)f2bf(tr * cs.x + ti * cs.y);
                dst[1024 + 16 * nt] = (bf16_t)f2bf(ti * cs.x - tr * cs.y); } }
    }
}

__device__ void fft2_phase(const Args& a, ldsp_t lds) {
    const int tid = threadIdx.x, lane = tid & 63, w = tid >> 6, g = lane >> 4, l15 = lane & 15;
    const bf16_t* F2 = (const bf16_t*)(a.ws + WS_F2);
    const bf16_t* T1 = (const bf16_t*)a.out;
    bf16_t* ZA = (bf16_t*)a.out + (size_t)T_ * 2048;
    bf16x8 Af[2][8];
#pragma unroll
    for (int mt = 0; mt < 2; ++mt)
#pragma unroll
        for (int ks = 0; ks < 8; ++ks) Af[mt][ks] = *(const bf16x8*)(F2 + (32 * w + 16 * mt + l15) * 256 + 32 * ks + 8 * g);
    constexpr int ZS = 528;
    const int cp = tid & 63, kg = tid >> 6;
    for (int tile = blockIdx.x; tile < 2048; tile += gridDim.x) {
        const int cb = tile & 7, k_lo = (tile >> 3) & 127, b = tile >> 10;
        const bf16_t* src = T1 + ((size_t)(b * 128 + k_lo) * 256) * 1024 + cb * 128 + 2 * cp;
        __syncthreads();
#pragma unroll 8
        for (int i = 0; i < 32; ++i) { const int kk = kg + 8 * i; const unsigned v = *(const unsigned*)(src + (size_t)kk * 1024);
            *(LAS unsigned short*)(lds + (2 * cp) * ZS + kk * 2) = (unsigned short)(v & 0xffffu);
            *(LAS unsigned short*)(lds + (2 * cp + 1) * ZS + kk * 2) = (unsigned short)(v >> 16); }
        __syncthreads();
        f32x4 acc[2][8];
#pragma unroll
        for (int mt = 0; mt < 2; ++mt)
#pragma unroll
            for (int nt = 0; nt < 8; ++nt) acc[mt][nt] = (f32x4){0.f, 0.f, 0.f, 0.f};
#pragma unroll
        for (int nt = 0; nt < 8; ++nt)
#pragma unroll
            for (int ks = 0; ks < 8; ++ks) { const bf16x8 bfr = *(const LAS bf16x8*)(lds + (16 * nt + l15) * ZS + (32 * ks + 8 * g) * 2);
                acc[0][nt] = __builtin_amdgcn_mfma_f32_16x16x32_bf16(Af[0][ks], bfr, acc[0][nt], 0, 0, 0);
                acc[1][nt] = __builtin_amdgcn_mfma_f32_16x16x32_bf16(Af[1][ks], bfr, acc[1][nt], 0, 0, 0); }
#pragma unroll
        for (int r = 0; r < 4; ++r) { const int k_hi = 16 * w + 4 * g + r;
            bf16_t* dst = ZA + (size_t)(b * S_ + 128 * k_hi + k_lo) * 2048 + cb * 128 + l15;
#pragma unroll
            for (int nt = 0; nt < 8; ++nt) { dst[16 * nt] = (bf16_t)f2bf(acc[0][nt][r]); dst[1024 + 16 * nt] = (bf16_t)f2bf(acc[1][nt][r]); } }
    }
}

__device__ __forceinline__ void gla_task_decode(int task, int& stream, int& eh, int& sg) {
    const int u = task & 255, i = task >> 8; stream = u >> 4; eh = i; sg = i ? 15 - (u & 15) : (u & 15);
}
__device__ __forceinline__ int gla_task_encode(int stream, int eh, int sg) { return eh * 256 + stream * 16 + (eh ? 15 - sg : sg); }

template <bool PB>
__device__ void gla_phase(const Args& a, ldsp_t lds) {
    const int tid = threadIdx.x, lane = tid & 63, w = tid >> 6, g = lane >> 4, l15 = lane & 15;
    const int d = tid & 127, tg = tid >> 7;
    const bf16_t* P = (const bf16_t*)(a.ws + WS_P);
    float* Lbuf = (float*)(a.ws + WS_L);
    float* DSEG = (float*)(a.ws + WS_DSEG);
    bf16_t* O = (bf16_t*)(a.ws + WS_O);
    constexpr int QS = 272, JS = 144;
    constexpr int OFF_QS = 0, OFF_KS = OFF_QS + 64 * QS, OFF_KDT = OFF_KS + 64 * QS, OFF_VT = OFF_KDT + 128 * JS, OFF_AS = OFF_VT + 128 * JS,
                  OFF_SB = OFF_AS + 64 * JS, OFF_A1 = OFF_SB + 128 * QS, OFF_TOT = OFF_A1 + 2048, OFF_DS = OFF_TOT + 2048, OFF_END = OFF_DS + 512;
    static_assert(OFF_END <= LDS_BYTES, "GLA LDS");
    LAS float* tot = (LAS float*)(lds + OFF_TOT);
    LAS float* dSv = (LAS float*)(lds + OFF_DS);

    for (int task = blockIdx.x; task < 512; task += gridDim.x) {
        int stream, eh, sg; gla_task_decode(task, stream, eh, sg);
        const int dir = stream & 1, h = (stream >> 1) & 3, b = stream >> 3;
        float wa[16];
#pragma unroll
        for (int r = 0; r < 16; ++r) wa[r] = a.in[I_WA2][(size_t)(dir * 16 + r) * 512 + h * 128 + d];
        const float ba = a.in[I_BA][dir * 512 + h * 128 + d];
        f32x4 Sst[8];
#pragma unroll
        for (int mt = 0; mt < 8; ++mt) Sst[mt] = (f32x4){0.f, 0.f, 0.f, 0.f};
        if (PB) {
            for (int sp = 0; sp < sg; ++sp) {
                const float* Lp = Lbuf + (size_t)gla_task_encode(stream, eh, sp) * 16384;
                const float* Dp = DSEG + (stream * 16 + sp) * 128;
#pragma unroll
                for (int mt = 0; mt < 8; ++mt) { const f32x4 dl = *(const f32x4*)(Dp + 16 * mt + 4 * g);
#pragma unroll
                    for (int r = 0; r < 4; ++r) Sst[mt][r] = Sst[mt][r] * __expf(dl[r]) + Lp[(mt * 4 + r) * 512 + tid]; }
            }
            __syncthreads();
#pragma unroll
            for (int mt = 0; mt < 8; ++mt) { u32x2 pw; pw.x = pk2(Sst[mt][0], Sst[mt][1]); pw.y = pk2(Sst[mt][2], Sst[mt][3]);
                *(LAS u32x2*)(lds + OFF_SB + (16 * w + l15) * QS + (16 * mt + 4 * g) * 2) = pw; }
        }
        float logD = 0.f;
        for (int ci = 0; ci < 16; ++ci) {
            const int tau0 = sg * 1024 + ci * 64;
            if (tid < 128) { const int i = tid >> 1, hf = tid & 1, tau = tau0 + i, t = dir ? (S_ - 1 - tau) : tau;
                const u32x4 v = *(const u32x4*)(P + (size_t)(b * S_ + t) * PW + PC_A1 + dir * 16 + hf * 8);
                *(LAS u32x4*)(lds + OFF_A1 + i * 32 + hf * 16) = v; }
            __syncthreads();
            float wv[16]; float run = 0.f;
#pragma unroll
            for (int ii = 0; ii < 16; ++ii) { const int i = 16 * tg + ii;
                const u32x4 p0 = *(const LAS u32x4*)(lds + OFF_A1 + i * 32), p1 = *(const LAS u32x4*)(lds + OFF_A1 + i * 32 + 16);
                const unsigned pw[8] = {p0.x, p0.y, p0.z, p0.w, p1.x, p1.y, p1.z, p1.w};
                float z = ba;
#pragma unroll
                for (int r = 0; r < 8; ++r) z += bflo(pw[r]) * wa[2 * r] + bfhi(pw[r]) * wa[2 * r + 1];
                const float ls = fminf(z, 0.f) - log1pf(__expf(-fabsf(z)));
                run += ls * (1.0f / 16.0f); wv[ii] = run; }
            tot[tg * 128 + d] = run;
            __syncthreads();
            float pre = 0.f, blast = 0.f;
#pragma unroll
            for (int q = 0; q < 4; ++q) { const float tq = tot[q * 128 + d]; blast += tq; pre += (q < tg) ? tq : 0.f; }
            if (tg == 0) { dSv[d] = __expf(blast); logD += blast; }
#pragma unroll
            for (int ii = 0; ii < 16; ++ii) { const int i = 16 * tg + ii, tau = tau0 + i, t = dir ? (S_ - 1 - tau) : tau;
                const bf16_t* prow = P + (size_t)(b * S_ + t) * PW;
                const float bi = pre + wv[ii];
                const float kv = bf2f(prow[PC_K + h * 128 + d]);
                if (PB) { const float qv = bf2f(prow[PC_Q + h * 128 + d]);
                    *(LAS unsigned short*)(lds + OFF_QS + i * QS + d * 2) = (unsigned short)f2bf(qv * 0.08838834764831845f * __expf(bi));
                    *(LAS unsigned short*)(lds + OFF_KS + i * QS + d * 2) = (unsigned short)f2bf(kv * __expf(-bi)); }
                *(LAS unsigned short*)(lds + OFF_KDT + d * JS + i * 2) = (unsigned short)f2bf(kv * __expf(blast - bi));
                *(LAS unsigned short*)(lds + OFF_VT + d * JS + i * 2) = prow[PC_V + h * 256 + eh * 128 + d]; }
            __syncthreads();
            f32x4 oacc[4];
            if (PB) {
#pragma unroll
                for (int q = 0; q < 2; ++q) { const int mt = w >> 1, nt = 2 * (w & 1) + q;
                    f32x4 sacc = {0.f, 0.f, 0.f, 0.f};
#pragma unroll
                    for (int ks = 0; ks < 4; ++ks) { const bf16x8 af = *(const LAS bf16x8*)(lds + OFF_QS + (16 * mt + l15) * QS + (32 * ks + 8 * g) * 2);
                        const bf16x8 bf = *(const LAS bf16x8*)(lds + OFF_KS + (16 * nt + l15) * QS + (32 * ks + 8 * g) * 2);
                        sacc = __builtin_amdgcn_mfma_f32_16x16x32_bf16(af, bf, sacc, 0, 0, 0); }
#pragma unroll
                    for (int r = 0; r < 4; ++r) { const int i = 16 * mt + 4 * g + r, j = 16 * nt + l15;
                        *(LAS unsigned short*)(lds + OFF_AS + i * JS + j * 2) = (unsigned short)f2bf(j <= i ? sacc[r] : 0.f); } }
                __syncthreads();
#pragma unroll
                for (int mt = 0; mt < 4; ++mt) oacc[mt] = (f32x4){0.f, 0.f, 0.f, 0.f};
#pragma unroll
                for (int ks = 0; ks < 4; ++ks) { const bf16x8 bf = *(const LAS bf16x8*)(lds + OFF_SB + (16 * w + l15) * QS + (32 * ks + 8 * g) * 2);
#pragma unroll
                    for (int mt = 0; mt < 4; ++mt) { const bf16x8 af = *(const LAS bf16x8*)(lds + OFF_QS + (16 * mt + l15) * QS + (32 * ks + 8 * g) * 2);
                        oacc[mt] = __builtin_amdgcn_mfma_f32_16x16x32_bf16(af, bf, oacc[mt], 0, 0, 0); } }
#pragma unroll
                for (int ks = 0; ks < 2; ++ks) { const bf16x8 bf = *(const LAS bf16x8*)(lds + OFF_VT + (16 * w + l15) * JS + (32 * ks + 8 * g) * 2);
#pragma unroll
                    for (int mt = 0; mt < 4; ++mt) { const bf16x8 af = *(const LAS bf16x8*)(lds + OFF_AS + (16 * mt + l15) * JS + (32 * ks + 8 * g) * 2);
                        oacc[mt] = __builtin_amdgcn_mfma_f32_16x16x32_bf16(af, bf, oacc[mt], 0, 0, 0); } }
            }
#pragma unroll
            for (int mt = 0; mt < 8; ++mt) { const f32x4 dsc = *(const LAS f32x4*)(lds + OFF_DS + (16 * mt + 4 * g) * 4);
                Sst[mt] = Sst[mt] * dsc; }
#pragma unroll
            for (int ks = 0; ks < 2; ++ks) { const bf16x8 bf = *(const LAS bf16x8*)(lds + OFF_VT + (16 * w + l15) * JS + (32 * ks + 8 * g) * 2);
#pragma unroll
                for (int mt = 0; mt < 8; ++mt) { const bf16x8 af = *(const LAS bf16x8*)(lds + OFF_KDT + (16 * mt + l15) * JS + (32 * ks + 8 * g) * 2);
                    Sst[mt] = __builtin_amdgcn_mfma_f32_16x16x32_bf16(af, bf, Sst[mt], 0, 0, 0); } }
            if (PB) {
                __syncthreads();
#pragma unroll
                for (int mt = 0; mt < 8; ++mt) { u32x2 pw; pw.x = pk2(Sst[mt][0], Sst[mt][1]); pw.y = pk2(Sst[mt][2], Sst[mt][3]);
                    *(LAS u32x2*)(lds + OFF_SB + (16 * w + l15) * QS + (16 * mt + 4 * g) * 2) = pw; }
#pragma unroll
                for (int mt = 0; mt < 4; ++mt)
#pragma unroll
                    for (int r = 0; r < 4; ++r) { const int i = 16 * mt + 4 * g + r, tau = tau0 + i, t = dir ? (S_ - 1 - tau) : tau;
                        O[((size_t)dir * T_ + (size_t)(b * S_ + t)) * 1024 + h * 256 + eh * 128 + 16 * w + l15] = (bf16_t)f2bf(oacc[mt][r]); }
            }
        }
        if (!PB) {
            float* Lp = Lbuf + (size_t)task * 16384;
#pragma unroll
            for (int mt = 0; mt < 8; ++mt)
#pragma unroll
                for (int r = 0; r < 4; ++r) Lp[(mt * 4 + r) * 512 + tid] = Sst[mt][r];
            if (tg == 0 && eh == 0) DSEG[(stream * 16 + sg) * 128 + d] = logD;
        }
        __syncthreads();
    }
}

__device__ void gla_post_phase(const Args& a) {
    const int lane = threadIdx.x & 63, wave = threadIdx.x >> 6, W = gridDim.x * 8;
    const bf16_t* O = (const bf16_t*)(a.ws + WS_O);
    const bf16_t* P = (const bf16_t*)(a.ws + WS_P);
    bf16_t* GO = (bf16_t*)(a.ws + WS_XN);
    const float* ng = a.in[I_GNG];
    for (int row = blockIdx.x * 8 + wave; row < T_; row += W) {
        const int e0 = lane * 16;
        float v[16]; float ss = 0.f;
#pragma unroll
        for (int q = 0; q < 2; ++q) { const u32x4 f = *(const u32x4*)(O + (size_t)row * 1024 + e0 + 8 * q), bk = *(const u32x4*)(O + ((size_t)T_ + row) * 1024 + e0 + 8 * q);
            const unsigned fw[4] = {f.x, f.y, f.z, f.w}, bw[4] = {bk.x, bk.y, bk.z, bk.w};
#pragma unroll
            for (int j = 0; j < 4; ++j) { v[8 * q + 2 * j] = bflo(fw[j]) + bflo(bw[j]); v[8 * q + 2 * j + 1] = bfhi(fw[j]) + bfhi(bw[j]); } }
#pragma unroll
        for (int j = 0; j < 16; ++j) ss += v[j] * v[j];
#pragma unroll
        for (int o = 8; o >= 1; o >>= 1) ss += __shfl_xor(ss, o);
        const float rstd = rsqrtf(ss * (1.0f / 256.0f) + EPS);
        unsigned ow[8];
#pragma unroll
        for (int q = 0; q < 2; ++q) { const u32x4 rr = *(const u32x4*)(P + (size_t)row * PW + PC_R + e0 + 8 * q); const unsigned rw[4] = {rr.x, rr.y, rr.z, rr.w};
#pragma unroll
            for (int j = 0; j < 4; ++j) { const int e = (e0 + 8 * q + 2 * j) & 255;
                const float r0 = bflo(rw[j]), r1 = bfhi(rw[j]);
                const float y0 = v[8 * q + 2 * j] * rstd * ng[e] * (r0 * sigmoidf_(r0)), y1 = v[8 * q + 2 * j + 1] * rstd * ng[e + 1] * (r1 * sigmoidf_(r1));
                ow[4 * q + j] = pk2(y0, y1); } }
        *(u32x4*)(GO + (size_t)row * 1024 + e0) = (u32x4){ow[0], ow[1], ow[2], ow[3]};
        *(u32x4*)(GO + (size_t)row * 1024 + e0 + 8) = (u32x4){ow[4], ow[5], ow[6], ow[7]};
    }
}

__device__ __forceinline__ unsigned f2ord(float f) { const unsigned u = __float_as_uint(f); return (u & 0x80000000u) ? ~u : (u | 0x80000000u); }
__device__ __forceinline__ float ord2f(unsigned o) { return __uint_as_float((o & 0x80000000u) ? (o & 0x7fffffffu) : ~o); }
#define CE_DESC(x, y) do { const unsigned _hi = max((x), (y)), _lo = min((x), (y)); (x) = _hi; (y) = _lo; } while (0)
#define CE_ASC(x, y) do { const unsigned _hi = max((x), (y)), _lo = min((x), (y)); (x) = _lo; (y) = _hi; } while (0)
template <int N> __device__ __forceinline__ void bitonic_sort_desc(unsigned (&k)[N]) {
#pragma unroll
    for (int sz = 2; sz <= N; sz <<= 1)
#pragma unroll
        for (int j = sz >> 1; j > 0; j >>= 1)
#pragma unroll
            for (int i = 0; i < N; ++i) { const int l = i ^ j; if (l > i) { if ((i & sz) == 0) CE_DESC(k[i], k[l]); else CE_ASC(k[i], k[l]); } }
}
template <int N> __device__ __forceinline__ void bitonic_merge_desc(unsigned (&k)[N]) {
#pragma unroll
    for (int j = N >> 1; j > 0; j >>= 1)
#pragma unroll
        for (int i = 0; i < N; ++i) { const int l = i ^ j; if (l > i) CE_DESC(k[i], k[l]); }
}
#define CE2_DESC(kx, px, ky, py) do { const bool _sw = (ky) > (kx); const unsigned _k0 = _sw ? (ky) : (kx), _k1 = _sw ? (kx) : (ky), _p0 = _sw ? (py) : (px), _p1 = _sw ? (px) : (py); \
        (kx) = _k0; (ky) = _k1; (px) = _p0; (py) = _p1; } while (0)
template <int N> __device__ __forceinline__ void bitonic_sort_desc2(unsigned (&k)[N], unsigned (&p)[N]) {
#pragma unroll
    for (int sz = 2; sz <= N; sz <<= 1)
#pragma unroll
        for (int j = sz >> 1; j > 0; j >>= 1)
#pragma unroll
            for (int i = 0; i < N; ++i) { const int l = i ^ j; if (l > i) { if ((i & sz) == 0) CE2_DESC(k[i], p[i], k[l], p[l]); else CE2_DESC(k[l], p[l], k[i], p[i]); } }
}
template <int N> __device__ __forceinline__ void bitonic_merge_desc2(unsigned (&k)[N], unsigned (&p)[N]) {
#pragma unroll
    for (int j = N >> 1; j > 0; j >>= 1)
#pragma unroll
        for (int i = 0; i < N; ++i) { const int l = i ^ j; if (l > i) CE2_DESC(k[i], p[i], k[l], p[l]); }
}
__device__ __forceinline__ void lane_merge16(unsigned (&k)[16], int xm) {
    unsigned o[16];
#pragma unroll
    for (int i = 0; i < 16; ++i) o[i] = (unsigned)__shfl_xor((int)k[i], xm);
#pragma unroll
    for (int i = 0; i < 16; ++i) k[i] = max(k[i], o[15 - i]);
    bitonic_merge_desc<16>(k);
}
__device__ __forceinline__ void lane_merge16_2(unsigned (&k)[16], unsigned (&p)[16], int xm) {
    unsigned ok[16], op[16];
#pragma unroll
    for (int i = 0; i < 16; ++i) { ok[i] = (unsigned)__shfl_xor((int)k[i], xm); op[i] = (unsigned)__shfl_xor((int)p[i], xm); }
#pragma unroll
    for (int i = 0; i < 16; ++i) { const bool sw = ok[15 - i] > k[i]; k[i] = sw ? ok[15 - i] : k[i]; p[i] = sw ? op[15 - i] : p[i]; }
    bitonic_merge_desc2<16>(k, p);
}

__device__ void peer_select_phase(const Args& a, ldsp_t lds) {
    const int lane = threadIdx.x & 63, wave = threadIdx.x >> 6, g = lane >> 4, l15 = lane & 15, W = gridDim.x * 8;
    const bf16_t* QP = (const bf16_t*)(a.ws + WS_QP);
    const bf16_t* KB = (const bf16_t*)(a.ws + WS_KEYS);
    int* IDX = (int*)(a.ws + WS_IDX); float* GW = (float*)(a.ws + WS_G);
    for (int item = blockIdx.x * 8 + wave; item < 2048 * 8; item += W) {
        const int tok0 = (item >> 3) * 16, h = item & 7, tok = tok0 + l15;
        LAS unsigned* tl = (LAS unsigned*)(lds + wave * 8192);
#pragma unroll 1
        for (int hf = 0; hf < 2; ++hf) {
            bf16x8 bq[4];
#pragma unroll
            for (int ks = 0; ks < 4; ++ks) bq[ks] = *(const bf16x8*)(QP + (size_t)tok * 2048 + h * 256 + hf * 128 + 32 * ks + 8 * g);
            unsigned key[32];
#pragma unroll
            for (int mt = 0; mt < 8; ++mt) { f32x4 acc = {0.f, 0.f, 0.f, 0.f};
#pragma unroll
                for (int ks = 0; ks < 4; ++ks) { const bf16x8 af = *(const bf16x8*)(KB + (size_t)((h * 2 + hf) * 128 + 16 * mt + l15) * 128 + 32 * ks + 8 * g);
                    acc = __builtin_amdgcn_mfma_f32_16x16x32_bf16(af, bq[ks], acc, 0, 0, 0); }
#pragma unroll
                for (int r = 0; r < 4; ++r) { const int n = 16 * mt + 4 * g + r; key[4 * mt + r] = (f2ord(acc[r]) & ~127u) | (unsigned)(127 - n); }
                __builtin_amdgcn_sched_barrier(0); }
            unsigned lo[16], hi[16];
#pragma unroll
            for (int i = 0; i < 16; ++i) { lo[i] = key[i]; hi[i] = key[16 + i]; }
            bitonic_sort_desc<16>(lo); bitonic_sort_desc<16>(hi);
#pragma unroll
            for (int i = 0; i < 16; ++i) lo[i] = max(lo[i], hi[15 - i]);
            bitonic_merge_desc<16>(lo);
            lane_merge16(lo, 16); lane_merge16(lo, 32);
#pragma unroll
            for (int i = 0; i < 16; ++i) tl[(hf * 16 + i) * 64 + lane] = lo[i];
        }
        unsigned top[2][16];
#pragma unroll
        for (int i = 0; i < 16; ++i) { top[0][i] = tl[i * 64 + lane]; top[1][i] = tl[(16 + i) * 64 + lane]; }
        unsigned ck[16], cp[16];
#pragma unroll
        for (int i = 0; i < 16; ++i) { ck[i] = 0u; cp[i] = 0u; }
#define PEER_CAND(slot, I, J) do { const float _s = ord2f(top[0][I] & ~127u) + ord2f(top[1][J] & ~127u); ck[slot] = f2ord(_s); cp[slot] = ((127u - (top[0][I] & 127u)) << 7) | (127u - (top[1][J] & 127u)); } while (0)
        if (g == 0) { PEER_CAND(0, 0, 0); PEER_CAND(1, 0, 1); PEER_CAND(2, 0, 2); PEER_CAND(3, 0, 3); PEER_CAND(4, 0, 4); PEER_CAND(5, 0, 5); PEER_CAND(6, 0, 6); PEER_CAND(7, 0, 7);
            PEER_CAND(8, 0, 8); PEER_CAND(9, 0, 9); PEER_CAND(10, 0, 10); PEER_CAND(11, 0, 11); PEER_CAND(12, 0, 12); PEER_CAND(13, 0, 13); PEER_CAND(14, 0, 14); PEER_CAND(15, 0, 15); }
        else if (g == 1) { PEER_CAND(0, 1, 0); PEER_CAND(1, 1, 1); PEER_CAND(2, 1, 2); PEER_CAND(3, 1, 3); PEER_CAND(4, 1, 4); PEER_CAND(5, 1, 5); PEER_CAND(6, 1, 6); PEER_CAND(7, 1, 7);
            PEER_CAND(8, 2, 0); PEER_CAND(9, 2, 1); PEER_CAND(10, 2, 2); PEER_CAND(11, 2, 3); PEER_CAND(12, 2, 4); PEER_CAND(13, 3, 0); PEER_CAND(14, 3, 1); PEER_CAND(15, 3, 2); }
        else if (g == 2) { PEER_CAND(0, 3, 3); PEER_CAND(1, 4, 0); PEER_CAND(2, 4, 1); PEER_CAND(3, 4, 2); PEER_CAND(4, 5, 0); PEER_CAND(5, 5, 1); PEER_CAND(6, 6, 0); PEER_CAND(7, 6, 1);
            PEER_CAND(8, 7, 0); PEER_CAND(9, 7, 1); PEER_CAND(10, 8, 0); PEER_CAND(11, 9, 0); PEER_CAND(12, 10, 0); PEER_CAND(13, 11, 0); PEER_CAND(14, 12, 0); PEER_CAND(15, 13, 0); }
        else { PEER_CAND(0, 14, 0); PEER_CAND(1, 15, 0); }
#undef PEER_CAND
        bitonic_sort_desc2<16>(ck, cp);
        lane_merge16_2(ck, cp, 16); lane_merge16_2(ck, cp, 32);
        float ev[16]; float sum = 0.f; const float mx = ord2f(ck[0]);
#pragma unroll
        for (int i = 0; i < 16; ++i) { ev[i] = __expf(ord2f(ck[i]) - mx); sum += ev[i]; }
        const float inv = 1.0f / sum;
#pragma unroll
        for (int i = 0; i < 16; ++i) if ((i >> 2) == g) { IDX[(size_t)tok * 128 + h * 16 + i] = (int)cp[i]; GW[(size_t)tok * 128 + h * 16 + i] = ev[i] * inv; }
    }
}

constexpr float U_SCALE = 32.0f, V_SCALE = 2.0f;
__device__ void cvt_flat_fp8(const float* src, unsigned char* dst, size_t n, float scale) {
    const size_t gt = (size_t)blockIdx.x * 512 + threadIdx.x, gs = (size_t)gridDim.x * 512;
    for (size_t i = gt * 16; i < n; i += gs * 16) {
        u32x4 w; unsigned ws_[4];
#pragma unroll
        for (int q = 0; q < 4; ++q) { const f32x4 v = *(const f32x4*)(src + i + 4 * q) * scale;
            int p = __builtin_amdgcn_cvt_pk_fp8_f32(v[0], v[1], 0, false); p = __builtin_amdgcn_cvt_pk_fp8_f32(v[2], v[3], p, true); ws_[q] = (unsigned)p; }
        w.x = ws_[0]; w.y = ws_[1]; w.z = ws_[2]; w.w = ws_[3];
        *(u32x4*)(dst + i) = w;
    }
}
__device__ __forceinline__ float gelu_erf(float x) { return 0.5f * x * (1.0f + erff(x * 0.70710678118654752f)); }
__device__ void peer_gather_phase(const Args& a) {
    const int lane = threadIdx.x & 63, wave = threadIdx.x >> 6, W = gridDim.x * 8;
    const bf16_t* XN = (const bf16_t*)(a.ws + WS_XN);
    const unsigned char* UB = a.ws + WS_UB;
    const unsigned char* VB = a.ws + WS_VB;
    const int* IDX = (const int*)(a.ws + WS_IDX); const float* GW = (const float*)(a.ws + WS_G);
    const float* mod = (const float*)(a.ws + WS_MOD);
    const float* fg = a.in[I_FNG];
    float* H = a.out;
    for (int tok = blockIdx.x * 8 + wave; tok < T_; tok += W) {
        float xf[2][16];
#pragma unroll
        for (int c = 0; c < 2; ++c)
#pragma unroll
            for (int q = 0; q < 2; ++q) { const u32x4 xv = *(const u32x4*)(XN + (size_t)tok * 2048 + (c * 64 + lane) * 16 + 8 * q); const unsigned xs[4] = {xv.x, xv.y, xv.z, xv.w};
#pragma unroll
                for (int j = 0; j < 4; ++j) { xf[c][8 * q + 2 * j] = bflo(xs[j]); xf[c][8 * q + 2 * j + 1] = bfhi(xs[j]); } }
        const int id0 = IDX[(size_t)tok * 128 + lane], id1 = IDX[(size_t)tok * 128 + 64 + lane];
        const float g0 = GW[(size_t)tok * 128 + lane], g1 = GW[(size_t)tok * 128 + 64 + lane];
        float o[2][16];
#pragma unroll
        for (int c = 0; c < 2; ++c)
#pragma unroll
            for (int j = 0; j < 16; ++j) o[c][j] = 0.f;
        for (int kk = 0; kk < 128; kk += 4) {
            int ex[4]; float gw[4];
#pragma unroll
            for (int e = 0; e < 4; ++e) { const int k = kk + e;
                ex[e] = (k < 64) ? __builtin_amdgcn_readlane(id0, k & 63) : __builtin_amdgcn_readlane(id1, k & 63);
                gw[e] = (k < 64) ? __uint_as_float(__builtin_amdgcn_readlane(__float_as_uint(g0), k & 63)) : __uint_as_float(__builtin_amdgcn_readlane(__float_as_uint(g1), k & 63)); }
            u32x4 ur[4][2], vr[4][2];
#pragma unroll
            for (int e = 0; e < 4; ++e)
#pragma unroll
                for (int c = 0; c < 2; ++c) ur[e][c] = *(const u32x4*)(UB + (size_t)ex[e] * 2048 + (c * 64 + lane) * 16);
#pragma unroll
            for (int e = 0; e < 4; ++e)
#pragma unroll
                for (int c = 0; c < 2; ++c) vr[e][c] = *(const u32x4*)(VB + (size_t)ex[e] * 2048 + (c * 64 + lane) * 16);
            float dt[4];
#pragma unroll
            for (int e = 0; e < 4; ++e) { float s = 0.f;
#pragma unroll
                for (int c = 0; c < 2; ++c) { const unsigned us[4] = {ur[e][c].x, ur[e][c].y, ur[e][c].z, ur[e][c].w};
#pragma unroll
                    for (int j = 0; j < 4; ++j) { const f32x2 l = __builtin_amdgcn_cvt_pk_f32_fp8((int)us[j], false), hh = __builtin_amdgcn_cvt_pk_f32_fp8((int)us[j], true);
                        s += l.x * xf[c][4 * j] + l.y * xf[c][4 * j + 1] + hh.x * xf[c][4 * j + 2] + hh.y * xf[c][4 * j + 3]; } }
                dt[e] = s; }
#pragma unroll
            for (int off = 32; off >= 1; off >>= 1)
#pragma unroll
                for (int e = 0; e < 4; ++e) dt[e] += __shfl_xor(dt[e], off);
#pragma unroll
            for (int e = 0; e < 4; ++e) { const float cf = gw[e] * gelu_erf(dt[e] * (1.0f / U_SCALE)) * (1.0f / V_SCALE);
#pragma unroll
                for (int c = 0; c < 2; ++c) { const unsigned vs[4] = {vr[e][c].x, vr[e][c].y, vr[e][c].z, vr[e][c].w};
#pragma unroll
                    for (int j = 0; j < 4; ++j) { const f32x2 l = __builtin_amdgcn_cvt_pk_f32_fp8((int)vs[j], false), hh = __builtin_amdgcn_cvt_pk_f32_fp8((int)vs[j], true);
                        o[c][4 * j] += cf * l.x; o[c][4 * j + 1] += cf * l.y; o[c][4 * j + 2] += cf * hh.x; o[c][4 * j + 3] += cf * hh.y; } } }
        }
        const int b = tok >> 14; float ss = 0.f;
#pragma unroll
        for (int c = 0; c < 2; ++c)
#pragma unroll
            for (int q = 0; q < 4; ++q) { const int d0 = (c * 64 + lane) * 16 + 4 * q;
                const f32x4 h0 = *(const f32x4*)(H + (size_t)tok * 2048 + d0), q0 = *(const f32x4*)(mod + b * 12288 + 5 * 2048 + d0);
#pragma unroll
                for (int j = 0; j < 4; ++j) { const float hv = h0[j] + q0[j] * o[c][4 * q + j]; o[c][4 * q + j] = hv; ss += hv * hv; } }
        ss = wave_sum(ss);
        const float rstd = rsqrtf(ss * (1.0f / 2048.0f) + EPS);
#pragma unroll
        for (int c = 0; c < 2; ++c)
#pragma unroll
            for (int q = 0; q < 4; ++q) { const int d0 = (c * 64 + lane) * 16 + 4 * q;
                const f32x4 f0 = *(const f32x4*)(fg + d0); f32x4 r0;
#pragma unroll
                for (int j = 0; j < 4; ++j) r0[j] = o[c][4 * q + j] * rstd * f0[j];
                *(f32x4*)(H + (size_t)tok * 2048 + d0) = r0; }
    }
}

__global__ void __launch_bounds__(512, 2) mega(Args a) {
    extern __shared__ __attribute__((aligned(16))) unsigned char lds_raw[];
    ldsp_t lds = (ldsp_t)lds_raw;
    cg::grid_group grid = cg::this_grid();
    const int lo = a.ph_lo, hi = a.ph_hi;
    unsigned char* ws = a.ws;
    const float* mod = (const float*)(ws + WS_MOD);
#ifdef ONLY_PHASE
#define IN(k) ((k) == ONLY_PHASE && lo <= (k) && (k) < hi)
#else
#define IN(k) (lo <= (k) && (k) < hi)
#endif
#define SEAM(k) do { if (IN(k) && IN((k) + 1)) grid.sync(); } while (0)

    if (IN(0)) phase0(a, lds);
    SEAM(0);
    if (IN(1)) norm_phase(a.in[I_X], a.in[I_N1G], mod, mod + 2048, (bf16_t*)(ws + WS_XN));
    SEAM(1);
    if (IN(2)) {
        pg8::Gemm g{(const bf16_t*)(ws + WS_XN), (const bf16_t*)(ws + WS_WIN), T_, PW, 2048, 2048};
        pg8::StaticOrder S; S.init(T_, PW, gridDim.x, blockIdx.x);
        pg8::EpiIn E{(bf16_t*)(ws + WS_P)};
        pg8::gemm_phase(lds, g, S, E);
    }
    SEAM(2);
    if (IN(3)) { fft1_phase(a, lds); __syncthreads(); gla_phase<false>(a, lds); }
    SEAM(3);
    if (IN(4)) { fft2_phase(a, lds); __syncthreads(); gla_phase<true>(a, lds); }
    SEAM(4);
    if (IN(5)) gla_post_phase(a);
    SEAM(5);
    if (IN(6)) {
        {
            pg8::Gemm g{(const bf16_t*)a.out + (size_t)T_ * 2048, (const bf16_t*)(ws + WS_WFN), T_, 2048, 2048, 2048};
            pg8::StaticOrder S; S.init(T_, 2048, gridDim.x, blockIdx.x);
            pg8::EpiGate<0> E{(bf16_t*)(ws + WS_O), 2048, (const bf16_t*)(ws + WS_P) + PC_GF, PW};
            pg8::gemm_phase(lds, g, S, E);
        }
        {
            pg8::Gemm g{(const bf16_t*)(ws + WS_XN), (const bf16_t*)(ws + WS_WGLA), T_, 2048, 1024, 1024};
            pg8::StaticOrder S; S.init(T_, 2048, gridDim.x, blockIdx.x);
            pg8::EpiGate<1> E{(bf16_t*)(ws + WS_O), 2048, (const bf16_t*)(ws + WS_P) + PC_GG, PW};
            pg8::gemm_phase(lds, g, S, E);
        }
    }
    SEAM(6);
    if (IN(7)) {
        pg8::Gemm g{(const bf16_t*)(ws + WS_O), (const bf16_t*)(ws + WS_WOUT), T_, 2048, 2048, 2048};
        pg8::StaticOrder S; S.init(T_, 2048, gridDim.x, blockIdx.x);
        pg8::EpiRes E{a.in[I_X], mod + 2 * 2048, a.out};
        pg8::gemm_phase(lds, g, S, E);
    }
    SEAM(7);
    if (IN(8)) {
        norm_phase(a.out, a.in[I_N2G], mod + 3 * 2048, mod + 4 * 2048, (bf16_t*)(ws + WS_XN));
        cvt_flat_fp8(a.in[I_U], ws + WS_UB, (size_t)16384 * 2048, U_SCALE);
        cvt_flat_fp8(a.in[I_V], ws + WS_VB, (size_t)16384 * 2048, V_SCALE);
    }
    SEAM(8);
    if (IN(9)) {
        pg8::Gemm g{(const bf16_t*)(ws + WS_XN), (const bf16_t*)(ws + WS_WQ), T_, 2048, 2048, 2048};
        pg8::StaticOrder S; S.init(T_, 2048, gridDim.x, blockIdx.x);
        pg8::EpiGate<2> E{(bf16_t*)(ws + WS_QP), 2048, nullptr, 0};
        pg8::gemm_phase(lds, g, S, E);
    }
    SEAM(9);
    if (IN(10)) peer_select_phase(a, lds);
    SEAM(10);
    if (IN(11)) peer_gather_phase(a);
#undef IN
#undef SEAM
}

constexpr int N_PHASES = 12;

extern "C" void kernel_launch(void* const* d_in, const int* in_sizes, int n_in, void* d_out, int out_size, void* d_ws, size_t ws_size, hipStream_t stream) {
    static int grid = 0;
    if (grid == 0) {
        int dev = 0, cus = 0, per_cu = 0;
        (void)hipGetDevice(&dev);
        (void)hipDeviceGetAttribute(&cus, hipDeviceAttributeMultiprocessorCount, dev);
        (void)hipFuncSetAttribute((const void*)mega, hipFuncAttributeMaxDynamicSharedMemorySize, LDS_BYTES);
        (void)hipOccupancyMaxActiveBlocksPerMultiprocessor(&per_cu, (const void*)mega, 512, LDS_BYTES);
        if (per_cu < 1 || n_in != 18 || ws_size < WS_END) { fprintf(stderr, "kernel_launch: unexpected configuration (per_cu %d, n_in %d, ws %zu)\n", per_cu, n_in, ws_size); grid = -1; return; }
        grid = cus;
    }
    if (grid < 0) return;
    Args a{};
    for (int i = 0; i < 18; ++i) a.in[i] = (const float*)d_in[i];
    a.out = (float*)d_out; a.ws = (unsigned char*)d_ws;
#if N_PHASE_LAUNCH
    for (int p = 0; p < N_PHASES; ++p) { a.ph_lo = p; a.ph_hi = p + 1;
        void* args[] = {&a};
        hipError_t e = hipLaunchCooperativeKernel((void*)mega, dim3(grid), dim3(512), args, LDS_BYTES, stream);
        if (e != hipSuccess) fprintf(stderr, "launch %d failed: %s\n", p, hipGetErrorString(e)); }
#else
    a.ph_lo = 0; a.ph_hi = N_PHASES;
    void* args[] = {&a};
    hipError_t e = hipLaunchCooperativeKernel((void*)mega, dim3(grid), dim3(512), args, LDS_BYTES, stream);
    if (e != hipSuccess) fprintf(stderr, "cooperative launch failed: %s (grid %d)\n", hipGetErrorString(e), grid);
#endif
}
```

```cpp
#include <hip/hip_runtime.h>
#include <hip/hip_cooperative_groups.h>
#include <cstdio>
namespace cg = cooperative_groups;

#define LAS __attribute__((address_space(3)))
typedef unsigned short bf16_t;
typedef short bf16x8 __attribute__((ext_vector_type(8)));
typedef float f32x4 __attribute__((ext_vector_type(4)));
typedef float f32x2 __attribute__((ext_vector_type(2)));
typedef unsigned u32x4 __attribute__((ext_vector_type(4)));
typedef unsigned u32x2 __attribute__((ext_vector_type(2)));
typedef LAS unsigned char* ldsp_t;

#ifndef N_PHASE_LAUNCH
#define N_PHASE_LAUNCH 0
#endif

constexpr int T_ = 32768, D_ = 2048, S_ = 16384;
constexpr float EPS = 1e-6f;
constexpr int PW = 8448;
constexpr int PC_Z = 0, PC_Q = 1024, PC_K = 1536, PC_V = 2048, PC_R = 3072, PC_GF = 4096, PC_GG = 6144, PC_A1 = 8192;
constexpr int LDS_BYTES = 135168;

constexpr size_t WS_CTL  = 0;
constexpr size_t WS_MOD  = 65536;
constexpr size_t WS_TW   = WS_MOD + 98304;
constexpr size_t WS_F1   = WS_TW + 131072;
constexpr size_t WS_F2   = WS_F1 + 65536;
constexpr size_t WS_DSEG = WS_F2 + 131072;
constexpr size_t WS_WIN  = WS_DSEG + 131072;
constexpr size_t WS_WFN  = WS_WIN + (size_t)8448 * 2048 * 2;
constexpr size_t WS_WGLA = WS_WFN + (size_t)2048 * 2048 * 2;
constexpr size_t WS_WOUT = WS_WGLA + (size_t)2048 * 1024 * 2;
constexpr size_t WS_WQ   = WS_WOUT + (size_t)2048 * 2048 * 2;
constexpr size_t WS_KEYS = WS_WQ + (size_t)2048 * 2048 * 2;
constexpr size_t WS_L    = WS_KEYS + (size_t)8 * 2 * 128 * 128 * 2;
constexpr size_t WS_XN   = WS_L + (size_t)512 * 16384 * 4;
constexpr size_t WS_O    = WS_XN + (size_t)T_ * 2048 * 2;
constexpr size_t WS_P    = WS_O + (size_t)T_ * 2048 * 2;
constexpr size_t WS_QP   = WS_P;
constexpr size_t WS_IDX  = WS_QP + (size_t)T_ * 2048 * 2;
constexpr size_t WS_G    = WS_IDX + (size_t)T_ * 128 * 4;
constexpr size_t WS_UB   = WS_G + (size_t)T_ * 128 * 4;
constexpr size_t WS_VB   = WS_UB + (size_t)16384 * 2048 * 2;
constexpr size_t WS_END  = WS_P + (size_t)T_ * PW * 2;
static_assert(WS_VB + (size_t)16384 * 2048 * 2 <= WS_END, "late buffers must fit in the P region");
static_assert(WS_END <= (size_t)1000 * 1000 * 1000, "workspace budget");

struct Args { const float* in[18]; float* out; unsigned char* ws; int ph_lo, ph_hi; };
enum { I_X = 0, I_C, I_WADA, I_BADA, I_N1G, I_WIN, I_WFNET, I_WA2, I_BA, I_GNG, I_WGLA, I_WOUT, I_N2G, I_WQ, I_KEYS, I_U, I_V, I_FNG };

__device__ __forceinline__ unsigned f2bf(float f) { unsigned u = __float_as_uint(f); return (u + 0x7fffu + ((u >> 16) & 1u)) >> 16; }
__device__ __forceinline__ float bf2f(unsigned h) { return __uint_as_float(h << 16); }
__device__ __forceinline__ unsigned pk2(float lo, float hi) { return f2bf(lo) | (f2bf(hi) << 16); }
__device__ __forceinline__ float bflo(unsigned w) { return __uint_as_float(w << 16); }
__device__ __forceinline__ float bfhi(unsigned w) { return __uint_as_float(w & 0xffff0000u); }
__device__ __forceinline__ float wave_sum(float v) {
#pragma unroll
    for (int o = 32; o >= 1; o >>= 1) v += __shfl_xor(v, o);
    return v;
}
__device__ __forceinline__ float sigmoidf_(float v) { return 1.0f / (1.0f + __expf(-v)); }


#define XB_TMO      128
#define XB_XCNT(j)  (256  + 64 * (j))
#define XB_XSUB(j)  (1280 + 64 * (j))
#define XB_XGEN(j)  (2304 + 64 * (j))
#define XB_TOP      3328
#define XB_TOPGEN   3392
#define XCD_BAR_WORDS 3456
#define XB_SPIN_CAP (1u << 22)
__device__ __forceinline__ unsigned xb_ld(unsigned* p)              { return __hip_atomic_load(p, __ATOMIC_RELAXED, __HIP_MEMORY_SCOPE_AGENT); }
__device__ __forceinline__ unsigned xb_add(unsigned* p, unsigned v) { return __hip_atomic_fetch_add(p, v, __ATOMIC_RELAXED, __HIP_MEMORY_SCOPE_AGENT); }
__device__ __forceinline__ unsigned xb_xcc_id() { return (unsigned)__builtin_amdgcn_s_getreg((3 << 11) | 20) & 0xFu; }
#define XB_SPIN(cond, bar) do { unsigned _sp = 0; while (cond) { __builtin_amdgcn_s_sleep(1); \
    if ((++_sp & 255u) == 0u) { if (xb_ld(&(bar)[XB_TMO])) break; if (_sp > XB_SPIN_CAP) { atomicAdd(&(bar)[XB_TMO], 1u); break; } } } } while (0)
struct XcdBarrier { unsigned* bar; unsigned x; volatile LAS unsigned* st; };
__device__ __forceinline__ XcdBarrier xcd_barrier_post(unsigned* bar, volatile LAS unsigned* st) {
    XcdBarrier b; b.bar = bar; b.x = xb_xcc_id(); b.st = st;
    if (threadIdx.x == 0) (void)xb_add(&bar[XB_XCNT(b.x)], 1u);
    return b;
}
__device__ __forceinline__ void xcd_barrier_complete(unsigned* bar, unsigned x, unsigned& nloc, unsigned& nx) {
    const unsigned G = gridDim.x * gridDim.y * gridDim.z;
    unsigned sum, cnt, mine, sp = 0u;
    for (;;) {
        sum = 0u; cnt = 0u; mine = 0u;
#pragma unroll
        for (unsigned j = 0; j < 16; ++j) { const unsigned c = xb_ld(&bar[XB_XCNT(j)]); sum += c; cnt += (c > 0u) ? 1u : 0u; mine = (j == x) ? c : mine; }
        if (sum == G) break;
        __builtin_amdgcn_s_sleep(1);
        if ((++sp & 255u) == 0u) { if (xb_ld(&bar[XB_TMO])) break; if (sp > XB_SPIN_CAP) { atomicAdd(&bar[XB_TMO], 1u); break; } }
    }
    nloc = mine > 0u ? mine : 1u; nx = cnt > 0u ? cnt : 1u;
}
__device__ __forceinline__ void xcd_barrier(const XcdBarrier& b) {
    asm volatile("s_waitcnt vmcnt(0)" ::: "memory");
    __syncthreads();
    if (threadIdx.x == 0) {
        unsigned* bar = b.bar;
        __builtin_amdgcn_s_waitcnt(0);
        unsigned nloc = b.st[0], nx = b.st[1];
        if (nloc == 0u) { xcd_barrier_complete(bar, b.x, nloc, nx); b.st[0] = nloc; b.st[1] = nx; }
        const unsigned old = xb_add(&bar[XB_XSUB(b.x)], 1u);
        const unsigned gen = old / nloc;
        if (old + 1u == (gen + 1u) * nloc) {
            __builtin_amdgcn_fence(__ATOMIC_RELEASE, "agent");
            asm volatile("s_waitcnt vmcnt(0)" ::: "memory");
            const unsigned og = xb_add(&bar[XB_TOP], 1u);
            const unsigned tg = og / nx;
            if (og + 1u == (tg + 1u) * nx) xb_add(&bar[XB_TOPGEN], 1u);
            else XB_SPIN(xb_ld(&bar[XB_TOPGEN]) == tg, bar);
            __builtin_amdgcn_fence(__ATOMIC_ACQUIRE, "agent");
            xb_add(&bar[XB_XGEN(b.x)], 1u);
            asm volatile("s_waitcnt vmcnt(0)" ::: "memory");
        } else {
            XB_SPIN(xb_ld(&bar[XB_XGEN(b.x)]) == gen, bar);
            __builtin_amdgcn_fence(__ATOMIC_ACQUIRE, "agent");
            asm volatile("s_waitcnt vmcnt(0)" ::: "memory");
        }
    }
    __syncthreads();
}

namespace pg8 {
constexpr int BM = 256, BK = 64, HALF = 128, HTB = HALF * BK * 2, STAGE_BYTES = 8 * HTB, NXCD = 8, WGM = 8;
__device__ __forceinline__ int lds_byte(int r, int c) { const int st = (r >> 4) * 2 + (c >> 5), rr = r & 15, cc = c & 31, ob = rr * 64 + cc * 2; return st * 1024 + (ob ^ (((ob >> 9) & 1) << 5)); }
__device__ __forceinline__ void stage_rc(int b, int& R, int& C) { const int st = b / 1024, sb = b % 1024, swz = sb ^ (((sb >> 9) & 1) << 5); R = (st >> 1) * 16 + swz / 64; C = (st & 1) * 32 + (swz % 64) / 2; }
__device__ __forceinline__ int perm32(int rho) { const int n = rho >> 4, i = rho & 15; return 8 * (i >> 2) + 4 * n + (i & 3); }

struct Unit { int pm, pn; };
struct Gemm { const bf16_t* A; const bf16_t* Bt; int M, N, K, lda; };

struct StaticOrder {
    int nM, nN, nwg, G, c;
    __device__ void init(int M, int N, int G_, int c_) { nM = M / BM; nN = N / BM; nwg = nM * nN; G = G_; c = c_; }
    __device__ bool next(int i, Unit& u) const {
        const long L = (long)i * G + c; if (L >= nwg) return false;
        int wgid = (int)L; { const int q = nwg / NXCD, r = nwg % NXCD, xcd = wgid % NXCD, off = wgid / NXCD; wgid = (xcd < r ? xcd * (q + 1) : r * (q + 1) + (xcd - r) * q) + off; }
        const int nig = WGM * nN, gid = wgid / nig, fm = gid * WGM, gsz = (nM - fm) < WGM ? (nM - fm) : WGM;
        u.pm = fm + ((wgid % nig) % gsz); u.pn = (wgid % nig) / gsz; return true;
    }
};

template <class Epi>
__device__ __forceinline__ void gemm_phase(ldsp_t lds, const Gemm g, const StaticOrder& S, const Epi& E) {
    const int tid = threadIdx.x, wid = __builtin_amdgcn_readfirstlane(tid >> 6), lane = tid & 63, wr = wid >> 2, wc = wid & 3, fr = lane & 15, fq = lane >> 4;
    const int K = g.K, nt = K / BK, lda = g.lda;
    unsigned voffA[2], voffB[2];
#pragma unroll
    for (int i = 0; i < 2; ++i) { int R, C; stage_rc(tid * 16 + i * 8192, R, C); const int Rb = Epi::PERM ? ((R & ~31) + perm32(R & 31)) : R;
        voffA[i] = (unsigned)(R * lda + C) * 2u; voffB[i] = (unsigned)(Rb * K + C) * 2u; }
    const size_t kstep = (size_t)(BK * 2);
    const size_t hstepA = (size_t)HALF * lda * 2, hstepB = (size_t)HALF * K * 2;
    const size_t tstepA = 2 * hstepA, tstepB = 2 * hstepB;
    const unsigned ldsw = (unsigned)wid * 1024u;
    const int aoff = lds_byte(wr * 64 + fr, fq * 8), boff = lds_byte(wc * 32 + fr, fq * 8);
#define PG8_SA(b, h) (((b) * 2 + (h)) * HTB)
#define PG8_SB(b, h) ((4 + (b) * 2 + (h)) * HTB)
#define PG8_STAGE(bufoff, gbase, voff) do { _Pragma("unroll") for (int _i = 0; _i < 2; ++_i) \
        __builtin_amdgcn_global_load_lds((const unsigned*)((const char*)(gbase) + (voff)[_i]), (LAS unsigned*)(lds + (bufoff) + ldsw + _i * 8192), 16, 0, 0); } while (0)
#define PG8_LDA(dst, b, h) do { _Pragma("unroll") for (int m = 0; m < 4; ++m) _Pragma("unroll") for (int k = 0; k < 2; ++k) dst[m][k] = *(const LAS bf16x8*)(lds + PG8_SA(b, h) + aoff + m * 2048 + k * 1024); } while (0)
#define PG8_LDB(dst, b, h) do { _Pragma("unroll") for (int n = 0; n < 2; ++n) _Pragma("unroll") for (int k = 0; k < 2; ++k) dst[n][k] = *(const LAS bf16x8*)(lds + PG8_SB(b, h) + boff + n * 2048 + k * 1024); } while (0)
#define PG8_MMA(ai, bj, At, Bt) do { __builtin_amdgcn_s_setprio(1); _Pragma("unroll") for (int m = 0; m < 4; ++m) _Pragma("unroll") for (int n = 0; n < 2; ++n) _Pragma("unroll") for (int k = 0; k < 2; ++k) \
        acc[ai][bj][m][n] = __builtin_amdgcn_mfma_f32_16x16x32_bf16(Bt[n][k], At[m][k], acc[ai][bj][m][n], 0, 0, 0); __builtin_amdgcn_s_setprio(0); } while (0)
#define PG8_WAIT_V(n) asm volatile("s_waitcnt vmcnt(" #n ")" ::: "memory")
#define PG8_WAIT_L(n) asm volatile("s_waitcnt lgkmcnt(" #n ")" ::: "memory")
#define PG8_BAR __builtin_amdgcn_s_barrier()
#define PG8_SCHED __builtin_amdgcn_sched_barrier(0)
    Unit cur, nxt; int ui = 0;
    if (!S.next(0, cur)) return;
    f32x4 acc[2][2][4][2];
#pragma unroll
    for (int a = 0; a < 2; ++a)
#pragma unroll
        for (int b = 0; b < 2; ++b)
#pragma unroll
            for (int m = 0; m < 4; ++m)
#pragma unroll
                for (int n = 0; n < 2; ++n) acc[a][b][m][n] = (f32x4){0.f, 0.f, 0.f, 0.f};
    bf16x8 At[4][2], B0[2][2], B1[2][2];
    const char* cA = (const char*)g.A + (size_t)cur.pm * tstepA; const char* cB = (const char*)g.Bt + (size_t)cur.pn * tstepB;
    PG8_STAGE(PG8_SB(0, 0), cB, voffB); PG8_STAGE(PG8_SA(0, 0), cA, voffA); PG8_STAGE(PG8_SB(0, 1), cB + hstepB, voffB); PG8_STAGE(PG8_SA(0, 1), cA + hstepA, voffA);
    if (wr == 1) PG8_BAR;
    PG8_WAIT_V(4); PG8_BAR;
    PG8_STAGE(PG8_SB(1, 0), cB + kstep, voffB); PG8_STAGE(PG8_SA(1, 0), cA + kstep, voffA); PG8_STAGE(PG8_SB(1, 1), cB + hstepB + kstep, voffB);
    PG8_WAIT_V(6); PG8_BAR;
    for (;;) {
        const bool has_next = S.next(ui + 1, nxt);
        const char* nA = has_next ? (const char*)g.A + (size_t)nxt.pm * tstepA : cA; const char* nB = has_next ? (const char*)g.Bt + (size_t)nxt.pn * tstepB : cB;
        for (int t = 0; t < nt; t += 2) {
            const bool last = (t == nt - 2);
            const char* a1 = cA + (size_t)(t + 1) * kstep;
            const char* a2 = last ? nA : cA + (size_t)(t + 2) * kstep; const char* b2 = last ? nB : cB + (size_t)(t + 2) * kstep;
            const char* a3 = a2 + kstep; const char* b3 = b2 + kstep;
            PG8_LDB(B0, 0, 0); PG8_SCHED; PG8_LDA(At, 0, 0); PG8_STAGE(PG8_SA(1, 1), a1 + hstepA, voffA);
            PG8_WAIT_L(8); PG8_BAR; PG8_WAIT_L(0); PG8_MMA(0, 0, At, B0); PG8_BAR; PG8_SCHED;
            PG8_LDB(B1, 0, 1); PG8_STAGE(PG8_SB(0, 0), b2, voffB);
            PG8_BAR; PG8_WAIT_L(0); PG8_MMA(0, 1, At, B1); PG8_BAR;
            PG8_LDA(At, 0, 1); PG8_STAGE(PG8_SA(0, 0), a2, voffA);
            PG8_BAR; PG8_WAIT_L(0); PG8_MMA(1, 0, At, B0); PG8_BAR; PG8_SCHED;
            PG8_STAGE(PG8_SB(0, 1), b2 + hstepB, voffB);
            PG8_WAIT_V(6); PG8_BAR; PG8_MMA(1, 1, At, B1); PG8_BAR;
            PG8_LDB(B0, 1, 0); PG8_SCHED; PG8_LDA(At, 1, 0); PG8_STAGE(PG8_SA(0, 1), a2 + hstepA, voffA);
            PG8_WAIT_L(8); PG8_BAR; PG8_WAIT_L(0); PG8_MMA(0, 0, At, B0); PG8_BAR; PG8_SCHED;
            PG8_LDB(B1, 1, 1); PG8_STAGE(PG8_SB(1, 0), b3, voffB);
            PG8_BAR; PG8_WAIT_L(0); PG8_MMA(0, 1, At, B1); PG8_BAR;
            PG8_LDA(At, 1, 1); PG8_STAGE(PG8_SA(1, 0), a3, voffA);
            PG8_BAR; PG8_WAIT_L(0); PG8_MMA(1, 0, At, B0); PG8_BAR; PG8_SCHED;
            PG8_STAGE(PG8_SB(1, 1), b3 + hstepB, voffB);
            PG8_WAIT_V(6); PG8_BAR; PG8_MMA(1, 1, At, B1); PG8_BAR;
        }
        E(acc, cur, wr, wc, fr, fq);
        if (!has_next) break;
#pragma unroll
        for (int a = 0; a < 2; ++a)
#pragma unroll
            for (int b = 0; b < 2; ++b)
#pragma unroll
                for (int m = 0; m < 4; ++m)
#pragma unroll
                    for (int n = 0; n < 2; ++n) acc[a][b][m][n] = (f32x4){0.f, 0.f, 0.f, 0.f};
        cur = nxt; cA = nA; cB = nB; ++ui;
    }
    PG8_WAIT_V(0);
    if (wr == 0) PG8_BAR;
    PG8_BAR;
#undef PG8_SA
#undef PG8_SB
#undef PG8_STAGE
#undef PG8_LDA
#undef PG8_LDB
#undef PG8_MMA
#undef PG8_WAIT_V
#undef PG8_WAIT_L
#undef PG8_BAR
#undef PG8_SCHED
}

struct EpiIn {
    static constexpr bool PERM = true;
    bf16_t* P;
    __device__ __forceinline__ void operator()(const f32x4 (&acc)[2][2][4][2], const Unit& u, int wr, int wc, int fr, int fq) const {
        const int row0 = u.pm * BM + wr * 64 + fr, col0 = u.pn * BM + wc * 32 + 8 * fq;
        const bool sg = (u.pn >= 16 && u.pn < 32);
#pragma unroll
        for (int ai = 0; ai < 2; ++ai)
#pragma unroll
            for (int m = 0; m < 4; ++m) { bf16_t* rowp = P + (size_t)(row0 + ai * HALF + m * 16) * PW + col0;
#pragma unroll
                for (int bj = 0; bj < 2; ++bj) { f32x4 v0 = acc[ai][bj][m][0], v1 = acc[ai][bj][m][1];
                    if (sg) {
#pragma unroll
                        for (int j = 0; j < 4; ++j) { v0[j] = sigmoidf_(v0[j]); v1[j] = sigmoidf_(v1[j]); } }
                    u32x4 w; w.x = pk2(v0[0], v0[1]); w.y = pk2(v0[2], v0[3]); w.z = pk2(v1[0], v1[1]); w.w = pk2(v1[2], v1[3]);
                    *(u32x4*)(rowp + bj * HALF) = w; } }
    }
};
template <int MODE> struct EpiGate {
    static constexpr bool PERM = true;
    bf16_t* O; int ldo; const bf16_t* G; int ldg;
    __device__ __forceinline__ void operator()(const f32x4 (&acc)[2][2][4][2], const Unit& u, int wr, int wc, int fr, int fq) const {
        const int row0 = u.pm * BM + wr * 64 + fr, col0 = u.pn * BM + wc * 32 + 8 * fq;
#pragma unroll
        for (int ai = 0; ai < 2; ++ai)
#pragma unroll
            for (int m = 0; m < 4; ++m) { const size_t row = (size_t)(row0 + ai * HALF + m * 16);
#pragma unroll
                for (int bj = 0; bj < 2; ++bj) { const f32x4 v0 = acc[ai][bj][m][0], v1 = acc[ai][bj][m][1];
                    float r[8] = {v0[0], v0[1], v0[2], v0[3], v1[0], v1[1], v1[2], v1[3]};
                    bf16_t* op = O + row * ldo + col0 + bj * HALF;
                    if (MODE != 2) { const u32x4 gw = *(const u32x4*)(G + row * ldg + col0 + bj * HALF);
                        const unsigned gws[4] = {gw.x, gw.y, gw.z, gw.w};
#pragma unroll
                        for (int j = 0; j < 4; ++j) { r[2 * j] *= bflo(gws[j]); r[2 * j + 1] *= bfhi(gws[j]); } }
                    if (MODE == 1) { const u32x4 ow = *(const u32x4*)op; const unsigned ows[4] = {ow.x, ow.y, ow.z, ow.w};
#pragma unroll
                        for (int j = 0; j < 4; ++j) { r[2 * j] += bflo(ows[j]); r[2 * j + 1] += bfhi(ows[j]); } }
                    u32x4 w; w.x = pk2(r[0], r[1]); w.y = pk2(r[2], r[3]); w.z = pk2(r[4], r[5]); w.w = pk2(r[6], r[7]);
                    *(u32x4*)op = w; } }
    }
};
struct EpiRes {
    static constexpr bool PERM = false;
    const float* X; const float* gmod; float* H;
    __device__ __forceinline__ void operator()(const f32x4 (&acc)[2][2][4][2], const Unit& u, int wr, int wc, int fr, int fq) const {
        const int row0 = u.pm * BM + wr * 64 + fr, col0 = u.pn * BM + wc * 32 + 4 * fq;
        const float* gm = gmod + (size_t)((u.pm * BM) >> 14) * 12288;
        f32x4 gv[2][2];
#pragma unroll
        for (int bj = 0; bj < 2; ++bj)
#pragma unroll
            for (int n = 0; n < 2; ++n) gv[bj][n] = *(const f32x4*)(gm + col0 + bj * HALF + n * 16);
#pragma unroll
        for (int ai = 0; ai < 2; ++ai)
#pragma unroll
            for (int m = 0; m < 4; ++m) { const size_t off = (size_t)(row0 + ai * HALF + m * 16) * 2048 + col0;
#pragma unroll
                for (int bj = 0; bj < 2; ++bj)
#pragma unroll
                    for (int n = 0; n < 2; ++n) { const f32x4 xs = *(const f32x4*)(X + off + bj * HALF + n * 16);
                        *(f32x4*)(H + off + bj * HALF + n * 16) = xs + gv[bj][n] * acc[ai][bj][m][n]; } }
    }
};
}

__device__ void gemv_task(const Args& a, int task, ldsp_t lds) {
    const int tid = threadIdx.x, cq = tid & 15, rl = tid >> 4;
    const float* W = a.in[I_WADA] + 64 * task + 4 * cq;
    const float* c = a.in[I_C];
    f32x4 acc0 = {0.f, 0.f, 0.f, 0.f}, acc1 = {0.f, 0.f, 0.f, 0.f};
    for (int r = rl; r < 2048; r += 32) {
        const f32x4 w = *(const f32x4*)(W + (size_t)r * 12288);
        const float c0 = c[r], c1 = c[2048 + r];
        const float s0 = c0 / (1.f + __expf(-c0)), s1 = c1 / (1.f + __expf(-c1));
        acc0 += s0 * w; acc1 += s1 * w;
    }
    LAS float* red = (LAS float*)lds;
    __syncthreads();
#pragma unroll
    for (int j = 0; j < 4; ++j) { red[(rl * 16 + cq) * 8 + j] = acc0[j]; red[(rl * 16 + cq) * 8 + 4 + j] = acc1[j]; }
    __syncthreads();
    if (tid < 128) {
        const int b = tid >> 6, col = tid & 63; float s = 0.f;
        for (int r = 0; r < 32; ++r) s += red[(r * 16 + (col >> 2)) * 8 + b * 4 + (col & 3)];
        float* mod = (float*)(a.ws + WS_MOD);
        mod[b * 12288 + 64 * task + col] = s + a.in[I_BADA][64 * task + col];
    }
    __syncthreads();
}

template <class CMap>
__device__ __forceinline__ void tr_tile(const float* src, int src_ld, int r0, int c0, CMap cmap, bf16_t* dst, int dst_ld, ldsp_t lds) {
    LAS float* tile = (LAS float*)lds;
    const int tid = threadIdx.x, cc = tid & 63, rr0 = tid >> 6;
    const int sc = cmap(c0 + cc);
#pragma unroll
    for (int i = 0; i < 8; ++i) { const int r = rr0 + 8 * i; tile[cc * 65 + r] = sc >= 0 ? src[(size_t)(r0 + r) * src_ld + sc] : 0.f; }
    __syncthreads();
    const int rp = (tid & 31) * 2, c1 = tid >> 5;
#pragma unroll
    for (int i = 0; i < 4; ++i) { const int c = c1 + 16 * i; *(unsigned*)(dst + (size_t)(c0 + c) * dst_ld + r0 + rp) = pk2(tile[c * 65 + rp], tile[c * 65 + rp + 1]); }
    __syncthreads();
}
struct MapId { __device__ int operator()(int c) const { return c; } };
struct MapWin { __device__ int operator()(int c) const { return c < 4096 ? c : (c < 8192 ? c + 32 : (c < 8224 ? c - 4096 : -1)); } };

__device__ void fold_tile(const Args& a, int tile, ldsp_t lds) {
    LAS float* wl = (LAS float*)lds;
    LAS float* ct = (LAS float*)(lds + 65536);
    const int tid = threadIdx.x;
    const int nb = tile & 31, kb = tile >> 5;
    const int ri = kb >> 4, g = (kb >> 2) & 3, c0 = (kb & 3) * 64, n0 = nb * 64;
    const float* wf = a.in[I_WFNET] + (size_t)(g * 256) * 2048 + n0;
    __syncthreads();
#pragma unroll
    for (int j = 0; j < 8; ++j) { const int row = (tid >> 4) + 32 * j, c4 = (tid & 15) * 4;
        const f32x4 v = *(const f32x4*)(wf + (size_t)row * 2048 + c4);
        wl[row * 64 + c4] = v[0]; wl[row * 64 + c4 + 1] = v[1]; wl[row * 64 + c4 + 2] = v[2]; wl[row * 64 + c4 + 3] = v[3]; }
    if (tid < 256) ct[tid] = cospif((float)tid * (1.0f / 128.0f));
    __syncthreads();
    const int kk = tid & 63, nn0 = tid >> 6, c = c0 + kk;
    float acc[8];
#pragma unroll
    for (int i = 0; i < 8; ++i) acc[i] = 0.f;
    for (int m = 0; m < 256; ++m) {
        const int idx = (m * c) & 255;
        const float cs = ri ? ct[(idx + 192) & 255] : ct[idx];
#pragma unroll
        for (int i = 0; i < 8; ++i) acc[i] += wl[m * 64 + nn0 + 8 * i] * cs;
    }
    bf16_t* dst = (bf16_t*)(a.ws + WS_WFN);
#pragma unroll
    for (int i = 0; i < 8; ++i) dst[(size_t)(n0 + nn0 + 8 * i) * 2048 + ri * 1024 + g * 256 + c] = (bf16_t)f2bf(acc[i] * (1.0f / 2048.0f));
    __syncthreads();
}

__device__ void tables_task(const Args& a, int task) {
    const int tid = threadIdx.x;
    bf16_t* F1 = (bf16_t*)(a.ws + WS_F1); bf16_t* F2 = (bf16_t*)(a.ws + WS_F2); float* TW = (float*)(a.ws + WS_TW);
    {
        const int e = task * 512 + tid, R = e >> 7, sh = e & 127, w = R >> 5, mt = (R >> 4) & 1, r = R & 15, kf = 16 * w + r;
        float s, c; sincospif((float)((kf * sh) & 127) * (1.0f / 64.0f), &s, &c);
        F1[e] = (bf16_t)f2bf(mt ? -s : c);
    }
#pragma unroll
    for (int q = 0; q < 2; ++q) {
        const int e = task * 1024 + q * 512 + tid, R = e >> 8, K = e & 255, sl = K >> 1, ri = K & 1, w = R >> 5, mt = (R >> 4) & 1, r = R & 15, kf = 16 * w + r;
        float s, c; sincospif((float)((kf * sl) & 127) * (1.0f / 64.0f), &s, &c);
        const float v = mt ? (ri ? c : -s) : (ri ? s : c);
        F2[e] = (bf16_t)f2bf(v);
    }
    if (task < 32) {
        const int e = task * 512 + tid, kl = e >> 7, sl = e & 127;
        float s, c; sincospif((float)(kl * sl) * (1.0f / 8192.0f), &s, &c);
        TW[2 * e] = c; TW[2 * e + 1] = s;
    }
}

__device__ void cvt_flat(const float* src, bf16_t* dst, size_t n) {
    const size_t gt = (size_t)blockIdx.x * 512 + threadIdx.x, gs = (size_t)gridDim.x * 512;
    for (size_t i = gt * 8; i < n; i += gs * 8) {
        const f32x4 v0 = *(const f32x4*)(src + i), v1 = *(const f32x4*)(src + i + 4);
        u32x4 w; w.x = pk2(v0[0], v0[1]); w.y = pk2(v0[2], v0[3]); w.z = pk2(v1[0], v1[1]); w.w = pk2(v1[2], v1[3]);
        *(u32x4*)(dst + i) = w;
    }
}

__device__ void phase0(const Args& a, ldsp_t lds) {
    const int G = gridDim.x, bx = blockIdx.x;
    for (int t = bx; t < 192; t += G) gemv_task(a, t, lds);
    for (int t = bx; t < 64; t += G) tables_task(a, t);
    cvt_flat(a.in[I_KEYS], (bf16_t*)(a.ws + WS_KEYS), (size_t)8 * 2 * 128 * 128);
    for (int t = bx; t < 132 * 32; t += G) tr_tile(a.in[I_WIN], 8224, (t & 31) * 64, (t >> 5) * 64, MapWin(), (bf16_t*)(a.ws + WS_WIN), 2048, lds);
    for (int t = bx; t < 32 * 16; t += G) tr_tile(a.in[I_WGLA], 2048, (t & 15) * 64, (t >> 4) * 64, MapId(), (bf16_t*)(a.ws + WS_WGLA), 1024, lds);
    for (int t = bx; t < 32 * 32; t += G) tr_tile(a.in[I_WOUT], 2048, (t & 31) * 64, (t >> 5) * 64, MapId(), (bf16_t*)(a.ws + WS_WOUT), 2048, lds);
    for (int t = bx; t < 32 * 32; t += G) tr_tile(a.in[I_WQ], 2048, (t & 31) * 64, (t >> 5) * 64, MapId(), (bf16_t*)(a.ws + WS_WQ), 2048, lds);
    for (int t = bx; t < 1024; t += G) fold_tile(a, t, lds);
}

__device__ void norm_phase(const float* X, const float* gvec, const float* mod_sh, const float* mod_sc, bf16_t* out) {
    const int lane = threadIdx.x & 63, wave = threadIdx.x >> 6;
    const int W = gridDim.x * 8;
    for (int row = blockIdx.x * 8 + wave; row < T_; row += W) {
        const float* xr = X + (size_t)row * 2048;
        const int b = row >> 14;
        f32x4 v[8]; float ss = 0.f;
#pragma unroll
        for (int j = 0; j < 8; ++j) { v[j] = *(const f32x4*)(xr + (j * 64 + lane) * 4); ss += v[j][0] * v[j][0] + v[j][1] * v[j][1] + v[j][2] * v[j][2] + v[j][3] * v[j][3]; }
        ss = wave_sum(ss);
        const float rstd = rsqrtf(ss * (1.0f / 2048.0f) + EPS);
#pragma unroll
        for (int j = 0; j < 8; ++j) { const int d = (j * 64 + lane) * 4;
            const f32x4 gg = *(const f32x4*)(gvec + d), sc = *(const f32x4*)(mod_sc + b * 12288 + d), sh = *(const f32x4*)(mod_sh + b * 12288 + d);
            f32x4 y = v[j] * rstd * gg * (1.0f + sc) + sh;
            u32x2 w; w.x = pk2(y[0], y[1]); w.y = pk2(y[2], y[3]);
            *(u32x2*)(out + (size_t)row * 2048 + d) = w; }
    }
}

__device__ void fft1_phase(const Args& a, ldsp_t lds) {
    const int tid = threadIdx.x, lane = tid & 63, w = tid >> 6, g = lane >> 4, l15 = lane & 15;
    const bf16_t* F1 = (const bf16_t*)(a.ws + WS_F1);
    const float* TW = (const float*)(a.ws + WS_TW);
    const bf16_t* P = (const bf16_t*)(a.ws + WS_P);
    bf16_t* T1 = (bf16_t*)a.out;
    bf16x8 Af[2][4];
#pragma unroll
    for (int mt = 0; mt < 2; ++mt)
#pragma unroll
        for (int ks = 0; ks < 4; ++ks) Af[mt][ks] = *(const bf16x8*)(F1 + (32 * w + 16 * mt + l15) * 128 + 32 * ks + 8 * g);
    constexpr int ZS = 272;
    const int cp = tid & 63, sg = tid >> 6;
    unsigned buf[16];
    int tile = blockIdx.x;
    if (tile < 2048) { const int cb = tile & 7, s_lo = (tile >> 3) & 127, b = tile >> 10;
        const bf16_t* src = P + (size_t)(b * S_ + s_lo) * PW + PC_Z + cb * 128 + 2 * cp;
#pragma unroll
        for (int i = 0; i < 16; ++i) buf[i] = *(const unsigned*)(src + (size_t)(sg + 8 * i) * 128 * PW); }
    for (; tile < 2048; tile += gridDim.x) {
        const int cb = tile & 7, s_lo = (tile >> 3) & 127, b = tile >> 10;
        __syncthreads();
#pragma unroll
        for (int i = 0; i < 16; ++i) { const int sh = sg + 8 * i;
            *(LAS unsigned short*)(lds + (2 * cp) * ZS + sh * 2) = (unsigned short)(buf[i] & 0xffffu);
            *(LAS unsigned short*)(lds + (2 * cp + 1) * ZS + sh * 2) = (unsigned short)(buf[i] >> 16); }
        __syncthreads();
        { const int nt_ = tile + gridDim.x;
          if (nt_ < 2048) { const int cb2 = nt_ & 7, s2 = (nt_ >> 3) & 127, b2 = nt_ >> 10;
            const bf16_t* src = P + (size_t)(b2 * S_ + s2) * PW + PC_Z + cb2 * 128 + 2 * cp;
#pragma unroll
            for (int i = 0; i < 16; ++i) buf[i] = *(const unsigned*)(src + (size_t)(sg + 8 * i) * 128 * PW); } }
        f32x4 acc[2][8];
#pragma unroll
        for (int mt = 0; mt < 2; ++mt)
#pragma unroll
            for (int nt = 0; nt < 8; ++nt) acc[mt][nt] = (f32x4){0.f, 0.f, 0.f, 0.f};
#pragma unroll
        for (int nt = 0; nt < 8; ++nt)
#pragma unroll
            for (int ks = 0; ks < 4; ++ks) { const bf16x8 bfr = *(const LAS bf16x8*)(lds + (16 * nt + l15) * ZS + (32 * ks + 8 * g) * 2);
                acc[0][nt] = __builtin_amdgcn_mfma_f32_16x16x32_bf16(Af[0][ks], bfr, acc[0][nt], 0, 0, 0);
                acc[1][nt] = __builtin_amdgcn_mfma_f32_16x16x32_bf16(Af[1][ks], bfr, acc[1][nt], 0, 0, 0); }
#pragma unroll
        for (int r = 0; r < 4; ++r) { const int k_lo = 16 * w + 4 * g + r;
            const f32x2 cs = *(const f32x2*)(TW + 2 * (k_lo * 128 + s_lo));
            bf16_t* dst = T1 + ((size_t)((b * 128 + k_lo) * 128 + s_lo) * 2) * 1024 + cb * 128 + l15;
#pragma unroll
            for (int nt = 0; nt < 8; ++nt) { const float tr = acc[0][nt][r], ti = acc[1][nt][r];
                dst[16 * nt] = (bf16_t)f2bf(tr * cs.x + ti * cs.y);
                dst[1024 + 16 * nt] = (bf16_t)f2bf(ti * cs.x - tr * cs.y); } }
    }
}

__device__ void fft2_phase(const Args& a, ldsp_t lds) {
    const int tid = threadIdx.x, lane = tid & 63, w = tid >> 6, g = lane >> 4, l15 = lane & 15;
    const bf16_t* F2 = (const bf16_t*)(a.ws + WS_F2);
    const bf16_t* T1 = (const bf16_t*)a.out;
    bf16_t* ZA = (bf16_t*)a.out + (size_t)T_ * 2048;
    bf16x8 Af[2][8];
#pragma unroll
    for (int mt = 0; mt < 2; ++mt)
#pragma unroll
        for (int ks = 0; ks < 8; ++ks) Af[mt][ks] = *(const bf16x8*)(F2 + (32 * w + 16 * mt + l15) * 256 + 32 * ks + 8 * g);
    constexpr int ZS = 528;
    const int cp = tid & 63, kg = tid >> 6;
    for (int tile = blockIdx.x; tile < 2048; tile += gridDim.x) {
        const int cb = tile & 7, k_lo = (tile >> 3) & 127, b = tile >> 10;
        const bf16_t* src = T1 + ((size_t)(b * 128 + k_lo) * 256) * 1024 + cb * 128 + 2 * cp;
        __syncthreads();
#pragma unroll 8
        for (int i = 0; i < 32; ++i) { const int kk = kg + 8 * i; const unsigned v = *(const unsigned*)(src + (size_t)kk * 1024);
            *(LAS unsigned short*)(lds + (2 * cp) * ZS + kk * 2) = (unsigned short)(v & 0xffffu);
            *(LAS unsigned short*)(lds + (2 * cp + 1) * ZS + kk * 2) = (unsigned short)(v >> 16); }
        __syncthreads();
        f32x4 acc[2][8];
#pragma unroll
        for (int mt = 0; mt < 2; ++mt)
#pragma unroll
            for (int nt = 0; nt < 8; ++nt) acc[mt][nt] = (f32x4){0.f, 0.f, 0.f, 0.f};
#pragma unroll
        for (int nt = 0; nt < 8; ++nt)
#pragma unroll
            for (int ks = 0; ks < 8; ++ks) { const bf16x8 bfr = *(const LAS bf16x8*)(lds + (16 * nt + l15) * ZS + (32 * ks + 8 * g) * 2);
                acc[0][nt] = __builtin_amdgcn_mfma_f32_16x16x32_bf16(Af[0][ks], bfr, acc[0][nt], 0, 0, 0);
                acc[1][nt] = __builtin_amdgcn_mfma_f32_16x16x32_bf16(Af[1][ks], bfr, acc[1][nt], 0, 0, 0); }
#pragma unroll
        for (int r = 0; r < 4; ++r) { const int k_hi = 16 * w + 4 * g + r;
            bf16_t* dst = ZA + (size_t)(b * S_ + 128 * k_hi + k_lo) * 2048 + cb * 128 + l15;
#pragma unroll
            for (int nt = 0; nt < 8; ++nt) { dst[16 * nt] = (bf16_t)f2bf(acc[0][nt][r]); dst[1024 + 16 * nt] = (bf16_t)f2bf(acc[1][nt][r]); } }
    }
}

__device__ __forceinline__ void gla_task_decode(int task, int& stream, int& eh, int& sg) {
    const int u = task & 255, i = task >> 8; stream = u >> 4; eh = i; sg = i ? 15 - (u & 15) : (u & 15);
}
__device__ __forceinline__ int gla_task_encode(int stream, int eh, int sg) { return eh * 256 + stream * 16 + (eh ? 15 - sg : sg); }

template <bool PB>
__device__ void gla_phase(const Args& a, ldsp_t lds) {
    const int tid = threadIdx.x, lane = tid & 63, w = tid >> 6, g = lane >> 4, l15 = lane & 15;
    const int d = tid & 127, tg = tid >> 7;
    const bf16_t* P = (const bf16_t*)(a.ws + WS_P);
    float* Lbuf = (float*)(a.ws + WS_L);
    float* DSEG = (float*)(a.ws + WS_DSEG);
    bf16_t* O = (bf16_t*)(a.ws + WS_O);
    constexpr int QS = 272, JS = 144;
    constexpr int OFF_QS = 0, OFF_KS = OFF_QS + 64 * QS, OFF_KDT = OFF_KS + 64 * QS, OFF_VT = OFF_KDT + 128 * JS, OFF_AS = OFF_VT + 128 * JS,
                  OFF_SB = OFF_AS + 64 * JS, OFF_A1 = OFF_SB + 128 * QS, OFF_TOT = OFF_A1 + 2048, OFF_DS = OFF_TOT + 2048, OFF_END = OFF_DS + 512;
    static_assert(OFF_END <= LDS_BYTES, "GLA LDS");
    LAS float* tot = (LAS float*)(lds + OFF_TOT);
    LAS float* dSv = (LAS float*)(lds + OFF_DS);

    for (int task = blockIdx.x; task < 512; task += gridDim.x) {
        int stream, eh, sg; gla_task_decode(task, stream, eh, sg);
        const int dir = stream & 1, h = (stream >> 1) & 3, b = stream >> 3;
        float wa[16];
#pragma unroll
        for (int r = 0; r < 16; ++r) wa[r] = a.in[I_WA2][(size_t)(dir * 16 + r) * 512 + h * 128 + d];
        const float ba = a.in[I_BA][dir * 512 + h * 128 + d];
        f32x4 Sst[8];
#pragma unroll
        for (int mt = 0; mt < 8; ++mt) Sst[mt] = (f32x4){0.f, 0.f, 0.f, 0.f};
        if (PB) {
            for (int sp = 0; sp < sg; ++sp) {
                const float* Lp = Lbuf + (size_t)gla_task_encode(stream, eh, sp) * 16384;
                const float* Dp = DSEG + (stream * 16 + sp) * 128;
#pragma unroll
                for (int mt = 0; mt < 8; ++mt) { const f32x4 dl = *(const f32x4*)(Dp + 16 * mt + 4 * g);
#pragma unroll
                    for (int r = 0; r < 4; ++r) Sst[mt][r] = Sst[mt][r] * __expf(dl[r]) + Lp[(mt * 4 + r) * 512 + tid]; }
            }
            __syncthreads();
#pragma unroll
            for (int mt = 0; mt < 8; ++mt) { u32x2 pw; pw.x = pk2(Sst[mt][0], Sst[mt][1]); pw.y = pk2(Sst[mt][2], Sst[mt][3]);
                *(LAS u32x2*)(lds + OFF_SB + (16 * w + l15) * QS + (16 * mt + 4 * g) * 2) = pw; }
        }
        float logD = 0.f;
        for (int ci = 0; ci < 16; ++ci) {
            const int tau0 = sg * 1024 + ci * 64;
            if (tid < 128) { const int i = tid >> 1, hf = tid & 1, tau = tau0 + i, t = dir ? (S_ - 1 - tau) : tau;
                const u32x4 v = *(const u32x4*)(P + (size_t)(b * S_ + t) * PW + PC_A1 + dir * 16 + hf * 8);
                *(LAS u32x4*)(lds + OFF_A1 + i * 32 + hf * 16) = v; }
            __syncthreads();
            float wv[16]; float run = 0.f;
#pragma unroll
            for (int ii = 0; ii < 16; ++ii) { const int i = 16 * tg + ii;
                const u32x4 p0 = *(const LAS u32x4*)(lds + OFF_A1 + i * 32), p1 = *(const LAS u32x4*)(lds + OFF_A1 + i * 32 + 16);
                const unsigned pw[8] = {p0.x, p0.y, p0.z, p0.w, p1.x, p1.y, p1.z, p1.w};
                float z = ba;
#pragma unroll
                for (int r = 0; r < 8; ++r) z += bflo(pw[r]) * wa[2 * r] + bfhi(pw[r]) * wa[2 * r + 1];
                const float ls = fminf(z, 0.f) - log1pf(__expf(-fabsf(z)));
                run += ls * (1.0f / 16.0f); wv[ii] = run; }
            tot[tg * 128 + d] = run;
            __syncthreads();
            float pre = 0.f, blast = 0.f;
#pragma unroll
            for (int q = 0; q < 4; ++q) { const float tq = tot[q * 128 + d]; blast += tq; pre += (q < tg) ? tq : 0.f; }
            if (tg == 0) { dSv[d] = __expf(blast); logD += blast; }
#pragma unroll
            for (int ii = 0; ii < 16; ++ii) { const int i = 16 * tg + ii, tau = tau0 + i, t = dir ? (S_ - 1 - tau) : tau;
                const bf16_t* prow = P + (size_t)(b * S_ + t) * PW;
                const float bi = pre + wv[ii];
                const float kv = bf2f(prow[PC_K + h * 128 + d]);
                if (PB) { const float qv = bf2f(prow[PC_Q + h * 128 + d]);
                    *(LAS unsigned short*)(lds + OFF_QS + i * QS + d * 2) = (unsigned short)f2bf(qv * 0.08838834764831845f * __expf(bi));
                    *(LAS unsigned short*)(lds + OFF_KS + i * QS + d * 2) = (unsigned short)f2bf(kv * __expf(-bi)); }
                *(LAS unsigned short*)(lds + OFF_KDT + d * JS + i * 2) = (unsigned short)f2bf(kv * __expf(blast - bi));
                *(LAS unsigned short*)(lds + OFF_VT + d * JS + i * 2) = prow[PC_V + h * 256 + eh * 128 + d]; }
            __syncthreads();
            f32x4 oacc[4];
            if (PB) {
#pragma unroll
                for (int q = 0; q < 2; ++q) { const int mt = w >> 1, nt = 2 * (w & 1) + q;
                    f32x4 sacc = {0.f, 0.f, 0.f, 0.f};
#pragma unroll
                    for (int ks = 0; ks < 4; ++ks) { const bf16x8 af = *(const LAS bf16x8*)(lds + OFF_QS + (16 * mt + l15) * QS + (32 * ks + 8 * g) * 2);
                        const bf16x8 bf = *(const LAS bf16x8*)(lds + OFF_KS + (16 * nt + l15) * QS + (32 * ks + 8 * g) * 2);
                        sacc = __builtin_amdgcn_mfma_f32_16x16x32_bf16(af, bf, sacc, 0, 0, 0); }
#pragma unroll
                    for (int r = 0; r < 4; ++r) { const int i = 16 * mt + 4 * g + r, j = 16 * nt + l15;
                        *(LAS unsigned short*)(lds + OFF_AS + i * JS + j * 2) = (unsigned short)f2bf(j <= i ? sacc[r] : 0.f); } }
                __syncthreads();
#pragma unroll
                for (int mt = 0; mt < 4; ++mt) oacc[mt] = (f32x4){0.f, 0.f, 0.f, 0.f};
#pragma unroll
                for (int ks = 0; ks < 4; ++ks) { const bf16x8 bf = *(const LAS bf16x8*)(lds + OFF_SB + (16 * w + l15) * QS + (32 * ks + 8 * g) * 2);
#pragma unroll
                    for (int mt = 0; mt < 4; ++mt) { const bf16x8 af = *(const LAS bf16x8*)(lds + OFF_QS + (16 * mt + l15) * QS + (32 * ks + 8 * g) * 2);
                        oacc[mt] = __builtin_amdgcn_mfma_f32_16x16x32_bf16(af, bf, oacc[mt], 0, 0, 0); } }
#pragma unroll
                for (int ks = 0; ks < 2; ++ks) { const bf16x8 bf = *(const LAS bf16x8*)(lds + OFF_VT + (16 * w + l15) * JS + (32 * ks + 8 * g) * 2);
#pragma unroll
                    for (int mt = 0; mt < 4; ++mt) { const bf16x8 af = *(const LAS bf16x8*)(lds + OFF_AS + (16 * mt + l15) * JS + (32 * ks + 8 * g) * 2);
                        oacc[mt] = __builtin_amdgcn_mfma_f32_16x16x32_bf16(af, bf, oacc[mt], 0, 0, 0); } }
            }
#pragma unroll
            for (int mt = 0; mt < 8; ++mt) { const f32x4 dsc = *(const LAS f32x4*)(lds + OFF_DS + (16 * mt + 4 * g) * 4);
                Sst[mt] = Sst[mt] * dsc; }
#pragma unroll
            for (int ks = 0; ks < 2; ++ks) { const bf16x8 bf = *(const LAS bf16x8*)(lds + OFF_VT + (16 * w + l15) * JS + (32 * ks + 8 * g) * 2);
#pragma unroll
                for (int mt = 0; mt < 8; ++mt) { const bf16x8 af = *(const LAS bf16x8*)(lds + OFF_KDT + (16 * mt + l15) * JS + (32 * ks + 8 * g) * 2);
                    Sst[mt] = __builtin_amdgcn_mfma_f32_16x16x32_bf16(af, bf, Sst[mt], 0, 0, 0); } }
            if (PB) {
                __syncthreads();
#pragma unroll
                for (int mt = 0; mt < 8; ++mt) { u32x2 pw; pw.x = pk2(Sst[mt][0], Sst[mt][1]); pw.y = pk2(Sst[mt][2], Sst[mt][3]);
                    *(LAS u32x2*)(lds + OFF_SB + (16 * w + l15) * QS + (16 * mt + 4 * g) * 2) = pw; }
#pragma unroll
                for (int mt = 0; mt < 4; ++mt)
#pragma unroll
                    for (int r = 0; r < 4; ++r) { const int i = 16 * mt + 4 * g + r, tau = tau0 + i, t = dir ? (S_ - 1 - tau) : tau;
                        O[((size_t)dir * T_ + (size_t)(b * S_ + t)) * 1024 + h * 256 + eh * 128 + 16 * w + l15] = (bf16_t)f2bf(oacc[mt][r]); }
            }
        }
        if (!PB) {
            float* Lp = Lbuf + (size_t)task * 16384;
#pragma unroll
            for (int mt = 0; mt < 8; ++mt)
#pragma unroll
                for (int r = 0; r < 4; ++r) Lp[(mt * 4 + r) * 512 + tid] = Sst[mt][r];
            if (tg == 0 && eh == 0) DSEG[(stream * 16 + sg) * 128 + d] = logD;
        }
        __syncthreads();
    }
}

__device__ void gla_post_phase(const Args& a) {
    const int lane = threadIdx.x & 63, wave = threadIdx.x >> 6, W = gridDim.x * 8;
    const bf16_t* O = (const bf16_t*)(a.ws + WS_O);
    const bf16_t* P = (const bf16_t*)(a.ws + WS_P);
    bf16_t* GO = (bf16_t*)(a.ws + WS_XN);
    const float* ng = a.in[I_GNG];
    for (int row = blockIdx.x * 8 + wave; row < T_; row += W) {
        const int e0 = lane * 16;
        float v[16]; float ss = 0.f;
#pragma unroll
        for (int q = 0; q < 2; ++q) { const u32x4 f = *(const u32x4*)(O + (size_t)row * 1024 + e0 + 8 * q), bk = *(const u32x4*)(O + ((size_t)T_ + row) * 1024 + e0 + 8 * q);
            const unsigned fw[4] = {f.x, f.y, f.z, f.w}, bw[4] = {bk.x, bk.y, bk.z, bk.w};
#pragma unroll
            for (int j = 0; j < 4; ++j) { v[8 * q + 2 * j] = bflo(fw[j]) + bflo(bw[j]); v[8 * q + 2 * j + 1] = bfhi(fw[j]) + bfhi(bw[j]); } }
#pragma unroll
        for (int j = 0; j < 16; ++j) ss += v[j] * v[j];
#pragma unroll
        for (int o = 8; o >= 1; o >>= 1) ss += __shfl_xor(ss, o);
        const float rstd = rsqrtf(ss * (1.0f / 256.0f) + EPS);
        unsigned ow[8];
#pragma unroll
        for (int q = 0; q < 2; ++q) { const u32x4 rr = *(const u32x4*)(P + (size_t)row * PW + PC_R + e0 + 8 * q); const unsigned rw[4] = {rr.x, rr.y, rr.z, rr.w};
#pragma unroll
            for (int j = 0; j < 4; ++j) { const int e = (e0 + 8 * q + 2 * j) & 255;
                const float r0 = bflo(rw[j]), r1 = bfhi(rw[j]);
                const float y0 = v[8 * q + 2 * j] * rstd * ng[e] * (r0 * sigmoidf_(r0)), y1 = v[8 * q + 2 * j + 1] * rstd * ng[e + 1] * (r1 * sigmoidf_(r1));
                ow[4 * q + j] = pk2(y0, y1); } }
        *(u32x4*)(GO + (size_t)row * 1024 + e0) = (u32x4){ow[0], ow[1], ow[2], ow[3]};
        *(u32x4*)(GO + (size_t)row * 1024 + e0 + 8) = (u32x4){ow[4], ow[5], ow[6], ow[7]};
    }
}

__device__ __forceinline__ unsigned f2ord(float f) { const unsigned u = __float_as_uint(f); return (u & 0x80000000u) ? ~u : (u | 0x80000000u); }
__device__ __forceinline__ float ord2f(unsigned o) { return __uint_as_float((o & 0x80000000u) ? (o & 0x7fffffffu) : ~o); }
#define CE_DESC(x, y) do { const unsigned _hi = max((x), (y)), _lo = min((x), (y)); (x) = _hi; (y) = _lo; } while (0)
#define CE_ASC(x, y) do { const unsigned _hi = max((x), (y)), _lo = min((x), (y)); (x) = _lo; (y) = _hi; } while (0)
template <int N> __device__ __forceinline__ void bitonic_sort_desc(unsigned (&k)[N]) {
#pragma unroll
    for (int sz = 2; sz <= N; sz <<= 1)
#pragma unroll
        for (int j = sz >> 1; j > 0; j >>= 1)
#pragma unroll
            for (int i = 0; i < N; ++i) { const int l = i ^ j; if (l > i) { if ((i & sz) == 0) CE_DESC(k[i], k[l]); else CE_ASC(k[i], k[l]); } }
}
template <int N> __device__ __forceinline__ void bitonic_merge_desc(unsigned (&k)[N]) {
#pragma unroll
    for (int j = N >> 1; j > 0; j >>= 1)
#pragma unroll
        for (int i = 0; i < N; ++i) { const int l = i ^ j; if (l > i) CE_DESC(k[i], k[l]); }
}
#define CE2_DESC(kx, px, ky, py) do { const bool _sw = (ky) > (kx); const unsigned _k0 = _sw ? (ky) : (kx), _k1 = _sw ? (kx) : (ky), _p0 = _sw ? (py) : (px), _p1 = _sw ? (px) : (py); \
        (kx) = _k0; (ky) = _k1; (px) = _p0; (py) = _p1; } while (0)
template <int N> __device__ __forceinline__ void bitonic_sort_desc2(unsigned (&k)[N], unsigned (&p)[N]) {
#pragma unroll
    for (int sz = 2; sz <= N; sz <<= 1)
#pragma unroll
        for (int j = sz >> 1; j > 0; j >>= 1)
#pragma unroll
            for (int i = 0; i < N; ++i) { const int l = i ^ j; if (l > i) { if ((i & sz) == 0) CE2_DESC(k[i], p[i], k[l], p[l]); else CE2_DESC(k[l], p[l], k[i], p[i]); } }
}
template <int N> __device__ __forceinline__ void bitonic_merge_desc2(unsigned (&k)[N], unsigned (&p)[N]) {
#pragma unroll
    for (int j = N >> 1; j > 0; j >>= 1)
#pragma unroll
        for (int i = 0; i < N; ++i) { const int l = i ^ j; if (l > i) CE2_DESC(k[i], p[i], k[l], p[l]); }
}
__device__ __forceinline__ void lane_merge16(unsigned (&k)[16], int xm) {
    unsigned o[16];
#pragma unroll
    for (int i = 0; i < 16; ++i) o[i] = (unsigned)__shfl_xor((int)k[i], xm);
#pragma unroll
    for (int i = 0; i < 16; ++i) k[i] = max(k[i], o[15 - i]);
    bitonic_merge_desc<16>(k);
}
__device__ __forceinline__ void lane_merge16_2(unsigned (&k)[16], unsigned (&p)[16], int xm) {
    unsigned ok[16], op[16];
#pragma unroll
    for (int i = 0; i < 16; ++i) { ok[i] = (unsigned)__shfl_xor((int)k[i], xm); op[i] = (unsigned)__shfl_xor((int)p[i], xm); }
#pragma unroll
    for (int i = 0; i < 16; ++i) { const bool sw = ok[15 - i] > k[i]; k[i] = sw ? ok[15 - i] : k[i]; p[i] = sw ? op[15 - i] : p[i]; }
    bitonic_merge_desc2<16>(k, p);
}

__device__ void peer_select_phase(const Args& a, ldsp_t lds) {
    const int lane = threadIdx.x & 63, wave = threadIdx.x >> 6, g = lane >> 4, l15 = lane & 15, W = gridDim.x * 8;
    const bf16_t* QP = (const bf16_t*)(a.ws + WS_QP);
    const bf16_t* KB = (const bf16_t*)(a.ws + WS_KEYS);
    int* IDX = (int*)(a.ws + WS_IDX); float* GW = (float*)(a.ws + WS_G);
    for (int item = blockIdx.x * 8 + wave; item < 2048 * 8; item += W) {
        const int tok0 = (item >> 3) * 16, h = item & 7, tok = tok0 + l15;
        LAS unsigned* tl = (LAS unsigned*)(lds + wave * 8192);
#pragma unroll 1
        for (int hf = 0; hf < 2; ++hf) {
            bf16x8 bq[4];
#pragma unroll
            for (int ks = 0; ks < 4; ++ks) bq[ks] = *(const bf16x8*)(QP + (size_t)tok * 2048 + h * 256 + hf * 128 + 32 * ks + 8 * g);
            unsigned key[32];
#pragma unroll
            for (int mt = 0; mt < 8; ++mt) { f32x4 acc = {0.f, 0.f, 0.f, 0.f};
#pragma unroll
                for (int ks = 0; ks < 4; ++ks) { const bf16x8 af = *(const bf16x8*)(KB + (size_t)((h * 2 + hf) * 128 + 16 * mt + l15) * 128 + 32 * ks + 8 * g);
                    acc = __builtin_amdgcn_mfma_f32_16x16x32_bf16(af, bq[ks], acc, 0, 0, 0); }
#pragma unroll
                for (int r = 0; r < 4; ++r) { const int n = 16 * mt + 4 * g + r; key[4 * mt + r] = (f2ord(acc[r]) & ~127u) | (unsigned)(127 - n); }
                __builtin_amdgcn_sched_barrier(0); }
            unsigned lo[16], hi[16];
#pragma unroll
            for (int i = 0; i < 16; ++i) { lo[i] = key[i]; hi[i] = key[16 + i]; }
            bitonic_sort_desc<16>(lo); bitonic_sort_desc<16>(hi);
#pragma unroll
            for (int i = 0; i < 16; ++i) lo[i] = max(lo[i], hi[15 - i]);
            bitonic_merge_desc<16>(lo);
            lane_merge16(lo, 16); lane_merge16(lo, 32);
#pragma unroll
            for (int i = 0; i < 16; ++i) tl[(hf * 16 + i) * 64 + lane] = lo[i];
        }
        unsigned top[2][16];
#pragma unroll
        for (int i = 0; i < 16; ++i) { top[0][i] = tl[i * 64 + lane]; top[1][i] = tl[(16 + i) * 64 + lane]; }
        unsigned ck[16], cp[16];
#pragma unroll
        for (int i = 0; i < 16; ++i) { ck[i] = 0u; cp[i] = 0u; }
#define PEER_CAND(slot, I, J) do { const float _s = ord2f(top[0][I] & ~127u) + ord2f(top[1][J] & ~127u); ck[slot] = f2ord(_s); cp[slot] = ((127u - (top[0][I] & 127u)) << 7) | (127u - (top[1][J] & 127u)); } while (0)
        if (g == 0) { PEER_CAND(0, 0, 0); PEER_CAND(1, 0, 1); PEER_CAND(2, 0, 2); PEER_CAND(3, 0, 3); PEER_CAND(4, 0, 4); PEER_CAND(5, 0, 5); PEER_CAND(6, 0, 6); PEER_CAND(7, 0, 7);
            PEER_CAND(8, 0, 8); PEER_CAND(9, 0, 9); PEER_CAND(10, 0, 10); PEER_CAND(11, 0, 11); PEER_CAND(12, 0, 12); PEER_CAND(13, 0, 13); PEER_CAND(14, 0, 14); PEER_CAND(15, 0, 15); }
        else if (g == 1) { PEER_CAND(0, 1, 0); PEER_CAND(1, 1, 1); PEER_CAND(2, 1, 2); PEER_CAND(3, 1, 3); PEER_CAND(4, 1, 4); PEER_CAND(5, 1, 5); PEER_CAND(6, 1, 6); PEER_CAND(7, 1, 7);
            PEER_CAND(8, 2, 0); PEER_CAND(9, 2, 1); PEER_CAND(10, 2, 2); PEER_CAND(11, 2, 3); PEER_CAND(12, 2, 4); PEER_CAND(13, 3, 0); PEER_CAND(14, 3, 1); PEER_CAND(15, 3, 2); }
        else if (g == 2) { PEER_CAND(0, 3, 3); PEER_CAND(1, 4, 0); PEER_CAND(2, 4, 1); PEER_CAND(3, 4, 2); PEER_CAND(4, 5, 0); PEER_CAND(5, 5, 1); PEER_CAND(6, 6, 0); PEER_CAND(7, 6, 1);
            PEER_CAND(8, 7, 0); PEER_CAND(9, 7, 1); PEER_CAND(10, 8, 0); PEER_CAND(11, 9, 0); PEER_CAND(12, 10, 0); PEER_CAND(13, 11, 0); PEER_CAND(14, 12, 0); PEER_CAND(15, 13, 0); }
        else { PEER_CAND(0, 14, 0); PEER_CAND(1, 15, 0); }
#undef PEER_CAND
        bitonic_sort_desc2<16>(ck, cp);
        lane_merge16_2(ck, cp, 16); lane_merge16_2(ck, cp, 32);
        float ev[16]; float sum = 0.f; const float mx = ord2f(ck[0]);
#pragma unroll
        for (int i = 0; i < 16; ++i) { ev[i] = __expf(ord2f(ck[i]) - mx); sum += ev[i]; }
        const float inv = 1.0f / sum;
#pragma unroll
        for (int i = 0; i < 16; ++i) if ((i >> 2) == g) { IDX[(size_t)tok * 128 + h * 16 + i] = (int)cp[i]; GW[(size_t)tok * 128 + h * 16 + i] = ev[i] * inv; }
    }
}

constexpr float U_SCALE = 32.0f, V_SCALE = 2.0f;
__device__ void cvt_flat_fp8(const float* src, unsigned char* dst, size_t n, float scale) {
    const size_t gt = (size_t)blockIdx.x * 512 + threadIdx.x, gs = (size_t)gridDim.x * 512;
    for (size_t i = gt * 16; i < n; i += gs * 16) {
        u32x4 w; unsigned ws_[4];
#pragma unroll
        for (int q = 0; q < 4; ++q) { const f32x4 v = *(const f32x4*)(src + i + 4 * q) * scale;
            int p = __builtin_amdgcn_cvt_pk_fp8_f32(v[0], v[1], 0, false); p = __builtin_amdgcn_cvt_pk_fp8_f32(v[2], v[3], p, true); ws_[q] = (unsigned)p; }
        w.x = ws_[0]; w.y = ws_[1]; w.z = ws_[2]; w.w = ws_[3];
        *(u32x4*)(dst + i) = w;
    }
}
__device__ __forceinline__ float gelu_erf(float x) { return 0.5f * x * (1.0f + erff(x * 0.70710678118654752f)); }
template <bool DRY> __device__ void peer_gather_phase(const Args& a) {
    const int lane = threadIdx.x & 63, wave = threadIdx.x >> 6, W = gridDim.x * 8;
    const bf16_t* XN = (const bf16_t*)(a.ws + WS_XN);
    const unsigned char* UB = a.ws + WS_UB;
    const unsigned char* VB = a.ws + WS_VB;
    const int* IDX = (const int*)(a.ws + WS_IDX); const float* GW = (const float*)(a.ws + WS_G);
    const float* mod = (const float*)(a.ws + WS_MOD);
    const float* fg = a.in[I_FNG];
    float* H = a.out;
    for (int tok = blockIdx.x * 8 + wave; tok < T_; tok += W) {
        float xf[2][16];
#pragma unroll
        for (int c = 0; c < 2; ++c)
#pragma unroll
            for (int q = 0; q < 2; ++q) { const u32x4 xv = *(const u32x4*)(XN + (size_t)tok * 2048 + (c * 64 + lane) * 16 + 8 * q); const unsigned xs[4] = {xv.x, xv.y, xv.z, xv.w};
#pragma unroll
                for (int j = 0; j < 4; ++j) { xf[c][8 * q + 2 * j] = bflo(xs[j]); xf[c][8 * q + 2 * j + 1] = bfhi(xs[j]); } }
        const int id0 = IDX[(size_t)tok * 128 + lane], id1 = IDX[(size_t)tok * 128 + 64 + lane];
        const float g0 = GW[(size_t)tok * 128 + lane], g1 = GW[(size_t)tok * 128 + 64 + lane];
        float o[2][16];
#pragma unroll
        for (int c = 0; c < 2; ++c)
#pragma unroll
            for (int j = 0; j < 16; ++j) o[c][j] = 0.f;
        for (int kk = 0; kk < 128; kk += 4) {
            int ex[4]; float gw[4];
#pragma unroll
            for (int e = 0; e < 4; ++e) { const int k = kk + e;
                ex[e] = (k < 64) ? __builtin_amdgcn_readlane(id0, k & 63) : __builtin_amdgcn_readlane(id1, k & 63);
                gw[e] = (k < 64) ? __uint_as_float(__builtin_amdgcn_readlane(__float_as_uint(g0), k & 63)) : __uint_as_float(__builtin_amdgcn_readlane(__float_as_uint(g1), k & 63)); }
            u32x4 ur[4][2], vr[4][2];
#pragma unroll
            for (int e = 0; e < 4; ++e)
#pragma unroll
                for (int c = 0; c < 2; ++c) ur[e][c] = *(const u32x4*)(UB + (size_t)ex[e] * 2048 + (c * 64 + lane) * 16);
#pragma unroll
            for (int e = 0; e < 4; ++e)
#pragma unroll
                for (int c = 0; c < 2; ++c) vr[e][c] = *(const u32x4*)(VB + (size_t)ex[e] * 2048 + (c * 64 + lane) * 16);
            float dt[4];
#pragma unroll
            for (int e = 0; e < 4; ++e) { float s = 0.f;
#pragma unroll
                for (int c = 0; c < 2; ++c) { const unsigned us[4] = {ur[e][c].x, ur[e][c].y, ur[e][c].z, ur[e][c].w};
#pragma unroll
                    for (int j = 0; j < 4; ++j) { const f32x2 l = __builtin_amdgcn_cvt_pk_f32_fp8((int)us[j], false), hh = __builtin_amdgcn_cvt_pk_f32_fp8((int)us[j], true);
                        s += l.x * xf[c][4 * j] + l.y * xf[c][4 * j + 1] + hh.x * xf[c][4 * j + 2] + hh.y * xf[c][4 * j + 3]; } }
                dt[e] = s; }
#pragma unroll
            for (int off = 32; off >= 1; off >>= 1)
#pragma unroll
                for (int e = 0; e < 4; ++e) dt[e] += __shfl_xor(dt[e], off);
#pragma unroll
            for (int e = 0; e < 4; ++e) { const float cf = gw[e] * gelu_erf(dt[e] * (1.0f / U_SCALE)) * (1.0f / V_SCALE);
#pragma unroll
                for (int c = 0; c < 2; ++c) { const unsigned vs[4] = {vr[e][c].x, vr[e][c].y, vr[e][c].z, vr[e][c].w};
#pragma unroll
                    for (int j = 0; j < 4; ++j) { const f32x2 l = __builtin_amdgcn_cvt_pk_f32_fp8((int)vs[j], false), hh = __builtin_amdgcn_cvt_pk_f32_fp8((int)vs[j], true);
                        o[c][4 * j] += cf * l.x; o[c][4 * j + 1] += cf * l.y; o[c][4 * j + 2] += cf * hh.x; o[c][4 * j + 3] += cf * hh.y; } } }
        }
        const int b = tok >> 14; float ss = 0.f;
#pragma unroll
        for (int c = 0; c < 2; ++c)
#pragma unroll
            for (int q = 0; q < 4; ++q) { const int d0 = (c * 64 + lane) * 16 + 4 * q;
                const f32x4 h0 = *(const f32x4*)(H + (size_t)tok * 2048 + d0), q0 = *(const f32x4*)(mod + b * 12288 + 5 * 2048 + d0);
#pragma unroll
                for (int j = 0; j < 4; ++j) { const float hv = h0[j] + q0[j] * o[c][4 * q + j]; o[c][4 * q + j] = hv; ss += hv * hv; } }
        ss = wave_sum(ss);
        const float rstd = rsqrtf(ss * (1.0f / 2048.0f) + EPS);
#pragma unroll
        for (int c = 0; c < 2; ++c)
#pragma unroll
            for (int q = 0; q < 4; ++q) { const int d0 = (c * 64 + lane) * 16 + 4 * q;
                const f32x4 f0 = *(const f32x4*)(fg + d0); f32x4 r0;
#pragma unroll
                for (int j = 0; j < 4; ++j) r0[j] = o[c][4 * q + j] * rstd * f0[j];
                if (!DRY || rstd < 0.f) *(f32x4*)(H + (size_t)tok * 2048 + d0) = r0; }
    }
}

__global__ void __launch_bounds__(512, 2) mega(Args a) {
    extern __shared__ __attribute__((aligned(16))) unsigned char lds_raw[];
    ldsp_t lds = (ldsp_t)lds_raw;
    cg::grid_group grid = cg::this_grid();
    const int lo = a.ph_lo, hi = a.ph_hi;
    unsigned char* ws = a.ws;
    const float* mod = (const float*)(ws + WS_MOD);
#ifdef ONLY_PHASE
#define IN(k) ((k) == ONLY_PHASE && lo <= (k) && (k) < hi)
#else
#define IN(k) (lo <= (k) && (k) < hi)
#endif
    volatile LAS unsigned* bst = (volatile LAS unsigned*)(lds + LDS_BYTES - 16);
    if (threadIdx.x == 0) { bst[0] = 0u; bst[1] = 0u; }
    __syncthreads();
    XcdBarrier xbar = xcd_barrier_post((unsigned*)(ws + WS_CTL), bst);
#define SEAM(k) do { if (IN(k) && IN((k) + 1)) { if ((k) == 0) grid.sync(); else xcd_barrier(xbar); } } while (0)
#ifndef DUP_PHASE
#define DUP_PHASE (-1)
#endif
#define REP(k) for (int rep_ = 0; rep_ < ((DUP_PHASE == (k)) ? 2 : 1); ++rep_)

    if (IN(0)) REP(0) phase0(a, lds);
    SEAM(0);
    if (IN(1)) REP(1) norm_phase(a.in[I_X], a.in[I_N1G], mod, mod + 2048, (bf16_t*)(ws + WS_XN));
    SEAM(1);
    if (IN(2)) REP(2) {
        pg8::Gemm g{(const bf16_t*)(ws + WS_XN), (const bf16_t*)(ws + WS_WIN), T_, PW, 2048, 2048};
        pg8::StaticOrder S; S.init(T_, PW, gridDim.x, blockIdx.x);
        pg8::EpiIn E{(bf16_t*)(ws + WS_P)};
        pg8::gemm_phase(lds, g, S, E);
    }
    SEAM(2);
    if (IN(3)) REP(3) { fft1_phase(a, lds); __syncthreads(); gla_phase<false>(a, lds); }
    SEAM(3);
    if (IN(4)) REP(4) { fft2_phase(a, lds); __syncthreads(); gla_phase<true>(a, lds); }
    SEAM(4);
    if (IN(5)) REP(5) gla_post_phase(a);
    SEAM(5);
    if (IN(6)) REP(6) {
        {
            pg8::Gemm g{(const bf16_t*)a.out + (size_t)T_ * 2048, (const bf16_t*)(ws + WS_WFN), T_, 2048, 2048, 2048};
            pg8::StaticOrder S; S.init(T_, 2048, gridDim.x, blockIdx.x);
            pg8::EpiGate<0> E{(bf16_t*)(ws + WS_O), 2048, (const bf16_t*)(ws + WS_P) + PC_GF, PW};
            pg8::gemm_phase(lds, g, S, E);
        }
        {
            pg8::Gemm g{(const bf16_t*)(ws + WS_XN), (const bf16_t*)(ws + WS_WGLA), T_, 2048, 1024, 1024};
            pg8::StaticOrder S; S.init(T_, 2048, gridDim.x, blockIdx.x);
            pg8::EpiGate<1> E{(bf16_t*)(ws + WS_O), 2048, (const bf16_t*)(ws + WS_P) + PC_GG, PW};
            pg8::gemm_phase(lds, g, S, E);
        }
    }
    SEAM(6);
    if (IN(7)) REP(7) {
        pg8::Gemm g{(const bf16_t*)(ws + WS_O), (const bf16_t*)(ws + WS_WOUT), T_, 2048, 2048, 2048};
        pg8::StaticOrder S; S.init(T_, 2048, gridDim.x, blockIdx.x);
        pg8::EpiRes E{a.in[I_X], mod + 2 * 2048, a.out};
        pg8::gemm_phase(lds, g, S, E);
    }
    SEAM(7);
    if (IN(8)) REP(8) {
        norm_phase(a.out, a.in[I_N2G], mod + 3 * 2048, mod + 4 * 2048, (bf16_t*)(ws + WS_XN));
        cvt_flat_fp8(a.in[I_U], ws + WS_UB, (size_t)16384 * 2048, U_SCALE);
        cvt_flat_fp8(a.in[I_V], ws + WS_VB, (size_t)16384 * 2048, V_SCALE);
    }
    SEAM(8);
    if (IN(9)) REP(9) {
        pg8::Gemm g{(const bf16_t*)(ws + WS_XN), (const bf16_t*)(ws + WS_WQ), T_, 2048, 2048, 2048};
        pg8::StaticOrder S; S.init(T_, 2048, gridDim.x, blockIdx.x);
        pg8::EpiGate<2> E{(bf16_t*)(ws + WS_QP), 2048, nullptr, 0};
        pg8::gemm_phase(lds, g, S, E);
    }
    SEAM(9);
    if (IN(10)) REP(10) peer_select_phase(a, lds);
    SEAM(10);
    if (IN(11)) { if (DUP_PHASE == 11) peer_gather_phase<true>(a); peer_gather_phase<false>(a); }
#undef IN
#undef SEAM
}

constexpr int N_PHASES = 12;

extern "C" void kernel_launch(void* const* d_in, const int* in_sizes, int n_in, void* d_out, int out_size, void* d_ws, size_t ws_size, hipStream_t stream) {
    static int grid = 0;
    if (grid == 0) {
        int dev = 0, cus = 0, per_cu = 0;
        (void)hipGetDevice(&dev);
        (void)hipDeviceGetAttribute(&cus, hipDeviceAttributeMultiprocessorCount, dev);
        (void)hipFuncSetAttribute((const void*)mega, hipFuncAttributeMaxDynamicSharedMemorySize, LDS_BYTES);
        (void)hipOccupancyMaxActiveBlocksPerMultiprocessor(&per_cu, (const void*)mega, 512, LDS_BYTES);
        if (per_cu < 1 || n_in != 18 || ws_size < WS_END) { fprintf(stderr, "kernel_launch: unexpected configuration (per_cu %d, n_in %d, ws %zu)\n", per_cu, n_in, ws_size); grid = -1; return; }
        grid = cus;
    }
    if (grid < 0) return;
    (void)hipMemsetAsync((char*)d_ws + WS_CTL, 0, XCD_BAR_WORDS * 4, stream);
    Args a{};
    for (int i = 0; i < 18; ++i) a.in[i] = (const float*)d_in[i];
    a.out = (float*)d_out; a.ws = (unsigned char*)d_ws;
#if N_PHASE_LAUNCH
    for (int p = 0; p < N_PHASES; ++p) { a.ph_lo = p; a.ph_hi = p + 1;
        void* args[] = {&a};
        hipError_t e = hipLaunchCooperativeKernel((void*)mega, dim3(grid), dim3(512), args, LDS_BYTES, stream);
        if (e != hipSuccess) fprintf(stderr, "launch %d failed: %s\n", p, hipGetErrorString(e)); }
#else
    a.ph_lo = 0; a.ph_hi = N_PHASES;
    void* args[] = {&a};
    hipError_t e = hipLaunchCooperativeKernel((void*)mega, dim3(grid), dim3(512), args, LDS_BYTES, stream);
    if (e != hipSuccess) fprintf(stderr, "cooperative launch failed: %s (grid %d)\n", hipGetErrorString(e), grid);
#endif
}
```

```cpp
#include <hip/hip_runtime.h>
#include <hip/hip_cooperative_groups.h>
#include <cstdio>
namespace cg = cooperative_groups;

#define LAS __attribute__((address_space(3)))
typedef unsigned short bf16_t;
typedef short bf16x8 __attribute__((ext_vector_type(8)));
typedef float f32x4 __attribute__((ext_vector_type(4)));
typedef float f32x2 __attribute__((ext_vector_type(2)));
typedef unsigned u32x4 __attribute__((ext_vector_type(4)));
typedef unsigned u32x2 __attribute__((ext_vector_type(2)));
typedef LAS unsigned char* ldsp_t;

#ifndef N_PHASE_LAUNCH
#define N_PHASE_LAUNCH 0
#endif

constexpr int T_ = 32768, D_ = 2048, S_ = 16384;
constexpr float EPS = 1e-6f;
constexpr int PW = 8448;
constexpr int PC_Z = 0, PC_Q = 1024, PC_K = 1536, PC_V = 2048, PC_R = 3072, PC_GF = 4096, PC_GG = 6144, PC_A1 = 8192;
constexpr int LDS_BYTES = 147456;

constexpr size_t WS_CTL  = 0;
constexpr size_t WS_MOD  = 65536;
constexpr size_t WS_TW   = WS_MOD + 98304;
constexpr size_t WS_F1   = WS_TW + 131072;
constexpr size_t WS_F2   = WS_F1 + 65536;
constexpr size_t WS_DSEG = WS_F2 + 131072;
constexpr size_t WS_WIN  = WS_DSEG + 131072;
constexpr size_t WS_WFN  = WS_WIN + (size_t)8448 * 2048 * 2;
constexpr size_t WS_WGLA = WS_WFN + (size_t)2048 * 2048 * 2;
constexpr size_t WS_WOUT = WS_WGLA + (size_t)2048 * 1024 * 2;
constexpr size_t WS_WQ   = WS_WOUT + (size_t)2048 * 2048 * 2;
constexpr size_t WS_KEYS = WS_WQ + (size_t)2048 * 2048 * 2;
constexpr size_t WS_L    = WS_KEYS + (size_t)8 * 2 * 128 * 128 * 2;
constexpr size_t WS_XN   = WS_L + (size_t)512 * 16384 * 4;
constexpr size_t WS_O    = WS_XN + (size_t)T_ * 2048 * 2;
constexpr size_t WS_P    = WS_O + (size_t)T_ * 2048 * 2;
constexpr size_t WS_QP   = WS_P;
constexpr size_t WS_IDX  = WS_QP + (size_t)T_ * 2048 * 2;
constexpr size_t WS_G    = WS_IDX + (size_t)T_ * 128 * 4;
constexpr size_t WS_UB   = WS_G + (size_t)T_ * 128 * 4;
constexpr size_t WS_VB   = WS_UB + (size_t)16384 * 2048 * 2;
constexpr size_t WS_END  = WS_P + (size_t)T_ * PW * 2;
static_assert(WS_VB + (size_t)16384 * 2048 * 2 <= WS_END, "late buffers must fit in the P region");
static_assert(WS_END <= (size_t)1000 * 1000 * 1000, "workspace budget");

struct Args { const float* in[18]; float* out; unsigned char* ws; int ph_lo, ph_hi; };
enum { I_X = 0, I_C, I_WADA, I_BADA, I_N1G, I_WIN, I_WFNET, I_WA2, I_BA, I_GNG, I_WGLA, I_WOUT, I_N2G, I_WQ, I_KEYS, I_U, I_V, I_FNG };

__device__ __forceinline__ unsigned f2bf(float f) { unsigned u = __float_as_uint(f); return (u + 0x7fffu + ((u >> 16) & 1u)) >> 16; }
__device__ __forceinline__ float bf2f(unsigned h) { return __uint_as_float(h << 16); }
__device__ __forceinline__ unsigned pk2(float lo, float hi) { return f2bf(lo) | (f2bf(hi) << 16); }
__device__ __forceinline__ float bflo(unsigned w) { return __uint_as_float(w << 16); }
__device__ __forceinline__ float bfhi(unsigned w) { return __uint_as_float(w & 0xffff0000u); }
__device__ __forceinline__ float wave_sum(float v) {
#pragma unroll
    for (int o = 32; o >= 1; o >>= 1) v += __shfl_xor(v, o);
    return v;
}
__device__ __forceinline__ float sigmoidf_(float v) { return 1.0f / (1.0f + __expf(-v)); }


#define XB_TMO      128
#define XB_XCNT(j)  (256  + 64 * (j))
#define XB_XSUB(j)  (1280 + 64 * (j))
#define XB_XGEN(j)  (2304 + 64 * (j))
#define XB_TOP      3328
#define XB_TOPGEN   3392
#define XCD_BAR_WORDS 3456
#define XB_SPIN_CAP (1u << 22)
__device__ __forceinline__ unsigned xb_ld(unsigned* p)              { return __hip_atomic_load(p, __ATOMIC_RELAXED, __HIP_MEMORY_SCOPE_AGENT); }
__device__ __forceinline__ unsigned xb_add(unsigned* p, unsigned v) { return __hip_atomic_fetch_add(p, v, __ATOMIC_RELAXED, __HIP_MEMORY_SCOPE_AGENT); }
__device__ __forceinline__ unsigned xb_xcc_id() { return (unsigned)__builtin_amdgcn_s_getreg((3 << 11) | 20) & 0xFu; }
#define XB_SPIN(cond, bar) do { unsigned _sp = 0; while (cond) { __builtin_amdgcn_s_sleep(1); \
    if ((++_sp & 255u) == 0u) { if (xb_ld(&(bar)[XB_TMO])) break; if (_sp > XB_SPIN_CAP) { atomicAdd(&(bar)[XB_TMO], 1u); break; } } } } while (0)
struct XcdBarrier { unsigned* bar; unsigned x; volatile LAS unsigned* st; };
__device__ __forceinline__ XcdBarrier xcd_barrier_post(unsigned* bar, volatile LAS unsigned* st) {
    XcdBarrier b; b.bar = bar; b.x = xb_xcc_id(); b.st = st;
    if (threadIdx.x == 0) (void)xb_add(&bar[XB_XCNT(b.x)], 1u);
    return b;
}
__device__ __forceinline__ void xcd_barrier_complete(unsigned* bar, unsigned x, unsigned& nloc, unsigned& nx) {
    const unsigned G = gridDim.x * gridDim.y * gridDim.z;
    unsigned sum, cnt, mine, sp = 0u;
    for (;;) {
        sum = 0u; cnt = 0u; mine = 0u;
#pragma unroll
        for (unsigned j = 0; j < 16; ++j) { const unsigned c = xb_ld(&bar[XB_XCNT(j)]); sum += c; cnt += (c > 0u) ? 1u : 0u; mine = (j == x) ? c : mine; }
        if (sum == G) break;
        __builtin_amdgcn_s_sleep(1);
        if ((++sp & 255u) == 0u) { if (xb_ld(&bar[XB_TMO])) break; if (sp > XB_SPIN_CAP) { atomicAdd(&bar[XB_TMO], 1u); break; } }
    }
    nloc = mine > 0u ? mine : 1u; nx = cnt > 0u ? cnt : 1u;
}
__device__ __forceinline__ void xcd_barrier(const XcdBarrier& b) {
    asm volatile("s_waitcnt vmcnt(0)" ::: "memory");
    __syncthreads();
    if (threadIdx.x == 0) {
        unsigned* bar = b.bar;
        __builtin_amdgcn_s_waitcnt(0);
        unsigned nloc = b.st[0], nx = b.st[1];
        if (nloc == 0u) { xcd_barrier_complete(bar, b.x, nloc, nx); b.st[0] = nloc; b.st[1] = nx; }
        const unsigned old = xb_add(&bar[XB_XSUB(b.x)], 1u);
        const unsigned gen = old / nloc;
        if (old + 1u == (gen + 1u) * nloc) {
            __builtin_amdgcn_fence(__ATOMIC_RELEASE, "agent");
            asm volatile("s_waitcnt vmcnt(0)" ::: "memory");
            const unsigned og = xb_add(&bar[XB_TOP], 1u);
            const unsigned tg = og / nx;
            if (og + 1u == (tg + 1u) * nx) xb_add(&bar[XB_TOPGEN], 1u);
            else XB_SPIN(xb_ld(&bar[XB_TOPGEN]) == tg, bar);
            __builtin_amdgcn_fence(__ATOMIC_ACQUIRE, "agent");
            xb_add(&bar[XB_XGEN(b.x)], 1u);
            asm volatile("s_waitcnt vmcnt(0)" ::: "memory");
        } else {
            XB_SPIN(xb_ld(&bar[XB_XGEN(b.x)]) == gen, bar);
            __builtin_amdgcn_fence(__ATOMIC_ACQUIRE, "agent");
            asm volatile("s_waitcnt vmcnt(0)" ::: "memory");
        }
    }
    __syncthreads();
}

namespace pg8 {
constexpr int BM = 256, BK = 64, HALF = 128, HTB = HALF * BK * 2, STAGE_BYTES = 8 * HTB, NXCD = 8, WGM = 8;
__device__ __forceinline__ int lds_byte(int r, int c) { const int st = (r >> 4) * 2 + (c >> 5), rr = r & 15, cc = c & 31, ob = rr * 64 + cc * 2; return st * 1024 + (ob ^ (((ob >> 9) & 1) << 5)); }
__device__ __forceinline__ void stage_rc(int b, int& R, int& C) { const int st = b / 1024, sb = b % 1024, swz = sb ^ (((sb >> 9) & 1) << 5); R = (st >> 1) * 16 + swz / 64; C = (st & 1) * 32 + (swz % 64) / 2; }
__device__ __forceinline__ int perm32(int rho) { const int n = rho >> 4, i = rho & 15; return 8 * (i >> 2) + 4 * n + (i & 3); }

struct Unit { int pm, pn; };
struct Gemm { const bf16_t* A; const bf16_t* Bt; int M, N, K, lda; };

struct StaticOrder {
    int nM, nN, nwg, G, c;
    __device__ void init(int M, int N, int G_, int c_) { nM = M / BM; nN = N / BM; nwg = nM * nN; G = G_; c = c_; }
    __device__ bool next(int i, Unit& u) const {
        const long L = (long)i * G + c; if (L >= nwg) return false;
        int wgid = (int)L; { const int q = nwg / NXCD, r = nwg % NXCD, xcd = wgid % NXCD, off = wgid / NXCD; wgid = (xcd < r ? xcd * (q + 1) : r * (q + 1) + (xcd - r) * q) + off; }
        const int nig = WGM * nN, gid = wgid / nig, fm = gid * WGM, gsz = (nM - fm) < WGM ? (nM - fm) : WGM;
        u.pm = fm + ((wgid % nig) % gsz); u.pn = (wgid % nig) / gsz; return true;
    }
};

template <class Epi>
__device__ __forceinline__ void gemm_phase(ldsp_t lds, const Gemm g, const StaticOrder& S, const Epi& E) {
    const int tid = threadIdx.x, wid = __builtin_amdgcn_readfirstlane(tid >> 6), lane = tid & 63, wr = wid >> 2, wc = wid & 3, fr = lane & 15, fq = lane >> 4;
    const int K = g.K, nt = K / BK, lda = g.lda;
    unsigned voffA[2], voffB[2];
#pragma unroll
    for (int i = 0; i < 2; ++i) { int R, C; stage_rc(tid * 16 + i * 8192, R, C); const int Rb = Epi::PERM ? ((R & ~31) + perm32(R & 31)) : R;
        voffA[i] = (unsigned)(R * lda + C) * 2u; voffB[i] = (unsigned)(Rb * K + C) * 2u; }
    const size_t kstep = (size_t)(BK * 2);
    const size_t hstepA = (size_t)HALF * lda * 2, hstepB = (size_t)HALF * K * 2;
    const size_t tstepA = 2 * hstepA, tstepB = 2 * hstepB;
    const unsigned ldsw = (unsigned)wid * 1024u;
    const int aoff = lds_byte(wr * 64 + fr, fq * 8), boff = lds_byte(wc * 32 + fr, fq * 8);
#define PG8_SA(b, h) (((b) * 2 + (h)) * HTB)
#define PG8_SB(b, h) ((4 + (b) * 2 + (h)) * HTB)
#define PG8_STAGE(bufoff, gbase, voff) do { _Pragma("unroll") for (int _i = 0; _i < 2; ++_i) \
        __builtin_amdgcn_global_load_lds((const unsigned*)((const char*)(gbase) + (voff)[_i]), (LAS unsigned*)(lds + (bufoff) + ldsw + _i * 8192), 16, 0, 0); } while (0)
#define PG8_LDA(dst, b, h) do { _Pragma("unroll") for (int m = 0; m < 4; ++m) _Pragma("unroll") for (int k = 0; k < 2; ++k) dst[m][k] = *(const LAS bf16x8*)(lds + PG8_SA(b, h) + aoff + m * 2048 + k * 1024); } while (0)
#define PG8_LDB(dst, b, h) do { _Pragma("unroll") for (int n = 0; n < 2; ++n) _Pragma("unroll") for (int k = 0; k < 2; ++k) dst[n][k] = *(const LAS bf16x8*)(lds + PG8_SB(b, h) + boff + n * 2048 + k * 1024); } while (0)
#define PG8_MMA(ai, bj, At, Bt) do { __builtin_amdgcn_s_setprio(1); _Pragma("unroll") for (int m = 0; m < 4; ++m) _Pragma("unroll") for (int n = 0; n < 2; ++n) _Pragma("unroll") for (int k = 0; k < 2; ++k) \
        acc[ai][bj][m][n] = __builtin_amdgcn_mfma_f32_16x16x32_bf16(Bt[n][k], At[m][k], acc[ai][bj][m][n], 0, 0, 0); __builtin_amdgcn_s_setprio(0); } while (0)
#define PG8_WAIT_V(n) asm volatile("s_waitcnt vmcnt(" #n ")" ::: "memory")
#define PG8_WAIT_L(n) asm volatile("s_waitcnt lgkmcnt(" #n ")" ::: "memory")
#define PG8_BAR __builtin_amdgcn_s_barrier()
#define PG8_SCHED __builtin_amdgcn_sched_barrier(0)
    Unit cur, nxt; int ui = 0;
    if (!S.next(0, cur)) return;
    f32x4 acc[2][2][4][2];
#pragma unroll
    for (int a = 0; a < 2; ++a)
#pragma unroll
        for (int b = 0; b < 2; ++b)
#pragma unroll
            for (int m = 0; m < 4; ++m)
#pragma unroll
                for (int n = 0; n < 2; ++n) acc[a][b][m][n] = (f32x4){0.f, 0.f, 0.f, 0.f};
    bf16x8 At[4][2], B0[2][2], B1[2][2];
    const char* cA = (const char*)g.A + (size_t)cur.pm * tstepA; const char* cB = (const char*)g.Bt + (size_t)cur.pn * tstepB;
    PG8_STAGE(PG8_SB(0, 0), cB, voffB); PG8_STAGE(PG8_SA(0, 0), cA, voffA); PG8_STAGE(PG8_SB(0, 1), cB + hstepB, voffB); PG8_STAGE(PG8_SA(0, 1), cA + hstepA, voffA);
    if (wr == 1) PG8_BAR;
    PG8_WAIT_V(4); PG8_BAR;
    PG8_STAGE(PG8_SB(1, 0), cB + kstep, voffB); PG8_STAGE(PG8_SA(1, 0), cA + kstep, voffA); PG8_STAGE(PG8_SB(1, 1), cB + hstepB + kstep, voffB);
    PG8_WAIT_V(6); PG8_BAR;
    for (;;) {
        const bool has_next = S.next(ui + 1, nxt);
        const char* nA = has_next ? (const char*)g.A + (size_t)nxt.pm * tstepA : cA; const char* nB = has_next ? (const char*)g.Bt + (size_t)nxt.pn * tstepB : cB;
        for (int t = 0; t < nt; t += 2) {
            const bool last = (t == nt - 2);
            const char* a1 = cA + (size_t)(t + 1) * kstep;
            const char* a2 = last ? nA : cA + (size_t)(t + 2) * kstep; const char* b2 = last ? nB : cB + (size_t)(t + 2) * kstep;
            const char* a3 = a2 + kstep; const char* b3 = b2 + kstep;
            PG8_LDB(B0, 0, 0); PG8_SCHED; PG8_LDA(At, 0, 0); PG8_STAGE(PG8_SA(1, 1), a1 + hstepA, voffA);
            PG8_WAIT_L(8); PG8_BAR; PG8_WAIT_L(0); PG8_MMA(0, 0, At, B0); PG8_BAR; PG8_SCHED;
            PG8_LDB(B1, 0, 1); PG8_STAGE(PG8_SB(0, 0), b2, voffB);
            PG8_BAR; PG8_WAIT_L(0); PG8_MMA(0, 1, At, B1); PG8_BAR;
            PG8_LDA(At, 0, 1); PG8_STAGE(PG8_SA(0, 0), a2, voffA);
            PG8_BAR; PG8_WAIT_L(0); PG8_MMA(1, 0, At, B0); PG8_BAR; PG8_SCHED;
            PG8_STAGE(PG8_SB(0, 1), b2 + hstepB, voffB);
            PG8_WAIT_V(6); PG8_BAR; PG8_MMA(1, 1, At, B1); PG8_BAR;
            PG8_LDB(B0, 1, 0); PG8_SCHED; PG8_LDA(At, 1, 0); PG8_STAGE(PG8_SA(0, 1), a2 + hstepA, voffA);
            PG8_WAIT_L(8); PG8_BAR; PG8_WAIT_L(0); PG8_MMA(0, 0, At, B0); PG8_BAR; PG8_SCHED;
            PG8_LDB(B1, 1, 1); PG8_STAGE(PG8_SB(1, 0), b3, voffB);
            PG8_BAR; PG8_WAIT_L(0); PG8_MMA(0, 1, At, B1); PG8_BAR;
            PG8_LDA(At, 1, 1); PG8_STAGE(PG8_SA(1, 0), a3, voffA);
            PG8_BAR; PG8_WAIT_L(0); PG8_MMA(1, 0, At, B0); PG8_BAR; PG8_SCHED;
            PG8_STAGE(PG8_SB(1, 1), b3 + hstepB, voffB);
            PG8_WAIT_V(6); PG8_BAR; PG8_MMA(1, 1, At, B1); PG8_BAR;
        }
        E(acc, cur, wr, wc, fr, fq);
        if (!has_next) break;
#pragma unroll
        for (int a = 0; a < 2; ++a)
#pragma unroll
            for (int b = 0; b < 2; ++b)
#pragma unroll
                for (int m = 0; m < 4; ++m)
#pragma unroll
                    for (int n = 0; n < 2; ++n) acc[a][b][m][n] = (f32x4){0.f, 0.f, 0.f, 0.f};
        cur = nxt; cA = nA; cB = nB; ++ui;
    }
    PG8_WAIT_V(0);
    if (wr == 0) PG8_BAR;
    PG8_BAR;
#undef PG8_SA
#undef PG8_SB
#undef PG8_STAGE
#undef PG8_LDA
#undef PG8_LDB
#undef PG8_MMA
#undef PG8_WAIT_V
#undef PG8_WAIT_L
#undef PG8_BAR
#undef PG8_SCHED
}

struct EpiIn {
    static constexpr bool PERM = true;
    bf16_t* P;
    __device__ __forceinline__ void operator()(const f32x4 (&acc)[2][2][4][2], const Unit& u, int wr, int wc, int fr, int fq) const {
        const int row0 = u.pm * BM + wr * 64 + fr, col0 = u.pn * BM + wc * 32 + 8 * fq;
        const bool sg = (u.pn >= 16 && u.pn < 32);
#pragma unroll
        for (int ai = 0; ai < 2; ++ai)
#pragma unroll
            for (int m = 0; m < 4; ++m) { bf16_t* rowp = P + (size_t)(row0 + ai * HALF + m * 16) * PW + col0;
#pragma unroll
                for (int bj = 0; bj < 2; ++bj) { f32x4 v0 = acc[ai][bj][m][0], v1 = acc[ai][bj][m][1];
                    if (sg) {
#pragma unroll
                        for (int j = 0; j < 4; ++j) { v0[j] = sigmoidf_(v0[j]); v1[j] = sigmoidf_(v1[j]); } }
                    u32x4 w; w.x = pk2(v0[0], v0[1]); w.y = pk2(v0[2], v0[3]); w.z = pk2(v1[0], v1[1]); w.w = pk2(v1[2], v1[3]);
                    *(u32x4*)(rowp + bj * HALF) = w; } }
    }
};
template <int MODE> struct EpiGate {
    static constexpr bool PERM = true;
    bf16_t* O; int ldo; const bf16_t* G; int ldg;
    __device__ __forceinline__ void operator()(const f32x4 (&acc)[2][2][4][2], const Unit& u, int wr, int wc, int fr, int fq) const {
        const int row0 = u.pm * BM + wr * 64 + fr, col0 = u.pn * BM + wc * 32 + 8 * fq;
#pragma unroll
        for (int ai = 0; ai < 2; ++ai)
#pragma unroll
            for (int m = 0; m < 4; ++m) { const size_t row = (size_t)(row0 + ai * HALF + m * 16);
#pragma unroll
                for (int bj = 0; bj < 2; ++bj) { const f32x4 v0 = acc[ai][bj][m][0], v1 = acc[ai][bj][m][1];
                    float r[8] = {v0[0], v0[1], v0[2], v0[3], v1[0], v1[1], v1[2], v1[3]};
                    bf16_t* op = O + row * ldo + col0 + bj * HALF;
                    if (MODE != 2) { const u32x4 gw = *(const u32x4*)(G + row * ldg + col0 + bj * HALF);
                        const unsigned gws[4] = {gw.x, gw.y, gw.z, gw.w};
#pragma unroll
                        for (int j = 0; j < 4; ++j) { r[2 * j] *= bflo(gws[j]); r[2 * j + 1] *= bfhi(gws[j]); } }
                    if (MODE == 1) { const u32x4 ow = *(const u32x4*)op; const unsigned ows[4] = {ow.x, ow.y, ow.z, ow.w};
#pragma unroll
                        for (int j = 0; j < 4; ++j) { r[2 * j] += bflo(ows[j]); r[2 * j + 1] += bfhi(ows[j]); } }
                    u32x4 w; w.x = pk2(r[0], r[1]); w.y = pk2(r[2], r[3]); w.z = pk2(r[4], r[5]); w.w = pk2(r[6], r[7]);
                    *(u32x4*)op = w; } }
    }
};
struct EpiRes {
    static constexpr bool PERM = false;
    const float* X; const float* gmod; float* H;
    __device__ __forceinline__ void operator()(const f32x4 (&acc)[2][2][4][2], const Unit& u, int wr, int wc, int fr, int fq) const {
        const int row0 = u.pm * BM + wr * 64 + fr, col0 = u.pn * BM + wc * 32 + 4 * fq;
        const float* gm = gmod + (size_t)((u.pm * BM) >> 14) * 12288;
        f32x4 gv[2][2];
#pragma unroll
        for (int bj = 0; bj < 2; ++bj)
#pragma unroll
            for (int n = 0; n < 2; ++n) gv[bj][n] = *(const f32x4*)(gm + col0 + bj * HALF + n * 16);
#pragma unroll
        for (int ai = 0; ai < 2; ++ai)
#pragma unroll
            for (int m = 0; m < 4; ++m) { const size_t off = (size_t)(row0 + ai * HALF + m * 16) * 2048 + col0;
#pragma unroll
                for (int bj = 0; bj < 2; ++bj)
#pragma unroll
                    for (int n = 0; n < 2; ++n) { const f32x4 xs = *(const f32x4*)(X + off + bj * HALF + n * 16);
                        *(f32x4*)(H + off + bj * HALF + n * 16) = xs + gv[bj][n] * acc[ai][bj][m][n]; } }
    }
};
}

__device__ void gemv_task(const Args& a, int task, ldsp_t lds) {
    const int tid = threadIdx.x, cq = tid & 15, rl = tid >> 4;
    const float* W = a.in[I_WADA] + 64 * task + 4 * cq;
    const float* c = a.in[I_C];
    f32x4 acc0 = {0.f, 0.f, 0.f, 0.f}, acc1 = {0.f, 0.f, 0.f, 0.f};
    for (int r = rl; r < 2048; r += 32) {
        const f32x4 w = *(const f32x4*)(W + (size_t)r * 12288);
        const float c0 = c[r], c1 = c[2048 + r];
        const float s0 = c0 / (1.f + __expf(-c0)), s1 = c1 / (1.f + __expf(-c1));
        acc0 += s0 * w; acc1 += s1 * w;
    }
    LAS float* red = (LAS float*)lds;
    __syncthreads();
#pragma unroll
    for (int j = 0; j < 4; ++j) { red[(rl * 16 + cq) * 8 + j] = acc0[j]; red[(rl * 16 + cq) * 8 + 4 + j] = acc1[j]; }
    __syncthreads();
    if (tid < 128) {
        const int b = tid >> 6, col = tid & 63; float s = 0.f;
        for (int r = 0; r < 32; ++r) s += red[(r * 16 + (col >> 2)) * 8 + b * 4 + (col & 3)];
        float* mod = (float*)(a.ws + WS_MOD);
        mod[b * 12288 + 64 * task + col] = s + a.in[I_BADA][64 * task + col];
    }
    __syncthreads();
}

template <class CMap>
__device__ __forceinline__ void tr_tile(const float* src, int src_ld, int r0, int c0, CMap cmap, bf16_t* dst, int dst_ld, ldsp_t lds) {
    LAS float* tile = (LAS float*)lds;
    const int tid = threadIdx.x, cc = tid & 63, rr0 = tid >> 6;
    const int sc = cmap(c0 + cc);
#pragma unroll
    for (int i = 0; i < 8; ++i) { const int r = rr0 + 8 * i; tile[cc * 65 + r] = sc >= 0 ? src[(size_t)(r0 + r) * src_ld + sc] : 0.f; }
    __syncthreads();
    const int rp = (tid & 31) * 2, c1 = tid >> 5;
#pragma unroll
    for (int i = 0; i < 4; ++i) { const int c = c1 + 16 * i; *(unsigned*)(dst + (size_t)(c0 + c) * dst_ld + r0 + rp) = pk2(tile[c * 65 + rp], tile[c * 65 + rp + 1]); }
    __syncthreads();
}
struct MapId { __device__ int operator()(int c) const { return c; } };
struct MapWin { __device__ int operator()(int c) const { return c < 4096 ? c : (c < 8192 ? c + 32 : (c < 8224 ? c - 4096 : -1)); } };

__device__ void fold_tile(const Args& a, int tile, ldsp_t lds) {
    LAS float* wl = (LAS float*)lds;
    LAS float* ct = (LAS float*)(lds + 65536);
    const int tid = threadIdx.x;
    const int nb = tile & 31, kb = tile >> 5;
    const int ri = kb >> 4, g = (kb >> 2) & 3, c0 = (kb & 3) * 64, n0 = nb * 64;
    const float* wf = a.in[I_WFNET] + (size_t)(g * 256) * 2048 + n0;
    __syncthreads();
#pragma unroll
    for (int j = 0; j < 8; ++j) { const int row = (tid >> 4) + 32 * j, c4 = (tid & 15) * 4;
        const f32x4 v = *(const f32x4*)(wf + (size_t)row * 2048 + c4);
        wl[row * 64 + c4] = v[0]; wl[row * 64 + c4 + 1] = v[1]; wl[row * 64 + c4 + 2] = v[2]; wl[row * 64 + c4 + 3] = v[3]; }
    if (tid < 256) ct[tid] = cospif((float)tid * (1.0f / 128.0f));
    __syncthreads();
    const int kk = tid & 63, nn0 = tid >> 6, c = c0 + kk;
    float acc[8];
#pragma unroll
    for (int i = 0; i < 8; ++i) acc[i] = 0.f;
    for (int m = 0; m < 256; ++m) {
        const int idx = (m * c) & 255;
        const float cs = ri ? ct[(idx + 192) & 255] : ct[idx];
#pragma unroll
        for (int i = 0; i < 8; ++i) acc[i] += wl[m * 64 + nn0 + 8 * i] * cs;
    }
    bf16_t* dst = (bf16_t*)(a.ws + WS_WFN);
#pragma unroll
    for (int i = 0; i < 8; ++i) dst[(size_t)(n0 + nn0 + 8 * i) * 2048 + ri * 1024 + g * 256 + c] = (bf16_t)f2bf(acc[i] * (1.0f / 2048.0f));
    __syncthreads();
}

__device__ void tables_task(const Args& a, int task) {
    const int tid = threadIdx.x;
    bf16_t* F1 = (bf16_t*)(a.ws + WS_F1); bf16_t* F2 = (bf16_t*)(a.ws + WS_F2); float* TW = (float*)(a.ws + WS_TW);
    {
        const int e = task * 512 + tid, R = e >> 7, sh = e & 127, w = R >> 5, mt = (R >> 4) & 1, r = R & 15, kf = 16 * w + r;
        float s, c; sincospif((float)((kf * sh) & 127) * (1.0f / 64.0f), &s, &c);
        F1[e] = (bf16_t)f2bf(mt ? -s : c);
    }
#pragma unroll
    for (int q = 0; q < 2; ++q) {
        const int e = task * 1024 + q * 512 + tid, R = e >> 8, K = e & 255, sl = K >> 1, ri = K & 1, w = R >> 5, mt = (R >> 4) & 1, r = R & 15, kf = 16 * w + r;
        float s, c; sincospif((float)((kf * sl) & 127) * (1.0f / 64.0f), &s, &c);
        const float v = mt ? (ri ? c : -s) : (ri ? s : c);
        F2[e] = (bf16_t)f2bf(v);
    }
    if (task < 32) {
        const int e = task * 512 + tid, kl = e >> 7, sl = e & 127;
        float s, c; sincospif((float)(kl * sl) * (1.0f / 8192.0f), &s, &c);
        TW[2 * e] = c; TW[2 * e + 1] = s;
    }
}

__device__ void cvt_flat(const float* src, bf16_t* dst, size_t n) {
    const size_t gt = (size_t)blockIdx.x * 512 + threadIdx.x, gs = (size_t)gridDim.x * 512;
    for (size_t i = gt * 8; i < n; i += gs * 8) {
        const f32x4 v0 = *(const f32x4*)(src + i), v1 = *(const f32x4*)(src + i + 4);
        u32x4 w; w.x = pk2(v0[0], v0[1]); w.y = pk2(v0[2], v0[3]); w.z = pk2(v1[0], v1[1]); w.w = pk2(v1[2], v1[3]);
        *(u32x4*)(dst + i) = w;
    }
}

__device__ void phase0(const Args& a, ldsp_t lds) {
    const int G = gridDim.x, bx = blockIdx.x;
    for (int t = bx; t < 192; t += G) gemv_task(a, t, lds);
    for (int t = bx; t < 64; t += G) tables_task(a, t);
    cvt_flat(a.in[I_KEYS], (bf16_t*)(a.ws + WS_KEYS), (size_t)8 * 2 * 128 * 128);
    for (int t = bx; t < 132 * 32; t += G) tr_tile(a.in[I_WIN], 8224, (t & 31) * 64, (t >> 5) * 64, MapWin(), (bf16_t*)(a.ws + WS_WIN), 2048, lds);
    for (int t = bx; t < 32 * 16; t += G) tr_tile(a.in[I_WGLA], 2048, (t & 15) * 64, (t >> 4) * 64, MapId(), (bf16_t*)(a.ws + WS_WGLA), 1024, lds);
    for (int t = bx; t < 32 * 32; t += G) tr_tile(a.in[I_WOUT], 2048, (t & 31) * 64, (t >> 5) * 64, MapId(), (bf16_t*)(a.ws + WS_WOUT), 2048, lds);
    for (int t = bx; t < 32 * 32; t += G) tr_tile(a.in[I_WQ], 2048, (t & 31) * 64, (t >> 5) * 64, MapId(), (bf16_t*)(a.ws + WS_WQ), 2048, lds);
    for (int t = bx; t < 1024; t += G) fold_tile(a, t, lds);
}

__device__ void norm_phase(const float* X, const float* gvec, const float* mod_sh, const float* mod_sc, bf16_t* out) {
    const int lane = threadIdx.x & 63, wave = threadIdx.x >> 6;
    const int W = gridDim.x * 8;
    for (int row = blockIdx.x * 8 + wave; row < T_; row += W) {
        const float* xr = X + (size_t)row * 2048;
        const int b = row >> 14;
        f32x4 v[8]; float ss = 0.f;
#pragma unroll
        for (int j = 0; j < 8; ++j) { v[j] = *(const f32x4*)(xr + (j * 64 + lane) * 4); ss += v[j][0] * v[j][0] + v[j][1] * v[j][1] + v[j][2] * v[j][2] + v[j][3] * v[j][3]; }
        ss = wave_sum(ss);
        const float rstd = rsqrtf(ss * (1.0f / 2048.0f) + EPS);
#pragma unroll
        for (int j = 0; j < 8; ++j) { const int d = (j * 64 + lane) * 4;
            const f32x4 gg = *(const f32x4*)(gvec + d), sc = *(const f32x4*)(mod_sc + b * 12288 + d), sh = *(const f32x4*)(mod_sh + b * 12288 + d);
            f32x4 y = v[j] * rstd * gg * (1.0f + sc) + sh;
            u32x2 w; w.x = pk2(y[0], y[1]); w.y = pk2(y[2], y[3]);
            *(u32x2*)(out + (size_t)row * 2048 + d) = w; }
    }
}

__device__ void fft1_phase(const Args& a, ldsp_t lds) {
    const int tid = threadIdx.x, lane = tid & 63, w = tid >> 6, g = lane >> 4, l15 = lane & 15;
    const bf16_t* F1 = (const bf16_t*)(a.ws + WS_F1);
    const float* TW = (const float*)(a.ws + WS_TW);
    const bf16_t* P = (const bf16_t*)(a.ws + WS_P);
    bf16_t* T1 = (bf16_t*)a.out;
    bf16x8 Af[2][4];
#pragma unroll
    for (int mt = 0; mt < 2; ++mt)
#pragma unroll
        for (int ks = 0; ks < 4; ++ks) Af[mt][ks] = *(const bf16x8*)(F1 + (32 * w + 16 * mt + l15) * 128 + 32 * ks + 8 * g);
    constexpr int ZS = 272, OS = 272, OFF_OUT = 128 * ZS;
    const int c16 = tid & 15, r32 = tid >> 4;
    u32x4 buf[4];
    int tile = blockIdx.x;
    if (tile < 2048) { const int cb = tile & 7, s_lo = (tile >> 3) & 127, b = tile >> 10;
        const bf16_t* src = P + (size_t)(b * S_ + s_lo) * PW + PC_Z + cb * 128 + 8 * c16;
#pragma unroll
        for (int i = 0; i < 4; ++i) buf[i] = *(const u32x4*)(src + (size_t)(r32 + 32 * i) * 128 * PW); }
    for (; tile < 2048; tile += gridDim.x) {
        const int cb = tile & 7, s_lo = (tile >> 3) & 127, b = tile >> 10;
        __syncthreads();
#pragma unroll
        for (int i = 0; i < 4; ++i) { const int sh = r32 + 32 * i; const unsigned ws_[4] = {buf[i].x, buf[i].y, buf[i].z, buf[i].w};
#pragma unroll
            for (int j = 0; j < 4; ++j) { *(LAS unsigned short*)(lds + (8 * c16 + 2 * j) * ZS + sh * 2) = (unsigned short)(ws_[j] & 0xffffu);
                *(LAS unsigned short*)(lds + (8 * c16 + 2 * j + 1) * ZS + sh * 2) = (unsigned short)(ws_[j] >> 16); } }
        __syncthreads();
        { const int nt_ = tile + gridDim.x;
          if (nt_ < 2048) { const int cb2 = nt_ & 7, s2 = (nt_ >> 3) & 127, b2 = nt_ >> 10;
            const bf16_t* src = P + (size_t)(b2 * S_ + s2) * PW + PC_Z + cb2 * 128 + 8 * c16;
#pragma unroll
            for (int i = 0; i < 4; ++i) buf[i] = *(const u32x4*)(src + (size_t)(r32 + 32 * i) * 128 * PW); } }
        f32x4 acc[2][8];
#pragma unroll
        for (int mt = 0; mt < 2; ++mt)
#pragma unroll
            for (int nt = 0; nt < 8; ++nt) acc[mt][nt] = (f32x4){0.f, 0.f, 0.f, 0.f};
#pragma unroll
        for (int nt = 0; nt < 8; ++nt)
#pragma unroll
            for (int ks = 0; ks < 4; ++ks) { const bf16x8 bfr = *(const LAS bf16x8*)(lds + (16 * nt + l15) * ZS + (32 * ks + 8 * g) * 2);
                acc[0][nt] = __builtin_amdgcn_mfma_f32_16x16x32_bf16(Af[0][ks], bfr, acc[0][nt], 0, 0, 0);
                acc[1][nt] = __builtin_amdgcn_mfma_f32_16x16x32_bf16(Af[1][ks], bfr, acc[1][nt], 0, 0, 0); }
#pragma unroll
        for (int r = 0; r < 4; ++r) { const int k_lo = 16 * w + 4 * g + r;
            const f32x2 cs = *(const f32x2*)(TW + 2 * (k_lo * 128 + s_lo));
#pragma unroll
            for (int nt = 0; nt < 8; ++nt) { const float tr = acc[0][nt][r], ti = acc[1][nt][r];
                *(LAS unsigned short*)(lds + OFF_OUT + (2 * k_lo) * OS + (16 * nt + l15) * 2) = (unsigned short)f2bf(tr * cs.x + ti * cs.y);
                *(LAS unsigned short*)(lds + OFF_OUT + (2 * k_lo + 1) * OS + (16 * nt + l15) * 2) = (unsigned short)f2bf(ti * cs.x - tr * cs.y); } }
        __syncthreads();
#pragma unroll
        for (int i = 0; i < 8; ++i) { const int row = r32 + 32 * i;
            const u32x4 v = *(const LAS u32x4*)(lds + OFF_OUT + row * OS + c16 * 16);
            *(u32x4*)(T1 + ((size_t)((b * 128 + (row >> 1)) * 128 + s_lo) * 2 + (row & 1)) * 1024 + cb * 128 + c16 * 8) = v; }
    }
}

__device__ void fft2_phase(const Args& a, ldsp_t lds) {
    const int tid = threadIdx.x, lane = tid & 63, w = tid >> 6, g = lane >> 4, l15 = lane & 15;
    const bf16_t* F2 = (const bf16_t*)(a.ws + WS_F2);
    const bf16_t* T1 = (const bf16_t*)a.out;
    bf16_t* ZA = (bf16_t*)a.out + (size_t)T_ * 2048;
    bf16x8 Af[2][8];
#pragma unroll
    for (int mt = 0; mt < 2; ++mt)
#pragma unroll
        for (int ks = 0; ks < 8; ++ks) Af[mt][ks] = *(const bf16x8*)(F2 + (32 * w + 16 * mt + l15) * 256 + 32 * ks + 8 * g);
    constexpr int ZS = 528, OS = 272, OFF_OUT = 128 * ZS;
    static_assert(OFF_OUT + 256 * OS <= LDS_BYTES - 16, "FFT2 LDS");
    const int c16 = tid & 15, r32 = tid >> 4;
    u32x4 buf[8];
    int tile = blockIdx.x;
    if (tile < 2048) { const int cb = tile & 7, k_lo = (tile >> 3) & 127, b = tile >> 10;
        const bf16_t* src = T1 + ((size_t)(b * 128 + k_lo) * 256) * 1024 + cb * 128 + 8 * c16;
#pragma unroll
        for (int i = 0; i < 8; ++i) buf[i] = *(const u32x4*)(src + (size_t)(r32 + 32 * i) * 1024); }
    for (; tile < 2048; tile += gridDim.x) {
        const int cb = tile & 7, k_lo = (tile >> 3) & 127, b = tile >> 10;
        __syncthreads();
#pragma unroll
        for (int i = 0; i < 8; ++i) { const int kk = r32 + 32 * i; const unsigned ws_[4] = {buf[i].x, buf[i].y, buf[i].z, buf[i].w};
#pragma unroll
            for (int j = 0; j < 4; ++j) { *(LAS unsigned short*)(lds + (8 * c16 + 2 * j) * ZS + kk * 2) = (unsigned short)(ws_[j] & 0xffffu);
                *(LAS unsigned short*)(lds + (8 * c16 + 2 * j + 1) * ZS + kk * 2) = (unsigned short)(ws_[j] >> 16); } }
        __syncthreads();
        { const int nt_ = tile + gridDim.x;
          if (nt_ < 2048) { const int cb2 = nt_ & 7, k2 = (nt_ >> 3) & 127, b2 = nt_ >> 10;
            const bf16_t* src = T1 + ((size_t)(b2 * 128 + k2) * 256) * 1024 + cb2 * 128 + 8 * c16;
#pragma unroll
            for (int i = 0; i < 8; ++i) buf[i] = *(const u32x4*)(src + (size_t)(r32 + 32 * i) * 1024); } }
        f32x4 acc[2][8];
#pragma unroll
        for (int mt = 0; mt < 2; ++mt)
#pragma unroll
            for (int nt = 0; nt < 8; ++nt) acc[mt][nt] = (f32x4){0.f, 0.f, 0.f, 0.f};
#pragma unroll
        for (int nt = 0; nt < 8; ++nt)
#pragma unroll
            for (int ks = 0; ks < 8; ++ks) { const bf16x8 bfr = *(const LAS bf16x8*)(lds + (16 * nt + l15) * ZS + (32 * ks + 8 * g) * 2);
                acc[0][nt] = __builtin_amdgcn_mfma_f32_16x16x32_bf16(Af[0][ks], bfr, acc[0][nt], 0, 0, 0);
                acc[1][nt] = __builtin_amdgcn_mfma_f32_16x16x32_bf16(Af[1][ks], bfr, acc[1][nt], 0, 0, 0); }
#pragma unroll
        for (int r = 0; r < 4; ++r) { const int k_hi = 16 * w + 4 * g + r;
#pragma unroll
            for (int nt = 0; nt < 8; ++nt) {
                *(LAS unsigned short*)(lds + OFF_OUT + (2 * k_hi) * OS + (16 * nt + l15) * 2) = (unsigned short)f2bf(acc[0][nt][r]);
                *(LAS unsigned short*)(lds + OFF_OUT + (2 * k_hi + 1) * OS + (16 * nt + l15) * 2) = (unsigned short)f2bf(acc[1][nt][r]); } }
        __syncthreads();
#pragma unroll
        for (int i = 0; i < 8; ++i) { const int row = r32 + 32 * i;
            const u32x4 v = *(const LAS u32x4*)(lds + OFF_OUT + row * OS + c16 * 16);
            *(u32x4*)(ZA + (size_t)(b * S_ + 128 * (row >> 1) + k_lo) * 2048 + (row & 1) * 1024 + cb * 128 + c16 * 8) = v; }
    }
}

constexpr size_t WS_QT  = WS_XN;
constexpr size_t WS_AS  = WS_QT + (size_t)4096 * 64 * 128 * 2;
constexpr size_t WS_KDT = WS_END;
constexpr size_t WS_BL  = WS_KDT + (size_t)4096 * 128 * 64 * 2;
constexpr size_t WS_END2 = WS_BL + (size_t)4096 * 128 * 4;
static_assert(WS_AS + (size_t)4096 * 64 * 64 * 2 <= WS_O, "GLA pre-pass buffers must fit in the XN region");
static_assert(WS_END2 <= (size_t)1000 * 1000 * 1000, "workspace budget");

__device__ __forceinline__ float fast_logsigmoid(float z) {
    const float e = __builtin_amdgcn_exp2f(-fabsf(z) * 1.4426950408889634f);
    return fminf(z, 0.f) - __builtin_amdgcn_logf(1.0f + e) * 0.6931471805599453f;
}

__device__ void gla_pre_phase(const Args& a, ldsp_t lds) {
    const int tid = threadIdx.x, lane = tid & 63, w = tid >> 6, g = lane >> 4, l15 = lane & 15;
    const int d = tid & 127, tg = tid >> 7;
    const bf16_t* P = (const bf16_t*)(a.ws + WS_P);
    bf16_t* QT = (bf16_t*)(a.ws + WS_QT); bf16_t* AS = (bf16_t*)(a.ws + WS_AS); bf16_t* KDT = (bf16_t*)(a.ws + WS_KDT); float* BL = (float*)(a.ws + WS_BL);
    constexpr int QS = 272, JS = 144;
    constexpr int OFF_QS = 0, OFF_KS = OFF_QS + 64 * QS, OFF_AS = OFF_KS + 64 * QS, OFF_A1 = OFF_AS + 64 * JS, OFF_TOT = OFF_A1 + 2048;
    LAS float* tot = (LAS float*)(lds + OFF_TOT);
    unsigned short qk[32];
    u32x4 a1v = {0u, 0u, 0u, 0u};
    const int task_base = (blockIdx.x >> 4) * 256 + (blockIdx.x & 15) * 16;
    int task = task_base;
#define GLA_PRE_LOADS(T) do { const int stream_ = (T) >> 8, chunk_ = (T) & 255, dir_ = stream_ & 1, h_ = (stream_ >> 1) & 3, b_ = stream_ >> 3; \
        if (tid < 128) { const int i_ = tid >> 1, hf_ = tid & 1, tau_ = chunk_ * 64 + i_, t_ = dir_ ? (S_ - 1 - tau_) : tau_; \
            a1v = *(const u32x4*)(P + (size_t)(b_ * S_ + t_) * PW + PC_A1 + dir_ * 16 + hf_ * 8); } \
        _Pragma("unroll") for (int ii = 0; ii < 16; ++ii) { const int tau_ = chunk_ * 64 + 16 * tg + ii, t_ = dir_ ? (S_ - 1 - tau_) : tau_; \
            const bf16_t* prow_ = P + (size_t)(b_ * S_ + t_) * PW; qk[2 * ii] = prow_[PC_Q + h_ * 128 + d]; qk[2 * ii + 1] = prow_[PC_K + h_ * 128 + d]; } } while (0)
    GLA_PRE_LOADS(task);
    for (; task < task_base + 16; ++task) {
        const int stream = task >> 8, dir = stream & 1, h = (stream >> 1) & 3;
        float wa[16];
#pragma unroll
        for (int r = 0; r < 16; ++r) wa[r] = a.in[I_WA2][(size_t)(dir * 16 + r) * 512 + h * 128 + d];
        const float ba = a.in[I_BA][dir * 512 + h * 128 + d];
        if (tid < 128) *(LAS u32x4*)(lds + OFF_A1 + (tid >> 1) * 32 + (tid & 1) * 16) = a1v;
        __syncthreads();
        float wv[16]; float run = 0.f;
#pragma unroll
        for (int ii = 0; ii < 16; ++ii) { const int i = 16 * tg + ii;
            const u32x4 p0 = *(const LAS u32x4*)(lds + OFF_A1 + i * 32), p1 = *(const LAS u32x4*)(lds + OFF_A1 + i * 32 + 16);
            const unsigned pw[8] = {p0.x, p0.y, p0.z, p0.w, p1.x, p1.y, p1.z, p1.w};
            float z = ba;
#pragma unroll
            for (int r = 0; r < 8; ++r) z += bflo(pw[r]) * wa[2 * r] + bfhi(pw[r]) * wa[2 * r + 1];
            run += fast_logsigmoid(z) * (1.0f / 16.0f); wv[ii] = run; }
        tot[tg * 128 + d] = run;
        __syncthreads();
        float pre = 0.f, blast = 0.f;
#pragma unroll
        for (int q = 0; q < 4; ++q) { const float tq = tot[q * 128 + d]; blast += tq; pre += (q < tg) ? tq : 0.f; }
        if (tg == 0) BL[(size_t)task * 128 + d] = blast;
        unsigned kd[8];
#pragma unroll
        for (int ii = 0; ii < 16; ii += 2) { float kdv[2];
#pragma unroll
            for (int e = 0; e < 2; ++e) { const int i = 16 * tg + ii + e; const float bi = pre + wv[ii + e];
                const float qv = bf2f(qk[2 * (ii + e)]), kv = bf2f(qk[2 * (ii + e) + 1]);
                *(LAS unsigned short*)(lds + OFF_QS + i * QS + d * 2) = (unsigned short)f2bf(qv * 0.08838834764831845f * __expf(bi));
                *(LAS unsigned short*)(lds + OFF_KS + i * QS + d * 2) = (unsigned short)f2bf(kv * __expf(-bi));
                kdv[e] = kv * __expf(blast - bi); }
            kd[ii >> 1] = pk2(kdv[0], kdv[1]); }
        { bf16_t* kp = KDT + ((size_t)task * 128 + d) * 64 + 16 * tg;
          *(u32x4*)kp = (u32x4){kd[0], kd[1], kd[2], kd[3]}; *(u32x4*)(kp + 8) = (u32x4){kd[4], kd[5], kd[6], kd[7]}; }
        __syncthreads();
        { const int nt_ = task + 1; if (nt_ < task_base + 16) GLA_PRE_LOADS(nt_); }
#pragma unroll
        for (int q = 0; q < 2; ++q) { const int mt = w >> 1, nt = 2 * (w & 1) + q;
            f32x4 sacc = {0.f, 0.f, 0.f, 0.f};
#pragma unroll
            for (int ks = 0; ks < 4; ++ks) { const bf16x8 af = *(const LAS bf16x8*)(lds + OFF_QS + (16 * mt + l15) * QS + (32 * ks + 8 * g) * 2);
                const bf16x8 bf = *(const LAS bf16x8*)(lds + OFF_KS + (16 * nt + l15) * QS + (32 * ks + 8 * g) * 2);
                sacc = __builtin_amdgcn_mfma_f32_16x16x32_bf16(af, bf, sacc, 0, 0, 0); }
#pragma unroll
            for (int r = 0; r < 4; ++r) { const int i = 16 * mt + 4 * g + r, j = 16 * nt + l15;
                *(LAS unsigned short*)(lds + OFF_AS + i * JS + j * 2) = (unsigned short)f2bf(j <= i ? sacc[r] : 0.f); } }
        __syncthreads();
#pragma unroll
        for (int p = 0; p < 2; ++p) { const int pc = tid + 512 * p, row = pc >> 4, c16 = pc & 15;
            *(u32x4*)(QT + ((size_t)task * 64 + row) * 128 + c16 * 8) = *(const LAS u32x4*)(lds + OFF_QS + row * QS + c16 * 16); }
        { const int row = tid >> 3, c8 = tid & 7;
          *(u32x4*)(AS + ((size_t)task * 64 + row) * 64 + c8 * 8) = *(const LAS u32x4*)(lds + OFF_AS + row * JS + c8 * 16); }
    }
#undef GLA_PRE_LOADS
    __threadfence();
    __syncthreads();
}

__device__ __forceinline__ void gla_task_decode(int task, int& stream, int& eh, int& sg) {
    const int u = task & 255, i = task >> 8; stream = u >> 4; eh = i; sg = i ? 15 - (u & 15) : (u & 15);
}
__device__ __forceinline__ int gla_lidx(int stream, int eh, int sg) { return (stream * 2 + eh) * 16 + sg; }

template <bool PB>
__device__ void gla_scan_phase(const Args& a, ldsp_t lds) {
    const int tid = threadIdx.x, lane = tid & 63, w = tid >> 6, g = lane >> 4, l15 = lane & 15;
    const bf16_t* P = (const bf16_t*)(a.ws + WS_P);
    const bf16_t* QT = (const bf16_t*)(a.ws + WS_QT); const bf16_t* AS = (const bf16_t*)(a.ws + WS_AS); const bf16_t* KDT = (const bf16_t*)(a.ws + WS_KDT); const float* BL = (const float*)(a.ws + WS_BL);
    float* Lbuf = (float*)(a.ws + WS_L);
    float* DSEG = (float*)(a.ws + WS_DSEG);
    bf16_t* O = (bf16_t*)(a.ws + WS_O);
    constexpr int QS = 272, JS = 144;
    constexpr int OFF_QS = 0, OFF_AS = OFF_QS + 64 * QS, OFF_KDT = OFF_AS + 64 * JS, OFF_VT = OFF_KDT + 128 * JS, OFF_SB = OFF_VT + 128 * JS, OFF_OB = OFF_SB + 128 * QS,
                  OFF_DS = OFF_OB + 64 * QS, OFF_END = OFF_DS + 512;
    static_assert(OFF_END <= LDS_BYTES - 16, "GLA LDS");
    const int c16 = tid & 15, r32 = tid >> 4, c8 = tid & 7, r64 = tid >> 3;

    for (int it = 0; it < 2; ++it) {
        int stream, eh, sg;
        if (PB) gla_task_decode(blockIdx.x + 256 * it, stream, eh, sg);
        else { stream = blockIdx.x >> 4; sg = blockIdx.x & 15; eh = it; }
        const int dir = stream & 1, h = (stream >> 1) & 3, b = stream >> 3;
        f32x4 Sst[8];
#pragma unroll
        for (int mt = 0; mt < 8; ++mt) Sst[mt] = (f32x4){0.f, 0.f, 0.f, 0.f};
        if (PB) {
            for (int sp = 0; sp < sg; ++sp) {
                const float* Lp = Lbuf + (size_t)gla_lidx(stream, eh, sp) * 16384;
                const float* Dp = DSEG + (stream * 16 + sp) * 128;
#pragma unroll
                for (int mt = 0; mt < 8; ++mt) { const f32x4 dl = *(const f32x4*)(Dp + 16 * mt + 4 * g);
#pragma unroll
                    for (int r = 0; r < 4; ++r) Sst[mt][r] = Sst[mt][r] * __expf(dl[r]) + Lp[(mt * 4 + r) * 512 + tid]; }
            }
            __syncthreads();
#pragma unroll
            for (int mt = 0; mt < 8; ++mt) { u32x2 pw; pw.x = pk2(Sst[mt][0], Sst[mt][1]); pw.y = pk2(Sst[mt][2], Sst[mt][3]);
                *(LAS u32x2*)(lds + OFF_SB + (16 * w + l15) * QS + (16 * mt + 4 * g) * 2) = pw; }
        }
        float logD = 0.f;
        u32x4 pk_[2], pv_[2], pq_[2], pa_ = {0u, 0u, 0u, 0u}; float pbl = 0.f;
#define GLA_SCAN_LOADS(CI) do { const int ct_ = stream * 256 + sg * 16 + (CI); \
        _Pragma("unroll") for (int p_ = 0; p_ < 2; ++p_) { const int pc_ = tid + 512 * p_; \
            pk_[p_] = *(const u32x4*)(KDT + ((size_t)ct_ * 128 + (pc_ >> 3)) * 64 + (pc_ & 7) * 8); \
            { const int j_ = pc_ >> 4, tau_ = (sg * 16 + (CI)) * 64 + j_, t_ = dir ? (S_ - 1 - tau_) : tau_; \
              pv_[p_] = *(const u32x4*)(P + (size_t)(b * S_ + t_) * PW + PC_V + h * 256 + eh * 128 + (pc_ & 15) * 8); } \
            if (PB) pq_[p_] = *(const u32x4*)(QT + ((size_t)ct_ * 64 + (pc_ >> 4)) * 128 + (pc_ & 15) * 8); } \
        if (PB) pa_ = *(const u32x4*)(AS + ((size_t)ct_ * 64 + r64) * 64 + c8 * 8); \
        if (tid < 128) pbl = BL[(size_t)ct_ * 128 + tid]; } while (0)
        GLA_SCAN_LOADS(0);
        for (int ci = 0; ci < 16; ++ci) {
            const int tau0 = (sg * 16 + ci) * 64;
#pragma unroll
            for (int p = 0; p < 2; ++p) { const int pc = tid + 512 * p;
                *(LAS u32x4*)(lds + OFF_KDT + (pc >> 3) * JS + (pc & 7) * 16) = pk_[p];
                { const int j = pc >> 4, e0 = (pc & 15) * 8; const unsigned vs[4] = {pv_[p].x, pv_[p].y, pv_[p].z, pv_[p].w};
#pragma unroll
                  for (int q = 0; q < 4; ++q) { *(LAS unsigned short*)(lds + OFF_VT + (e0 + 2 * q) * JS + j * 2) = (unsigned short)(vs[q] & 0xffffu);
                      *(LAS unsigned short*)(lds + OFF_VT + (e0 + 2 * q + 1) * JS + j * 2) = (unsigned short)(vs[q] >> 16); } }
                if (PB) *(LAS u32x4*)(lds + OFF_QS + (pc >> 4) * QS + (pc & 15) * 16) = pq_[p]; }
            if (PB) *(LAS u32x4*)(lds + OFF_AS + r64 * JS + c8 * 16) = pa_;
            if (tid < 128) { *(LAS float*)(lds + OFF_DS + tid * 4) = __expf(pbl); logD += pbl; }
            __syncthreads();
            if (ci + 1 < 16) GLA_SCAN_LOADS(ci + 1);
            f32x4 oacc[4];
            if (PB) {
#pragma unroll
                for (int mt = 0; mt < 4; ++mt) oacc[mt] = (f32x4){0.f, 0.f, 0.f, 0.f};
#pragma unroll
                for (int ks = 0; ks < 4; ++ks) { const bf16x8 bf = *(const LAS bf16x8*)(lds + OFF_SB + (16 * w + l15) * QS + (32 * ks + 8 * g) * 2);
#pragma unroll
                    for (int mt = 0; mt < 4; ++mt) { const bf16x8 af = *(const LAS bf16x8*)(lds + OFF_QS + (16 * mt + l15) * QS + (32 * ks + 8 * g) * 2);
                        oacc[mt] = __builtin_amdgcn_mfma_f32_16x16x32_bf16(af, bf, oacc[mt], 0, 0, 0); } }
#pragma unroll
                for (int ks = 0; ks < 2; ++ks) { const bf16x8 bf = *(const LAS bf16x8*)(lds + OFF_VT + (16 * w + l15) * JS + (32 * ks + 8 * g) * 2);
#pragma unroll
                    for (int mt = 0; mt < 4; ++mt) { const bf16x8 af = *(const LAS bf16x8*)(lds + OFF_AS + (16 * mt + l15) * JS + (32 * ks + 8 * g) * 2);
                        oacc[mt] = __builtin_amdgcn_mfma_f32_16x16x32_bf16(af, bf, oacc[mt], 0, 0, 0); } }
            }
#pragma unroll
            for (int mt = 0; mt < 8; ++mt) { const f32x4 dsc = *(const LAS f32x4*)(lds + OFF_DS + (16 * mt + 4 * g) * 4);
                Sst[mt] = Sst[mt] * dsc; }
#pragma unroll
            for (int ks = 0; ks < 2; ++ks) { const bf16x8 bf = *(const LAS bf16x8*)(lds + OFF_VT + (16 * w + l15) * JS + (32 * ks + 8 * g) * 2);
#pragma unroll
                for (int mt = 0; mt < 8; ++mt) { const bf16x8 af = *(const LAS bf16x8*)(lds + OFF_KDT + (16 * mt + l15) * JS + (32 * ks + 8 * g) * 2);
                    Sst[mt] = __builtin_amdgcn_mfma_f32_16x16x32_bf16(af, bf, Sst[mt], 0, 0, 0); } }
            __syncthreads();
            if (PB) {
#pragma unroll
                for (int mt = 0; mt < 8; ++mt) { u32x2 pw; pw.x = pk2(Sst[mt][0], Sst[mt][1]); pw.y = pk2(Sst[mt][2], Sst[mt][3]);
                    *(LAS u32x2*)(lds + OFF_SB + (16 * w + l15) * QS + (16 * mt + 4 * g) * 2) = pw; }
#pragma unroll
                for (int mt = 0; mt < 4; ++mt)
#pragma unroll
                    for (int r = 0; r < 4; ++r) *(LAS unsigned short*)(lds + OFF_OB + (16 * mt + 4 * g + r) * QS + (16 * w + l15) * 2) = (unsigned short)f2bf(oacc[mt][r]);
                __syncthreads();
#pragma unroll
                for (int p = 0; p < 2; ++p) { const int pc = tid + 512 * p, i = pc >> 4, tau = tau0 + i, t = dir ? (S_ - 1 - tau) : tau;
                    *(u32x4*)(O + ((size_t)dir * T_ + (size_t)(b * S_ + t)) * 1024 + h * 256 + eh * 128 + (pc & 15) * 8) = *(const LAS u32x4*)(lds + OFF_OB + i * QS + (pc & 15) * 16); }
            }
        }
#undef GLA_SCAN_LOADS
        if (!PB) {
            float* Lp = Lbuf + (size_t)gla_lidx(stream, eh, sg) * 16384;
#pragma unroll
            for (int mt = 0; mt < 8; ++mt)
#pragma unroll
                for (int r = 0; r < 4; ++r) Lp[(mt * 4 + r) * 512 + tid] = Sst[mt][r];
            if (tid < 128 && eh == 0) DSEG[(stream * 16 + sg) * 128 + tid] = logD;
        }
        __syncthreads();
    }
}

__device__ void gla_post_phase(const Args& a) {
    const int lane = threadIdx.x & 63, wave = threadIdx.x >> 6, W = gridDim.x * 8;
    const bf16_t* O = (const bf16_t*)(a.ws + WS_O);
    const bf16_t* P = (const bf16_t*)(a.ws + WS_P);
    bf16_t* GO = (bf16_t*)(a.ws + WS_XN);
    const float* ng = a.in[I_GNG];
    for (int row = blockIdx.x * 8 + wave; row < T_; row += W) {
        const int e0 = lane * 16;
        float v[16]; float ss = 0.f;
#pragma unroll
        for (int q = 0; q < 2; ++q) { const u32x4 f = *(const u32x4*)(O + (size_t)row * 1024 + e0 + 8 * q), bk = *(const u32x4*)(O + ((size_t)T_ + row) * 1024 + e0 + 8 * q);
            const unsigned fw[4] = {f.x, f.y, f.z, f.w}, bw[4] = {bk.x, bk.y, bk.z, bk.w};
#pragma unroll
            for (int j = 0; j < 4; ++j) { v[8 * q + 2 * j] = bflo(fw[j]) + bflo(bw[j]); v[8 * q + 2 * j + 1] = bfhi(fw[j]) + bfhi(bw[j]); } }
#pragma unroll
        for (int j = 0; j < 16; ++j) ss += v[j] * v[j];
#pragma unroll
        for (int o = 8; o >= 1; o >>= 1) ss += __shfl_xor(ss, o);
        const float rstd = rsqrtf(ss * (1.0f / 256.0f) + EPS);
        unsigned ow[8];
#pragma unroll
        for (int q = 0; q < 2; ++q) { const u32x4 rr = *(const u32x4*)(P + (size_t)row * PW + PC_R + e0 + 8 * q); const unsigned rw[4] = {rr.x, rr.y, rr.z, rr.w};
#pragma unroll
            for (int j = 0; j < 4; ++j) { const int e = (e0 + 8 * q + 2 * j) & 255;
                const float r0 = bflo(rw[j]), r1 = bfhi(rw[j]);
                const float y0 = v[8 * q + 2 * j] * rstd * ng[e] * (r0 * sigmoidf_(r0)), y1 = v[8 * q + 2 * j + 1] * rstd * ng[e + 1] * (r1 * sigmoidf_(r1));
                ow[4 * q + j] = pk2(y0, y1); } }
        *(u32x4*)(GO + (size_t)row * 1024 + e0) = (u32x4){ow[0], ow[1], ow[2], ow[3]};
        *(u32x4*)(GO + (size_t)row * 1024 + e0 + 8) = (u32x4){ow[4], ow[5], ow[6], ow[7]};
    }
}

__device__ __forceinline__ unsigned f2ord(float f) { const unsigned u = __float_as_uint(f); return (u & 0x80000000u) ? ~u : (u | 0x80000000u); }
__device__ __forceinline__ float ord2f(unsigned o) { return __uint_as_float((o & 0x80000000u) ? (o & 0x7fffffffu) : ~o); }
#define CE_DESC(x, y) do { const unsigned _hi = max((x), (y)), _lo = min((x), (y)); (x) = _hi; (y) = _lo; } while (0)
#define CE_ASC(x, y) do { const unsigned _hi = max((x), (y)), _lo = min((x), (y)); (x) = _lo; (y) = _hi; } while (0)
template <int N> __device__ __forceinline__ void bitonic_sort_desc(unsigned (&k)[N]) {
#pragma unroll
    for (int sz = 2; sz <= N; sz <<= 1)
#pragma unroll
        for (int j = sz >> 1; j > 0; j >>= 1)
#pragma unroll
            for (int i = 0; i < N; ++i) { const int l = i ^ j; if (l > i) { if ((i & sz) == 0) CE_DESC(k[i], k[l]); else CE_ASC(k[i], k[l]); } }
}
template <int N> __device__ __forceinline__ void bitonic_merge_desc(unsigned (&k)[N]) {
#pragma unroll
    for (int j = N >> 1; j > 0; j >>= 1)
#pragma unroll
        for (int i = 0; i < N; ++i) { const int l = i ^ j; if (l > i) CE_DESC(k[i], k[l]); }
}
#define CE2_DESC(kx, px, ky, py) do { const bool _sw = (ky) > (kx); const unsigned _k0 = _sw ? (ky) : (kx), _k1 = _sw ? (kx) : (ky), _p0 = _sw ? (py) : (px), _p1 = _sw ? (px) : (py); \
        (kx) = _k0; (ky) = _k1; (px) = _p0; (py) = _p1; } while (0)
template <int N> __device__ __forceinline__ void bitonic_sort_desc2(unsigned (&k)[N], unsigned (&p)[N]) {
#pragma unroll
    for (int sz = 2; sz <= N; sz <<= 1)
#pragma unroll
        for (int j = sz >> 1; j > 0; j >>= 1)
#pragma unroll
            for (int i = 0; i < N; ++i) { const int l = i ^ j; if (l > i) { if ((i & sz) == 0) CE2_DESC(k[i], p[i], k[l], p[l]); else CE2_DESC(k[l], p[l], k[i], p[i]); } }
}
template <int N> __device__ __forceinline__ void bitonic_merge_desc2(unsigned (&k)[N], unsigned (&p)[N]) {
#pragma unroll
    for (int j = N >> 1; j > 0; j >>= 1)
#pragma unroll
        for (int i = 0; i < N; ++i) { const int l = i ^ j; if (l > i) CE2_DESC(k[i], p[i], k[l], p[l]); }
}
__device__ __forceinline__ void lane_merge16(unsigned (&k)[16], int xm) {
    unsigned o[16];
#pragma unroll
    for (int i = 0; i < 16; ++i) o[i] = (unsigned)__shfl_xor((int)k[i], xm);
#pragma unroll
    for (int i = 0; i < 16; ++i) k[i] = max(k[i], o[15 - i]);
    bitonic_merge_desc<16>(k);
}
__device__ __forceinline__ void lane_merge16_2(unsigned (&k)[16], unsigned (&p)[16], int xm) {
    unsigned ok[16], op[16];
#pragma unroll
    for (int i = 0; i < 16; ++i) { ok[i] = (unsigned)__shfl_xor((int)k[i], xm); op[i] = (unsigned)__shfl_xor((int)p[i], xm); }
#pragma unroll
    for (int i = 0; i < 16; ++i) { const bool sw = ok[15 - i] > k[i]; k[i] = sw ? ok[15 - i] : k[i]; p[i] = sw ? op[15 - i] : p[i]; }
    bitonic_merge_desc2<16>(k, p);
}

__device__ void peer_select_phase(const Args& a, ldsp_t lds) {
    const int lane = threadIdx.x & 63, wave = threadIdx.x >> 6, g = lane >> 4, l15 = lane & 15, W = gridDim.x * 8;
    const bf16_t* QP = (const bf16_t*)(a.ws + WS_QP);
    const bf16_t* KB = (const bf16_t*)(a.ws + WS_KEYS);
    int* IDX = (int*)(a.ws + WS_IDX); float* GW = (float*)(a.ws + WS_G);
    for (int item = blockIdx.x * 8 + wave; item < 2048 * 8; item += W) {
        const int tok0 = (item >> 3) * 16, h = item & 7, tok = tok0 + l15;
        LAS unsigned* tl = (LAS unsigned*)(lds + wave * 8192);
#pragma unroll 1
        for (int hf = 0; hf < 2; ++hf) {
            bf16x8 bq[4];
#pragma unroll
            for (int ks = 0; ks < 4; ++ks) bq[ks] = *(const bf16x8*)(QP + (size_t)tok * 2048 + h * 256 + hf * 128 + 32 * ks + 8 * g);
            unsigned key[32];
#pragma unroll
            for (int mt = 0; mt < 8; ++mt) { f32x4 acc = {0.f, 0.f, 0.f, 0.f};
#pragma unroll
                for (int ks = 0; ks < 4; ++ks) { const bf16x8 af = *(const bf16x8*)(KB + (size_t)((h * 2 + hf) * 128 + 16 * mt + l15) * 128 + 32 * ks + 8 * g);
                    acc = __builtin_amdgcn_mfma_f32_16x16x32_bf16(af, bq[ks], acc, 0, 0, 0); }
#pragma unroll
                for (int r = 0; r < 4; ++r) { const int n = 16 * mt + 4 * g + r; key[4 * mt + r] = (f2ord(acc[r]) & ~127u) | (unsigned)(127 - n); }
                __builtin_amdgcn_sched_barrier(0); }
            unsigned lo[16], hi[16];
#pragma unroll
            for (int i = 0; i < 16; ++i) { lo[i] = key[i]; hi[i] = key[16 + i]; }
            bitonic_sort_desc<16>(lo); bitonic_sort_desc<16>(hi);
#pragma unroll
            for (int i = 0; i < 16; ++i) lo[i] = max(lo[i], hi[15 - i]);
            bitonic_merge_desc<16>(lo);
            lane_merge16(lo, 16); lane_merge16(lo, 32);
#pragma unroll
            for (int i = 0; i < 16; ++i) tl[(hf * 16 + i) * 64 + lane] = lo[i];
        }
        unsigned top[2][16];
#pragma unroll
        for (int i = 0; i < 16; ++i) { top[0][i] = tl[i * 64 + lane]; top[1][i] = tl[(16 + i) * 64 + lane]; }
        unsigned ck[16], cp[16];
#pragma unroll
        for (int i = 0; i < 16; ++i) { ck[i] = 0u; cp[i] = 0u; }
#define PEER_CAND(slot, I, J) do { const float _s = ord2f(top[0][I] & ~127u) + ord2f(top[1][J] & ~127u); ck[slot] = f2ord(_s); cp[slot] = ((127u - (top[0][I] & 127u)) << 7) | (127u - (top[1][J] & 127u)); } while (0)
        if (g == 0) { PEER_CAND(0, 0, 0); PEER_CAND(1, 0, 1); PEER_CAND(2, 0, 2); PEER_CAND(3, 0, 3); PEER_CAND(4, 0, 4); PEER_CAND(5, 0, 5); PEER_CAND(6, 0, 6); PEER_CAND(7, 0, 7);
            PEER_CAND(8, 0, 8); PEER_CAND(9, 0, 9); PEER_CAND(10, 0, 10); PEER_CAND(11, 0, 11); PEER_CAND(12, 0, 12); PEER_CAND(13, 0, 13); PEER_CAND(14, 0, 14); PEER_CAND(15, 0, 15); }
        else if (g == 1) { PEER_CAND(0, 1, 0); PEER_CAND(1, 1, 1); PEER_CAND(2, 1, 2); PEER_CAND(3, 1, 3); PEER_CAND(4, 1, 4); PEER_CAND(5, 1, 5); PEER_CAND(6, 1, 6); PEER_CAND(7, 1, 7);
            PEER_CAND(8, 2, 0); PEER_CAND(9, 2, 1); PEER_CAND(10, 2, 2); PEER_CAND(11, 2, 3); PEER_CAND(12, 2, 4); PEER_CAND(13, 3, 0); PEER_CAND(14, 3, 1); PEER_CAND(15, 3, 2); }
        else if (g == 2) { PEER_CAND(0, 3, 3); PEER_CAND(1, 4, 0); PEER_CAND(2, 4, 1); PEER_CAND(3, 4, 2); PEER_CAND(4, 5, 0); PEER_CAND(5, 5, 1); PEER_CAND(6, 6, 0); PEER_CAND(7, 6, 1);
            PEER_CAND(8, 7, 0); PEER_CAND(9, 7, 1); PEER_CAND(10, 8, 0); PEER_CAND(11, 9, 0); PEER_CAND(12, 10, 0); PEER_CAND(13, 11, 0); PEER_CAND(14, 12, 0); PEER_CAND(15, 13, 0); }
        else { PEER_CAND(0, 14, 0); PEER_CAND(1, 15, 0); }
#undef PEER_CAND
        bitonic_sort_desc2<16>(ck, cp);
        lane_merge16_2(ck, cp, 16); lane_merge16_2(ck, cp, 32);
        float ev[16]; float sum = 0.f; const float mx = ord2f(ck[0]);
#pragma unroll
        for (int i = 0; i < 16; ++i) { ev[i] = __expf(ord2f(ck[i]) - mx); sum += ev[i]; }
        const float inv = 1.0f / sum;
#pragma unroll
        for (int i = 0; i < 16; ++i) if ((i >> 2) == g) { IDX[(size_t)tok * 128 + h * 16 + i] = (int)cp[i]; GW[(size_t)tok * 128 + h * 16 + i] = ev[i] * inv; }
    }
}

constexpr float U_SCALE = 32.0f, V_SCALE = 2.0f;
__device__ void cvt_flat_fp8(const float* src, unsigned char* dst, size_t n, float scale) {
    const size_t gt = (size_t)blockIdx.x * 512 + threadIdx.x, gs = (size_t)gridDim.x * 512;
    for (size_t i = gt * 16; i < n; i += gs * 16) {
        u32x4 w; unsigned ws_[4];
#pragma unroll
        for (int q = 0; q < 4; ++q) { const f32x4 v = *(const f32x4*)(src + i + 4 * q) * scale;
            int p = __builtin_amdgcn_cvt_pk_fp8_f32(v[0], v[1], 0, false); p = __builtin_amdgcn_cvt_pk_fp8_f32(v[2], v[3], p, true); ws_[q] = (unsigned)p; }
        w.x = ws_[0]; w.y = ws_[1]; w.z = ws_[2]; w.w = ws_[3];
        *(u32x4*)(dst + i) = w;
    }
}
__device__ __forceinline__ float gelu_erf(float x) { return 0.5f * x * (1.0f + erff(x * 0.70710678118654752f)); }
template <bool DRY> __device__ void peer_gather_phase(const Args& a) {
    const int lane = threadIdx.x & 63, wave = threadIdx.x >> 6, W = gridDim.x * 8;
    const bf16_t* XN = (const bf16_t*)(a.ws + WS_XN);
    const unsigned char* UB = a.ws + WS_UB;
    const unsigned char* VB = a.ws + WS_VB;
    const int* IDX = (const int*)(a.ws + WS_IDX); const float* GW = (const float*)(a.ws + WS_G);
    const float* mod = (const float*)(a.ws + WS_MOD);
    const float* fg = a.in[I_FNG];
    float* H = a.out;
    for (int tok = blockIdx.x * 8 + wave; tok < T_; tok += W) {
        float xf[2][16];
#pragma unroll
        for (int c = 0; c < 2; ++c)
#pragma unroll
            for (int q = 0; q < 2; ++q) { const u32x4 xv = *(const u32x4*)(XN + (size_t)tok * 2048 + (c * 64 + lane) * 16 + 8 * q); const unsigned xs[4] = {xv.x, xv.y, xv.z, xv.w};
#pragma unroll
                for (int j = 0; j < 4; ++j) { xf[c][8 * q + 2 * j] = bflo(xs[j]); xf[c][8 * q + 2 * j + 1] = bfhi(xs[j]); } }
        const int id0 = IDX[(size_t)tok * 128 + lane], id1 = IDX[(size_t)tok * 128 + 64 + lane];
        const float g0 = GW[(size_t)tok * 128 + lane], g1 = GW[(size_t)tok * 128 + 64 + lane];
        float o[2][16];
#pragma unroll
        for (int c = 0; c < 2; ++c)
#pragma unroll
            for (int j = 0; j < 16; ++j) o[c][j] = 0.f;
        for (int kk = 0; kk < 128; kk += 4) {
            int ex[4]; float gw[4];
#pragma unroll
            for (int e = 0; e < 4; ++e) { const int k = kk + e;
                ex[e] = (k < 64) ? __builtin_amdgcn_readlane(id0, k & 63) : __builtin_amdgcn_readlane(id1, k & 63);
                gw[e] = (k < 64) ? __uint_as_float(__builtin_amdgcn_readlane(__float_as_uint(g0), k & 63)) : __uint_as_float(__builtin_amdgcn_readlane(__float_as_uint(g1), k & 63)); }
            u32x4 ur[4][2], vr[4][2];
#pragma unroll
            for (int e = 0; e < 4; ++e)
#pragma unroll
                for (int c = 0; c < 2; ++c) ur[e][c] = *(const u32x4*)(UB + (size_t)ex[e] * 2048 + (c * 64 + lane) * 16);
#pragma unroll
            for (int e = 0; e < 4; ++e)
#pragma unroll
                for (int c = 0; c < 2; ++c) vr[e][c] = *(const u32x4*)(VB + (size_t)ex[e] * 2048 + (c * 64 + lane) * 16);
            float dt[4];
#pragma unroll
            for (int e = 0; e < 4; ++e) { float s = 0.f;
#pragma unroll
                for (int c = 0; c < 2; ++c) { const unsigned us[4] = {ur[e][c].x, ur[e][c].y, ur[e][c].z, ur[e][c].w};
#pragma unroll
                    for (int j = 0; j < 4; ++j) { const f32x2 l = __builtin_amdgcn_cvt_pk_f32_fp8((int)us[j], false), hh = __builtin_amdgcn_cvt_pk_f32_fp8((int)us[j], true);
                        s += l.x * xf[c][4 * j] + l.y * xf[c][4 * j + 1] + hh.x * xf[c][4 * j + 2] + hh.y * xf[c][4 * j + 3]; } }
                dt[e] = s; }
#pragma unroll
            for (int off = 32; off >= 1; off >>= 1)
#pragma unroll
                for (int e = 0; e < 4; ++e) dt[e] += __shfl_xor(dt[e], off);
#pragma unroll
            for (int e = 0; e < 4; ++e) { const float cf = gw[e] * gelu_erf(dt[e] * (1.0f / U_SCALE)) * (1.0f / V_SCALE);
#pragma unroll
                for (int c = 0; c < 2; ++c) { const unsigned vs[4] = {vr[e][c].x, vr[e][c].y, vr[e][c].z, vr[e][c].w};
#pragma unroll
                    for (int j = 0; j < 4; ++j) { const f32x2 l = __builtin_amdgcn_cvt_pk_f32_fp8((int)vs[j], false), hh = __builtin_amdgcn_cvt_pk_f32_fp8((int)vs[j], true);
                        o[c][4 * j] += cf * l.x; o[c][4 * j + 1] += cf * l.y; o[c][4 * j + 2] += cf * hh.x; o[c][4 * j + 3] += cf * hh.y; } } }
        }
        const int b = tok >> 14; float ss = 0.f;
#pragma unroll
        for (int c = 0; c < 2; ++c)
#pragma unroll
            for (int q = 0; q < 4; ++q) { const int d0 = (c * 64 + lane) * 16 + 4 * q;
                const f32x4 h0 = *(const f32x4*)(H + (size_t)tok * 2048 + d0), q0 = *(const f32x4*)(mod + b * 12288 + 5 * 2048 + d0);
#pragma unroll
                for (int j = 0; j < 4; ++j) { const float hv = h0[j] + q0[j] * o[c][4 * q + j]; o[c][4 * q + j] = hv; ss += hv * hv; } }
        ss = wave_sum(ss);
        const float rstd = rsqrtf(ss * (1.0f / 2048.0f) + EPS);
#pragma unroll
        for (int c = 0; c < 2; ++c)
#pragma unroll
            for (int q = 0; q < 4; ++q) { const int d0 = (c * 64 + lane) * 16 + 4 * q;
                const f32x4 f0 = *(const f32x4*)(fg + d0); f32x4 r0;
#pragma unroll
                for (int j = 0; j < 4; ++j) r0[j] = o[c][4 * q + j] * rstd * f0[j];
                if (!DRY || rstd < 0.f) *(f32x4*)(H + (size_t)tok * 2048 + d0) = r0; }
    }
}

__global__ void __launch_bounds__(512, 2) mega(Args a) {
    extern __shared__ __attribute__((aligned(16))) unsigned char lds_raw[];
    ldsp_t lds = (ldsp_t)lds_raw;
    cg::grid_group grid = cg::this_grid();
    const int lo = a.ph_lo, hi = a.ph_hi;
    unsigned char* ws = a.ws;
    const float* mod = (const float*)(ws + WS_MOD);
#ifdef ONLY_PHASE
#define IN(k) ((k) == ONLY_PHASE && lo <= (k) && (k) < hi)
#else
#define IN(k) (lo <= (k) && (k) < hi)
#endif
    volatile LAS unsigned* bst = (volatile LAS unsigned*)(lds + LDS_BYTES - 16);
    if (threadIdx.x == 0) { bst[0] = 0u; bst[1] = 0u; }
    __syncthreads();
    XcdBarrier xbar = xcd_barrier_post((unsigned*)(ws + WS_CTL), bst);
#define SEAM(k) do { if (IN(k) && IN((k) + 1)) { if ((k) == 0) grid.sync(); else xcd_barrier(xbar); } } while (0)
#ifndef DUP_PHASE
#define DUP_PHASE (-1)
#endif
#define REP(k) for (int rep_ = 0; rep_ < ((DUP_PHASE == (k)) ? 2 : 1); ++rep_)

    if (IN(0)) REP(0) phase0(a, lds);
    SEAM(0);
    if (IN(1)) REP(1) norm_phase(a.in[I_X], a.in[I_N1G], mod, mod + 2048, (bf16_t*)(ws + WS_XN));
    SEAM(1);
    if (IN(2)) REP(2) {
        pg8::Gemm g{(const bf16_t*)(ws + WS_XN), (const bf16_t*)(ws + WS_WIN), T_, PW, 2048, 2048};
        pg8::StaticOrder S; S.init(T_, PW, gridDim.x, blockIdx.x);
        pg8::EpiIn E{(bf16_t*)(ws + WS_P)};
        pg8::gemm_phase(lds, g, S, E);
    }
    SEAM(2);
    if (IN(3)) REP(3) { fft1_phase(a, lds); __syncthreads(); gla_pre_phase(a, lds); gla_scan_phase<false>(a, lds); }
    SEAM(3);
    if (IN(4)) REP(4) { fft2_phase(a, lds); __syncthreads(); gla_scan_phase<true>(a, lds); }
    SEAM(4);
    if (IN(5)) REP(5) gla_post_phase(a);
    SEAM(5);
    if (IN(6)) REP(6) {
        {
            pg8::Gemm g{(const bf16_t*)a.out + (size_t)T_ * 2048, (const bf16_t*)(ws + WS_WFN), T_, 2048, 2048, 2048};
            pg8::StaticOrder S; S.init(T_, 2048, gridDim.x, blockIdx.x);
            pg8::EpiGate<0> E{(bf16_t*)(ws + WS_O), 2048, (const bf16_t*)(ws + WS_P) + PC_GF, PW};
            pg8::gemm_phase(lds, g, S, E);
        }
        {
            pg8::Gemm g{(const bf16_t*)(ws + WS_XN), (const bf16_t*)(ws + WS_WGLA), T_, 2048, 1024, 1024};
            pg8::StaticOrder S; S.init(T_, 2048, gridDim.x, blockIdx.x);
            pg8::EpiGate<1> E{(bf16_t*)(ws + WS_O), 2048, (const bf16_t*)(ws + WS_P) + PC_GG, PW};
            pg8::gemm_phase(lds, g, S, E);
        }
    }
    SEAM(6);
    if (IN(7)) REP(7) {
        pg8::Gemm g{(const bf16_t*)(ws + WS_O), (const bf16_t*)(ws + WS_WOUT), T_, 2048, 2048, 2048};
        pg8::StaticOrder S; S.init(T_, 2048, gridDim.x, blockIdx.x);
        pg8::EpiRes E{a.in[I_X], mod + 2 * 2048, a.out};
        pg8::gemm_phase(lds, g, S, E);
    }
    SEAM(7);
    if (IN(8)) REP(8) {
        norm_phase(a.out, a.in[I_N2G], mod + 3 * 2048, mod + 4 * 2048, (bf16_t*)(ws + WS_XN));
        cvt_flat_fp8(a.in[I_U], ws + WS_UB, (size_t)16384 * 2048, U_SCALE);
        cvt_flat_fp8(a.in[I_V], ws + WS_VB, (size_t)16384 * 2048, V_SCALE);
    }
    SEAM(8);
    if (IN(9)) REP(9) {
        pg8::Gemm g{(const bf16_t*)(ws + WS_XN), (const bf16_t*)(ws + WS_WQ), T_, 2048, 2048, 2048};
        pg8::StaticOrder S; S.init(T_, 2048, gridDim.x, blockIdx.x);
        pg8::EpiGate<2> E{(bf16_t*)(ws + WS_QP), 2048, nullptr, 0};
        pg8::gemm_phase(lds, g, S, E);
    }
    SEAM(9);
    if (IN(10)) REP(10) peer_select_phase(a, lds);
    SEAM(10);
    if (IN(11)) { if (DUP_PHASE == 11) peer_gather_phase<true>(a); peer_gather_phase<false>(a); }
#undef IN
#undef SEAM
}

constexpr int N_PHASES = 12;

extern "C" void kernel_launch(void* const* d_in, const int* in_sizes, int n_in, void* d_out, int out_size, void* d_ws, size_t ws_size, hipStream_t stream) {
    static int grid = 0;
    if (grid == 0) {
        int dev = 0, cus = 0, per_cu = 0;
        (void)hipGetDevice(&dev);
        (void)hipDeviceGetAttribute(&cus, hipDeviceAttributeMultiprocessorCount, dev);
        (void)hipFuncSetAttribute((const void*)mega, hipFuncAttributeMaxDynamicSharedMemorySize, LDS_BYTES);
        (void)hipOccupancyMaxActiveBlocksPerMultiprocessor(&per_cu, (const void*)mega, 512, LDS_BYTES);
        if (per_cu < 1 || n_in != 18 || ws_size < WS_END2 || cus != 256) { fprintf(stderr, "kernel_launch: unexpected configuration (per_cu %d, n_in %d, ws %zu)\n", per_cu, n_in, ws_size); grid = -1; return; }
        grid = cus;
    }
    if (grid < 0) return;
    (void)hipMemsetAsync((char*)d_ws + WS_CTL, 0, XCD_BAR_WORDS * 4, stream);
    Args a{};
    for (int i = 0; i < 18; ++i) a.in[i] = (const float*)d_in[i];
    a.out = (float*)d_out; a.ws = (unsigned char*)d_ws;
#if N_PHASE_LAUNCH
    for (int p = 0; p < N_PHASES; ++p) { a.ph_lo = p; a.ph_hi = p + 1;
        void* args[] = {&a};
        hipError_t e = hipLaunchCooperativeKernel((void*)mega, dim3(grid), dim3(512), args, LDS_BYTES, stream);
        if (e != hipSuccess) fprintf(stderr, "launch %d failed: %s\n", p, hipGetErrorString(e)); }
#else
    a.ph_lo = 0; a.ph_hi = N_PHASES;
    void* args[] = {&a};
    hipError_t e = hipLaunchCooperativeKernel((void*)mega, dim3(grid), dim3(512), args, LDS_BYTES, stream);
    if (e != hipSuccess) fprintf(stderr, "cooperative launch failed: %s (grid %d)\n", hipGetErrorString(e), grid);
#endif
}
```

```cpp
#include <hip/hip_runtime.h>
#include <hip/hip_cooperative_groups.h>
#include <cstdio>
namespace cg = cooperative_groups;

#define LAS __attribute__((address_space(3)))
typedef unsigned short bf16_t;
typedef short bf16x8 __attribute__((ext_vector_type(8)));
typedef float f32x4 __attribute__((ext_vector_type(4)));
typedef float f32x2 __attribute__((ext_vector_type(2)));
typedef unsigned u32x4 __attribute__((ext_vector_type(4)));
typedef unsigned u32x2 __attribute__((ext_vector_type(2)));
typedef LAS unsigned char* ldsp_t;

#ifndef N_PHASE_LAUNCH
#define N_PHASE_LAUNCH 0
#endif

constexpr int T_ = 32768, D_ = 2048, S_ = 16384;
constexpr float EPS = 1e-6f;
constexpr int PW = 8448;
constexpr int PC_Z = 0, PC_Q = 1024, PC_K = 1536, PC_V = 2048, PC_R = 3072, PC_GF = 4096, PC_GG = 6144, PC_A1 = 8192;
constexpr int LDS_BYTES = 147456;

constexpr size_t WS_CTL  = 0;
constexpr size_t WS_MOD  = 65536;
constexpr size_t WS_TW   = WS_MOD + 98304;
constexpr size_t WS_F1   = WS_TW + 131072;
constexpr size_t WS_F2   = WS_F1 + 65536;
constexpr size_t WS_DSEG = WS_F2 + 131072;
constexpr size_t WS_WIN  = WS_DSEG + 131072;
constexpr size_t WS_WFN  = WS_WIN + (size_t)8448 * 2048 * 2;
constexpr size_t WS_WGLA = WS_WFN + (size_t)2048 * 2048 * 2;
constexpr size_t WS_WOUT = WS_WGLA + (size_t)2048 * 1024 * 2;
constexpr size_t WS_WQ   = WS_WOUT + (size_t)2048 * 2048 * 2;
constexpr size_t WS_KEYS = WS_WQ + (size_t)2048 * 2048 * 2;
constexpr size_t WS_L    = WS_KEYS + (size_t)8 * 2 * 128 * 128 * 2;
constexpr size_t WS_XN   = WS_L + (size_t)512 * 16384 * 4;
constexpr size_t WS_O    = WS_XN + (size_t)T_ * 2048 * 2;
constexpr size_t WS_P    = WS_O + (size_t)T_ * 2048 * 2;
constexpr size_t WS_QP   = WS_P;
constexpr size_t WS_IDX  = WS_QP + (size_t)T_ * 2048 * 2;
constexpr size_t WS_G    = WS_IDX + (size_t)T_ * 128 * 4;
constexpr size_t WS_UB   = WS_G + (size_t)T_ * 128 * 4;
constexpr size_t WS_VB   = WS_UB + (size_t)16384 * 2048 * 2;
constexpr size_t WS_END  = WS_P + (size_t)T_ * PW * 2;
static_assert(WS_VB + (size_t)16384 * 2048 * 2 <= WS_END, "late buffers must fit in the P region");
static_assert(WS_END <= (size_t)1000 * 1000 * 1000, "workspace budget");

struct Args { const float* in[18]; float* out; unsigned char* ws; int ph_lo, ph_hi, li, pad; };
enum { I_X = 0, I_C, I_WADA, I_BADA, I_N1G, I_WIN, I_WFNET, I_WA2, I_BA, I_GNG, I_WGLA, I_WOUT, I_N2G, I_WQ, I_KEYS, I_U, I_V, I_FNG };

typedef __bf16 hwbf16x2 __attribute__((ext_vector_type(2)));
__device__ __forceinline__ unsigned f2bf(float f) { const __bf16 b = (__bf16)f; return (unsigned)__builtin_bit_cast(unsigned short, b); }
__device__ __forceinline__ float bf2f(unsigned h) { return __uint_as_float(h << 16); }
__device__ __forceinline__ unsigned pk2(float lo, float hi) { const f32x2 v = {lo, hi}; const hwbf16x2 b = __builtin_convertvector(v, hwbf16x2); return __builtin_bit_cast(unsigned, b); }
__device__ __forceinline__ float bflo(unsigned w) { return __uint_as_float(w << 16); }
__device__ __forceinline__ float bfhi(unsigned w) { return __uint_as_float(w & 0xffff0000u); }
__device__ __forceinline__ float wave_sum(float v) {
#pragma unroll
    for (int o = 32; o >= 1; o >>= 1) v += __shfl_xor(v, o);
    return v;
}
__device__ __forceinline__ float sigmoidf_(float v) { return 1.0f / (1.0f + __expf(-v)); }


#define XB_TMO      128
#define XB_XCNT(j)  (256  + 64 * (j))
#define XB_XSUB(j)  (1280 + 64 * (j))
#define XB_XGEN(j)  (2304 + 64 * (j))
#define XB_TOP      3328
#define XB_TOPGEN   3392
#define XCD_BAR_WORDS 3456
#define XB_SPIN_CAP (1u << 22)
__device__ __forceinline__ unsigned xb_ld(unsigned* p)              { return __hip_atomic_load(p, __ATOMIC_RELAXED, __HIP_MEMORY_SCOPE_AGENT); }
__device__ __forceinline__ unsigned xb_add(unsigned* p, unsigned v) { return __hip_atomic_fetch_add(p, v, __ATOMIC_RELAXED, __HIP_MEMORY_SCOPE_AGENT); }
__device__ __forceinline__ unsigned xb_xcc_id() { return (unsigned)__builtin_amdgcn_s_getreg((3 << 11) | 20) & 0xFu; }
#define XB_SPIN(cond, bar) do { unsigned _sp = 0; while (cond) { __builtin_amdgcn_s_sleep(1); \
    if ((++_sp & 255u) == 0u) { if (xb_ld(&(bar)[XB_TMO])) break; if (_sp > XB_SPIN_CAP) { atomicAdd(&(bar)[XB_TMO], 1u); break; } } } } while (0)
struct XcdBarrier { unsigned* bar; unsigned x; volatile LAS unsigned* st; };
__device__ __forceinline__ XcdBarrier xcd_barrier_post(unsigned* bar, volatile LAS unsigned* st) {
    XcdBarrier b; b.bar = bar; b.x = xb_xcc_id(); b.st = st;
    if (threadIdx.x == 0) (void)xb_add(&bar[XB_XCNT(b.x)], 1u);
    return b;
}
__device__ __forceinline__ void xcd_barrier_complete(unsigned* bar, unsigned x, unsigned& nloc, unsigned& nx) {
    const unsigned G = gridDim.x * gridDim.y * gridDim.z;
    unsigned sum, cnt, mine, sp = 0u;
    for (;;) {
        sum = 0u; cnt = 0u; mine = 0u;
#pragma unroll
        for (unsigned j = 0; j < 16; ++j) { const unsigned c = xb_ld(&bar[XB_XCNT(j)]); sum += c; cnt += (c > 0u) ? 1u : 0u; mine = (j == x) ? c : mine; }
        if (sum == G) break;
        __builtin_amdgcn_s_sleep(1);
        if ((++sp & 255u) == 0u) { if (xb_ld(&bar[XB_TMO])) break; if (sp > XB_SPIN_CAP) { atomicAdd(&bar[XB_TMO], 1u); break; } }
    }
    nloc = mine > 0u ? mine : 1u; nx = cnt > 0u ? cnt : 1u;
}
__device__ __forceinline__ void xcd_barrier(const XcdBarrier& b) {
    asm volatile("s_waitcnt vmcnt(0)" ::: "memory");
    __syncthreads();
    if (threadIdx.x == 0) {
        unsigned* bar = b.bar;
        __builtin_amdgcn_s_waitcnt(0);
        unsigned nloc = b.st[0], nx = b.st[1];
        if (nloc == 0u) { xcd_barrier_complete(bar, b.x, nloc, nx); b.st[0] = nloc; b.st[1] = nx; }
        const unsigned old = xb_add(&bar[XB_XSUB(b.x)], 1u);
        const unsigned gen = old / nloc;
        if (old + 1u == (gen + 1u) * nloc) {
            __builtin_amdgcn_fence(__ATOMIC_RELEASE, "agent");
            asm volatile("s_waitcnt vmcnt(0)" ::: "memory");
            const unsigned og = xb_add(&bar[XB_TOP], 1u);
            const unsigned tg = og / nx;
            if (og + 1u == (tg + 1u) * nx) xb_add(&bar[XB_TOPGEN], 1u);
            else XB_SPIN(xb_ld(&bar[XB_TOPGEN]) == tg, bar);
            __builtin_amdgcn_fence(__ATOMIC_ACQUIRE, "agent");
            xb_add(&bar[XB_XGEN(b.x)], 1u);
            asm volatile("s_waitcnt vmcnt(0)" ::: "memory");
        } else {
            XB_SPIN(xb_ld(&bar[XB_XGEN(b.x)]) == gen, bar);
            __builtin_amdgcn_fence(__ATOMIC_ACQUIRE, "agent");
            asm volatile("s_waitcnt vmcnt(0)" ::: "memory");
        }
    }
    __syncthreads();
}

__device__ __forceinline__ unsigned tr_off(unsigned row, unsigned ch) { return 256u * row + 16u * (ch ^ (((row & 3u) << 2) | ((row >> 2) & 3u))); }
#define TR_FRAG_ISSUE(r0, r1, base, lane, c, ks) do { const unsigned g_ = (lane) >> 4, q_ = ((lane) & 15) >> 2, p_ = (lane) & 3; \
    const unsigned a0_ = (base) + tr_off(32u * (ks) + 8u * g_ + q_, 2u * (c) + (p_ >> 1)) + 8u * (p_ & 1u); \
    const unsigned a1_ = (base) + tr_off(32u * (ks) + 8u * g_ + 4u + q_, 2u * (c) + (p_ >> 1)) + 8u * (p_ & 1u); \
    asm volatile("ds_read_b64_tr_b16 %0, %2\n\tds_read_b64_tr_b16 %1, %3" : "=&v"(r0), "=&v"(r1) : "v"(a0_), "v"(a1_) : "memory"); } while (0)
__device__ __forceinline__ bf16x8 tr_join(u32x2 r0, u32x2 r1) { const u32x4 v = {r0.x, r0.y, r1.x, r1.y}; return __builtin_bit_cast(bf16x8, v); }

namespace pg8 {
constexpr int BM = 256, BK = 64, HALF = 128, HTB = HALF * BK * 2, STAGE_BYTES = 8 * HTB, NXCD = 8, WGM = 8;
__device__ __forceinline__ int lds_byte(int r, int c) { const int st = (r >> 4) * 2 + (c >> 5), rr = r & 15, cc = c & 31, ob = rr * 64 + cc * 2; return st * 1024 + (ob ^ (((ob >> 9) & 1) << 5)); }
__device__ __forceinline__ void stage_rc(int b, int& R, int& C) { const int st = b / 1024, sb = b % 1024, swz = sb ^ (((sb >> 9) & 1) << 5); R = (st >> 1) * 16 + swz / 64; C = (st & 1) * 32 + (swz % 64) / 2; }
__device__ __forceinline__ int perm32(int rho) { const int n = rho >> 4, i = rho & 15; return 8 * (i >> 2) + 4 * n + (i & 3); }

struct Unit { int pm, pn; };
struct Gemm { const bf16_t* A; const bf16_t* Bt; int M, N, K, lda; };

struct StaticOrder {
    int nM, nN, nwg, G, c;
    __device__ void init(int M, int N, int G_, int c_) { nM = M / BM; nN = N / BM; nwg = nM * nN; G = G_; c = c_; }
    __device__ bool next(int i, Unit& u) const {
        const long L = (long)i * G + c; if (L >= nwg) return false;
        int wgid = (int)L; { const int q = nwg / NXCD, r = nwg % NXCD, xcd = wgid % NXCD, off = wgid / NXCD; wgid = (xcd < r ? xcd * (q + 1) : r * (q + 1) + (xcd - r) * q) + off; }
        const int nig = WGM * nN, gid = wgid / nig, fm = gid * WGM, gsz = (nM - fm) < WGM ? (nM - fm) : WGM;
        u.pm = fm + ((wgid % nig) % gsz); u.pn = (wgid % nig) / gsz; return true;
    }
};

template <class Epi>
__device__ __forceinline__ void gemm_phase(ldsp_t lds, const Gemm g, const StaticOrder& S, const Epi& E) {
    const int tid = threadIdx.x, wid = __builtin_amdgcn_readfirstlane(tid >> 6), lane = tid & 63, wr = wid >> 2, wc = wid & 3, fr = lane & 15, fq = lane >> 4;
    const int K = g.K, nt = K / BK, lda = g.lda;
    unsigned voffA[2], voffB[2];
#pragma unroll
    for (int i = 0; i < 2; ++i) { int R, C; stage_rc(tid * 16 + i * 8192, R, C); const int Rb = Epi::PERM ? ((R & ~31) + perm32(R & 31)) : R;
        voffA[i] = (unsigned)(R * lda + C) * 2u; voffB[i] = (unsigned)(Rb * K + C) * 2u; }
    const size_t kstep = (size_t)(BK * 2);
    const size_t hstepA = (size_t)HALF * lda * 2, hstepB = (size_t)HALF * K * 2;
    const size_t tstepA = 2 * hstepA, tstepB = 2 * hstepB;
    const unsigned ldsw = (unsigned)wid * 1024u;
    const int aoff = lds_byte(wr * 64 + fr, fq * 8), boff = lds_byte(wc * 32 + fr, fq * 8);
#define PG8_SA(b, h) (((b) * 2 + (h)) * HTB)
#define PG8_SB(b, h) ((4 + (b) * 2 + (h)) * HTB)
#define PG8_STAGE(bufoff, gbase, voff) do { _Pragma("unroll") for (int _i = 0; _i < 2; ++_i) \
        __builtin_amdgcn_global_load_lds((const unsigned*)((const char*)(gbase) + (voff)[_i]), (LAS unsigned*)(lds + (bufoff) + ldsw + _i * 8192), 16, 0, 0); } while (0)
#define PG8_LDA(dst, b, h) do { _Pragma("unroll") for (int m = 0; m < 4; ++m) _Pragma("unroll") for (int k = 0; k < 2; ++k) dst[m][k] = *(const LAS bf16x8*)(lds + PG8_SA(b, h) + aoff + m * 2048 + k * 1024); } while (0)
#define PG8_LDB(dst, b, h) do { _Pragma("unroll") for (int n = 0; n < 2; ++n) _Pragma("unroll") for (int k = 0; k < 2; ++k) dst[n][k] = *(const LAS bf16x8*)(lds + PG8_SB(b, h) + boff + n * 2048 + k * 1024); } while (0)
#define PG8_MMA(ai, bj, At, Bt) do { __builtin_amdgcn_s_setprio(1); _Pragma("unroll") for (int m = 0; m < 4; ++m) _Pragma("unroll") for (int n = 0; n < 2; ++n) _Pragma("unroll") for (int k = 0; k < 2; ++k) \
        acc[ai][bj][m][n] = __builtin_amdgcn_mfma_f32_16x16x32_bf16(Bt[n][k], At[m][k], acc[ai][bj][m][n], 0, 0, 0); __builtin_amdgcn_s_setprio(0); } while (0)
#define PG8_WAIT_V(n) asm volatile("s_waitcnt vmcnt(" #n ")" ::: "memory")
#define PG8_WAIT_L(n) asm volatile("s_waitcnt lgkmcnt(" #n ")" ::: "memory")
#define PG8_BAR __builtin_amdgcn_s_barrier()
#define PG8_SCHED __builtin_amdgcn_sched_barrier(0)
    Unit cur, nxt; int ui = 0;
    if (!S.next(0, cur)) return;
    f32x4 acc[2][2][4][2];
#pragma unroll
    for (int a = 0; a < 2; ++a)
#pragma unroll
        for (int b = 0; b < 2; ++b)
#pragma unroll
            for (int m = 0; m < 4; ++m)
#pragma unroll
                for (int n = 0; n < 2; ++n) acc[a][b][m][n] = (f32x4){0.f, 0.f, 0.f, 0.f};
    bf16x8 At[4][2], B0[2][2], B1[2][2];
    const char* cA = (const char*)g.A + (size_t)cur.pm * tstepA; const char* cB = (const char*)g.Bt + (size_t)cur.pn * tstepB;
    PG8_STAGE(PG8_SB(0, 0), cB, voffB); PG8_STAGE(PG8_SA(0, 0), cA, voffA); PG8_STAGE(PG8_SB(0, 1), cB + hstepB, voffB); PG8_STAGE(PG8_SA(0, 1), cA + hstepA, voffA);
    if (wr == 1) PG8_BAR;
    PG8_WAIT_V(4); PG8_BAR;
    PG8_STAGE(PG8_SB(1, 0), cB + kstep, voffB); PG8_STAGE(PG8_SA(1, 0), cA + kstep, voffA); PG8_STAGE(PG8_SB(1, 1), cB + hstepB + kstep, voffB);
    PG8_WAIT_V(6); PG8_BAR;
    for (;;) {
        const bool has_next = S.next(ui + 1, nxt);
        const char* nA = has_next ? (const char*)g.A + (size_t)nxt.pm * tstepA : cA; const char* nB = has_next ? (const char*)g.Bt + (size_t)nxt.pn * tstepB : cB;
        for (int t = 0; t < nt; t += 2) {
            const bool last = (t == nt - 2);
            const char* a1 = cA + (size_t)(t + 1) * kstep;
            const char* a2 = last ? nA : cA + (size_t)(t + 2) * kstep; const char* b2 = last ? nB : cB + (size_t)(t + 2) * kstep;
            const char* a3 = a2 + kstep; const char* b3 = b2 + kstep;
            PG8_LDB(B0, 0, 0); PG8_SCHED; PG8_LDA(At, 0, 0); PG8_STAGE(PG8_SA(1, 1), a1 + hstepA, voffA);
            PG8_WAIT_L(8); PG8_BAR; PG8_WAIT_L(0); PG8_MMA(0, 0, At, B0); PG8_BAR; PG8_SCHED;
            PG8_LDB(B1, 0, 1); PG8_STAGE(PG8_SB(0, 0), b2, voffB);
            PG8_BAR; PG8_WAIT_L(0); PG8_MMA(0, 1, At, B1); PG8_BAR;
            PG8_LDA(At, 0, 1); PG8_STAGE(PG8_SA(0, 0), a2, voffA);
            PG8_BAR; PG8_WAIT_L(0); PG8_MMA(1, 0, At, B0); PG8_BAR; PG8_SCHED;
            PG8_STAGE(PG8_SB(0, 1), b2 + hstepB, voffB);
            PG8_WAIT_V(6); PG8_BAR; PG8_MMA(1, 1, At, B1); PG8_BAR;
            PG8_LDB(B0, 1, 0); PG8_SCHED; PG8_LDA(At, 1, 0); PG8_STAGE(PG8_SA(0, 1), a2 + hstepA, voffA);
            PG8_WAIT_L(8); PG8_BAR; PG8_WAIT_L(0); PG8_MMA(0, 0, At, B0); PG8_BAR; PG8_SCHED;
            PG8_LDB(B1, 1, 1); PG8_STAGE(PG8_SB(1, 0), b3, voffB);
            PG8_BAR; PG8_WAIT_L(0); PG8_MMA(0, 1, At, B1); PG8_BAR;
            PG8_LDA(At, 1, 1); PG8_STAGE(PG8_SA(1, 0), a3, voffA);
            PG8_BAR; PG8_WAIT_L(0); PG8_MMA(1, 0, At, B0); PG8_BAR; PG8_SCHED;
            PG8_STAGE(PG8_SB(1, 1), b3 + hstepB, voffB);
            PG8_WAIT_V(6); PG8_BAR; PG8_MMA(1, 1, At, B1); PG8_BAR;
        }
        E(acc, cur, wr, wc, fr, fq);
        if (!has_next) break;
#pragma unroll
        for (int a = 0; a < 2; ++a)
#pragma unroll
            for (int b = 0; b < 2; ++b)
#pragma unroll
                for (int m = 0; m < 4; ++m)
#pragma unroll
                    for (int n = 0; n < 2; ++n) acc[a][b][m][n] = (f32x4){0.f, 0.f, 0.f, 0.f};
        cur = nxt; cA = nA; cB = nB; ++ui;
    }
    PG8_WAIT_V(0);
    if (wr == 0) PG8_BAR;
    PG8_BAR;
#undef PG8_SA
#undef PG8_SB
#undef PG8_STAGE
#undef PG8_LDA
#undef PG8_LDB
#undef PG8_MMA
#undef PG8_WAIT_V
#undef PG8_WAIT_L
#undef PG8_BAR
#undef PG8_SCHED
}

struct EpiIn {
    static constexpr bool PERM = true;
    bf16_t* P;
    __device__ __forceinline__ void operator()(const f32x4 (&acc)[2][2][4][2], const Unit& u, int wr, int wc, int fr, int fq) const {
        const int row0 = u.pm * BM + wr * 64 + fr, col0 = u.pn * BM + wc * 32 + 8 * fq;
        const bool sg = (u.pn >= 16 && u.pn < 32);
#pragma unroll
        for (int ai = 0; ai < 2; ++ai)
#pragma unroll
            for (int m = 0; m < 4; ++m) { bf16_t* rowp = P + (size_t)(row0 + ai * HALF + m * 16) * PW + col0;
#pragma unroll
                for (int bj = 0; bj < 2; ++bj) { f32x4 v0 = acc[ai][bj][m][0], v1 = acc[ai][bj][m][1];
                    if (sg) {
#pragma unroll
                        for (int j = 0; j < 4; ++j) { v0[j] = sigmoidf_(v0[j]); v1[j] = sigmoidf_(v1[j]); } }
                    u32x4 w; w.x = pk2(v0[0], v0[1]); w.y = pk2(v0[2], v0[3]); w.z = pk2(v1[0], v1[1]); w.w = pk2(v1[2], v1[3]);
                    *(u32x4*)(rowp + bj * HALF) = w; } }
    }
};
template <int MODE> struct EpiGate {
    static constexpr bool PERM = true;
    bf16_t* O; int ldo; const bf16_t* G; int ldg;
    __device__ __forceinline__ void operator()(const f32x4 (&acc)[2][2][4][2], const Unit& u, int wr, int wc, int fr, int fq) const {
        const int row0 = u.pm * BM + wr * 64 + fr, col0 = u.pn * BM + wc * 32 + 8 * fq;
#pragma unroll
        for (int ai = 0; ai < 2; ++ai)
#pragma unroll
            for (int m = 0; m < 4; ++m) { const size_t row = (size_t)(row0 + ai * HALF + m * 16);
#pragma unroll
                for (int bj = 0; bj < 2; ++bj) { const f32x4 v0 = acc[ai][bj][m][0], v1 = acc[ai][bj][m][1];
                    float r[8] = {v0[0], v0[1], v0[2], v0[3], v1[0], v1[1], v1[2], v1[3]};
                    bf16_t* op = O + row * ldo + col0 + bj * HALF;
                    if (MODE != 2) { const u32x4 gw = *(const u32x4*)(G + row * ldg + col0 + bj * HALF);
                        const unsigned gws[4] = {gw.x, gw.y, gw.z, gw.w};
#pragma unroll
                        for (int j = 0; j < 4; ++j) { r[2 * j] *= bflo(gws[j]); r[2 * j + 1] *= bfhi(gws[j]); } }
                    if (MODE == 1) { const u32x4 ow = *(const u32x4*)op; const unsigned ows[4] = {ow.x, ow.y, ow.z, ow.w};
#pragma unroll
                        for (int j = 0; j < 4; ++j) { r[2 * j] += bflo(ows[j]); r[2 * j + 1] += bfhi(ows[j]); } }
                    u32x4 w; w.x = pk2(r[0], r[1]); w.y = pk2(r[2], r[3]); w.z = pk2(r[4], r[5]); w.w = pk2(r[6], r[7]);
                    *(u32x4*)op = w; } }
    }
};
struct EpiRes {
    static constexpr bool PERM = false;
    const float* X; const float* gmod; float* H;
    __device__ __forceinline__ void operator()(const f32x4 (&acc)[2][2][4][2], const Unit& u, int wr, int wc, int fr, int fq) const {
        const int row0 = u.pm * BM + wr * 64 + fr, col0 = u.pn * BM + wc * 32 + 4 * fq;
        const float* gm = gmod + (size_t)((u.pm * BM) >> 14) * 12288;
        f32x4 gv[2][2];
#pragma unroll
        for (int bj = 0; bj < 2; ++bj)
#pragma unroll
            for (int n = 0; n < 2; ++n) gv[bj][n] = *(const f32x4*)(gm + col0 + bj * HALF + n * 16);
#pragma unroll
        for (int ai = 0; ai < 2; ++ai)
#pragma unroll
            for (int m = 0; m < 4; ++m) { const size_t off = (size_t)(row0 + ai * HALF + m * 16) * 2048 + col0;
#pragma unroll
                for (int bj = 0; bj < 2; ++bj)
#pragma unroll
                    for (int n = 0; n < 2; ++n) { const f32x4 xs = *(const f32x4*)(X + off + bj * HALF + n * 16);
                        *(f32x4*)(H + off + bj * HALF + n * 16) = xs + gv[bj][n] * acc[ai][bj][m][n]; } }
    }
};
}

__device__ void gemv_task(const Args& a, int task, ldsp_t lds) {
    const int tid = threadIdx.x, cq = tid & 15, rl = tid >> 4;
    const float* W = a.in[I_WADA] + 64 * task + 4 * cq;
    const float* c = a.in[I_C];
    f32x4 acc0 = {0.f, 0.f, 0.f, 0.f}, acc1 = {0.f, 0.f, 0.f, 0.f};
    for (int r = rl; r < 2048; r += 32) {
        const f32x4 w = *(const f32x4*)(W + (size_t)r * 12288);
        const float c0 = c[r], c1 = c[2048 + r];
        const float s0 = c0 / (1.f + __expf(-c0)), s1 = c1 / (1.f + __expf(-c1));
        acc0 += s0 * w; acc1 += s1 * w;
    }
    LAS float* red = (LAS float*)lds;
    __syncthreads();
#pragma unroll
    for (int j = 0; j < 4; ++j) { red[(rl * 16 + cq) * 8 + j] = acc0[j]; red[(rl * 16 + cq) * 8 + 4 + j] = acc1[j]; }
    __syncthreads();
    if (tid < 128) {
        const int b = tid >> 6, col = tid & 63; float s = 0.f;
        for (int r = 0; r < 32; ++r) s += red[(r * 16 + (col >> 2)) * 8 + b * 4 + (col & 3)];
        float* mod = (float*)(a.ws + WS_MOD);
        mod[b * 12288 + 64 * task + col] = s + a.in[I_BADA][64 * task + col];
    }
    __syncthreads();
}

template <class CMap>
__device__ __forceinline__ void tr_tile(const float* src, int src_ld, int r0, int c0, CMap cmap, bf16_t* dst, int dst_ld, ldsp_t lds) {
    LAS float* tile = (LAS float*)lds;
    const int tid = threadIdx.x, cc = tid & 63, rr0 = tid >> 6;
    const int sc = cmap(c0 + cc);
#pragma unroll
    for (int i = 0; i < 8; ++i) { const int r = rr0 + 8 * i; tile[cc * 65 + r] = sc >= 0 ? src[(size_t)(r0 + r) * src_ld + sc] : 0.f; }
    __syncthreads();
    const int rp = (tid & 31) * 2, c1 = tid >> 5;
#pragma unroll
    for (int i = 0; i < 4; ++i) { const int c = c1 + 16 * i; *(unsigned*)(dst + (size_t)(c0 + c) * dst_ld + r0 + rp) = pk2(tile[c * 65 + rp], tile[c * 65 + rp + 1]); }
    __syncthreads();
}
struct MapId { __device__ int operator()(int c) const { return c; } };
struct MapWin { __device__ int operator()(int c) const { return c < 4096 ? c : (c < 8192 ? c + 32 : (c < 8224 ? c - 4096 : -1)); } };

__device__ void fold_tile(const Args& a, int tile, ldsp_t lds) {
    LAS float* wl = (LAS float*)lds;
    LAS float* ct = (LAS float*)(lds + 65536);
    const int tid = threadIdx.x;
    const int nb = tile & 31, kb = tile >> 5;
    const int ri = kb >> 4, g = (kb >> 2) & 3, c0 = (kb & 3) * 64, n0 = nb * 64;
    const float* wf = a.in[I_WFNET] + (size_t)(g * 256) * 2048 + n0;
    __syncthreads();
#pragma unroll
    for (int j = 0; j < 8; ++j) { const int row = (tid >> 4) + 32 * j, c4 = (tid & 15) * 4;
        const f32x4 v = *(const f32x4*)(wf + (size_t)row * 2048 + c4);
        wl[row * 64 + c4] = v[0]; wl[row * 64 + c4 + 1] = v[1]; wl[row * 64 + c4 + 2] = v[2]; wl[row * 64 + c4 + 3] = v[3]; }
    if (tid < 256) ct[tid] = cospif((float)tid * (1.0f / 128.0f));
    __syncthreads();
    const int kk = tid & 63, nn0 = tid >> 6, c = c0 + kk;
    float acc[8];
#pragma unroll
    for (int i = 0; i < 8; ++i) acc[i] = 0.f;
    for (int m = 0; m < 256; ++m) {
        const int idx = (m * c) & 255;
        const float cs = ri ? ct[(idx + 192) & 255] : ct[idx];
#pragma unroll
        for (int i = 0; i < 8; ++i) acc[i] += wl[m * 64 + nn0 + 8 * i] * cs;
    }
    bf16_t* dst = (bf16_t*)(a.ws + WS_WFN);
#pragma unroll
    for (int i = 0; i < 8; ++i) dst[(size_t)(n0 + nn0 + 8 * i) * 2048 + ri * 1024 + g * 256 + c] = (bf16_t)f2bf(acc[i] * (1.0f / 2048.0f));
    __syncthreads();
}

__device__ void tables_task(const Args& a, int task) {
    const int tid = threadIdx.x;
    bf16_t* F1 = (bf16_t*)(a.ws + WS_F1); bf16_t* F2 = (bf16_t*)(a.ws + WS_F2); float* TW = (float*)(a.ws + WS_TW);
    {
        const int e = task * 512 + tid, R = e >> 7, sh = e & 127, w = R >> 5, mt = (R >> 4) & 1, r = R & 15, kf = 16 * w + r;
        float s, c; sincospif((float)((kf * sh) & 127) * (1.0f / 64.0f), &s, &c);
        F1[e] = (bf16_t)f2bf(mt ? -s : c);
    }
#pragma unroll
    for (int q = 0; q < 2; ++q) {
        const int e = task * 1024 + q * 512 + tid, R = e >> 8, K = e & 255, sl = K >> 1, ri = K & 1, w = R >> 5, mt = (R >> 4) & 1, r = R & 15, kf = 16 * w + r;
        float s, c; sincospif((float)((kf * sl) & 127) * (1.0f / 64.0f), &s, &c);
        const float v = mt ? (ri ? c : -s) : (ri ? s : c);
        F2[e] = (bf16_t)f2bf(v);
    }
    if (task < 32) {
        const int e = task * 512 + tid, kl = e >> 7, sl = e & 127;
        float s, c; sincospif((float)(kl * sl) * (1.0f / 8192.0f), &s, &c);
        TW[2 * e] = c; TW[2 * e + 1] = s;
    }
}

__device__ void cvt_flat(const float* src, bf16_t* dst, size_t n) {
    const size_t gt = (size_t)blockIdx.x * 512 + threadIdx.x, gs = (size_t)gridDim.x * 512;
    for (size_t i = gt * 8; i < n; i += gs * 8) {
        const f32x4 v0 = *(const f32x4*)(src + i), v1 = *(const f32x4*)(src + i + 4);
        u32x4 w; w.x = pk2(v0[0], v0[1]); w.y = pk2(v0[2], v0[3]); w.z = pk2(v1[0], v1[1]); w.w = pk2(v1[2], v1[3]);
        *(u32x4*)(dst + i) = w;
    }
}

__device__ void phase0(const Args& a, ldsp_t lds) {
    const int G = gridDim.x, bx = blockIdx.x;
    for (int t = bx; t < 192; t += G) gemv_task(a, t, lds);
    for (int t = bx; t < 64; t += G) tables_task(a, t);
    cvt_flat(a.in[I_KEYS], (bf16_t*)(a.ws + WS_KEYS), (size_t)8 * 2 * 128 * 128);
    for (int t = bx; t < 132 * 32; t += G) tr_tile(a.in[I_WIN], 8224, (t & 31) * 64, (t >> 5) * 64, MapWin(), (bf16_t*)(a.ws + WS_WIN), 2048, lds);
    for (int t = bx; t < 32 * 16; t += G) tr_tile(a.in[I_WGLA], 2048, (t & 15) * 64, (t >> 4) * 64, MapId(), (bf16_t*)(a.ws + WS_WGLA), 1024, lds);
    for (int t = bx; t < 32 * 32; t += G) tr_tile(a.in[I_WOUT], 2048, (t & 31) * 64, (t >> 5) * 64, MapId(), (bf16_t*)(a.ws + WS_WOUT), 2048, lds);
    for (int t = bx; t < 32 * 32; t += G) tr_tile(a.in[I_WQ], 2048, (t & 31) * 64, (t >> 5) * 64, MapId(), (bf16_t*)(a.ws + WS_WQ), 2048, lds);
    for (int t = bx; t < 1024; t += G) fold_tile(a, t, lds);
}

__device__ void norm_phase(const float* X, const float* gvec, const float* mod_sh, const float* mod_sc, bf16_t* out) {
    const int lane = threadIdx.x & 63, wave = threadIdx.x >> 6;
    const int W = gridDim.x * 8;
    for (int row = blockIdx.x * 8 + wave; row < T_; row += W) {
        const float* xr = X + (size_t)row * 2048;
        const int b = row >> 14;
        f32x4 v[8]; float ss = 0.f;
#pragma unroll
        for (int j = 0; j < 8; ++j) { v[j] = *(const f32x4*)(xr + (j * 64 + lane) * 4); ss += v[j][0] * v[j][0] + v[j][1] * v[j][1] + v[j][2] * v[j][2] + v[j][3] * v[j][3]; }
        ss = wave_sum(ss);
        const float rstd = rsqrtf(ss * (1.0f / 2048.0f) + EPS);
#pragma unroll
        for (int j = 0; j < 8; ++j) { const int d = (j * 64 + lane) * 4;
            const f32x4 gg = *(const f32x4*)(gvec + d), sc = *(const f32x4*)(mod_sc + b * 12288 + d), sh = *(const f32x4*)(mod_sh + b * 12288 + d);
            f32x4 y = v[j] * rstd * gg * (1.0f + sc) + sh;
            u32x2 w; w.x = pk2(y[0], y[1]); w.y = pk2(y[2], y[3]);
            *(u32x2*)(out + (size_t)row * 2048 + d) = w; }
    }
}

__device__ void fft1_phase(const Args& a, ldsp_t lds) {
    const int tid = threadIdx.x, lane = tid & 63, w = tid >> 6, g = lane >> 4, l15 = lane & 15;
    const bf16_t* F1 = (const bf16_t*)(a.ws + WS_F1);
    const float* TW = (const float*)(a.ws + WS_TW);
    const bf16_t* P = (const bf16_t*)(a.ws + WS_P);
    bf16_t* T1 = (bf16_t*)a.out;
    bf16x8 Af[2][4];
#pragma unroll
    for (int mt = 0; mt < 2; ++mt)
#pragma unroll
        for (int ks = 0; ks < 4; ++ks) Af[mt][ks] = *(const bf16x8*)(F1 + (32 * w + 16 * mt + l15) * 128 + 32 * ks + 8 * g);
    constexpr int OS = 272, OFF_OUT = 128 * 256;
    const unsigned ldsb = (unsigned)(size_t)lds;
    const int c16 = tid & 15, r32 = tid >> 4;
    u32x4 buf[4];
    int tile = blockIdx.x;
    if (tile < 2048) { const int cb = tile & 7, s_lo = (tile >> 3) & 127, b = tile >> 10;
        const bf16_t* src = P + (size_t)(b * S_ + s_lo) * PW + PC_Z + cb * 128 + 8 * c16;
#pragma unroll
        for (int i = 0; i < 4; ++i) buf[i] = *(const u32x4*)(src + (size_t)(r32 + 32 * i) * 128 * PW); }
    for (; tile < 2048; tile += gridDim.x) {
        const int cb = tile & 7, s_lo = (tile >> 3) & 127, b = tile >> 10;
        __syncthreads();
#pragma unroll
        for (int i = 0; i < 4; ++i) *(LAS u32x4*)(lds + tr_off(r32 + 32 * i, c16)) = buf[i];
        __syncthreads();
        { const int nt_ = tile + gridDim.x;
          if (nt_ < 2048) { const int cb2 = nt_ & 7, s2 = (nt_ >> 3) & 127, b2 = nt_ >> 10;
            const bf16_t* src = P + (size_t)(b2 * S_ + s2) * PW + PC_Z + cb2 * 128 + 8 * c16;
#pragma unroll
            for (int i = 0; i < 4; ++i) buf[i] = *(const u32x4*)(src + (size_t)(r32 + 32 * i) * 128 * PW); } }
        f32x4 acc[2][8];
#pragma unroll
        for (int mt = 0; mt < 2; ++mt)
#pragma unroll
            for (int nt = 0; nt < 8; ++nt) acc[mt][nt] = (f32x4){0.f, 0.f, 0.f, 0.f};
#pragma unroll
        for (int nt = 0; nt < 8; ++nt) { u32x2 t0[4], t1[4];
            unsigned lv = (unsigned)lane; asm volatile("" : "+v"(lv));
#pragma unroll
            for (int ks = 0; ks < 4; ++ks) TR_FRAG_ISSUE(t0[ks], t1[ks], ldsb, lv, nt, ks);
            asm volatile("s_waitcnt lgkmcnt(0)" : "+v"(t0[0]), "+v"(t1[0]), "+v"(t0[1]), "+v"(t1[1]), "+v"(t0[2]), "+v"(t1[2]), "+v"(t0[3]), "+v"(t1[3]) :: "memory");
#pragma unroll
            for (int ks = 0; ks < 4; ++ks) { const bf16x8 bfr = tr_join(t0[ks], t1[ks]);
                acc[0][nt] = __builtin_amdgcn_mfma_f32_16x16x32_bf16(Af[0][ks], bfr, acc[0][nt], 0, 0, 0);
                acc[1][nt] = __builtin_amdgcn_mfma_f32_16x16x32_bf16(Af[1][ks], bfr, acc[1][nt], 0, 0, 0); } }
#pragma unroll
        for (int r = 0; r < 4; ++r) { const int k_lo = 16 * w + 4 * g + r;
            const f32x2 cs = *(const f32x2*)(TW + 2 * (k_lo * 128 + s_lo));
#pragma unroll
            for (int nt = 0; nt < 8; ++nt) { const float tr = acc[0][nt][r], ti = acc[1][nt][r];
                *(LAS unsigned short*)(lds + OFF_OUT + (2 * k_lo) * OS + (16 * nt + l15) * 2) = (unsigned short)f2bf(tr * cs.x + ti * cs.y);
                *(LAS unsigned short*)(lds + OFF_OUT + (2 * k_lo + 1) * OS + (16 * nt + l15) * 2) = (unsigned short)f2bf(ti * cs.x - tr * cs.y); } }
        __syncthreads();
#pragma unroll
        for (int i = 0; i < 8; ++i) { const int row = r32 + 32 * i;
            const u32x4 v = *(const LAS u32x4*)(lds + OFF_OUT + row * OS + c16 * 16);
            *(u32x4*)(T1 + ((size_t)((b * 128 + (row >> 1)) * 128 + s_lo) * 2 + (row & 1)) * 1024 + cb * 128 + c16 * 8) = v; }
    }
}

__device__ void fft2_phase(const Args& a, ldsp_t lds) {
    const int tid = threadIdx.x, lane = tid & 63, w = tid >> 6, g = lane >> 4, l15 = lane & 15;
    const bf16_t* F2 = (const bf16_t*)(a.ws + WS_F2);
    const bf16_t* T1 = (const bf16_t*)a.out;
    bf16_t* ZA = (bf16_t*)a.out + (size_t)T_ * 2048;
    bf16x8 Af[2][8];
#pragma unroll
    for (int mt = 0; mt < 2; ++mt)
#pragma unroll
        for (int ks = 0; ks < 8; ++ks) Af[mt][ks] = *(const bf16x8*)(F2 + (32 * w + 16 * mt + l15) * 256 + 32 * ks + 8 * g);
    constexpr int OS = 272, OFF_OUT = 256 * 256;
    const unsigned ldsb = (unsigned)(size_t)lds;
    static_assert(OFF_OUT + 256 * OS <= LDS_BYTES - 16, "FFT2 LDS");
    const int c16 = tid & 15, r32 = tid >> 4;
    u32x4 buf[8];
    int tile = blockIdx.x;
    if (tile < 2048) { const int cb = tile & 7, k_lo = (tile >> 3) & 127, b = tile >> 10;
        const bf16_t* src = T1 + ((size_t)(b * 128 + k_lo) * 256) * 1024 + cb * 128 + 8 * c16;
#pragma unroll
        for (int i = 0; i < 8; ++i) buf[i] = *(const u32x4*)(src + (size_t)(r32 + 32 * i) * 1024); }
    for (; tile < 2048; tile += gridDim.x) {
        const int cb = tile & 7, k_lo = (tile >> 3) & 127, b = tile >> 10;
        __syncthreads();
#pragma unroll
        for (int i = 0; i < 8; ++i) *(LAS u32x4*)(lds + tr_off(r32 + 32 * i, c16)) = buf[i];
        __syncthreads();
        { const int nt_ = tile + gridDim.x;
          if (nt_ < 2048) { const int cb2 = nt_ & 7, k2 = (nt_ >> 3) & 127, b2 = nt_ >> 10;
            const bf16_t* src = T1 + ((size_t)(b2 * 128 + k2) * 256) * 1024 + cb2 * 128 + 8 * c16;
#pragma unroll
            for (int i = 0; i < 8; ++i) buf[i] = *(const u32x4*)(src + (size_t)(r32 + 32 * i) * 1024); } }
        f32x4 acc[2][8];
#pragma unroll
        for (int mt = 0; mt < 2; ++mt)
#pragma unroll
            for (int nt = 0; nt < 8; ++nt) acc[mt][nt] = (f32x4){0.f, 0.f, 0.f, 0.f};
#pragma unroll
        for (int nt = 0; nt < 8; ++nt)
#pragma unroll
            for (int kh = 0; kh < 2; ++kh) { u32x2 t0[4], t1[4];
                unsigned lv = (unsigned)lane; asm volatile("" : "+v"(lv));
#pragma unroll
                for (int ks = 0; ks < 4; ++ks) TR_FRAG_ISSUE(t0[ks], t1[ks], ldsb, lv, nt, 4 * kh + ks);
                asm volatile("s_waitcnt lgkmcnt(0)" : "+v"(t0[0]), "+v"(t1[0]), "+v"(t0[1]), "+v"(t1[1]), "+v"(t0[2]), "+v"(t1[2]), "+v"(t0[3]), "+v"(t1[3]) :: "memory");
#pragma unroll
                for (int ks = 0; ks < 4; ++ks) { const bf16x8 bfr = tr_join(t0[ks], t1[ks]);
                    acc[0][nt] = __builtin_amdgcn_mfma_f32_16x16x32_bf16(Af[0][4 * kh + ks], bfr, acc[0][nt], 0, 0, 0);
                    acc[1][nt] = __builtin_amdgcn_mfma_f32_16x16x32_bf16(Af[1][4 * kh + ks], bfr, acc[1][nt], 0, 0, 0); } }
#pragma unroll
        for (int r = 0; r < 4; ++r) { const int k_hi = 16 * w + 4 * g + r;
#pragma unroll
            for (int nt = 0; nt < 8; ++nt) {
                *(LAS unsigned short*)(lds + OFF_OUT + (2 * k_hi) * OS + (16 * nt + l15) * 2) = (unsigned short)f2bf(acc[0][nt][r]);
                *(LAS unsigned short*)(lds + OFF_OUT + (2 * k_hi + 1) * OS + (16 * nt + l15) * 2) = (unsigned short)f2bf(acc[1][nt][r]); } }
        __syncthreads();
#pragma unroll
        for (int i = 0; i < 8; ++i) { const int row = r32 + 32 * i;
            const u32x4 v = *(const LAS u32x4*)(lds + OFF_OUT + row * OS + c16 * 16);
            *(u32x4*)(ZA + (size_t)(b * S_ + 128 * (row >> 1) + k_lo) * 2048 + (row & 1) * 1024 + cb * 128 + c16 * 8) = v; }
    }
}

constexpr size_t WS_QT  = WS_XN;
constexpr size_t WS_AS  = WS_QT + (size_t)4096 * 64 * 128 * 2;
constexpr size_t WS_KDT = WS_END;
constexpr size_t WS_BL  = WS_KDT + (size_t)4096 * 128 * 64 * 2;
constexpr size_t WS_END2 = WS_BL + (size_t)4096 * 128 * 4;
static_assert(WS_AS + (size_t)4096 * 64 * 64 * 2 <= WS_O, "GLA pre-pass buffers must fit in the XN region");
static_assert(WS_END2 <= (size_t)1000 * 1000 * 1000, "workspace budget");

__device__ __forceinline__ float fast_logsigmoid(float z) {
    const float e = __builtin_amdgcn_exp2f(-fabsf(z) * 1.4426950408889634f);
    return fminf(z, 0.f) - __builtin_amdgcn_logf(1.0f + e) * 0.6931471805599453f;
}

__device__ void gla_pre_phase(const Args& a, ldsp_t lds) {
    const int tid = threadIdx.x, lane = tid & 63, w = tid >> 6, g = lane >> 4, l15 = lane & 15;
    const int d = tid & 127, tg = tid >> 7;
    const bf16_t* P = (const bf16_t*)(a.ws + WS_P);
    bf16_t* QT = (bf16_t*)(a.ws + WS_QT); bf16_t* AS = (bf16_t*)(a.ws + WS_AS); bf16_t* KDT = (bf16_t*)(a.ws + WS_KDT); float* BL = (float*)(a.ws + WS_BL);
    constexpr int QS = 272, JS = 144;
    constexpr int OFF_QS = 0, OFF_KS = OFF_QS + 64 * QS, OFF_AS = OFF_KS + 64 * QS, OFF_A1 = OFF_AS + 64 * JS, OFF_TOT = OFF_A1 + 2048;
    LAS float* tot = (LAS float*)(lds + OFF_TOT);
    unsigned short qk[32];
    u32x4 a1v = {0u, 0u, 0u, 0u};
    const int task_base = (blockIdx.x >> 4) * 256 + (blockIdx.x & 15) * 16;
    int task = task_base;
#define GLA_PRE_LOADS(T) do { const int stream_ = (T) >> 8, chunk_ = (T) & 255, dir_ = stream_ & 1, h_ = (stream_ >> 1) & 3, b_ = stream_ >> 3; \
        if (tid < 128) { const int i_ = tid >> 1, hf_ = tid & 1, tau_ = chunk_ * 64 + i_, t_ = dir_ ? (S_ - 1 - tau_) : tau_; \
            a1v = *(const u32x4*)(P + (size_t)(b_ * S_ + t_) * PW + PC_A1 + dir_ * 16 + hf_ * 8); } \
        _Pragma("unroll") for (int ii = 0; ii < 16; ++ii) { const int tau_ = chunk_ * 64 + 16 * tg + ii, t_ = dir_ ? (S_ - 1 - tau_) : tau_; \
            const bf16_t* prow_ = P + (size_t)(b_ * S_ + t_) * PW; qk[2 * ii] = prow_[PC_Q + h_ * 128 + d]; qk[2 * ii + 1] = prow_[PC_K + h_ * 128 + d]; } } while (0)
    GLA_PRE_LOADS(task);
    float wa[16]; float ba;
    { const int stream = task_base >> 8, dir = stream & 1, h = (stream >> 1) & 3;
#pragma unroll
      for (int r = 0; r < 16; ++r) wa[r] = a.in[I_WA2][(size_t)(dir * 16 + r) * 512 + h * 128 + d];
      ba = a.in[I_BA][dir * 512 + h * 128 + d]; }
    for (; task < task_base + 16; ++task) {
        if (tid < 128) *(LAS u32x4*)(lds + OFF_A1 + (tid >> 1) * 32 + (tid & 1) * 16) = a1v;
        __syncthreads();
        float wv[16]; float run = 0.f;
#pragma unroll
        for (int ii = 0; ii < 16; ++ii) { const int i = 16 * tg + ii;
            const u32x4 p0 = *(const LAS u32x4*)(lds + OFF_A1 + i * 32), p1 = *(const LAS u32x4*)(lds + OFF_A1 + i * 32 + 16);
            const unsigned pw[8] = {p0.x, p0.y, p0.z, p0.w, p1.x, p1.y, p1.z, p1.w};
            float z = ba;
#pragma unroll
            for (int r = 0; r < 8; ++r) z += bflo(pw[r]) * wa[2 * r] + bfhi(pw[r]) * wa[2 * r + 1];
            run += fast_logsigmoid(z) * (1.0f / 16.0f); wv[ii] = run; }
        tot[tg * 128 + d] = run;
        __syncthreads();
        float pre = 0.f, blast = 0.f;
#pragma unroll
        for (int q = 0; q < 4; ++q) { const float tq = tot[q * 128 + d]; blast += tq; pre += (q < tg) ? tq : 0.f; }
        if (tg == 0) BL[(size_t)task * 128 + d] = blast;
        unsigned kd[8];
#pragma unroll
        for (int ii = 0; ii < 16; ii += 2) { float kdv[2];
#pragma unroll
            for (int e = 0; e < 2; ++e) { const int i = 16 * tg + ii + e; const float bi = pre + wv[ii + e];
                const float qv = bf2f(qk[2 * (ii + e)]), kv = bf2f(qk[2 * (ii + e) + 1]);
                *(LAS unsigned short*)(lds + OFF_QS + i * QS + d * 2) = (unsigned short)f2bf(qv * 0.08838834764831845f * __expf(bi));
                *(LAS unsigned short*)(lds + OFF_KS + i * QS + d * 2) = (unsigned short)f2bf(kv * __expf(-bi));
                kdv[e] = kv * __expf(blast - bi); }
            kd[ii >> 1] = pk2(kdv[0], kdv[1]); }
        { bf16_t* kp = KDT + ((size_t)task * 128 + d) * 64 + 16 * tg;
          *(u32x4*)kp = (u32x4){kd[0], kd[1], kd[2], kd[3]}; *(u32x4*)(kp + 8) = (u32x4){kd[4], kd[5], kd[6], kd[7]}; }
        __syncthreads();
        { const int nt_ = task + 1; if (nt_ < task_base + 16) GLA_PRE_LOADS(nt_); }
#pragma unroll
        for (int q = 0; q < 2; ++q) { const int mt = w >> 1, nt = 2 * (w & 1) + q;
            f32x4 sacc = {0.f, 0.f, 0.f, 0.f};
#pragma unroll
            for (int ks = 0; ks < 4; ++ks) { const bf16x8 af = *(const LAS bf16x8*)(lds + OFF_QS + (16 * mt + l15) * QS + (32 * ks + 8 * g) * 2);
                const bf16x8 bf = *(const LAS bf16x8*)(lds + OFF_KS + (16 * nt + l15) * QS + (32 * ks + 8 * g) * 2);
                sacc = __builtin_amdgcn_mfma_f32_16x16x32_bf16(af, bf, sacc, 0, 0, 0); }
#pragma unroll
            for (int r = 0; r < 4; ++r) { const int i = 16 * mt + 4 * g + r, j = 16 * nt + l15;
                *(LAS unsigned short*)(lds + OFF_AS + i * JS + j * 2) = (unsigned short)f2bf(j <= i ? sacc[r] : 0.f); } }
        __syncthreads();
#pragma unroll
        for (int p = 0; p < 2; ++p) { const int pc = tid + 512 * p, row = pc >> 4, c16 = pc & 15;
            *(u32x4*)(QT + ((size_t)task * 64 + row) * 128 + c16 * 8) = *(const LAS u32x4*)(lds + OFF_QS + row * QS + c16 * 16); }
        { const int row = tid >> 3, c8 = tid & 7;
          *(u32x4*)(AS + ((size_t)task * 64 + row) * 64 + c8 * 8) = *(const LAS u32x4*)(lds + OFF_AS + row * JS + c8 * 16); }
    }
#undef GLA_PRE_LOADS
    __threadfence();
    __syncthreads();
}

__device__ __forceinline__ void gla_task_decode(int task, int& stream, int& eh, int& sg) {
    const int u = task & 255, i = task >> 8; stream = u >> 4; eh = i; sg = i ? 15 - (u & 15) : (u & 15);
}
__device__ __forceinline__ int gla_lidx(int stream, int eh, int sg) { return (stream * 2 + eh) * 16 + sg; }

#ifndef GLA_DEPTH_B
#define GLA_DEPTH_B 2
#endif
#ifndef GLA_DEPTH_A
#define GLA_DEPTH_A 2
#endif
template <bool PB>
__device__ void gla_scan_phase(const Args& a, ldsp_t lds) {
    const int tid = threadIdx.x, lane = tid & 63, w = tid >> 6, g = lane >> 4, l15 = lane & 15;
    const bf16_t* P = (const bf16_t*)(a.ws + WS_P);
    const bf16_t* QT = (const bf16_t*)(a.ws + WS_QT); const bf16_t* AS = (const bf16_t*)(a.ws + WS_AS); const bf16_t* KDT = (const bf16_t*)(a.ws + WS_KDT); const float* BL = (const float*)(a.ws + WS_BL);
    float* Lbuf = (float*)(a.ws + WS_L);
    float* DSEG = (float*)(a.ws + WS_DSEG);
    bf16_t* O = (bf16_t*)(a.ws + WS_O);
    constexpr int QS = 272, JS = 144;
    constexpr int OFF_QS = 0, OFF_AS = OFF_QS + 64 * QS, OFF_KDT = OFF_AS + 64 * JS, OFF_VT = OFF_KDT + 128 * JS, OFF_SB = OFF_VT + 128 * JS, OFF_OB = OFF_SB + 128 * QS,
                  OFF_DS = OFF_OB + 64 * QS, OFF_END = OFF_DS + 512;
    static_assert(OFF_END <= LDS_BYTES - 16, "GLA LDS");
    const int c16 = tid & 15, r32 = tid >> 4, c8 = tid & 7, r64 = tid >> 3;
    const unsigned ldsb = (unsigned)(size_t)lds;

    for (int it = 0; it < 2; ++it) {
        int stream, eh, sg;
        if (PB) gla_task_decode(blockIdx.x + 256 * it, stream, eh, sg);
        else { stream = blockIdx.x >> 4; sg = blockIdx.x & 15; eh = it; }
        const int dir = stream & 1, h = (stream >> 1) & 3, b = stream >> 3;
        f32x4 Sst[8];
#pragma unroll
        for (int mt = 0; mt < 8; ++mt) Sst[mt] = (f32x4){0.f, 0.f, 0.f, 0.f};
        if (PB) {
            for (int sp = 0; sp < sg; ++sp) {
                const float* Lp = Lbuf + (size_t)gla_lidx(stream, eh, sp) * 16384;
                const float* Dp = DSEG + (stream * 16 + sp) * 128;
#pragma unroll
                for (int mt = 0; mt < 8; ++mt) { const f32x4 dl = *(const f32x4*)(Dp + 16 * mt + 4 * g);
#pragma unroll
                    for (int r = 0; r < 4; ++r) Sst[mt][r] = Sst[mt][r] * __expf(dl[r]) + Lp[(mt * 4 + r) * 512 + tid]; }
            }
            __syncthreads();
#pragma unroll
            for (int mt = 0; mt < 8; ++mt) { u32x2 pw; pw.x = pk2(Sst[mt][0], Sst[mt][1]); pw.y = pk2(Sst[mt][2], Sst[mt][3]);
                *(LAS u32x2*)(lds + OFF_SB + (16 * w + l15) * QS + (16 * mt + 4 * g) * 2) = pw; }
        }
        float logD = 0.f;
        constexpr int DEPTH = PB ? GLA_DEPTH_B : GLA_DEPTH_A;
        u32x4 pk_[DEPTH][2], pv_[DEPTH][2], pq_[DEPTH][2], pa_[DEPTH]; float pbl[DEPTH];
#define GLA_SCAN_LOADS(SET, CI) do { const int ct_ = stream * 256 + sg * 16 + (CI); \
        _Pragma("unroll") for (int p_ = 0; p_ < 2; ++p_) { const int pc_ = tid + 512 * p_; \
            pk_[SET][p_] = *(const u32x4*)(KDT + ((size_t)ct_ * 128 + (pc_ >> 3)) * 64 + (pc_ & 7) * 8); \
            { const int j_ = pc_ >> 4, tau_ = (sg * 16 + (CI)) * 64 + j_, t_ = dir ? (S_ - 1 - tau_) : tau_; \
              pv_[SET][p_] = *(const u32x4*)(P + (size_t)(b * S_ + t_) * PW + PC_V + h * 256 + eh * 128 + (pc_ & 15) * 8); } \
            if (PB) pq_[SET][p_] = *(const u32x4*)(QT + ((size_t)ct_ * 64 + (pc_ >> 4)) * 128 + (pc_ & 15) * 8); } \
        if (PB) pa_[SET] = *(const u32x4*)(AS + ((size_t)ct_ * 64 + r64) * 64 + c8 * 8); \
        pbl[SET] = (tid < 128) ? BL[(size_t)ct_ * 128 + tid] : 0.f; } while (0)
#pragma unroll
        for (int s_ = 0; s_ < DEPTH; ++s_) GLA_SCAN_LOADS(s_, s_);
        for (int ci0 = 0; ci0 < 16; ci0 += DEPTH) {
#pragma unroll
          for (int s_ = 0; s_ < DEPTH; ++s_) {
            const int ci = ci0 + s_;
            if (ci >= 16) break;
            const int tau0 = (sg * 16 + ci) * 64;
#pragma unroll
            for (int p = 0; p < 2; ++p) { const int pc = tid + 512 * p;
                *(LAS u32x4*)(lds + OFF_KDT + (pc >> 3) * JS + (pc & 7) * 16) = pk_[s_][p];
                *(LAS u32x4*)(lds + OFF_VT + tr_off(pc >> 4, pc & 15)) = pv_[s_][p];
                if (PB) *(LAS u32x4*)(lds + OFF_QS + (pc >> 4) * QS + (pc & 15) * 16) = pq_[s_][p]; }
            if (PB) *(LAS u32x4*)(lds + OFF_AS + r64 * JS + c8 * 16) = pa_[s_];
            if (tid < 128) { *(LAS float*)(lds + OFF_DS + tid * 4) = __expf(pbl[s_]); logD += pbl[s_]; }
            __syncthreads();
            if (ci + DEPTH < 16) GLA_SCAN_LOADS(s_, ci + DEPTH);
            bf16x8 vfr[2];
            { u32x2 t0[2], t1[2];
              TR_FRAG_ISSUE(t0[0], t1[0], ldsb + OFF_VT, lane, w, 0); TR_FRAG_ISSUE(t0[1], t1[1], ldsb + OFF_VT, lane, w, 1);
              asm volatile("s_waitcnt lgkmcnt(0)" : "+v"(t0[0]), "+v"(t1[0]), "+v"(t0[1]), "+v"(t1[1]) :: "memory");
              vfr[0] = tr_join(t0[0], t1[0]); vfr[1] = tr_join(t0[1], t1[1]); }
            f32x4 oacc[4];
            if (PB) {
#pragma unroll
                for (int mt = 0; mt < 4; ++mt) oacc[mt] = (f32x4){0.f, 0.f, 0.f, 0.f};
#pragma unroll
                for (int ks = 0; ks < 4; ++ks) { const bf16x8 bf = *(const LAS bf16x8*)(lds + OFF_SB + (16 * w + l15) * QS + (32 * ks + 8 * g) * 2);
#pragma unroll
                    for (int mt = 0; mt < 4; ++mt) { const bf16x8 af = *(const LAS bf16x8*)(lds + OFF_QS + (16 * mt + l15) * QS + (32 * ks + 8 * g) * 2);
                        oacc[mt] = __builtin_amdgcn_mfma_f32_16x16x32_bf16(af, bf, oacc[mt], 0, 0, 0); } }
#pragma unroll
                for (int ks = 0; ks < 2; ++ks) { const bf16x8 bf = vfr[ks];
#pragma unroll
                    for (int mt = 0; mt < 4; ++mt) { const bf16x8 af = *(const LAS bf16x8*)(lds + OFF_AS + (16 * mt + l15) * JS + (32 * ks + 8 * g) * 2);
                        oacc[mt] = __builtin_amdgcn_mfma_f32_16x16x32_bf16(af, bf, oacc[mt], 0, 0, 0); } }
            }
#pragma unroll
            for (int mt = 0; mt < 8; ++mt) { const f32x4 dsc = *(const LAS f32x4*)(lds + OFF_DS + (16 * mt + 4 * g) * 4);
                Sst[mt] = Sst[mt] * dsc; }
#pragma unroll
            for (int ks = 0; ks < 2; ++ks) { const bf16x8 bf = vfr[ks];
#pragma unroll
                for (int mt = 0; mt < 8; ++mt) { const bf16x8 af = *(const LAS bf16x8*)(lds + OFF_KDT + (16 * mt + l15) * JS + (32 * ks + 8 * g) * 2);
                    Sst[mt] = __builtin_amdgcn_mfma_f32_16x16x32_bf16(af, bf, Sst[mt], 0, 0, 0); } }
            __syncthreads();
            if (PB) {
#pragma unroll
                for (int mt = 0; mt < 8; ++mt) { u32x2 pw; pw.x = pk2(Sst[mt][0], Sst[mt][1]); pw.y = pk2(Sst[mt][2], Sst[mt][3]);
                    *(LAS u32x2*)(lds + OFF_SB + (16 * w + l15) * QS + (16 * mt + 4 * g) * 2) = pw; }
#pragma unroll
                for (int mt = 0; mt < 4; ++mt)
#pragma unroll
                    for (int r = 0; r < 4; ++r) *(LAS unsigned short*)(lds + OFF_OB + (16 * mt + 4 * g + r) * QS + (16 * w + l15) * 2) = (unsigned short)f2bf(oacc[mt][r]);
                __syncthreads();
#pragma unroll
                for (int p = 0; p < 2; ++p) { const int pc = tid + 512 * p, i = pc >> 4, tau = tau0 + i, t = dir ? (S_ - 1 - tau) : tau;
                    *(u32x4*)(O + ((size_t)dir * T_ + (size_t)(b * S_ + t)) * 1024 + h * 256 + eh * 128 + (pc & 15) * 8) = *(const LAS u32x4*)(lds + OFF_OB + i * QS + (pc & 15) * 16); }
            }
          }
        }
#undef GLA_SCAN_LOADS
        if (!PB) {
            float* Lp = Lbuf + (size_t)gla_lidx(stream, eh, sg) * 16384;
#pragma unroll
            for (int mt = 0; mt < 8; ++mt)
#pragma unroll
                for (int r = 0; r < 4; ++r) Lp[(mt * 4 + r) * 512 + tid] = Sst[mt][r];
            if (tid < 128 && eh == 0) DSEG[(stream * 16 + sg) * 128 + tid] = logD;
        }
        __syncthreads();
    }
}

__device__ void gla_post_phase(const Args& a) {
    const int lane = threadIdx.x & 63, wave = threadIdx.x >> 6, W = gridDim.x * 8;
    const bf16_t* O = (const bf16_t*)(a.ws + WS_O);
    const bf16_t* P = (const bf16_t*)(a.ws + WS_P);
    bf16_t* GO = (bf16_t*)(a.ws + WS_XN);
    const float* ng = a.in[I_GNG];
    for (int row = blockIdx.x * 8 + wave; row < T_; row += W) {
        const int e0 = lane * 16;
        float v[16]; float ss = 0.f;
#pragma unroll
        for (int q = 0; q < 2; ++q) { const u32x4 f = *(const u32x4*)(O + (size_t)row * 1024 + e0 + 8 * q), bk = *(const u32x4*)(O + ((size_t)T_ + row) * 1024 + e0 + 8 * q);
            const unsigned fw[4] = {f.x, f.y, f.z, f.w}, bw[4] = {bk.x, bk.y, bk.z, bk.w};
#pragma unroll
            for (int j = 0; j < 4; ++j) { v[8 * q + 2 * j] = bflo(fw[j]) + bflo(bw[j]); v[8 * q + 2 * j + 1] = bfhi(fw[j]) + bfhi(bw[j]); } }
#pragma unroll
        for (int j = 0; j < 16; ++j) ss += v[j] * v[j];
#pragma unroll
        for (int o = 8; o >= 1; o >>= 1) ss += __shfl_xor(ss, o);
        const float rstd = rsqrtf(ss * (1.0f / 256.0f) + EPS);
        unsigned ow[8];
#pragma unroll
        for (int q = 0; q < 2; ++q) { const u32x4 rr = *(const u32x4*)(P + (size_t)row * PW + PC_R + e0 + 8 * q); const unsigned rw[4] = {rr.x, rr.y, rr.z, rr.w};
#pragma unroll
            for (int j = 0; j < 4; ++j) { const int e = (e0 + 8 * q + 2 * j) & 255;
                const float r0 = bflo(rw[j]), r1 = bfhi(rw[j]);
                const float y0 = v[8 * q + 2 * j] * rstd * ng[e] * (r0 * sigmoidf_(r0)), y1 = v[8 * q + 2 * j + 1] * rstd * ng[e + 1] * (r1 * sigmoidf_(r1));
                ow[4 * q + j] = pk2(y0, y1); } }
        *(u32x4*)(GO + (size_t)row * 1024 + e0) = (u32x4){ow[0], ow[1], ow[2], ow[3]};
        *(u32x4*)(GO + (size_t)row * 1024 + e0 + 8) = (u32x4){ow[4], ow[5], ow[6], ow[7]};
    }
}

__device__ __forceinline__ unsigned f2ord(float f) { const unsigned u = __float_as_uint(f); return (u & 0x80000000u) ? ~u : (u | 0x80000000u); }
__device__ __forceinline__ float ord2f(unsigned o) { return __uint_as_float((o & 0x80000000u) ? (o & 0x7fffffffu) : ~o); }
#define CE_DESC(x, y) do { const unsigned _hi = max((x), (y)), _lo = min((x), (y)); (x) = _hi; (y) = _lo; } while (0)
#define CE_ASC(x, y) do { const unsigned _hi = max((x), (y)), _lo = min((x), (y)); (x) = _lo; (y) = _hi; } while (0)
template <int N> __device__ __forceinline__ void bitonic_sort_desc(unsigned (&k)[N]) {
#pragma unroll
    for (int sz = 2; sz <= N; sz <<= 1)
#pragma unroll
        for (int j = sz >> 1; j > 0; j >>= 1)
#pragma unroll
            for (int i = 0; i < N; ++i) { const int l = i ^ j; if (l > i) { if ((i & sz) == 0) CE_DESC(k[i], k[l]); else CE_ASC(k[i], k[l]); } }
}
template <int N> __device__ __forceinline__ void bitonic_merge_desc(unsigned (&k)[N]) {
#pragma unroll
    for (int j = N >> 1; j > 0; j >>= 1)
#pragma unroll
        for (int i = 0; i < N; ++i) { const int l = i ^ j; if (l > i) CE_DESC(k[i], k[l]); }
}
#define CE2_DESC(kx, px, ky, py) do { const bool _sw = (ky) > (kx); const unsigned _k0 = _sw ? (ky) : (kx), _k1 = _sw ? (kx) : (ky), _p0 = _sw ? (py) : (px), _p1 = _sw ? (px) : (py); \
        (kx) = _k0; (ky) = _k1; (px) = _p0; (py) = _p1; } while (0)
template <int N> __device__ __forceinline__ void bitonic_sort_desc2(unsigned (&k)[N], unsigned (&p)[N]) {
#pragma unroll
    for (int sz = 2; sz <= N; sz <<= 1)
#pragma unroll
        for (int j = sz >> 1; j > 0; j >>= 1)
#pragma unroll
            for (int i = 0; i < N; ++i) { const int l = i ^ j; if (l > i) { if ((i & sz) == 0) CE2_DESC(k[i], p[i], k[l], p[l]); else CE2_DESC(k[l], p[l], k[i], p[i]); } }
}
template <int N> __device__ __forceinline__ void bitonic_merge_desc2(unsigned (&k)[N], unsigned (&p)[N]) {
#pragma unroll
    for (int j = N >> 1; j > 0; j >>= 1)
#pragma unroll
        for (int i = 0; i < N; ++i) { const int l = i ^ j; if (l > i) CE2_DESC(k[i], p[i], k[l], p[l]); }
}
__device__ __forceinline__ void lane_merge16(unsigned (&k)[16], int xm) {
    unsigned o[16];
#pragma unroll
    for (int i = 0; i < 16; ++i) o[i] = (unsigned)__shfl_xor((int)k[i], xm);
#pragma unroll
    for (int i = 0; i < 16; ++i) k[i] = max(k[i], o[15 - i]);
    bitonic_merge_desc<16>(k);
}
__device__ __forceinline__ void lane_merge16_2(unsigned (&k)[16], unsigned (&p)[16], int xm) {
    unsigned ok[16], op[16];
#pragma unroll
    for (int i = 0; i < 16; ++i) { ok[i] = (unsigned)__shfl_xor((int)k[i], xm); op[i] = (unsigned)__shfl_xor((int)p[i], xm); }
#pragma unroll
    for (int i = 0; i < 16; ++i) { const bool sw = ok[15 - i] > k[i]; k[i] = sw ? ok[15 - i] : k[i]; p[i] = sw ? op[15 - i] : p[i]; }
    bitonic_merge_desc2<16>(k, p);
}

__device__ void peer_select_phase(const Args& a, ldsp_t lds) {
    const int lane = threadIdx.x & 63, wave = threadIdx.x >> 6, g = lane >> 4, l15 = lane & 15, W = gridDim.x * 8;
    const bf16_t* QP = (const bf16_t*)(a.ws + WS_QP);
    const bf16_t* KB = (const bf16_t*)(a.ws + WS_KEYS);
    int* IDX = (int*)(a.ws + WS_IDX); float* GW = (float*)(a.ws + WS_G);
    for (int item = blockIdx.x * 8 + wave; item < 2048 * 8; item += W) {
        const int tok0 = (item >> 3) * 16, h = item & 7, tok = tok0 + l15;
        LAS unsigned* tl = (LAS unsigned*)(lds + wave * 8192);
#pragma unroll 1
        for (int hf = 0; hf < 2; ++hf) {
            bf16x8 bq[4];
#pragma unroll
            for (int ks = 0; ks < 4; ++ks) bq[ks] = *(const bf16x8*)(QP + (size_t)tok * 2048 + h * 256 + hf * 128 + 32 * ks + 8 * g);
            unsigned key[32];
#pragma unroll
            for (int mt = 0; mt < 8; ++mt) { f32x4 acc = {0.f, 0.f, 0.f, 0.f};
#pragma unroll
                for (int ks = 0; ks < 4; ++ks) { const bf16x8 af = *(const bf16x8*)(KB + (size_t)((h * 2 + hf) * 128 + 16 * mt + l15) * 128 + 32 * ks + 8 * g);
                    acc = __builtin_amdgcn_mfma_f32_16x16x32_bf16(af, bq[ks], acc, 0, 0, 0); }
#pragma unroll
                for (int r = 0; r < 4; ++r) { const int n = 16 * mt + 4 * g + r; key[4 * mt + r] = (f2ord(acc[r]) & ~127u) | (unsigned)(127 - n); }
                __builtin_amdgcn_sched_barrier(0); }
            unsigned lo[16], hi[16];
#pragma unroll
            for (int i = 0; i < 16; ++i) { lo[i] = key[i]; hi[i] = key[16 + i]; }
            bitonic_sort_desc<16>(lo); bitonic_sort_desc<16>(hi);
#pragma unroll
            for (int i = 0; i < 16; ++i) lo[i] = max(lo[i], hi[15 - i]);
            bitonic_merge_desc<16>(lo);
            lane_merge16(lo, 16); lane_merge16(lo, 32);
#pragma unroll
            for (int i = 0; i < 16; ++i) tl[(hf * 16 + i) * 64 + lane] = lo[i];
        }
        unsigned top[2][16];
#pragma unroll
        for (int i = 0; i < 16; ++i) { top[0][i] = tl[i * 64 + lane]; top[1][i] = tl[(16 + i) * 64 + lane]; }
        unsigned ck[16], cp[16];
#pragma unroll
        for (int i = 0; i < 16; ++i) { ck[i] = 0u; cp[i] = 0u; }
#define PEER_CAND(slot, I, J) do { const float _s = ord2f(top[0][I] & ~127u) + ord2f(top[1][J] & ~127u); ck[slot] = f2ord(_s); cp[slot] = ((127u - (top[0][I] & 127u)) << 7) | (127u - (top[1][J] & 127u)); } while (0)
        if (g == 0) { PEER_CAND(0, 0, 0); PEER_CAND(1, 0, 1); PEER_CAND(2, 0, 2); PEER_CAND(3, 0, 3); PEER_CAND(4, 0, 4); PEER_CAND(5, 0, 5); PEER_CAND(6, 0, 6); PEER_CAND(7, 0, 7);
            PEER_CAND(8, 0, 8); PEER_CAND(9, 0, 9); PEER_CAND(10, 0, 10); PEER_CAND(11, 0, 11); PEER_CAND(12, 0, 12); PEER_CAND(13, 0, 13); PEER_CAND(14, 0, 14); PEER_CAND(15, 0, 15); }
        else if (g == 1) { PEER_CAND(0, 1, 0); PEER_CAND(1, 1, 1); PEER_CAND(2, 1, 2); PEER_CAND(3, 1, 3); PEER_CAND(4, 1, 4); PEER_CAND(5, 1, 5); PEER_CAND(6, 1, 6); PEER_CAND(7, 1, 7);
            PEER_CAND(8, 2, 0); PEER_CAND(9, 2, 1); PEER_CAND(10, 2, 2); PEER_CAND(11, 2, 3); PEER_CAND(12, 2, 4); PEER_CAND(13, 3, 0); PEER_CAND(14, 3, 1); PEER_CAND(15, 3, 2); }
        else if (g == 2) { PEER_CAND(0, 3, 3); PEER_CAND(1, 4, 0); PEER_CAND(2, 4, 1); PEER_CAND(3, 4, 2); PEER_CAND(4, 5, 0); PEER_CAND(5, 5, 1); PEER_CAND(6, 6, 0); PEER_CAND(7, 6, 1);
            PEER_CAND(8, 7, 0); PEER_CAND(9, 7, 1); PEER_CAND(10, 8, 0); PEER_CAND(11, 9, 0); PEER_CAND(12, 10, 0); PEER_CAND(13, 11, 0); PEER_CAND(14, 12, 0); PEER_CAND(15, 13, 0); }
        else { PEER_CAND(0, 14, 0); PEER_CAND(1, 15, 0); }
#undef PEER_CAND
        bitonic_sort_desc2<16>(ck, cp);
        lane_merge16_2(ck, cp, 16); lane_merge16_2(ck, cp, 32);
        float ev[16]; float sum = 0.f; const float mx = ord2f(ck[0]);
#pragma unroll
        for (int i = 0; i < 16; ++i) { ev[i] = __expf(ord2f(ck[i]) - mx); sum += ev[i]; }
        const float inv = 1.0f / sum;
#pragma unroll
        for (int i = 0; i < 16; ++i) if ((i >> 2) == g) { IDX[(size_t)tok * 128 + h * 16 + i] = (int)cp[i]; GW[(size_t)tok * 128 + h * 16 + i] = ev[i] * inv; }
    }
}

typedef float f32x16 __attribute__((ext_vector_type(16)));
typedef float f32x32 __attribute__((ext_vector_type(32)));
typedef unsigned u32x6 __attribute__((ext_vector_type(6)));
constexpr float U_SCALE = 48.0f, V_SCALE = 2.5f;
constexpr int ROW6 = 1536;
__device__ void cvt_rows_fp6(const float* src, unsigned char* dst, int nrows, float scale) {
    const size_t gt = (size_t)blockIdx.x * 512 + threadIdx.x, gs = (size_t)gridDim.x * 512;
    for (size_t idx = gt; idx < (size_t)nrows * 64; idx += gs) {
        const size_t row = idx >> 6; const int l = (int)(idx & 63);
        const float* sp = src + row * 2048 + 32 * l;
        f32x16 a, b;
#pragma unroll
        for (int q = 0; q < 8; ++q) { const f32x4 vv = *(const f32x4*)(sp + 4 * q);
            a[2 * q] = fminf(fmaxf(vv[0] * scale, -7.5f), 7.5f); b[2 * q] = fminf(fmaxf(vv[1] * scale, -7.5f), 7.5f);
            a[2 * q + 1] = fminf(fmaxf(vv[2] * scale, -7.5f), 7.5f); b[2 * q + 1] = fminf(fmaxf(vv[3] * scale, -7.5f), 7.5f); }
        const u32x6 pk = __builtin_amdgcn_cvt_scalef32_2xpk16_fp6_f32(a, b, 1.0f);
        unsigned char* dp = dst + row * ROW6;
        *(u32x4*)(dp + 16 * l) = (u32x4){pk[0], pk[1], pk[2], pk[3]};
        *(u32x2*)(dp + 1024 + 8 * l) = (u32x2){pk[4], pk[5]};
    }
}
__device__ __forceinline__ float gelu_erf(float x) { return 0.5f * x * (1.0f + erff(x * 0.70710678118654752f)); }
template <bool DRY> __device__ void peer_gather_phase(const Args& a) {
    const int lane = threadIdx.x & 63, wave = threadIdx.x >> 6, W = gridDim.x * 8;
    const bf16_t* XN = (const bf16_t*)(a.ws + WS_XN);
    const unsigned char* UB = a.ws + WS_UB;
    const unsigned char* VB = a.ws + WS_VB;
    const int* IDX = (const int*)(a.ws + WS_IDX); const float* GW = (const float*)(a.ws + WS_G);
    const float* mod = (const float*)(a.ws + WS_MOD);
    const float* fg = a.in[I_FNG];
    float* H = a.out;
    for (int tok = blockIdx.x * 8 + wave; tok < T_; tok += W) {
        float xf[32];
#pragma unroll
        for (int q = 0; q < 4; ++q) { const u32x4 xv = *(const u32x4*)(XN + (size_t)tok * 2048 + 32 * lane + 8 * q); const unsigned xs[4] = {xv.x, xv.y, xv.z, xv.w};
#pragma unroll
            for (int j = 0; j < 4; ++j) { xf[8 * q + 2 * j] = bflo(xs[j]); xf[8 * q + 2 * j + 1] = bfhi(xs[j]); } }
        const int id0 = IDX[(size_t)tok * 128 + lane], id1 = IDX[(size_t)tok * 128 + 64 + lane];
        const float g0 = GW[(size_t)tok * 128 + lane], g1 = GW[(size_t)tok * 128 + 64 + lane];
        float o[32];
#pragma unroll
        for (int j = 0; j < 32; ++j) o[j] = 0.f;
        for (int kk = 0; kk < 128; kk += 4) {
            int ex[4]; float gw[4];
#pragma unroll
            for (int e = 0; e < 4; ++e) { const int k = kk + e;
                ex[e] = (k < 64) ? __builtin_amdgcn_readlane(id0, k & 63) : __builtin_amdgcn_readlane(id1, k & 63);
                gw[e] = (k < 64) ? __uint_as_float(__builtin_amdgcn_readlane(__float_as_uint(g0), k & 63)) : __uint_as_float(__builtin_amdgcn_readlane(__float_as_uint(g1), k & 63)); }
            u32x4 ua[4], va[4]; u32x2 ub[4], vb[4];
#pragma unroll
            for (int e = 0; e < 4; ++e) { const unsigned char* up = UB + (size_t)ex[e] * ROW6; ua[e] = *(const u32x4*)(up + 16 * lane); ub[e] = *(const u32x2*)(up + 1024 + 8 * lane); }
#pragma unroll
            for (int e = 0; e < 4; ++e) { const unsigned char* vp = VB + (size_t)ex[e] * ROW6; va[e] = *(const u32x4*)(vp + 16 * lane); vb[e] = *(const u32x2*)(vp + 1024 + 8 * lane); }
            float dt[4];
#pragma unroll
            for (int e = 0; e < 4; ++e) { const u32x6 pk = {ua[e].x, ua[e].y, ua[e].z, ua[e].w, ub[e].x, ub[e].y};
                const f32x32 uf = __builtin_amdgcn_cvt_scalef32_pk32_f32_fp6(pk, 1.0f);
                float s = 0.f;
#pragma unroll
                for (int j = 0; j < 32; ++j) s += uf[j] * xf[j];
                dt[e] = s; }
#pragma unroll
            for (int off = 32; off >= 1; off >>= 1)
#pragma unroll
                for (int e = 0; e < 4; ++e) dt[e] += __shfl_xor(dt[e], off);
#pragma unroll
            for (int e = 0; e < 4; ++e) { const float cf = gw[e] * gelu_erf(dt[e] * (1.0f / U_SCALE)) * (1.0f / V_SCALE);
                const u32x6 pk = {va[e].x, va[e].y, va[e].z, va[e].w, vb[e].x, vb[e].y};
                const f32x32 vf = __builtin_amdgcn_cvt_scalef32_pk32_f32_fp6(pk, 1.0f);
#pragma unroll
                for (int j = 0; j < 32; ++j) o[j] += cf * vf[j]; }
        }
        const int b = tok >> 14; float ss = 0.f;
#pragma unroll
        for (int q = 0; q < 8; ++q) { const int d0 = 32 * lane + 4 * q;
            const f32x4 h0 = *(const f32x4*)(H + (size_t)tok * 2048 + d0), q0 = *(const f32x4*)(mod + b * 12288 + 5 * 2048 + d0);
#pragma unroll
            for (int j = 0; j < 4; ++j) { const float hv = h0[j] + q0[j] * o[4 * q + j]; o[4 * q + j] = hv; ss += hv * hv; } }
        ss = wave_sum(ss);
        const float rstd = rsqrtf(ss * (1.0f / 2048.0f) + EPS);
#pragma unroll
        for (int q = 0; q < 8; ++q) { const int d0 = 32 * lane + 4 * q;
            const f32x4 f0 = *(const f32x4*)(fg + d0); f32x4 r0;
#pragma unroll
            for (int j = 0; j < 4; ++j) r0[j] = o[4 * q + j] * rstd * f0[j];
            if (!DRY || rstd < 0.f) *(f32x4*)(H + (size_t)tok * 2048 + d0) = r0; }
    }
}

__global__ void __launch_bounds__(512, 2) mega(Args a) {
    extern __shared__ __attribute__((aligned(16))) unsigned char lds_raw[];
    ldsp_t lds = (ldsp_t)lds_raw;
    cg::grid_group grid = cg::this_grid();
    const int lo = a.ph_lo, hi = a.ph_hi;
    unsigned char* ws = a.ws;
    const float* mod = (const float*)(ws + WS_MOD);
#ifdef ONLY_PHASE
#define IN(k) ((k) == ONLY_PHASE && lo <= (k) && (k) < hi)
#else
#define IN(k) (lo <= (k) && (k) < hi)
#endif
    volatile LAS unsigned* bst = (volatile LAS unsigned*)(lds + LDS_BYTES - 16);
    if (threadIdx.x == 0) { bst[0] = 0u; bst[1] = 0u; }
    __syncthreads();
    XcdBarrier xbar = xcd_barrier_post((unsigned*)(ws + WS_CTL) + a.li * XCD_BAR_WORDS, bst);
#define SEAM(k) do { if (IN(k) && IN((k) + 1)) { if ((k) == 0) grid.sync(); else xcd_barrier(xbar); } } while (0)
#ifndef DUP_PHASE
#define DUP_PHASE (-1)
#endif
#define REP(k)

    if (IN(0)) phase0(a, lds);
    SEAM(0);
    if (IN(1)) norm_phase(a.in[I_X], a.in[I_N1G], mod, mod + 2048, (bf16_t*)(ws + WS_XN));
    SEAM(1);
    if (IN(2)) {
        pg8::Gemm g{(const bf16_t*)(ws + WS_XN), (const bf16_t*)(ws + WS_WIN), T_, PW, 2048, 2048};
        pg8::StaticOrder S; S.init(T_, PW, gridDim.x, blockIdx.x);
        pg8::EpiIn E{(bf16_t*)(ws + WS_P)};
        pg8::gemm_phase(lds, g, S, E);
    }
    SEAM(2);
    if (IN(3)) { fft1_phase(a, lds); __syncthreads(); }
    if (IN(4)) gla_pre_phase(a, lds);
    if (IN(5)) gla_scan_phase<false>(a, lds);
    SEAM(5);
    if (IN(6)) { fft2_phase(a, lds); __syncthreads(); }
    if (IN(7)) gla_scan_phase<true>(a, lds);
    SEAM(7);
    if (IN(8)) gla_post_phase(a);
    SEAM(8);
    if (IN(9)) {
        {
            pg8::Gemm g{(const bf16_t*)a.out + (size_t)T_ * 2048, (const bf16_t*)(ws + WS_WFN), T_, 2048, 2048, 2048};
            pg8::StaticOrder S; S.init(T_, 2048, gridDim.x, blockIdx.x);
            pg8::EpiGate<0> E{(bf16_t*)(ws + WS_O), 2048, (const bf16_t*)(ws + WS_P) + PC_GF, PW};
            pg8::gemm_phase(lds, g, S, E);
        }
        {
            pg8::Gemm g{(const bf16_t*)(ws + WS_XN), (const bf16_t*)(ws + WS_WGLA), T_, 2048, 1024, 1024};
            pg8::StaticOrder S; S.init(T_, 2048, gridDim.x, blockIdx.x);
            pg8::EpiGate<1> E{(bf16_t*)(ws + WS_O), 2048, (const bf16_t*)(ws + WS_P) + PC_GG, PW};
            pg8::gemm_phase(lds, g, S, E);
        }
    }
    SEAM(9);
    if (IN(10)) {
        pg8::Gemm g{(const bf16_t*)(ws + WS_O), (const bf16_t*)(ws + WS_WOUT), T_, 2048, 2048, 2048};
        pg8::StaticOrder S; S.init(T_, 2048, gridDim.x, blockIdx.x);
        pg8::EpiRes E{a.in[I_X], mod + 2 * 2048, a.out};
        pg8::gemm_phase(lds, g, S, E);
    }
    SEAM(10);
    if (IN(11)) {
        norm_phase(a.out, a.in[I_N2G], mod + 3 * 2048, mod + 4 * 2048, (bf16_t*)(ws + WS_XN));
        cvt_rows_fp6(a.in[I_U], ws + WS_UB, 16384, U_SCALE);
        cvt_rows_fp6(a.in[I_V], ws + WS_VB, 16384, V_SCALE);
    }
    SEAM(11);
    if (IN(12)) {
        pg8::Gemm g{(const bf16_t*)(ws + WS_XN), (const bf16_t*)(ws + WS_WQ), T_, 2048, 2048, 2048};
        pg8::StaticOrder S; S.init(T_, 2048, gridDim.x, blockIdx.x);
        pg8::EpiGate<2> E{(bf16_t*)(ws + WS_QP), 2048, nullptr, 0};
        pg8::gemm_phase(lds, g, S, E);
    }
    SEAM(12);
    if (IN(13)) peer_select_phase(a, lds);
    SEAM(13);
    if (IN(14)) peer_gather_phase<false>(a);
    if (IN(15)) peer_gather_phase<true>(a);
#undef IN
#undef SEAM
}

constexpr int N_PHASES = 15;

extern "C" void kernel_launch(void* const* d_in, const int* in_sizes, int n_in, void* d_out, int out_size, void* d_ws, size_t ws_size, hipStream_t stream) {
    static int grid = 0;
    if (grid == 0) {
        int dev = 0, cus = 0, per_cu = 0;
        (void)hipGetDevice(&dev);
        (void)hipDeviceGetAttribute(&cus, hipDeviceAttributeMultiprocessorCount, dev);
        (void)hipFuncSetAttribute((const void*)mega, hipFuncAttributeMaxDynamicSharedMemorySize, LDS_BYTES);
        (void)hipOccupancyMaxActiveBlocksPerMultiprocessor(&per_cu, (const void*)mega, 512, LDS_BYTES);
        if (per_cu < 1 || n_in != 18 || ws_size < WS_END2 || cus != 256) { fprintf(stderr, "kernel_launch: unexpected configuration (per_cu %d, n_in %d, ws %zu)\n", per_cu, n_in, ws_size); grid = -1; return; }
        grid = cus;
    }
    if (grid < 0) return;
    (void)hipMemsetAsync((char*)d_ws + WS_CTL, 0, 4 * XCD_BAR_WORDS * 4, stream);
    Args a{};
    for (int i = 0; i < 18; ++i) a.in[i] = (const float*)d_in[i];
    a.out = (float*)d_out; a.ws = (unsigned char*)d_ws; a.li = 0; a.pad = 0;
#if DUP_PHASE >= 0
    const int lo_[3] = {0, DUP_PHASE == 14 ? 15 : DUP_PHASE, DUP_PHASE == 14 ? 14 : DUP_PHASE + 1}, hi_[3] = {DUP_PHASE == 14 ? 14 : DUP_PHASE + 1, DUP_PHASE == 14 ? 16 : DUP_PHASE + 1, N_PHASES};
    for (int li = 0; li < 3; ++li) { a.ph_lo = lo_[li]; a.ph_hi = hi_[li]; a.li = li;
        if (DUP_PHASE == 100 && li == 1) continue;
        if (a.ph_lo >= a.ph_hi) continue;
        void* args[] = {&a};
        hipError_t e = hipLaunchCooperativeKernel((void*)mega, dim3(grid), dim3(512), args, LDS_BYTES, stream);
        if (e != hipSuccess) fprintf(stderr, "launch %d failed: %s\n", li, hipGetErrorString(e)); }
#else
    a.ph_lo = 0; a.ph_hi = N_PHASES;
    void* args[] = {&a};
    hipError_t e = hipLaunchCooperativeKernel((void*)mega, dim3(grid), dim3(512), args, LDS_BYTES, stream);
    if (e != hipSuccess) fprintf(stderr, "cooperative launch failed: %s (grid %d)\n", hipGetErrorString(e), grid);
#endif
}
```

```cpp
#include <hip/hip_runtime.h>
#include <hip/hip_cooperative_groups.h>
#include <cstdio>
namespace cg = cooperative_groups;

#define LAS __attribute__((address_space(3)))
typedef unsigned short bf16_t;
typedef short bf16x8 __attribute__((ext_vector_type(8)));
typedef float f32x4 __attribute__((ext_vector_type(4)));
typedef float f32x2 __attribute__((ext_vector_type(2)));
typedef unsigned u32x4 __attribute__((ext_vector_type(4)));
typedef unsigned u32x2 __attribute__((ext_vector_type(2)));
typedef LAS unsigned char* ldsp_t;

#ifndef N_PHASE_LAUNCH
#define N_PHASE_LAUNCH 0
#endif

constexpr int T_ = 32768, D_ = 2048, S_ = 16384;
constexpr float EPS = 1e-6f;
constexpr int PW = 8448;
constexpr int PC_Z = 0, PC_Q = 1024, PC_K = 1536, PC_V = 2048, PC_R = 3072, PC_GF = 4096, PC_GG = 6144, PC_A1 = 8192;
constexpr int LDS_BYTES = 147456;

constexpr size_t WS_CTL  = 0;
constexpr size_t WS_MOD  = 65536;
constexpr size_t WS_TW   = WS_MOD + 98304;
constexpr size_t WS_F1   = WS_TW + 131072;
constexpr size_t WS_F2   = WS_F1 + 65536;
constexpr size_t WS_DSEG = WS_F2 + 131072;
constexpr size_t WS_WIN  = WS_DSEG + 131072;
constexpr size_t WS_WFN  = WS_WIN + (size_t)8448 * 2048 * 2;
constexpr size_t WS_WGLA = WS_WFN + (size_t)2048 * 2048 * 2;
constexpr size_t WS_WOUT = WS_WGLA + (size_t)2048 * 1024 * 2;
constexpr size_t WS_WQ   = WS_WOUT + (size_t)2048 * 2048 * 2;
constexpr size_t WS_KEYS = WS_WQ + (size_t)2048 * 2048 * 2;
constexpr size_t WS_L    = WS_KEYS + (size_t)8 * 2 * 128 * 128 * 2;
constexpr size_t WS_XN   = WS_L + (size_t)512 * 16384 * 4;
constexpr size_t WS_O    = WS_XN + (size_t)T_ * 2048 * 2;
constexpr size_t WS_P    = WS_O + (size_t)T_ * 2048 * 2;
constexpr size_t WS_QP   = WS_P;
constexpr size_t WS_IDX  = WS_QP + (size_t)T_ * 2048 * 2;
constexpr size_t WS_G    = WS_IDX + (size_t)T_ * 128 * 4;
constexpr size_t WS_UB   = WS_G + (size_t)T_ * 128 * 4;
constexpr size_t WS_VB   = WS_UB + (size_t)16384 * 2048 * 2;
constexpr size_t WS_END  = WS_P + (size_t)T_ * PW * 2;
static_assert(WS_VB + (size_t)16384 * 2048 * 2 <= WS_END, "late buffers must fit in the P region");
static_assert(WS_END <= (size_t)1000 * 1000 * 1000, "workspace budget");

struct Args { const float* in[18]; float* out; unsigned char* ws; int ph_lo, ph_hi, li, pad; };
enum { I_X = 0, I_C, I_WADA, I_BADA, I_N1G, I_WIN, I_WFNET, I_WA2, I_BA, I_GNG, I_WGLA, I_WOUT, I_N2G, I_WQ, I_KEYS, I_U, I_V, I_FNG };

typedef __bf16 hwbf16x2 __attribute__((ext_vector_type(2)));
__device__ __forceinline__ unsigned f2bf(float f) { const __bf16 b = (__bf16)f; return (unsigned)__builtin_bit_cast(unsigned short, b); }
__device__ __forceinline__ float bf2f(unsigned h) { return __uint_as_float(h << 16); }
__device__ __forceinline__ unsigned pk2(float lo, float hi) { const f32x2 v = {lo, hi}; const hwbf16x2 b = __builtin_convertvector(v, hwbf16x2); return __builtin_bit_cast(unsigned, b); }
__device__ __forceinline__ float bflo(unsigned w) { return __uint_as_float(w << 16); }
__device__ __forceinline__ float bfhi(unsigned w) { return __uint_as_float(w & 0xffff0000u); }
__device__ __forceinline__ float wave_sum(float v) {
#pragma unroll
    for (int o = 32; o >= 1; o >>= 1) v += __shfl_xor(v, o);
    return v;
}
__device__ __forceinline__ float sigmoidf_(float v) { return 1.0f / (1.0f + __expf(-v)); }


#define XB_TMO      128
#define XB_XCNT(j)  (256  + 64 * (j))
#define XB_XSUB(j)  (1280 + 64 * (j))
#define XB_XGEN(j)  (2304 + 64 * (j))
#define XB_TOP      3328
#define XB_TOPGEN   3392
#define XCD_BAR_WORDS 3456
#define XB_SPIN_CAP (1u << 22)
__device__ __forceinline__ unsigned xb_ld(unsigned* p)              { return __hip_atomic_load(p, __ATOMIC_RELAXED, __HIP_MEMORY_SCOPE_AGENT); }
__device__ __forceinline__ unsigned xb_add(unsigned* p, unsigned v) { return __hip_atomic_fetch_add(p, v, __ATOMIC_RELAXED, __HIP_MEMORY_SCOPE_AGENT); }
__device__ __forceinline__ unsigned xb_xcc_id() { return (unsigned)__builtin_amdgcn_s_getreg((3 << 11) | 20) & 0xFu; }
#define XB_SPIN(cond, bar) do { unsigned _sp = 0; while (cond) { __builtin_amdgcn_s_sleep(1); \
    if ((++_sp & 255u) == 0u) { if (xb_ld(&(bar)[XB_TMO])) break; if (_sp > XB_SPIN_CAP) { atomicAdd(&(bar)[XB_TMO], 1u); break; } } } } while (0)
struct XcdBarrier { unsigned* bar; unsigned x; volatile LAS unsigned* st; };
__device__ __forceinline__ XcdBarrier xcd_barrier_post(unsigned* bar, volatile LAS unsigned* st) {
    XcdBarrier b; b.bar = bar; b.x = xb_xcc_id(); b.st = st;
    if (threadIdx.x == 0) (void)xb_add(&bar[XB_XCNT(b.x)], 1u);
    return b;
}
__device__ __forceinline__ void xcd_barrier_complete(unsigned* bar, unsigned x, unsigned& nloc, unsigned& nx) {
    const unsigned G = gridDim.x * gridDim.y * gridDim.z;
    unsigned sum, cnt, mine, sp = 0u;
    for (;;) {
        sum = 0u; cnt = 0u; mine = 0u;
#pragma unroll
        for (unsigned j = 0; j < 16; ++j) { const unsigned c = xb_ld(&bar[XB_XCNT(j)]); sum += c; cnt += (c > 0u) ? 1u : 0u; mine = (j == x) ? c : mine; }
        if (sum == G) break;
        __builtin_amdgcn_s_sleep(1);
        if ((++sp & 255u) == 0u) { if (xb_ld(&bar[XB_TMO])) break; if (sp > XB_SPIN_CAP) { atomicAdd(&bar[XB_TMO], 1u); break; } }
    }
    nloc = mine > 0u ? mine : 1u; nx = cnt > 0u ? cnt : 1u;
}
__device__ __forceinline__ void xcd_barrier(const XcdBarrier& b) {
    asm volatile("s_waitcnt vmcnt(0)" ::: "memory");
    __syncthreads();
    if (threadIdx.x == 0) {
        unsigned* bar = b.bar;
        __builtin_amdgcn_s_waitcnt(0);
        unsigned nloc = b.st[0], nx = b.st[1];
        if (nloc == 0u) { xcd_barrier_complete(bar, b.x, nloc, nx); b.st[0] = nloc; b.st[1] = nx; }
        const unsigned old = xb_add(&bar[XB_XSUB(b.x)], 1u);
        const unsigned gen = old / nloc;
        if (old + 1u == (gen + 1u) * nloc) {
            __builtin_amdgcn_fence(__ATOMIC_RELEASE, "agent");
            asm volatile("s_waitcnt vmcnt(0)" ::: "memory");
            const unsigned og = xb_add(&bar[XB_TOP], 1u);
            const unsigned tg = og / nx;
            if (og + 1u == (tg + 1u) * nx) xb_add(&bar[XB_TOPGEN], 1u);
            else XB_SPIN(xb_ld(&bar[XB_TOPGEN]) == tg, bar);
            __builtin_amdgcn_fence(__ATOMIC_ACQUIRE, "agent");
            xb_add(&bar[XB_XGEN(b.x)], 1u);
            asm volatile("s_waitcnt vmcnt(0)" ::: "memory");
        } else {
            XB_SPIN(xb_ld(&bar[XB_XGEN(b.x)]) == gen, bar);
            __builtin_amdgcn_fence(__ATOMIC_ACQUIRE, "agent");
            asm volatile("s_waitcnt vmcnt(0)" ::: "memory");
        }
    }
    __syncthreads();
}

__device__ __forceinline__ unsigned tr_off(unsigned row, unsigned ch) { return 256u * row + 16u * (ch ^ (((row & 3u) << 2) | ((row >> 2) & 3u))); }
#define TR_FRAG_ISSUE(r0, r1, base, lane, c, ks) do { const unsigned g_ = (lane) >> 4, q_ = ((lane) & 15) >> 2, p_ = (lane) & 3; \
    const unsigned a0_ = (base) + tr_off(32u * (ks) + 8u * g_ + q_, 2u * (c) + (p_ >> 1)) + 8u * (p_ & 1u); \
    const unsigned a1_ = (base) + tr_off(32u * (ks) + 8u * g_ + 4u + q_, 2u * (c) + (p_ >> 1)) + 8u * (p_ & 1u); \
    asm volatile("ds_read_b64_tr_b16 %0, %2\n\tds_read_b64_tr_b16 %1, %3" : "=&v"(r0), "=&v"(r1) : "v"(a0_), "v"(a1_) : "memory"); } while (0)
__device__ __forceinline__ bf16x8 tr_join(u32x2 r0, u32x2 r1) { const u32x4 v = {r0.x, r0.y, r1.x, r1.y}; return __builtin_bit_cast(bf16x8, v); }

#define LDS_RD128(dst, addr) asm volatile("ds_read_b128 %0, %1" : "=&v"(dst) : "v"((unsigned)(addr)) : "memory")
#define LDS_WAIT4(a, b, c, d) asm volatile("s_waitcnt lgkmcnt(0)" : "+v"(a), "+v"(b), "+v"(c), "+v"(d) :: "memory")
#define LDS_WAIT8(a, b, c, d, e, f, g, h) asm volatile("s_waitcnt lgkmcnt(0)" : "+v"(a), "+v"(b), "+v"(c), "+v"(d), "+v"(e), "+v"(f), "+v"(g), "+v"(h) :: "memory")
#define LDS_RD128_O(dst, base, OFF) asm volatile("ds_read_b128 %0, %1 offset:%2" : "=&v"(dst) : "v"((unsigned)(base)), "n"(OFF) : "memory")
#define LDS_RD4(arr, base, STRIDE) do { LDS_RD128_O((arr)[0], base, 0); LDS_RD128_O((arr)[1], base, (STRIDE)); LDS_RD128_O((arr)[2], base, 2 * (STRIDE)); LDS_RD128_O((arr)[3], base, 3 * (STRIDE)); } while (0)
#define LDS_RD8(arr, base, STRIDE) do { LDS_RD4(arr, base, STRIDE); LDS_RD128_O((arr)[4], base, 4 * (STRIDE)); LDS_RD128_O((arr)[5], base, 5 * (STRIDE)); LDS_RD128_O((arr)[6], base, 6 * (STRIDE)); LDS_RD128_O((arr)[7], base, 7 * (STRIDE)); } while (0)

namespace pg8 {
constexpr int BM = 256, BK = 64, HALF = 128, HTB = HALF * BK * 2, STAGE_BYTES = 8 * HTB, NXCD = 8, WGM = 8;
__device__ __forceinline__ int lds_byte(int r, int c) { const int st = (r >> 4) * 2 + (c >> 5), rr = r & 15, cc = c & 31, ob = rr * 64 + cc * 2; return st * 1024 + (ob ^ (((ob >> 9) & 1) << 5)); }
__device__ __forceinline__ void stage_rc(int b, int& R, int& C) { const int st = b / 1024, sb = b % 1024, swz = sb ^ (((sb >> 9) & 1) << 5); R = (st >> 1) * 16 + swz / 64; C = (st & 1) * 32 + (swz % 64) / 2; }
__device__ __forceinline__ int perm32(int rho) { const int n = rho >> 4, i = rho & 15; return 8 * (i >> 2) + 4 * n + (i & 3); }

struct Unit { int pm, pn; };
struct Gemm { const bf16_t* A; const bf16_t* Bt; int M, N, K, lda; };

struct StaticOrder {
    int nM, nN, nwg, G, c;
    __device__ void init(int M, int N, int G_, int c_) { nM = M / BM; nN = N / BM; nwg = nM * nN; G = G_; c = c_; }
    __device__ bool next(int i, Unit& u) const {
        const long L = (long)i * G + c; if (L >= nwg) return false;
        int wgid = (int)L; { const int q = nwg / NXCD, r = nwg % NXCD, xcd = wgid % NXCD, off = wgid / NXCD; wgid = (xcd < r ? xcd * (q + 1) : r * (q + 1) + (xcd - r) * q) + off; }
        const int nig = WGM * nN, gid = wgid / nig, fm = gid * WGM, gsz = (nM - fm) < WGM ? (nM - fm) : WGM;
        u.pm = fm + ((wgid % nig) % gsz); u.pn = (wgid % nig) / gsz; return true;
    }
};

template <class Epi>
__device__ __forceinline__ void gemm_phase(ldsp_t lds, const Gemm g, const StaticOrder& S, const Epi& E) {
    const int tid = threadIdx.x, wid = __builtin_amdgcn_readfirstlane(tid >> 6), lane = tid & 63, wr = wid >> 2, wc = wid & 3, fr = lane & 15, fq = lane >> 4;
    const int K = g.K, nt = K / BK, lda = g.lda;
    unsigned voffA[2], voffB[2];
#pragma unroll
    for (int i = 0; i < 2; ++i) { int R, C; stage_rc(tid * 16 + i * 8192, R, C); const int Rb = Epi::PERM ? ((R & ~31) + perm32(R & 31)) : R;
        voffA[i] = (unsigned)(R * lda + C) * 2u; voffB[i] = (unsigned)(Rb * K + C) * 2u; }
    const size_t kstep = (size_t)(BK * 2);
    const size_t hstepA = (size_t)HALF * lda * 2, hstepB = (size_t)HALF * K * 2;
    const size_t tstepA = 2 * hstepA, tstepB = 2 * hstepB;
    const unsigned ldsw = (unsigned)wid * 1024u;
    const int aoff = lds_byte(wr * 64 + fr, fq * 8), boff = lds_byte(wc * 32 + fr, fq * 8);
#define PG8_SA(b, h) (((b) * 2 + (h)) * HTB)
#define PG8_SB(b, h) ((4 + (b) * 2 + (h)) * HTB)
#define PG8_STAGE(bufoff, gbase, voff) do { _Pragma("unroll") for (int _i = 0; _i < 2; ++_i) \
        __builtin_amdgcn_global_load_lds((const unsigned*)((const char*)(gbase) + (voff)[_i]), (LAS unsigned*)(lds + (bufoff) + ldsw + _i * 8192), 16, 0, 0); } while (0)
#define PG8_LDA(dst, b, h) do { _Pragma("unroll") for (int m = 0; m < 4; ++m) _Pragma("unroll") for (int k = 0; k < 2; ++k) dst[m][k] = *(const LAS bf16x8*)(lds + PG8_SA(b, h) + aoff + m * 2048 + k * 1024); } while (0)
#define PG8_LDB(dst, b, h) do { _Pragma("unroll") for (int n = 0; n < 2; ++n) _Pragma("unroll") for (int k = 0; k < 2; ++k) dst[n][k] = *(const LAS bf16x8*)(lds + PG8_SB(b, h) + boff + n * 2048 + k * 1024); } while (0)
#define PG8_MMA(ai, bj, At, Bt) do { __builtin_amdgcn_s_setprio(1); _Pragma("unroll") for (int m = 0; m < 4; ++m) _Pragma("unroll") for (int n = 0; n < 2; ++n) _Pragma("unroll") for (int k = 0; k < 2; ++k) \
        acc[ai][bj][m][n] = __builtin_amdgcn_mfma_f32_16x16x32_bf16(Bt[n][k], At[m][k], acc[ai][bj][m][n], 0, 0, 0); __builtin_amdgcn_s_setprio(0); } while (0)
#define PG8_WAIT_V(n) asm volatile("s_waitcnt vmcnt(" #n ")" ::: "memory")
#define PG8_WAIT_L(n) asm volatile("s_waitcnt lgkmcnt(" #n ")" ::: "memory")
#define PG8_BAR __builtin_amdgcn_s_barrier()
#define PG8_SCHED __builtin_amdgcn_sched_barrier(0)
    Unit cur, nxt; int ui = 0;
    if (!S.next(0, cur)) return;
    f32x4 acc[2][2][4][2];
#pragma unroll
    for (int a = 0; a < 2; ++a)
#pragma unroll
        for (int b = 0; b < 2; ++b)
#pragma unroll
            for (int m = 0; m < 4; ++m)
#pragma unroll
                for (int n = 0; n < 2; ++n) acc[a][b][m][n] = (f32x4){0.f, 0.f, 0.f, 0.f};
    bf16x8 At[4][2], B0[2][2], B1[2][2];
    const char* cA = (const char*)g.A + (size_t)cur.pm * tstepA; const char* cB = (const char*)g.Bt + (size_t)cur.pn * tstepB;
    PG8_STAGE(PG8_SB(0, 0), cB, voffB); PG8_STAGE(PG8_SA(0, 0), cA, voffA); PG8_STAGE(PG8_SB(0, 1), cB + hstepB, voffB); PG8_STAGE(PG8_SA(0, 1), cA + hstepA, voffA);
    if (wr == 1) PG8_BAR;
    PG8_WAIT_V(4); PG8_BAR;
    PG8_STAGE(PG8_SB(1, 0), cB + kstep, voffB); PG8_STAGE(PG8_SA(1, 0), cA + kstep, voffA); PG8_STAGE(PG8_SB(1, 1), cB + hstepB + kstep, voffB);
    PG8_WAIT_V(6); PG8_BAR;
    for (;;) {
        const bool has_next = S.next(ui + 1, nxt);
        const char* nA = has_next ? (const char*)g.A + (size_t)nxt.pm * tstepA : cA; const char* nB = has_next ? (const char*)g.Bt + (size_t)nxt.pn * tstepB : cB;
        for (int t = 0; t < nt; t += 2) {
            const bool last = (t == nt - 2);
            const char* a1 = cA + (size_t)(t + 1) * kstep;
            const char* a2 = last ? nA : cA + (size_t)(t + 2) * kstep; const char* b2 = last ? nB : cB + (size_t)(t + 2) * kstep;
            const char* a3 = a2 + kstep; const char* b3 = b2 + kstep;
            PG8_LDB(B0, 0, 0); PG8_SCHED; PG8_LDA(At, 0, 0); PG8_STAGE(PG8_SA(1, 1), a1 + hstepA, voffA);
            PG8_WAIT_L(8); PG8_BAR; PG8_WAIT_L(0); PG8_MMA(0, 0, At, B0); PG8_BAR; PG8_SCHED;
            PG8_LDB(B1, 0, 1); PG8_STAGE(PG8_SB(0, 0), b2, voffB);
            PG8_BAR; PG8_WAIT_L(0); PG8_MMA(0, 1, At, B1); PG8_BAR;
            PG8_LDA(At, 0, 1); PG8_STAGE(PG8_SA(0, 0), a2, voffA);
            PG8_BAR; PG8_WAIT_L(0); PG8_MMA(1, 0, At, B0); PG8_BAR; PG8_SCHED;
            PG8_STAGE(PG8_SB(0, 1), b2 + hstepB, voffB);
            PG8_WAIT_V(6); PG8_BAR; PG8_MMA(1, 1, At, B1); PG8_BAR;
            PG8_LDB(B0, 1, 0); PG8_SCHED; PG8_LDA(At, 1, 0); PG8_STAGE(PG8_SA(0, 1), a2 + hstepA, voffA);
            PG8_WAIT_L(8); PG8_BAR; PG8_WAIT_L(0); PG8_MMA(0, 0, At, B0); PG8_BAR; PG8_SCHED;
            PG8_LDB(B1, 1, 1); PG8_STAGE(PG8_SB(1, 0), b3, voffB);
            PG8_BAR; PG8_WAIT_L(0); PG8_MMA(0, 1, At, B1); PG8_BAR;
            PG8_LDA(At, 1, 1); PG8_STAGE(PG8_SA(1, 0), a3, voffA);
            PG8_BAR; PG8_WAIT_L(0); PG8_MMA(1, 0, At, B0); PG8_BAR; PG8_SCHED;
            PG8_STAGE(PG8_SB(1, 1), b3 + hstepB, voffB);
            PG8_WAIT_V(6); PG8_BAR; PG8_MMA(1, 1, At, B1); PG8_BAR;
        }
        E(acc, cur, wr, wc, fr, fq);
        if (!has_next) break;
#pragma unroll
        for (int a = 0; a < 2; ++a)
#pragma unroll
            for (int b = 0; b < 2; ++b)
#pragma unroll
                for (int m = 0; m < 4; ++m)
#pragma unroll
                    for (int n = 0; n < 2; ++n) acc[a][b][m][n] = (f32x4){0.f, 0.f, 0.f, 0.f};
        cur = nxt; cA = nA; cB = nB; ++ui;
    }
    PG8_WAIT_V(0);
    if (wr == 0) PG8_BAR;
    PG8_BAR;
#undef PG8_SA
#undef PG8_SB
#undef PG8_STAGE
#undef PG8_LDA
#undef PG8_LDB
#undef PG8_MMA
#undef PG8_WAIT_V
#undef PG8_WAIT_L
#undef PG8_BAR
#undef PG8_SCHED
}

struct EpiIn {
    static constexpr bool PERM = true;
    bf16_t* P;
    __device__ __forceinline__ void operator()(const f32x4 (&acc)[2][2][4][2], const Unit& u, int wr, int wc, int fr, int fq) const {
        const int row0 = u.pm * BM + wr * 64 + fr, col0 = u.pn * BM + wc * 32 + 8 * fq;
        const bool sg = (u.pn >= 16 && u.pn < 32);
#pragma unroll
        for (int ai = 0; ai < 2; ++ai)
#pragma unroll
            for (int m = 0; m < 4; ++m) { bf16_t* rowp = P + (size_t)(row0 + ai * HALF + m * 16) * PW + col0;
#pragma unroll
                for (int bj = 0; bj < 2; ++bj) { f32x4 v0 = acc[ai][bj][m][0], v1 = acc[ai][bj][m][1];
                    if (sg) {
#pragma unroll
                        for (int j = 0; j < 4; ++j) { v0[j] = sigmoidf_(v0[j]); v1[j] = sigmoidf_(v1[j]); } }
                    u32x4 w; w.x = pk2(v0[0], v0[1]); w.y = pk2(v0[2], v0[3]); w.z = pk2(v1[0], v1[1]); w.w = pk2(v1[2], v1[3]);
                    *(u32x4*)(rowp + bj * HALF) = w; } }
    }
};
template <int MODE> struct EpiGate {
    static constexpr bool PERM = true;
    bf16_t* O; int ldo; const bf16_t* G; int ldg;
    __device__ __forceinline__ void operator()(const f32x4 (&acc)[2][2][4][2], const Unit& u, int wr, int wc, int fr, int fq) const {
        const int row0 = u.pm * BM + wr * 64 + fr, col0 = u.pn * BM + wc * 32 + 8 * fq;
#pragma unroll
        for (int ai = 0; ai < 2; ++ai)
#pragma unroll
            for (int m = 0; m < 4; ++m) { const size_t row = (size_t)(row0 + ai * HALF + m * 16);
#pragma unroll
                for (int bj = 0; bj < 2; ++bj) { const f32x4 v0 = acc[ai][bj][m][0], v1 = acc[ai][bj][m][1];
                    float r[8] = {v0[0], v0[1], v0[2], v0[3], v1[0], v1[1], v1[2], v1[3]};
                    bf16_t* op = O + row * ldo + col0 + bj * HALF;
                    if (MODE != 2) { const u32x4 gw = *(const u32x4*)(G + row * ldg + col0 + bj * HALF);
                        const unsigned gws[4] = {gw.x, gw.y, gw.z, gw.w};
#pragma unroll
                        for (int j = 0; j < 4; ++j) { r[2 * j] *= bflo(gws[j]); r[2 * j + 1] *= bfhi(gws[j]); } }
                    if (MODE == 1) { const u32x4 ow = *(const u32x4*)op; const unsigned ows[4] = {ow.x, ow.y, ow.z, ow.w};
#pragma unroll
                        for (int j = 0; j < 4; ++j) { r[2 * j] += bflo(ows[j]); r[2 * j + 1] += bfhi(ows[j]); } }
                    u32x4 w; w.x = pk2(r[0], r[1]); w.y = pk2(r[2], r[3]); w.z = pk2(r[4], r[5]); w.w = pk2(r[6], r[7]);
                    *(u32x4*)op = w; } }
    }
};
struct EpiRes {
    static constexpr bool PERM = false;
    const float* X; const float* gmod; float* H;
    __device__ __forceinline__ void operator()(const f32x4 (&acc)[2][2][4][2], const Unit& u, int wr, int wc, int fr, int fq) const {
        const int row0 = u.pm * BM + wr * 64 + fr, col0 = u.pn * BM + wc * 32 + 4 * fq;
        const float* gm = gmod + (size_t)((u.pm * BM) >> 14) * 12288;
        f32x4 gv[2][2];
#pragma unroll
        for (int bj = 0; bj < 2; ++bj)
#pragma unroll
            for (int n = 0; n < 2; ++n) gv[bj][n] = *(const f32x4*)(gm + col0 + bj * HALF + n * 16);
#pragma unroll
        for (int ai = 0; ai < 2; ++ai)
#pragma unroll
            for (int m = 0; m < 4; ++m) { const size_t off = (size_t)(row0 + ai * HALF + m * 16) * 2048 + col0;
#pragma unroll
                for (int bj = 0; bj < 2; ++bj)
#pragma unroll
                    for (int n = 0; n < 2; ++n) { const f32x4 xs = *(const f32x4*)(X + off + bj * HALF + n * 16);
                        *(f32x4*)(H + off + bj * HALF + n * 16) = xs + gv[bj][n] * acc[ai][bj][m][n]; } }
    }
};
struct EpiNull {
    static constexpr bool PERM = true;
    float* sink;
    __device__ __forceinline__ void operator()(const f32x4 (&acc)[2][2][4][2], const Unit& u, int wr, int wc, int fr, int fq) const {
        float s = 0.f;
#pragma unroll
        for (int ai = 0; ai < 2; ++ai)
#pragma unroll
            for (int bj = 0; bj < 2; ++bj)
#pragma unroll
                for (int m = 0; m < 4; ++m)
#pragma unroll
                    for (int n = 0; n < 2; ++n) s += acc[ai][bj][m][n][0] + acc[ai][bj][m][n][1] + acc[ai][bj][m][n][2] + acc[ai][bj][m][n][3];
        if (s == 123.456f) sink[threadIdx.x] = s;
    }
};
}

__device__ void gemv_task(const Args& a, int task, ldsp_t lds) {
    const int tid = threadIdx.x, cq = tid & 15, rl = tid >> 4;
    const float* W = a.in[I_WADA] + 64 * task + 4 * cq;
    const float* c = a.in[I_C];
    f32x4 acc0 = {0.f, 0.f, 0.f, 0.f}, acc1 = {0.f, 0.f, 0.f, 0.f};
    for (int r = rl; r < 2048; r += 32) {
        const f32x4 w = *(const f32x4*)(W + (size_t)r * 12288);
        const float c0 = c[r], c1 = c[2048 + r];
        const float s0 = c0 / (1.f + __expf(-c0)), s1 = c1 / (1.f + __expf(-c1));
        acc0 += s0 * w; acc1 += s1 * w;
    }
    LAS float* red = (LAS float*)lds;
    __syncthreads();
#pragma unroll
    for (int j = 0; j < 4; ++j) { red[(rl * 16 + cq) * 8 + j] = acc0[j]; red[(rl * 16 + cq) * 8 + 4 + j] = acc1[j]; }
    __syncthreads();
    if (tid < 128) {
        const int b = tid >> 6, col = tid & 63; float s = 0.f;
        for (int r = 0; r < 32; ++r) s += red[(r * 16 + (col >> 2)) * 8 + b * 4 + (col & 3)];
        float* mod = (float*)(a.ws + WS_MOD);
        mod[b * 12288 + 64 * task + col] = s + a.in[I_BADA][64 * task + col];
    }
    __syncthreads();
}

template <class CMap>
__device__ __forceinline__ void tr_tile(const float* src, int src_ld, int r0, int c0, CMap cmap, bf16_t* dst, int dst_ld, ldsp_t lds) {
    LAS float* tile = (LAS float*)lds;
    const int tid = threadIdx.x, cc = tid & 63, rr0 = tid >> 6;
    const int sc = cmap(c0 + cc);
#pragma unroll
    for (int i = 0; i < 8; ++i) { const int r = rr0 + 8 * i; tile[cc * 65 + r] = sc >= 0 ? src[(size_t)(r0 + r) * src_ld + sc] : 0.f; }
    __syncthreads();
    const int rp = (tid & 31) * 2, c1 = tid >> 5;
#pragma unroll
    for (int i = 0; i < 4; ++i) { const int c = c1 + 16 * i; *(unsigned*)(dst + (size_t)(c0 + c) * dst_ld + r0 + rp) = pk2(tile[c * 65 + rp], tile[c * 65 + rp + 1]); }
    __syncthreads();
}
struct MapId { __device__ int operator()(int c) const { return c; } };
struct MapWin { __device__ int operator()(int c) const { return c < 4096 ? c : (c < 8192 ? c + 32 : (c < 8224 ? c - 4096 : -1)); } };

__device__ void fold_tile(const Args& a, int tile, ldsp_t lds) {
    LAS float* wl = (LAS float*)lds;
    LAS float* ct = (LAS float*)(lds + 65536);
    const int tid = threadIdx.x;
    const int nb = tile & 31, kb = tile >> 5;
    const int ri = kb >> 4, g = (kb >> 2) & 3, c0 = (kb & 3) * 64, n0 = nb * 64;
    const float* wf = a.in[I_WFNET] + (size_t)(g * 256) * 2048 + n0;
    __syncthreads();
#pragma unroll
    for (int j = 0; j < 8; ++j) { const int row = (tid >> 4) + 32 * j, c4 = (tid & 15) * 4;
        const f32x4 v = *(const f32x4*)(wf + (size_t)row * 2048 + c4);
        wl[row * 64 + c4] = v[0]; wl[row * 64 + c4 + 1] = v[1]; wl[row * 64 + c4 + 2] = v[2]; wl[row * 64 + c4 + 3] = v[3]; }
    if (tid < 256) ct[tid] = cospif((float)tid * (1.0f / 128.0f));
    __syncthreads();
    const int kk = tid & 63, nn0 = tid >> 6, c = c0 + kk;
    float acc[8];
#pragma unroll
    for (int i = 0; i < 8; ++i) acc[i] = 0.f;
    for (int m = 0; m < 256; ++m) {
        const int idx = (m * c) & 255;
        const float cs = ri ? ct[(idx + 192) & 255] : ct[idx];
#pragma unroll
        for (int i = 0; i < 8; ++i) acc[i] += wl[m * 64 + nn0 + 8 * i] * cs;
    }
    bf16_t* dst = (bf16_t*)(a.ws + WS_WFN);
#pragma unroll
    for (int i = 0; i < 8; ++i) dst[(size_t)(n0 + nn0 + 8 * i) * 2048 + ri * 1024 + g * 256 + c] = (bf16_t)f2bf(acc[i] * (1.0f / 2048.0f));
    __syncthreads();
}

__device__ void tables_task(const Args& a, int task) {
    const int tid = threadIdx.x;
    bf16_t* F1 = (bf16_t*)(a.ws + WS_F1); bf16_t* F2 = (bf16_t*)(a.ws + WS_F2); float* TW = (float*)(a.ws + WS_TW);
    {
        const int e = task * 512 + tid, R = e >> 7, sh = e & 127, w = R >> 5, mt = (R >> 4) & 1, r = R & 15, kf = 16 * w + r;
        float s, c; sincospif((float)((kf * sh) & 127) * (1.0f / 64.0f), &s, &c);
        F1[e] = (bf16_t)f2bf(mt ? -s : c);
    }
#pragma unroll
    for (int q = 0; q < 2; ++q) {
        const int e = task * 1024 + q * 512 + tid, R = e >> 8, K = e & 255, sl = K >> 1, ri = K & 1, w = R >> 5, mt = (R >> 4) & 1, r = R & 15, kf = 16 * w + r;
        float s, c; sincospif((float)((kf * sl) & 127) * (1.0f / 64.0f), &s, &c);
        const float v = mt ? (ri ? c : -s) : (ri ? s : c);
        F2[e] = (bf16_t)f2bf(v);
    }
    if (task < 32) {
        const int e = task * 512 + tid, kl = e >> 7, sl = e & 127;
        float s, c; sincospif((float)(kl * sl) * (1.0f / 8192.0f), &s, &c);
        TW[2 * e] = c; TW[2 * e + 1] = s;
    }
}

__device__ void cvt_flat(const float* src, bf16_t* dst, size_t n) {
    const size_t gt = (size_t)blockIdx.x * 512 + threadIdx.x, gs = (size_t)gridDim.x * 512;
    for (size_t i = gt * 8; i < n; i += gs * 8) {
        const f32x4 v0 = *(const f32x4*)(src + i), v1 = *(const f32x4*)(src + i + 4);
        u32x4 w; w.x = pk2(v0[0], v0[1]); w.y = pk2(v0[2], v0[3]); w.z = pk2(v1[0], v1[1]); w.w = pk2(v1[2], v1[3]);
        *(u32x4*)(dst + i) = w;
    }
}

__device__ void phase0(const Args& a, ldsp_t lds) {
    const int G = gridDim.x, bx = blockIdx.x;
    for (int t = bx; t < 192; t += G) gemv_task(a, t, lds);
    for (int t = bx; t < 64; t += G) tables_task(a, t);
    cvt_flat(a.in[I_KEYS], (bf16_t*)(a.ws + WS_KEYS), (size_t)8 * 2 * 128 * 128);
    for (int t = bx; t < 132 * 32; t += G) tr_tile(a.in[I_WIN], 8224, (t & 31) * 64, (t >> 5) * 64, MapWin(), (bf16_t*)(a.ws + WS_WIN), 2048, lds);
    for (int t = bx; t < 32 * 16; t += G) tr_tile(a.in[I_WGLA], 2048, (t & 15) * 64, (t >> 4) * 64, MapId(), (bf16_t*)(a.ws + WS_WGLA), 1024, lds);
    for (int t = bx; t < 32 * 32; t += G) tr_tile(a.in[I_WOUT], 2048, (t & 31) * 64, (t >> 5) * 64, MapId(), (bf16_t*)(a.ws + WS_WOUT), 2048, lds);
    for (int t = bx; t < 32 * 32; t += G) tr_tile(a.in[I_WQ], 2048, (t & 31) * 64, (t >> 5) * 64, MapId(), (bf16_t*)(a.ws + WS_WQ), 2048, lds);
    for (int t = bx; t < 1024; t += G) fold_tile(a, t, lds);
}

__device__ void norm_phase(const float* X, const float* gvec, const float* mod_sh, const float* mod_sc, bf16_t* out) {
    const int lane = threadIdx.x & 63, wave = threadIdx.x >> 6;
    const int W = gridDim.x * 8;
    for (int row = blockIdx.x * 8 + wave; row < T_; row += W) {
        const float* xr = X + (size_t)row * 2048;
        const int b = row >> 14;
        f32x4 v[8]; float ss = 0.f;
#pragma unroll
        for (int j = 0; j < 8; ++j) { v[j] = *(const f32x4*)(xr + (j * 64 + lane) * 4); ss += v[j][0] * v[j][0] + v[j][1] * v[j][1] + v[j][2] * v[j][2] + v[j][3] * v[j][3]; }
        ss = wave_sum(ss);
        const float rstd = rsqrtf(ss * (1.0f / 2048.0f) + EPS);
#pragma unroll
        for (int j = 0; j < 8; ++j) { const int d = (j * 64 + lane) * 4;
            const f32x4 gg = *(const f32x4*)(gvec + d), sc = *(const f32x4*)(mod_sc + b * 12288 + d), sh = *(const f32x4*)(mod_sh + b * 12288 + d);
            f32x4 y = v[j] * rstd * gg * (1.0f + sc) + sh;
            u32x2 w; w.x = pk2(y[0], y[1]); w.y = pk2(y[2], y[3]);
            *(u32x2*)(out + (size_t)row * 2048 + d) = w; }
    }
}

__device__ void fft1_phase(const Args& a, ldsp_t lds) {
    const int tid = threadIdx.x, lane = tid & 63, w = tid >> 6, g = lane >> 4, l15 = lane & 15;
    const bf16_t* F1 = (const bf16_t*)(a.ws + WS_F1);
    const float* TW = (const float*)(a.ws + WS_TW);
    const bf16_t* P = (const bf16_t*)(a.ws + WS_P);
    bf16_t* T1 = (bf16_t*)a.out;
    bf16x8 Af[2][4];
#pragma unroll
    for (int mt = 0; mt < 2; ++mt)
#pragma unroll
        for (int ks = 0; ks < 4; ++ks) Af[mt][ks] = *(const bf16x8*)(F1 + (32 * w + 16 * mt + l15) * 128 + 32 * ks + 8 * g);
    constexpr int OS = 272, OFF_OUT = 128 * 256;
    const unsigned ldsb = (unsigned)(size_t)lds;
    const int c16 = tid & 15, r32 = tid >> 4;
    u32x4 buf[4];
    int tile = blockIdx.x;
    if (tile < 2048) { const int cb = tile & 7, s_lo = (tile >> 3) & 127, b = tile >> 10;
        const bf16_t* src = P + (size_t)(b * S_ + s_lo) * PW + PC_Z + cb * 128 + 8 * c16;
#pragma unroll
        for (int i = 0; i < 4; ++i) buf[i] = *(const u32x4*)(src + (size_t)(r32 + 32 * i) * 128 * PW); }
    for (; tile < 2048; tile += gridDim.x) {
        const int cb = tile & 7, s_lo = (tile >> 3) & 127, b = tile >> 10;
        __syncthreads();
#pragma unroll
        for (int i = 0; i < 4; ++i) *(LAS u32x4*)(lds + tr_off(r32 + 32 * i, c16)) = buf[i];
        __syncthreads();
        { const int nt_ = tile + gridDim.x;
          if (nt_ < 2048) { const int cb2 = nt_ & 7, s2 = (nt_ >> 3) & 127, b2 = nt_ >> 10;
            const bf16_t* src = P + (size_t)(b2 * S_ + s2) * PW + PC_Z + cb2 * 128 + 8 * c16;
#pragma unroll
            for (int i = 0; i < 4; ++i) buf[i] = *(const u32x4*)(src + (size_t)(r32 + 32 * i) * 128 * PW); } }
        f32x4 acc[2][8];
#pragma unroll
        for (int mt = 0; mt < 2; ++mt)
#pragma unroll
            for (int nt = 0; nt < 8; ++nt) acc[mt][nt] = (f32x4){0.f, 0.f, 0.f, 0.f};
#pragma unroll
        for (int nt = 0; nt < 8; ++nt) { u32x2 t0[4], t1[4];
            unsigned lv = (unsigned)lane; asm volatile("" : "+v"(lv));
#pragma unroll
            for (int ks = 0; ks < 4; ++ks) TR_FRAG_ISSUE(t0[ks], t1[ks], ldsb, lv, nt, ks);
            asm volatile("s_waitcnt lgkmcnt(0)" : "+v"(t0[0]), "+v"(t1[0]), "+v"(t0[1]), "+v"(t1[1]), "+v"(t0[2]), "+v"(t1[2]), "+v"(t0[3]), "+v"(t1[3]) :: "memory");
#pragma unroll
            for (int ks = 0; ks < 4; ++ks) { const bf16x8 bfr = tr_join(t0[ks], t1[ks]);
                acc[0][nt] = __builtin_amdgcn_mfma_f32_16x16x32_bf16(Af[0][ks], bfr, acc[0][nt], 0, 0, 0);
                acc[1][nt] = __builtin_amdgcn_mfma_f32_16x16x32_bf16(Af[1][ks], bfr, acc[1][nt], 0, 0, 0); } }
#pragma unroll
        for (int r = 0; r < 4; ++r) { const int k_lo = 16 * w + 4 * g + r;
            const f32x2 cs = *(const f32x2*)(TW + 2 * (k_lo * 128 + s_lo));
#pragma unroll
            for (int nt = 0; nt < 8; ++nt) { const float tr = acc[0][nt][r], ti = acc[1][nt][r];
                *(LAS unsigned short*)(lds + OFF_OUT + (2 * k_lo) * OS + (16 * nt + l15) * 2) = (unsigned short)f2bf(tr * cs.x + ti * cs.y);
                *(LAS unsigned short*)(lds + OFF_OUT + (2 * k_lo + 1) * OS + (16 * nt + l15) * 2) = (unsigned short)f2bf(ti * cs.x - tr * cs.y); } }
        __syncthreads();
#pragma unroll
        for (int i = 0; i < 8; ++i) { const int row = r32 + 32 * i;
            const u32x4 v = *(const LAS u32x4*)(lds + OFF_OUT + row * OS + c16 * 16);
            *(u32x4*)(T1 + ((size_t)((b * 128 + (row >> 1)) * 128 + s_lo) * 2 + (row & 1)) * 1024 + cb * 128 + c16 * 8) = v; }
    }
}

__device__ void fft2_phase(const Args& a, ldsp_t lds) {
    const int tid = threadIdx.x, lane = tid & 63, w = tid >> 6, g = lane >> 4, l15 = lane & 15;
    const bf16_t* F2 = (const bf16_t*)(a.ws + WS_F2);
    const bf16_t* T1 = (const bf16_t*)a.out;
    bf16_t* ZA = (bf16_t*)a.out + (size_t)T_ * 2048;
    bf16x8 Af[2][8];
#pragma unroll
    for (int mt = 0; mt < 2; ++mt)
#pragma unroll
        for (int ks = 0; ks < 8; ++ks) Af[mt][ks] = *(const bf16x8*)(F2 + (32 * w + 16 * mt + l15) * 256 + 32 * ks + 8 * g);
    constexpr int OS = 272, OFF_OUT = 256 * 256;
    const unsigned ldsb = (unsigned)(size_t)lds;
    static_assert(OFF_OUT + 256 * OS <= LDS_BYTES - 16, "FFT2 LDS");
    const int c16 = tid & 15, r32 = tid >> 4;
    u32x4 buf[8];
    int tile = blockIdx.x;
    if (tile < 2048) { const int cb = tile & 7, k_lo = (tile >> 3) & 127, b = tile >> 10;
        const bf16_t* src = T1 + ((size_t)(b * 128 + k_lo) * 256) * 1024 + cb * 128 + 8 * c16;
#pragma unroll
        for (int i = 0; i < 8; ++i) buf[i] = *(const u32x4*)(src + (size_t)(r32 + 32 * i) * 1024); }
    for (; tile < 2048; tile += gridDim.x) {
        const int cb = tile & 7, k_lo = (tile >> 3) & 127, b = tile >> 10;
        __syncthreads();
#pragma unroll
        for (int i = 0; i < 8; ++i) *(LAS u32x4*)(lds + tr_off(r32 + 32 * i, c16)) = buf[i];
        __syncthreads();
        { const int nt_ = tile + gridDim.x;
          if (nt_ < 2048) { const int cb2 = nt_ & 7, k2 = (nt_ >> 3) & 127, b2 = nt_ >> 10;
            const bf16_t* src = T1 + ((size_t)(b2 * 128 + k2) * 256) * 1024 + cb2 * 128 + 8 * c16;
#pragma unroll
            for (int i = 0; i < 8; ++i) buf[i] = *(const u32x4*)(src + (size_t)(r32 + 32 * i) * 1024); } }
        f32x4 acc[2][8];
#pragma unroll
        for (int mt = 0; mt < 2; ++mt)
#pragma unroll
            for (int nt = 0; nt < 8; ++nt) acc[mt][nt] = (f32x4){0.f, 0.f, 0.f, 0.f};
#pragma unroll
        for (int nt = 0; nt < 8; ++nt)
#pragma unroll
            for (int kh = 0; kh < 2; ++kh) { u32x2 t0[4], t1[4];
                unsigned lv = (unsigned)lane; asm volatile("" : "+v"(lv));
#pragma unroll
                for (int ks = 0; ks < 4; ++ks) TR_FRAG_ISSUE(t0[ks], t1[ks], ldsb, lv, nt, 4 * kh + ks);
                asm volatile("s_waitcnt lgkmcnt(0)" : "+v"(t0[0]), "+v"(t1[0]), "+v"(t0[1]), "+v"(t1[1]), "+v"(t0[2]), "+v"(t1[2]), "+v"(t0[3]), "+v"(t1[3]) :: "memory");
#pragma unroll
                for (int ks = 0; ks < 4; ++ks) { const bf16x8 bfr = tr_join(t0[ks], t1[ks]);
                    acc[0][nt] = __builtin_amdgcn_mfma_f32_16x16x32_bf16(Af[0][4 * kh + ks], bfr, acc[0][nt], 0, 0, 0);
                    acc[1][nt] = __builtin_amdgcn_mfma_f32_16x16x32_bf16(Af[1][4 * kh + ks], bfr, acc[1][nt], 0, 0, 0); } }
#pragma unroll
        for (int r = 0; r < 4; ++r) { const int k_hi = 16 * w + 4 * g + r;
#pragma unroll
            for (int nt = 0; nt < 8; ++nt) {
                *(LAS unsigned short*)(lds + OFF_OUT + (2 * k_hi) * OS + (16 * nt + l15) * 2) = (unsigned short)f2bf(acc[0][nt][r]);
                *(LAS unsigned short*)(lds + OFF_OUT + (2 * k_hi + 1) * OS + (16 * nt + l15) * 2) = (unsigned short)f2bf(acc[1][nt][r]); } }
        __syncthreads();
#pragma unroll
        for (int i = 0; i < 8; ++i) { const int row = r32 + 32 * i;
            const u32x4 v = *(const LAS u32x4*)(lds + OFF_OUT + row * OS + c16 * 16);
            *(u32x4*)(ZA + (size_t)(b * S_ + 128 * (row >> 1) + k_lo) * 2048 + (row & 1) * 1024 + cb * 128 + c16 * 8) = v; }
    }
}

constexpr size_t WS_QT  = WS_XN;
constexpr size_t WS_AS  = WS_QT + (size_t)4096 * 64 * 128 * 2;
constexpr size_t WS_KDT = WS_END;
constexpr size_t WS_BL  = WS_KDT + (size_t)4096 * 128 * 64 * 2;
constexpr size_t WS_END2 = WS_BL + (size_t)4096 * 128 * 4;
static_assert(WS_AS + (size_t)4096 * 64 * 64 * 2 <= WS_O, "GLA pre-pass buffers must fit in the XN region");
static_assert(WS_END2 <= (size_t)1000 * 1000 * 1000, "workspace budget");

__device__ __forceinline__ float fast_logsigmoid(float z) {
    const float e = __builtin_amdgcn_exp2f(-fabsf(z) * 1.4426950408889634f);
    return fminf(z, 0.f) - __builtin_amdgcn_logf(1.0f + e) * 0.6931471805599453f;
}

__device__ void gla_pre_phase(const Args& a, ldsp_t lds) {
    const int tid = threadIdx.x, lane = tid & 63, w = tid >> 6, g = lane >> 4, l15 = lane & 15;
    const int d = tid & 127, tg = tid >> 7;
    const bf16_t* P = (const bf16_t*)(a.ws + WS_P);
    bf16_t* QT = (bf16_t*)(a.ws + WS_QT); bf16_t* AS = (bf16_t*)(a.ws + WS_AS); bf16_t* KDT = (bf16_t*)(a.ws + WS_KDT); float* BL = (float*)(a.ws + WS_BL);
    constexpr int QS = 272, JS = 144;
    constexpr int OFF_QS = 0, OFF_KS = OFF_QS + 64 * QS, OFF_AS = OFF_KS + 64 * QS, OFF_A1 = OFF_AS + 64 * JS, OFF_TOT = OFF_A1 + 2048;
    LAS float* tot = (LAS float*)(lds + OFF_TOT);
    unsigned short qk[32];
    u32x4 a1v = {0u, 0u, 0u, 0u};
    const int task_base = (blockIdx.x >> 4) * 256 + (blockIdx.x & 15) * 16;
    int task = task_base;
#define GLA_PRE_LOADS(T) do { const int stream_ = (T) >> 8, chunk_ = (T) & 255, dir_ = stream_ & 1, h_ = (stream_ >> 1) & 3, b_ = stream_ >> 3; \
        if (tid < 128) { const int i_ = tid >> 1, hf_ = tid & 1, tau_ = chunk_ * 64 + i_, t_ = dir_ ? (S_ - 1 - tau_) : tau_; \
            a1v = *(const u32x4*)(P + (size_t)(b_ * S_ + t_) * PW + PC_A1 + dir_ * 16 + hf_ * 8); } \
        _Pragma("unroll") for (int ii = 0; ii < 16; ++ii) { const int tau_ = chunk_ * 64 + 16 * tg + ii, t_ = dir_ ? (S_ - 1 - tau_) : tau_; \
            const bf16_t* prow_ = P + (size_t)(b_ * S_ + t_) * PW; qk[2 * ii] = prow_[PC_Q + h_ * 128 + d]; qk[2 * ii + 1] = prow_[PC_K + h_ * 128 + d]; } } while (0)
    GLA_PRE_LOADS(task);
    float wa[16]; float ba;
    { const int stream = task_base >> 8, dir = stream & 1, h = (stream >> 1) & 3;
#pragma unroll
      for (int r = 0; r < 16; ++r) wa[r] = a.in[I_WA2][(size_t)(dir * 16 + r) * 512 + h * 128 + d];
      ba = a.in[I_BA][dir * 512 + h * 128 + d]; }
    for (; task < task_base + 16; ++task) {
        if (tid < 128) *(LAS u32x4*)(lds + OFF_A1 + (tid >> 1) * 32 + (tid & 1) * 16) = a1v;
        __syncthreads();
        float wv[16]; float run = 0.f;
#pragma unroll
        for (int ii = 0; ii < 16; ++ii) { const int i = 16 * tg + ii;
            const u32x4 p0 = *(const LAS u32x4*)(lds + OFF_A1 + i * 32), p1 = *(const LAS u32x4*)(lds + OFF_A1 + i * 32 + 16);
            const unsigned pw[8] = {p0.x, p0.y, p0.z, p0.w, p1.x, p1.y, p1.z, p1.w};
            float z = ba;
#pragma unroll
            for (int r = 0; r < 8; ++r) z += bflo(pw[r]) * wa[2 * r] + bfhi(pw[r]) * wa[2 * r + 1];
            run += fast_logsigmoid(z) * (1.0f / 16.0f); wv[ii] = run; }
        tot[tg * 128 + d] = run;
        __syncthreads();
        float pre = 0.f, blast = 0.f;
#pragma unroll
        for (int q = 0; q < 4; ++q) { const float tq = tot[q * 128 + d]; blast += tq; pre += (q < tg) ? tq : 0.f; }
        if (tg == 0) BL[(size_t)task * 128 + d] = blast;
        unsigned kd[8];
#pragma unroll
        for (int ii = 0; ii < 16; ii += 2) { float kdv[2];
#pragma unroll
            for (int e = 0; e < 2; ++e) { const int i = 16 * tg + ii + e; const float bi = pre + wv[ii + e];
                const float qv = bf2f(qk[2 * (ii + e)]), kv = bf2f(qk[2 * (ii + e) + 1]);
                *(LAS unsigned short*)(lds + OFF_QS + i * QS + d * 2) = (unsigned short)f2bf(qv * 0.08838834764831845f * __expf(bi));
                *(LAS unsigned short*)(lds + OFF_KS + i * QS + d * 2) = (unsigned short)f2bf(kv * __expf(-bi));
                kdv[e] = kv * __expf(blast - bi); }
            kd[ii >> 1] = pk2(kdv[0], kdv[1]); }
        { bf16_t* kp = KDT + ((size_t)task * 128 + d) * 64 + 16 * tg;
          *(u32x4*)kp = (u32x4){kd[0], kd[1], kd[2], kd[3]}; *(u32x4*)(kp + 8) = (u32x4){kd[4], kd[5], kd[6], kd[7]}; }
        __syncthreads();
        { const int nt_ = task + 1; if (nt_ < task_base + 16) GLA_PRE_LOADS(nt_); }
#pragma unroll
        for (int q = 0; q < 2; ++q) { const int mt = w >> 1, nt = 2 * (w & 1) + q;
            f32x4 sacc = {0.f, 0.f, 0.f, 0.f};
#pragma unroll
            for (int ks = 0; ks < 4; ++ks) { const bf16x8 af = *(const LAS bf16x8*)(lds + OFF_QS + (16 * mt + l15) * QS + (32 * ks + 8 * g) * 2);
                const bf16x8 bf = *(const LAS bf16x8*)(lds + OFF_KS + (16 * nt + l15) * QS + (32 * ks + 8 * g) * 2);
                sacc = __builtin_amdgcn_mfma_f32_16x16x32_bf16(af, bf, sacc, 0, 0, 0); }
#pragma unroll
            for (int r = 0; r < 4; ++r) { const int i = 16 * mt + 4 * g + r, j = 16 * nt + l15;
                *(LAS unsigned short*)(lds + OFF_AS + i * JS + j * 2) = (unsigned short)f2bf(j <= i ? sacc[r] : 0.f); } }
        __syncthreads();
#pragma unroll
        for (int p = 0; p < 2; ++p) { const int pc = tid + 512 * p, row = pc >> 4, c16 = pc & 15;
            *(u32x4*)(QT + ((size_t)task * 64 + row) * 128 + c16 * 8) = *(const LAS u32x4*)(lds + OFF_QS + row * QS + c16 * 16); }
        { const int row = tid >> 3, c8 = tid & 7;
          *(u32x4*)(AS + ((size_t)task * 64 + row) * 64 + c8 * 8) = *(const LAS u32x4*)(lds + OFF_AS + row * JS + c8 * 16); }
    }
#undef GLA_PRE_LOADS
    __threadfence();
    __syncthreads();
}

__device__ __forceinline__ void gla_task_decode(int task, int& stream, int& eh, int& sg) {
    const int u = task & 255, i = task >> 8; stream = u >> 4; eh = i; sg = i ? 15 - (u & 15) : (u & 15);
}
__device__ __forceinline__ int gla_lidx(int stream, int eh, int sg) { return (stream * 2 + eh) * 16 + sg; }

#ifndef GLA_DEPTH_B
#define GLA_DEPTH_B 2
#endif
#ifndef GLA_DEPTH_A
#define GLA_DEPTH_A 2
#endif
template <bool PB>
__device__ void gla_scan_phase(const Args& a, ldsp_t lds) {
    const int tid = threadIdx.x, lane = tid & 63, w = tid >> 6, g = lane >> 4, l15 = lane & 15;
    const bf16_t* P = (const bf16_t*)(a.ws + WS_P);
    const bf16_t* QT = (const bf16_t*)(a.ws + WS_QT); const bf16_t* AS = (const bf16_t*)(a.ws + WS_AS); const bf16_t* KDT = (const bf16_t*)(a.ws + WS_KDT); const float* BL = (const float*)(a.ws + WS_BL);
    float* Lbuf = (float*)(a.ws + WS_L);
    float* DSEG = (float*)(a.ws + WS_DSEG);
    bf16_t* O = (bf16_t*)(a.ws + WS_O);
    constexpr int QS = 272, JS = 144;
    constexpr int OFF_QS = 0, OFF_AS = OFF_QS + 64 * QS, OFF_KDT = OFF_AS + 64 * JS, OFF_VT = OFF_KDT + 128 * JS, OFF_SB = OFF_VT + 128 * JS, OFF_OB = OFF_SB + 128 * QS,
                  OFF_DS = OFF_OB + 64 * QS, OFF_END = OFF_DS + 512;
    static_assert(OFF_END <= LDS_BYTES - 16, "GLA LDS");
    const int c16 = tid & 15, r32 = tid >> 4, c8 = tid & 7, r64 = tid >> 3;
    const unsigned ldsb = (unsigned)(size_t)lds;

    for (int it = 0; it < 2; ++it) {
        int stream, eh, sg;
        if (PB) gla_task_decode(blockIdx.x + 256 * it, stream, eh, sg);
        else { stream = blockIdx.x >> 4; sg = blockIdx.x & 15; eh = it; }
        const int dir = stream & 1, h = (stream >> 1) & 3, b = stream >> 3;
        f32x4 Sst[8];
#pragma unroll
        for (int mt = 0; mt < 8; ++mt) Sst[mt] = (f32x4){0.f, 0.f, 0.f, 0.f};
        if (PB) {
            for (int sp = 0; sp < sg; ++sp) {
                const float* Lp = Lbuf + (size_t)gla_lidx(stream, eh, sp) * 16384;
                const float* Dp = DSEG + (stream * 16 + sp) * 128;
#pragma unroll
                for (int mt = 0; mt < 8; ++mt) { const f32x4 dl = *(const f32x4*)(Dp + 16 * mt + 4 * g);
#pragma unroll
                    for (int r = 0; r < 4; ++r) Sst[mt][r] = Sst[mt][r] * __expf(dl[r]) + Lp[(mt * 4 + r) * 512 + tid]; }
            }
            __syncthreads();
#pragma unroll
            for (int mt = 0; mt < 8; ++mt) { u32x2 pw; pw.x = pk2(Sst[mt][0], Sst[mt][1]); pw.y = pk2(Sst[mt][2], Sst[mt][3]);
                *(LAS u32x2*)(lds + OFF_SB + (16 * w + l15) * QS + (16 * mt + 4 * g) * 2) = pw; }
        }
        float logD = 0.f;
        constexpr int DEPTH = PB ? GLA_DEPTH_B : GLA_DEPTH_A;
        u32x4 pk_[DEPTH][2], pv_[DEPTH][2], pq_[DEPTH][2], pa_[DEPTH]; float pbl[DEPTH];
#define GLA_SCAN_LOADS(SET, CI) do { const int ct_ = stream * 256 + sg * 16 + (CI); \
        _Pragma("unroll") for (int p_ = 0; p_ < 2; ++p_) { const int pc_ = tid + 512 * p_; \
            pk_[SET][p_] = *(const u32x4*)(KDT + ((size_t)ct_ * 128 + (pc_ >> 3)) * 64 + (pc_ & 7) * 8); \
            { const int j_ = pc_ >> 4, tau_ = (sg * 16 + (CI)) * 64 + j_, t_ = dir ? (S_ - 1 - tau_) : tau_; \
              pv_[SET][p_] = *(const u32x4*)(P + (size_t)(b * S_ + t_) * PW + PC_V + h * 256 + eh * 128 + (pc_ & 15) * 8); } \
            if (PB) pq_[SET][p_] = *(const u32x4*)(QT + ((size_t)ct_ * 64 + (pc_ >> 4)) * 128 + (pc_ & 15) * 8); } \
        if (PB) pa_[SET] = *(const u32x4*)(AS + ((size_t)ct_ * 64 + r64) * 64 + c8 * 8); \
        pbl[SET] = (tid < 128) ? BL[(size_t)ct_ * 128 + tid] : 0.f; } while (0)
#pragma unroll
        for (int s_ = 0; s_ < DEPTH; ++s_) GLA_SCAN_LOADS(s_, s_);
        for (int ci0 = 0; ci0 < 16; ci0 += DEPTH) {
#pragma unroll
          for (int s_ = 0; s_ < DEPTH; ++s_) {
            const int ci = ci0 + s_;
            if (ci >= 16) break;
            const int tau0 = (sg * 16 + ci) * 64;
#pragma unroll
            for (int p = 0; p < 2; ++p) { const int pc = tid + 512 * p;
                *(LAS u32x4*)(lds + OFF_KDT + (pc >> 3) * JS + (pc & 7) * 16) = pk_[s_][p];
                *(LAS u32x4*)(lds + OFF_VT + tr_off(pc >> 4, pc & 15)) = pv_[s_][p];
                if (PB) *(LAS u32x4*)(lds + OFF_QS + (pc >> 4) * QS + (pc & 15) * 16) = pq_[s_][p]; }
            if (PB) *(LAS u32x4*)(lds + OFF_AS + r64 * JS + c8 * 16) = pa_[s_];
            if (tid < 128) { *(LAS float*)(lds + OFF_DS + tid * 4) = __expf(pbl[s_]); logD += pbl[s_]; }
            __syncthreads();
            if (ci + DEPTH < 16) GLA_SCAN_LOADS(s_, ci + DEPTH);
            bf16x8 vfr[2];
            { u32x2 t0[2], t1[2];
              TR_FRAG_ISSUE(t0[0], t1[0], ldsb + OFF_VT, lane, w, 0); TR_FRAG_ISSUE(t0[1], t1[1], ldsb + OFF_VT, lane, w, 1);
              asm volatile("s_waitcnt lgkmcnt(0)" : "+v"(t0[0]), "+v"(t1[0]), "+v"(t0[1]), "+v"(t1[1]) :: "memory");
              vfr[0] = tr_join(t0[0], t1[0]); vfr[1] = tr_join(t0[1], t1[1]); }
            f32x4 oacc[4];
            if (PB) {
#pragma unroll
                for (int mt = 0; mt < 4; ++mt) oacc[mt] = (f32x4){0.f, 0.f, 0.f, 0.f};
                const unsigned qb = ldsb + OFF_QS + l15 * QS + g * 16, sbb = ldsb + OFF_SB + (16 * w + l15) * QS + g * 16;
#pragma unroll
                for (int ks = 0; ks < 4; ++ks) { bf16x8 sf, qf[4];
                    LDS_RD128_O(sf, sbb + ks * 64, 0); LDS_RD4(qf, qb + ks * 64, 16 * QS);
                    LDS_WAIT4(qf[0], qf[1], qf[2], qf[3]); asm volatile("" : "+v"(sf));
#pragma unroll
                    for (int mt = 0; mt < 4; ++mt) oacc[mt] = __builtin_amdgcn_mfma_f32_16x16x32_bf16(qf[mt], sf, oacc[mt], 0, 0, 0); }
                { const unsigned ab = ldsb + OFF_AS + l15 * JS + g * 16;
#pragma unroll
                  for (int ks = 0; ks < 2; ++ks) { bf16x8 af[4];
                      LDS_RD4(af, ab + ks * 64, 16 * JS);
                      LDS_WAIT4(af[0], af[1], af[2], af[3]);
#pragma unroll
                      for (int mt = 0; mt < 4; ++mt) oacc[mt] = __builtin_amdgcn_mfma_f32_16x16x32_bf16(af[mt], vfr[ks], oacc[mt], 0, 0, 0); } }
            }
#pragma unroll
            for (int mt = 0; mt < 8; ++mt) { const f32x4 dsc = *(const LAS f32x4*)(lds + OFF_DS + (16 * mt + 4 * g) * 4);
                Sst[mt] = Sst[mt] * dsc; }
            { const unsigned kb = ldsb + OFF_KDT + l15 * JS + g * 16;
#pragma unroll
              for (int ks = 0; ks < 2; ++ks) { bf16x8 kf[8];
                  LDS_RD8(kf, kb + ks * 64, 16 * JS);
                  LDS_WAIT8(kf[0], kf[1], kf[2], kf[3], kf[4], kf[5], kf[6], kf[7]);
#pragma unroll
                  for (int mt = 0; mt < 8; ++mt) Sst[mt] = __builtin_amdgcn_mfma_f32_16x16x32_bf16(kf[mt], vfr[ks], Sst[mt], 0, 0, 0); } }
            __syncthreads();
            if (PB) {
#pragma unroll
                for (int mt = 0; mt < 8; ++mt) { u32x2 pw; pw.x = pk2(Sst[mt][0], Sst[mt][1]); pw.y = pk2(Sst[mt][2], Sst[mt][3]);
                    *(LAS u32x2*)(lds + OFF_SB + (16 * w + l15) * QS + (16 * mt + 4 * g) * 2) = pw; }
#pragma unroll
                for (int mt = 0; mt < 4; ++mt)
#pragma unroll
                    for (int r = 0; r < 4; ++r) *(LAS unsigned short*)(lds + OFF_OB + (16 * mt + 4 * g + r) * QS + (16 * w + l15) * 2) = (unsigned short)f2bf(oacc[mt][r]);
                __syncthreads();
#pragma unroll
                for (int p = 0; p < 2; ++p) { const int pc = tid + 512 * p, i = pc >> 4, tau = tau0 + i, t = dir ? (S_ - 1 - tau) : tau;
                    *(u32x4*)(O + ((size_t)dir * T_ + (size_t)(b * S_ + t)) * 1024 + h * 256 + eh * 128 + (pc & 15) * 8) = *(const LAS u32x4*)(lds + OFF_OB + i * QS + (pc & 15) * 16); }
            }
          }
        }
#undef GLA_SCAN_LOADS
        if (!PB) {
            float* Lp = Lbuf + (size_t)gla_lidx(stream, eh, sg) * 16384;
#pragma unroll
            for (int mt = 0; mt < 8; ++mt)
#pragma unroll
                for (int r = 0; r < 4; ++r) Lp[(mt * 4 + r) * 512 + tid] = Sst[mt][r];
            if (tid < 128 && eh == 0) DSEG[(stream * 16 + sg) * 128 + tid] = logD;
        }
        __syncthreads();
    }
}

__device__ void gla_post_phase(const Args& a) {
    const int lane = threadIdx.x & 63, wave = threadIdx.x >> 6, W = gridDim.x * 8;
    const bf16_t* O = (const bf16_t*)(a.ws + WS_O);
    const bf16_t* P = (const bf16_t*)(a.ws + WS_P);
    bf16_t* GO = (bf16_t*)(a.ws + WS_XN);
    const float* ng = a.in[I_GNG];
    for (int row = blockIdx.x * 8 + wave; row < T_; row += W) {
        const int e0 = lane * 16;
        float v[16]; float ss = 0.f;
#pragma unroll
        for (int q = 0; q < 2; ++q) { const u32x4 f = *(const u32x4*)(O + (size_t)row * 1024 + e0 + 8 * q), bk = *(const u32x4*)(O + ((size_t)T_ + row) * 1024 + e0 + 8 * q);
            const unsigned fw[4] = {f.x, f.y, f.z, f.w}, bw[4] = {bk.x, bk.y, bk.z, bk.w};
#pragma unroll
            for (int j = 0; j < 4; ++j) { v[8 * q + 2 * j] = bflo(fw[j]) + bflo(bw[j]); v[8 * q + 2 * j + 1] = bfhi(fw[j]) + bfhi(bw[j]); } }
#pragma unroll
        for (int j = 0; j < 16; ++j) ss += v[j] * v[j];
#pragma unroll
        for (int o = 8; o >= 1; o >>= 1) ss += __shfl_xor(ss, o);
        const float rstd = rsqrtf(ss * (1.0f / 256.0f) + EPS);
        unsigned ow[8];
#pragma unroll
        for (int q = 0; q < 2; ++q) { const u32x4 rr = *(const u32x4*)(P + (size_t)row * PW + PC_R + e0 + 8 * q); const unsigned rw[4] = {rr.x, rr.y, rr.z, rr.w};
#pragma unroll
            for (int j = 0; j < 4; ++j) { const int e = (e0 + 8 * q + 2 * j) & 255;
                const float r0 = bflo(rw[j]), r1 = bfhi(rw[j]);
                const float y0 = v[8 * q + 2 * j] * rstd * ng[e] * (r0 * sigmoidf_(r0)), y1 = v[8 * q + 2 * j + 1] * rstd * ng[e + 1] * (r1 * sigmoidf_(r1));
                ow[4 * q + j] = pk2(y0, y1); } }
        *(u32x4*)(GO + (size_t)row * 1024 + e0) = (u32x4){ow[0], ow[1], ow[2], ow[3]};
        *(u32x4*)(GO + (size_t)row * 1024 + e0 + 8) = (u32x4){ow[4], ow[5], ow[6], ow[7]};
    }
}

__device__ __forceinline__ unsigned f2ord(float f) { const unsigned u = __float_as_uint(f); return (u & 0x80000000u) ? ~u : (u | 0x80000000u); }
__device__ __forceinline__ float ord2f(unsigned o) { return __uint_as_float((o & 0x80000000u) ? (o & 0x7fffffffu) : ~o); }
#define CE_DESC(x, y) do { const unsigned _hi = max((x), (y)), _lo = min((x), (y)); (x) = _hi; (y) = _lo; } while (0)
#define CE_ASC(x, y) do { const unsigned _hi = max((x), (y)), _lo = min((x), (y)); (x) = _lo; (y) = _hi; } while (0)
template <int N> __device__ __forceinline__ void bitonic_sort_desc(unsigned (&k)[N]) {
#pragma unroll
    for (int sz = 2; sz <= N; sz <<= 1)
#pragma unroll
        for (int j = sz >> 1; j > 0; j >>= 1)
#pragma unroll
            for (int i = 0; i < N; ++i) { const int l = i ^ j; if (l > i) { if ((i & sz) == 0) CE_DESC(k[i], k[l]); else CE_ASC(k[i], k[l]); } }
}
template <int N> __device__ __forceinline__ void bitonic_merge_desc(unsigned (&k)[N]) {
#pragma unroll
    for (int j = N >> 1; j > 0; j >>= 1)
#pragma unroll
        for (int i = 0; i < N; ++i) { const int l = i ^ j; if (l > i) CE_DESC(k[i], k[l]); }
}
#define CE2_DESC(kx, px, ky, py) do { const bool _sw = (ky) > (kx); const unsigned _k0 = _sw ? (ky) : (kx), _k1 = _sw ? (kx) : (ky), _p0 = _sw ? (py) : (px), _p1 = _sw ? (px) : (py); \
        (kx) = _k0; (ky) = _k1; (px) = _p0; (py) = _p1; } while (0)
template <int N> __device__ __forceinline__ void bitonic_sort_desc2(unsigned (&k)[N], unsigned (&p)[N]) {
#pragma unroll
    for (int sz = 2; sz <= N; sz <<= 1)
#pragma unroll
        for (int j = sz >> 1; j > 0; j >>= 1)
#pragma unroll
            for (int i = 0; i < N; ++i) { const int l = i ^ j; if (l > i) { if ((i & sz) == 0) CE2_DESC(k[i], p[i], k[l], p[l]); else CE2_DESC(k[l], p[l], k[i], p[i]); } }
}
template <int N> __device__ __forceinline__ void bitonic_merge_desc2(unsigned (&k)[N], unsigned (&p)[N]) {
#pragma unroll
    for (int j = N >> 1; j > 0; j >>= 1)
#pragma unroll
        for (int i = 0; i < N; ++i) { const int l = i ^ j; if (l > i) CE2_DESC(k[i], p[i], k[l], p[l]); }
}
__device__ __forceinline__ void lane_merge16(unsigned (&k)[16], int xm) {
    unsigned o[16];
#pragma unroll
    for (int i = 0; i < 16; ++i) o[i] = (unsigned)__shfl_xor((int)k[i], xm);
#pragma unroll
    for (int i = 0; i < 16; ++i) k[i] = max(k[i], o[15 - i]);
    bitonic_merge_desc<16>(k);
}
__device__ __forceinline__ void lane_merge16_2(unsigned (&k)[16], unsigned (&p)[16], int xm) {
    unsigned ok[16], op[16];
#pragma unroll
    for (int i = 0; i < 16; ++i) { ok[i] = (unsigned)__shfl_xor((int)k[i], xm); op[i] = (unsigned)__shfl_xor((int)p[i], xm); }
#pragma unroll
    for (int i = 0; i < 16; ++i) { const bool sw = ok[15 - i] > k[i]; k[i] = sw ? ok[15 - i] : k[i]; p[i] = sw ? op[15 - i] : p[i]; }
    bitonic_merge_desc2<16>(k, p);
}

__device__ void peer_select_phase(const Args& a, ldsp_t lds) {
    const int tid = threadIdx.x, lane = tid & 63, wave = tid >> 6, g = lane >> 4, l15 = lane & 15, W = gridDim.x * 8;
    const bf16_t* QP = (const bf16_t*)(a.ws + WS_QP);
    const bf16_t* KB = (const bf16_t*)(a.ws + WS_KEYS);
    int* IDX = (int*)(a.ws + WS_IDX); float* GW = (float*)(a.ws + WS_G);
    constexpr int KS = 272, OFF_TL = 2 * 128 * KS;
    static_assert(OFF_TL + 8 * 8192 <= LDS_BYTES - 16, "select LDS");
    const unsigned ldsb = (unsigned)(size_t)lds;
    LAS unsigned* tl = (LAS unsigned*)(lds + OFF_TL + wave * 8192);
    for (int h = 0; h < 8; ++h) {
        __syncthreads();
#pragma unroll
        for (int p = 0; p < 8; ++p) { const int pc = tid + 512 * p, row = pc >> 4, c16 = pc & 15;
            *(LAS u32x4*)(lds + row * KS + c16 * 16) = *(const u32x4*)(KB + (size_t)(h * 256 + row) * 128 + c16 * 8); }
        __syncthreads();
      for (int grp = blockIdx.x * 8 + wave; grp < 2048; grp += W) {
        const int tok0 = grp * 16, tok = tok0 + l15;
        bf16x8 bq[2][4];
#pragma unroll
        for (int hf = 0; hf < 2; ++hf)
#pragma unroll
            for (int ks = 0; ks < 4; ++ks) bq[hf][ks] = *(const bf16x8*)(QP + (size_t)tok * 2048 + h * 256 + hf * 128 + 32 * ks + 8 * g);
#pragma unroll 1
        for (int hf = 0; hf < 2; ++hf) {
            f32x4 acc[8];
#pragma unroll
            for (int mt = 0; mt < 8; ++mt) acc[mt] = (f32x4){0.f, 0.f, 0.f, 0.f};
            const unsigned kbase = ldsb + (unsigned)((hf * 128 + l15) * KS + g * 16);
#pragma unroll
            for (int ks = 0; ks < 4; ++ks) { bf16x8 af[8];
                LDS_RD8(af, kbase + ks * 64, 16 * KS);
                LDS_WAIT8(af[0], af[1], af[2], af[3], af[4], af[5], af[6], af[7]);
                const bf16x8 bfr = hf ? bq[1][ks] : bq[0][ks];
#pragma unroll
                for (int mt = 0; mt < 8; ++mt) acc[mt] = __builtin_amdgcn_mfma_f32_16x16x32_bf16(af[mt], bfr, acc[mt], 0, 0, 0); }
            unsigned key[32];
#pragma unroll
            for (int mt = 0; mt < 8; ++mt)
#pragma unroll
                for (int r = 0; r < 4; ++r) { const int n = 16 * mt + 4 * g + r; key[4 * mt + r] = (f2ord(acc[mt][r]) & ~127u) | (unsigned)(127 - n); }
            unsigned lo[16], hi[16];
#pragma unroll
            for (int i = 0; i < 16; ++i) { lo[i] = key[i]; hi[i] = key[16 + i]; }
            bitonic_sort_desc<16>(lo); bitonic_sort_desc<16>(hi);
#pragma unroll
            for (int i = 0; i < 16; ++i) lo[i] = max(lo[i], hi[15 - i]);
            bitonic_merge_desc<16>(lo);
            lane_merge16(lo, 16); lane_merge16(lo, 32);
#pragma unroll
            for (int i = 0; i < 16; ++i) tl[(hf * 16 + i) * 64 + lane] = lo[i];
        }
        unsigned top[2][16];
#pragma unroll
        for (int i = 0; i < 16; ++i) { top[0][i] = tl[i * 64 + lane]; top[1][i] = tl[(16 + i) * 64 + lane]; }
        unsigned ck[16], cp[16];
#pragma unroll
        for (int i = 0; i < 16; ++i) { ck[i] = 0u; cp[i] = 0u; }
#define PEER_CAND(slot, I, J) do { const float _s = ord2f(top[0][I] & ~127u) + ord2f(top[1][J] & ~127u); ck[slot] = f2ord(_s); cp[slot] = ((127u - (top[0][I] & 127u)) << 7) | (127u - (top[1][J] & 127u)); } while (0)
        if (g == 0) { PEER_CAND(0, 0, 0); PEER_CAND(1, 0, 1); PEER_CAND(2, 0, 2); PEER_CAND(3, 0, 3); PEER_CAND(4, 0, 4); PEER_CAND(5, 0, 5); PEER_CAND(6, 0, 6); PEER_CAND(7, 0, 7);
            PEER_CAND(8, 0, 8); PEER_CAND(9, 0, 9); PEER_CAND(10, 0, 10); PEER_CAND(11, 0, 11); PEER_CAND(12, 0, 12); PEER_CAND(13, 0, 13); PEER_CAND(14, 0, 14); PEER_CAND(15, 0, 15); }
        else if (g == 1) { PEER_CAND(0, 1, 0); PEER_CAND(1, 1, 1); PEER_CAND(2, 1, 2); PEER_CAND(3, 1, 3); PEER_CAND(4, 1, 4); PEER_CAND(5, 1, 5); PEER_CAND(6, 1, 6); PEER_CAND(7, 1, 7);
            PEER_CAND(8, 2, 0); PEER_CAND(9, 2, 1); PEER_CAND(10, 2, 2); PEER_CAND(11, 2, 3); PEER_CAND(12, 2, 4); PEER_CAND(13, 3, 0); PEER_CAND(14, 3, 1); PEER_CAND(15, 3, 2); }
        else if (g == 2) { PEER_CAND(0, 3, 3); PEER_CAND(1, 4, 0); PEER_CAND(2, 4, 1); PEER_CAND(3, 4, 2); PEER_CAND(4, 5, 0); PEER_CAND(5, 5, 1); PEER_CAND(6, 6, 0); PEER_CAND(7, 6, 1);
            PEER_CAND(8, 7, 0); PEER_CAND(9, 7, 1); PEER_CAND(10, 8, 0); PEER_CAND(11, 9, 0); PEER_CAND(12, 10, 0); PEER_CAND(13, 11, 0); PEER_CAND(14, 12, 0); PEER_CAND(15, 13, 0); }
        else { PEER_CAND(0, 14, 0); PEER_CAND(1, 15, 0); }
#undef PEER_CAND
        bitonic_sort_desc2<16>(ck, cp);
        lane_merge16_2(ck, cp, 16); lane_merge16_2(ck, cp, 32);
        float ev[16]; float sum = 0.f; const float mx = ord2f(ck[0]);
#pragma unroll
        for (int i = 0; i < 16; ++i) { ev[i] = __expf(ord2f(ck[i]) - mx); sum += ev[i]; }
        const float inv = 1.0f / sum;
#pragma unroll
        for (int i = 0; i < 16; ++i) if ((i >> 2) == g) { IDX[(size_t)tok * 128 + h * 16 + i] = (int)cp[i]; GW[(size_t)tok * 128 + h * 16 + i] = ev[i] * inv; }
      }
    }
}

typedef float f32x16 __attribute__((ext_vector_type(16)));
typedef float f32x32 __attribute__((ext_vector_type(32)));
typedef unsigned u32x6 __attribute__((ext_vector_type(6)));
constexpr float U_SCALE = 48.0f, V_SCALE = 2.5f;
constexpr int ROW6 = 1536;
__device__ void cvt_rows_fp6(const float* src, unsigned char* dst, int nrows, float scale) {
    const size_t gt = (size_t)blockIdx.x * 512 + threadIdx.x, gs = (size_t)gridDim.x * 512;
    for (size_t idx = gt; idx < (size_t)nrows * 64; idx += gs) {
        const size_t row = idx >> 6; const int l = (int)(idx & 63);
        const float* sp = src + row * 2048 + 32 * l;
        f32x16 a, b;
#pragma unroll
        for (int q = 0; q < 8; ++q) { const f32x4 vv = *(const f32x4*)(sp + 4 * q);
            a[2 * q] = fminf(fmaxf(vv[0] * scale, -7.5f), 7.5f); b[2 * q] = fminf(fmaxf(vv[1] * scale, -7.5f), 7.5f);
            a[2 * q + 1] = fminf(fmaxf(vv[2] * scale, -7.5f), 7.5f); b[2 * q + 1] = fminf(fmaxf(vv[3] * scale, -7.5f), 7.5f); }
        const u32x6 pk = __builtin_amdgcn_cvt_scalef32_2xpk16_fp6_f32(a, b, 1.0f);
        unsigned char* dp = dst + row * ROW6;
        *(u32x4*)(dp + 16 * l) = (u32x4){pk[0], pk[1], pk[2], pk[3]};
        *(u32x2*)(dp + 1024 + 8 * l) = (u32x2){pk[4], pk[5]};
    }
}
__device__ __forceinline__ float gelu_erf(float x) { return 0.5f * x * (1.0f + erff(x * 0.70710678118654752f)); }
template <bool DRY> __device__ void peer_gather_phase(const Args& a) {
    const int lane = threadIdx.x & 63, wave = threadIdx.x >> 6, W = gridDim.x * 8;
    const bf16_t* XN = (const bf16_t*)(a.ws + WS_XN);
    const unsigned char* UB = a.ws + WS_UB;
    const unsigned char* VB = a.ws + WS_VB;
    const int* IDX = (const int*)(a.ws + WS_IDX); const float* GW = (const float*)(a.ws + WS_G);
    const float* mod = (const float*)(a.ws + WS_MOD);
    const float* fg = a.in[I_FNG];
    float* H = a.out;
    for (int tok = blockIdx.x * 8 + wave; tok < T_; tok += W) {
        float xf[32];
#pragma unroll
        for (int q = 0; q < 4; ++q) { const u32x4 xv = *(const u32x4*)(XN + (size_t)tok * 2048 + 32 * lane + 8 * q); const unsigned xs[4] = {xv.x, xv.y, xv.z, xv.w};
#pragma unroll
            for (int j = 0; j < 4; ++j) { xf[8 * q + 2 * j] = bflo(xs[j]); xf[8 * q + 2 * j + 1] = bfhi(xs[j]); } }
        const int id0 = IDX[(size_t)tok * 128 + lane], id1 = IDX[(size_t)tok * 128 + 64 + lane];
        const float g0 = GW[(size_t)tok * 128 + lane], g1 = GW[(size_t)tok * 128 + 64 + lane];
        float o[32];
#pragma unroll
        for (int j = 0; j < 32; ++j) o[j] = 0.f;
        for (int kk = 0; kk < 128; kk += 4) {
            int ex[4]; float gw[4];
#pragma unroll
            for (int e = 0; e < 4; ++e) { const int k = kk + e;
                ex[e] = (k < 64) ? __builtin_amdgcn_readlane(id0, k & 63) : __builtin_amdgcn_readlane(id1, k & 63);
                gw[e] = (k < 64) ? __uint_as_float(__builtin_amdgcn_readlane(__float_as_uint(g0), k & 63)) : __uint_as_float(__builtin_amdgcn_readlane(__float_as_uint(g1), k & 63)); }
            u32x4 ua[4], va[4]; u32x2 ub[4], vb[4];
#pragma unroll
            for (int e = 0; e < 4; ++e) { const unsigned char* up = UB + (size_t)ex[e] * ROW6; ua[e] = *(const u32x4*)(up + 16 * lane); ub[e] = *(const u32x2*)(up + 1024 + 8 * lane); }
#pragma unroll
            for (int e = 0; e < 4; ++e) { const unsigned char* vp = VB + (size_t)ex[e] * ROW6; va[e] = *(const u32x4*)(vp + 16 * lane); vb[e] = *(const u32x2*)(vp + 1024 + 8 * lane); }
            float dt[4];
#pragma unroll
            for (int e = 0; e < 4; ++e) { const u32x6 pk = {ua[e].x, ua[e].y, ua[e].z, ua[e].w, ub[e].x, ub[e].y};
                const f32x32 uf = __builtin_amdgcn_cvt_scalef32_pk32_f32_fp6(pk, 1.0f);
                float s = 0.f;
#pragma unroll
                for (int j = 0; j < 32; ++j) s += uf[j] * xf[j];
                dt[e] = s; }
#pragma unroll
            for (int off = 32; off >= 1; off >>= 1)
#pragma unroll
                for (int e = 0; e < 4; ++e) dt[e] += __shfl_xor(dt[e], off);
#pragma unroll
            for (int e = 0; e < 4; ++e) { const float cf = gw[e] * gelu_erf(dt[e] * (1.0f / U_SCALE)) * (1.0f / V_SCALE);
                const u32x6 pk = {va[e].x, va[e].y, va[e].z, va[e].w, vb[e].x, vb[e].y};
                const f32x32 vf = __builtin_amdgcn_cvt_scalef32_pk32_f32_fp6(pk, 1.0f);
#pragma unroll
                for (int j = 0; j < 32; ++j) o[j] += cf * vf[j]; }
        }
        const int b = tok >> 14; float ss = 0.f;
#pragma unroll
        for (int q = 0; q < 8; ++q) { const int d0 = 32 * lane + 4 * q;
            const f32x4 h0 = *(const f32x4*)(H + (size_t)tok * 2048 + d0), q0 = *(const f32x4*)(mod + b * 12288 + 5 * 2048 + d0);
#pragma unroll
            for (int j = 0; j < 4; ++j) { const float hv = h0[j] + q0[j] * o[4 * q + j]; o[4 * q + j] = hv; ss += hv * hv; } }
        ss = wave_sum(ss);
        const float rstd = rsqrtf(ss * (1.0f / 2048.0f) + EPS);
#pragma unroll
        for (int q = 0; q < 8; ++q) { const int d0 = 32 * lane + 4 * q;
            const f32x4 f0 = *(const f32x4*)(fg + d0); f32x4 r0;
#pragma unroll
            for (int j = 0; j < 4; ++j) r0[j] = o[4 * q + j] * rstd * f0[j];
            if (!DRY || rstd < 0.f) *(f32x4*)(H + (size_t)tok * 2048 + d0) = r0; }
    }
}

__global__ void __launch_bounds__(512, 2) mega(Args a) {
    extern __shared__ __attribute__((aligned(16))) unsigned char lds_raw[];
    ldsp_t lds = (ldsp_t)lds_raw;
    cg::grid_group grid = cg::this_grid();
    const int lo = a.ph_lo, hi = a.ph_hi;
    unsigned char* ws = a.ws;
    const float* mod = (const float*)(ws + WS_MOD);
#ifdef ONLY_PHASE
#define IN(k) ((k) == ONLY_PHASE && lo <= (k) && (k) < hi)
#else
#define IN(k) (lo <= (k) && (k) < hi)
#endif
    volatile LAS unsigned* bst = (volatile LAS unsigned*)(lds + LDS_BYTES - 16);
    if (threadIdx.x == 0) { bst[0] = 0u; bst[1] = 0u; }
    __syncthreads();
    XcdBarrier xbar = xcd_barrier_post((unsigned*)(ws + WS_CTL) + a.li * XCD_BAR_WORDS, bst);
#define SEAM(k) do { if (IN(k) && IN((k) + 1)) { if ((k) == 0) grid.sync(); else xcd_barrier(xbar); } } while (0)
#ifndef DUP_PHASE
#define DUP_PHASE (-1)
#endif
#define REP(k)

    if (IN(0)) phase0(a, lds);
    SEAM(0);
    if (IN(1)) norm_phase(a.in[I_X], a.in[I_N1G], mod, mod + 2048, (bf16_t*)(ws + WS_XN));
    SEAM(1);
    if (IN(2)) {
        pg8::Gemm g{(const bf16_t*)(ws + WS_XN), (const bf16_t*)(ws + WS_WIN), T_, PW, 2048, 2048};
        pg8::StaticOrder S; S.init(T_, PW, gridDim.x, blockIdx.x);
        pg8::EpiIn E{(bf16_t*)(ws + WS_P)};
        pg8::gemm_phase(lds, g, S, E);
    }
    SEAM(2);
    if (IN(3)) { fft1_phase(a, lds); __syncthreads(); }
    if (IN(4)) gla_pre_phase(a, lds);
    if (IN(5)) gla_scan_phase<false>(a, lds);
    SEAM(5);
    if (IN(6)) { fft2_phase(a, lds); __syncthreads(); }
    if (IN(7)) gla_scan_phase<true>(a, lds);
    SEAM(7);
    if (IN(8)) gla_post_phase(a);
    SEAM(8);
    if (IN(9)) {
        {
            pg8::Gemm g{(const bf16_t*)a.out + (size_t)T_ * 2048, (const bf16_t*)(ws + WS_WFN), T_, 2048, 2048, 2048};
            pg8::StaticOrder S; S.init(T_, 2048, gridDim.x, blockIdx.x);
            pg8::EpiGate<0> E{(bf16_t*)(ws + WS_O), 2048, (const bf16_t*)(ws + WS_P) + PC_GF, PW};
            pg8::gemm_phase(lds, g, S, E);
        }
        {
            pg8::Gemm g{(const bf16_t*)(ws + WS_XN), (const bf16_t*)(ws + WS_WGLA), T_, 2048, 1024, 1024};
            pg8::StaticOrder S; S.init(T_, 2048, gridDim.x, blockIdx.x);
            pg8::EpiGate<1> E{(bf16_t*)(ws + WS_O), 2048, (const bf16_t*)(ws + WS_P) + PC_GG, PW};
            pg8::gemm_phase(lds, g, S, E);
        }
    }
    SEAM(9);
    if (IN(10)) {
        pg8::Gemm g{(const bf16_t*)(ws + WS_O), (const bf16_t*)(ws + WS_WOUT), T_, 2048, 2048, 2048};
        pg8::StaticOrder S; S.init(T_, 2048, gridDim.x, blockIdx.x);
        pg8::EpiRes E{a.in[I_X], mod + 2 * 2048, a.out};
        pg8::gemm_phase(lds, g, S, E);
    }
    SEAM(10);
    if (IN(11)) {
        norm_phase(a.out, a.in[I_N2G], mod + 3 * 2048, mod + 4 * 2048, (bf16_t*)(ws + WS_XN));
        cvt_rows_fp6(a.in[I_U], ws + WS_UB, 16384, U_SCALE);
        cvt_rows_fp6(a.in[I_V], ws + WS_VB, 16384, V_SCALE);
    }
    SEAM(11);
    if (IN(12)) {
        pg8::Gemm g{(const bf16_t*)(ws + WS_XN), (const bf16_t*)(ws + WS_WQ), T_, 2048, 2048, 2048};
        pg8::StaticOrder S; S.init(T_, 2048, gridDim.x, blockIdx.x);
        pg8::EpiGate<2> E{(bf16_t*)(ws + WS_QP), 2048, nullptr, 0};
        pg8::gemm_phase(lds, g, S, E);
    }
    SEAM(12);
    if (IN(13)) peer_select_phase(a, lds);
    SEAM(13);
    if (IN(14)) peer_gather_phase<false>(a);
    if (IN(15)) peer_gather_phase<true>(a);
#ifdef PROBE_GEMM
    if (IN(16)) {
        pg8::Gemm g{(const bf16_t*)(ws + WS_XN), (const bf16_t*)(ws + WS_WQ), T_, 2048, 2048, 2048};
        pg8::StaticOrder S; S.init(T_, 2048, gridDim.x, blockIdx.x);
        pg8::EpiNull E{(float*)(ws + WS_CTL + 32768)};
        pg8::gemm_phase(lds, g, S, E);
    }
#endif
#undef IN
#undef SEAM
}

constexpr int N_PHASES = 15;

extern "C" void kernel_launch(void* const* d_in, const int* in_sizes, int n_in, void* d_out, int out_size, void* d_ws, size_t ws_size, hipStream_t stream) {
    static int grid = 0;
    if (grid == 0) {
        int dev = 0, cus = 0, per_cu = 0;
        (void)hipGetDevice(&dev);
        (void)hipDeviceGetAttribute(&cus, hipDeviceAttributeMultiprocessorCount, dev);
        (void)hipFuncSetAttribute((const void*)mega, hipFuncAttributeMaxDynamicSharedMemorySize, LDS_BYTES);
        (void)hipOccupancyMaxActiveBlocksPerMultiprocessor(&per_cu, (const void*)mega, 512, LDS_BYTES);
        if (per_cu < 1 || n_in != 18 || ws_size < WS_END2 || cus != 256) { fprintf(stderr, "kernel_launch: unexpected configuration (per_cu %d, n_in %d, ws %zu)\n", per_cu, n_in, ws_size); grid = -1; return; }
        grid = cus;
    }
    if (grid < 0) return;
    (void)hipMemsetAsync((char*)d_ws + WS_CTL, 0, 4 * XCD_BAR_WORDS * 4, stream);
    Args a{};
    for (int i = 0; i < 18; ++i) a.in[i] = (const float*)d_in[i];
    a.out = (float*)d_out; a.ws = (unsigned char*)d_ws; a.li = 0; a.pad = 0;
#if DUP_PHASE >= 0
#if DUP_PHASE == 116
    const int lo_[3] = {0, 16, 13}, hi_[3] = {13, 17, N_PHASES};
#else
    const int lo_[3] = {0, DUP_PHASE == 14 ? 15 : DUP_PHASE, DUP_PHASE == 14 ? 14 : DUP_PHASE + 1}, hi_[3] = {DUP_PHASE == 14 ? 14 : DUP_PHASE + 1, DUP_PHASE == 14 ? 16 : DUP_PHASE + 1, N_PHASES};
#endif
    for (int li = 0; li < 3; ++li) { a.ph_lo = lo_[li]; a.ph_hi = hi_[li]; a.li = li;
        if (DUP_PHASE == 100 && li == 1) continue;
        if (a.ph_lo >= a.ph_hi) continue;
        void* args[] = {&a};
        hipError_t e = hipLaunchCooperativeKernel((void*)mega, dim3(grid), dim3(512), args, LDS_BYTES, stream);
        if (e != hipSuccess) fprintf(stderr, "launch %d failed: %s\n", li, hipGetErrorString(e)); }
#else
    a.ph_lo = 0; a.ph_hi = N_PHASES;
    void* args[] = {&a};
    hipError_t e = hipLaunchCooperativeKernel((void*)mega, dim3(grid), dim3(512), args, LDS_BYTES, stream);
    if (e != hipSuccess) fprintf(stderr, "cooperative launch failed: %s (grid %d)\n", hipGetErrorString(e), grid);
#endif
}
```

```cpp
#include <hip/hip_runtime.h>
#include <hip/hip_cooperative_groups.h>
#include <cstdio>
namespace cg = cooperative_groups;

#define LAS __attribute__((address_space(3)))
typedef unsigned short bf16_t;
typedef short bf16x8 __attribute__((ext_vector_type(8)));
typedef float f32x4 __attribute__((ext_vector_type(4)));
typedef float f32x2 __attribute__((ext_vector_type(2)));
typedef unsigned u32x4 __attribute__((ext_vector_type(4)));
typedef unsigned u32x2 __attribute__((ext_vector_type(2)));
typedef LAS unsigned char* ldsp_t;

#ifndef N_PHASE_LAUNCH
#define N_PHASE_LAUNCH 0
#endif

constexpr int T_ = 32768, D_ = 2048, S_ = 16384;
constexpr float EPS = 1e-6f;
constexpr int PW = 8448;
constexpr int PC_Z = 0, PC_Q = 1024, PC_K = 1536, PC_V = 2048, PC_R = 3072, PC_GF = 4096, PC_GG = 6144, PC_A1 = 8192;
constexpr int LDS_BYTES = 147456;

constexpr size_t WS_CTL  = 0;
constexpr size_t WS_MOD  = 65536;
constexpr size_t WS_TW   = WS_MOD + 98304;
constexpr size_t WS_F1   = WS_TW + 131072;
constexpr size_t WS_F2   = WS_F1 + 65536;
constexpr size_t WS_DSEG = WS_F2 + 131072;
constexpr size_t WS_WIN  = WS_DSEG + 131072;
constexpr size_t WS_WFN  = WS_WIN + (size_t)8448 * 2048 * 2;
constexpr size_t WS_WGLA = WS_WFN + (size_t)2048 * 2048 * 2;
constexpr size_t WS_WOUT = WS_WGLA + (size_t)2048 * 1024 * 2;
constexpr size_t WS_WQ   = WS_WOUT + (size_t)2048 * 2048 * 2;
constexpr size_t WS_KEYS = WS_WQ + (size_t)2048 * 2048 * 2;
constexpr size_t WS_L    = WS_KEYS + (size_t)8 * 2 * 128 * 128 * 2;
constexpr size_t WS_XN   = WS_L + (size_t)512 * 16384 * 4;
constexpr size_t WS_O    = WS_XN + (size_t)T_ * 2048 * 2;
constexpr size_t WS_P    = WS_O + (size_t)T_ * 2048 * 2;
constexpr size_t WS_QP   = WS_P;
constexpr size_t WS_IDX  = WS_QP + (size_t)T_ * 2048 * 2;
constexpr size_t WS_G    = WS_IDX + (size_t)T_ * 128 * 4;
constexpr size_t WS_UB   = WS_G + (size_t)T_ * 128 * 4;
constexpr size_t WS_VB   = WS_UB + (size_t)16384 * 2048 * 2;
constexpr size_t WS_END  = WS_P + (size_t)T_ * PW * 2;
static_assert(WS_VB + (size_t)16384 * 2048 * 2 <= WS_END, "late buffers must fit in the P region");
static_assert(WS_END <= (size_t)1000 * 1000 * 1000, "workspace budget");

struct Args { const float* in[18]; float* out; unsigned char* ws; int ph_lo, ph_hi, li, pad; };
enum { I_X = 0, I_C, I_WADA, I_BADA, I_N1G, I_WIN, I_WFNET, I_WA2, I_BA, I_GNG, I_WGLA, I_WOUT, I_N2G, I_WQ, I_KEYS, I_U, I_V, I_FNG };

typedef __bf16 hwbf16x2 __attribute__((ext_vector_type(2)));
__device__ __forceinline__ unsigned f2bf(float f) { const __bf16 b = (__bf16)f; return (unsigned)__builtin_bit_cast(unsigned short, b); }
__device__ __forceinline__ float bf2f(unsigned h) { return __uint_as_float(h << 16); }
__device__ __forceinline__ unsigned pk2(float lo, float hi) { const f32x2 v = {lo, hi}; const hwbf16x2 b = __builtin_convertvector(v, hwbf16x2); return __builtin_bit_cast(unsigned, b); }
__device__ __forceinline__ float bflo(unsigned w) { return __uint_as_float(w << 16); }
__device__ __forceinline__ float bfhi(unsigned w) { return __uint_as_float(w & 0xffff0000u); }
__device__ __forceinline__ int lane_hw() { int l; asm volatile("v_mbcnt_lo_u32_b32 %0, -1, 0\n\tv_mbcnt_hi_u32_b32 %0, -1, %0" : "=v"(l)); return l; }
#define TID_A(a) ((((a).pad) << 6) | lane_hw())
constexpr float WIN8_SCALE = 32.0f;
constexpr size_t WS_WIN8 = (WS_END + (size_t)4096 * 128 * 64 * 2 + (size_t)4096 * 128 * 4 + 255) & ~(size_t)255;
constexpr size_t WS_END3 = WS_WIN8 + (size_t)8448 * 2048;
constexpr size_t WS_HB   = WS_END;
constexpr size_t WS_END4 = (WS_HB + (size_t)T_ * 2048 * 2) > WS_END3 ? (WS_HB + (size_t)T_ * 2048 * 2) : WS_END3;
static_assert(WS_END4 <= (size_t)1073741824, "workspace budget");
#ifndef F8_MASK
#define F8_MASK 0xFFFFFFFFu
#endif
__device__ __forceinline__ bool in_f8(int ct) { return ct < 32 && ((F8_MASK >> ct) & 1u); }
#ifndef F8_FNET
#define F8_FNET 1
#endif
constexpr float ZA8_SCALE = 1.0f / 256.0f, WFN8_SCALE = 4096.0f;
#ifndef F8_GLA
#define F8_GLA 1
#endif
#ifndef F8_OUT
#define F8_OUT 1
#endif
__device__ __forceinline__ unsigned fp8_byte(float v) { v = fminf(fmaxf(v, -448.0f), 448.0f); return (unsigned)__builtin_amdgcn_cvt_pk_fp8_f32(v, v, 0, false) & 0xFFu; }
__device__ __forceinline__ int pack_fp8x4(float a, float b, float c, float d) { int p = __builtin_amdgcn_cvt_pk_fp8_f32(a, b, 0, false); return __builtin_amdgcn_cvt_pk_fp8_f32(c, d, p, true); }
__device__ __forceinline__ float q8rt(float x) { const int p = __builtin_amdgcn_cvt_pk_fp8_f32(x, x, 0, false); return __builtin_amdgcn_cvt_f32_fp8(p, 0); }
__device__ __forceinline__ float wave_sum(float v) {
#pragma unroll
    for (int o = 32; o >= 1; o >>= 1) v += __shfl_xor(v, o);
    return v;
}
__device__ __forceinline__ float sigmoidf_(float v) { return __builtin_amdgcn_rcpf(1.0f + __expf(-v)); }


#define XB_TMO      128
#define XB_XCNT(j)  (256  + 64 * (j))
#define XB_XSUB(j)  (1280 + 64 * (j))
#define XB_XGEN(j)  (2304 + 64 * (j))
#define XB_TOP      3328
#define XB_TOPGEN   3392
#define XCD_BAR_WORDS 3456
#define XB_SPIN_CAP (1u << 22)
__device__ __forceinline__ unsigned xb_ld(unsigned* p)              { return __hip_atomic_load(p, __ATOMIC_RELAXED, __HIP_MEMORY_SCOPE_AGENT); }
__device__ __forceinline__ unsigned xb_add(unsigned* p, unsigned v) { return __hip_atomic_fetch_add(p, v, __ATOMIC_RELAXED, __HIP_MEMORY_SCOPE_AGENT); }
__device__ __forceinline__ unsigned xb_xcc_id() { return (unsigned)__builtin_amdgcn_s_getreg((3 << 11) | 20) & 0xFu; }
#define XB_SPIN(cond, bar) do { unsigned _sp = 0; while (cond) { __builtin_amdgcn_s_sleep(1); \
    if ((++_sp & 255u) == 0u) { if (xb_ld(&(bar)[XB_TMO])) break; if (_sp > XB_SPIN_CAP) { atomicAdd(&(bar)[XB_TMO], 1u); break; } } } } while (0)
struct XcdBarrier { unsigned* bar; unsigned x; volatile LAS unsigned* st; int wv; };
__device__ __forceinline__ XcdBarrier xcd_barrier_post(unsigned* bar, volatile LAS unsigned* st, int wv) {
    XcdBarrier b; b.bar = bar; b.x = xb_xcc_id(); b.st = st; b.wv = wv;
    if (threadIdx.x == 0) (void)xb_add(&bar[XB_XCNT(b.x)], 1u);
    return b;
}
__device__ __forceinline__ void xcd_barrier_complete(unsigned* bar, unsigned x, unsigned& nloc, unsigned& nx) {
    const unsigned G = gridDim.x * gridDim.y * gridDim.z;
    unsigned sum, cnt, mine, sp = 0u;
    for (;;) {
        sum = 0u; cnt = 0u; mine = 0u;
#pragma unroll
        for (unsigned j = 0; j < 16; ++j) { const unsigned c = xb_ld(&bar[XB_XCNT(j)]); sum += c; cnt += (c > 0u) ? 1u : 0u; mine = (j == x) ? c : mine; }
        if (sum == G) break;
        __builtin_amdgcn_s_sleep(1);
        if ((++sp & 255u) == 0u) { if (xb_ld(&bar[XB_TMO])) break; if (sp > XB_SPIN_CAP) { atomicAdd(&bar[XB_TMO], 1u); break; } }
    }
    nloc = mine > 0u ? mine : 1u; nx = cnt > 0u ? cnt : 1u;
}
__device__ __forceinline__ void xcd_barrier(const XcdBarrier& b) {
    asm volatile("s_waitcnt vmcnt(0)" ::: "memory");
    __syncthreads();
    if (threadIdx.x == 0) {
        unsigned* bar = b.bar;
        __builtin_amdgcn_s_waitcnt(0);
        unsigned nloc = b.st[0], nx = b.st[1];
        if (nloc == 0u) { xcd_barrier_complete(bar, b.x, nloc, nx); b.st[0] = nloc; b.st[1] = nx; }
        const unsigned old = xb_add(&bar[XB_XSUB(b.x)], 1u);
        const unsigned gen = old / nloc;
        if (old + 1u == (gen + 1u) * nloc) {
            __builtin_amdgcn_fence(__ATOMIC_RELEASE, "agent");
            asm volatile("s_waitcnt vmcnt(0)" ::: "memory");
            const unsigned og = xb_add(&bar[XB_TOP], 1u);
            const unsigned tg = og / nx;
            if (og + 1u == (tg + 1u) * nx) xb_add(&bar[XB_TOPGEN], 1u);
            else XB_SPIN(xb_ld(&bar[XB_TOPGEN]) == tg, bar);
            __builtin_amdgcn_fence(__ATOMIC_ACQUIRE, "agent");
            xb_add(&bar[XB_XGEN(b.x)], 1u);
            asm volatile("s_waitcnt vmcnt(0)" ::: "memory");
        } else {
            XB_SPIN(xb_ld(&bar[XB_XGEN(b.x)]) == gen, bar);
            __builtin_amdgcn_fence(__ATOMIC_ACQUIRE, "agent");
            asm volatile("s_waitcnt vmcnt(0)" ::: "memory");
        }
    }
    __syncthreads();
}

__device__ __forceinline__ unsigned tr_off(unsigned row, unsigned ch) { return 256u * row + 16u * (ch ^ (((row & 3u) << 2) | ((row >> 2) & 3u))); }
#define TR_FRAG_ISSUE(r0, r1, base, lane, c, ks) do { const unsigned g_ = (lane) >> 4, q_ = ((lane) & 15) >> 2, p_ = (lane) & 3; \
    const unsigned a0_ = (base) + tr_off(32u * (ks) + 8u * g_ + q_, 2u * (c) + (p_ >> 1)) + 8u * (p_ & 1u); \
    const unsigned a1_ = (base) + tr_off(32u * (ks) + 8u * g_ + 4u + q_, 2u * (c) + (p_ >> 1)) + 8u * (p_ & 1u); \
    asm volatile("ds_read_b64_tr_b16 %0, %2\n\tds_read_b64_tr_b16 %1, %3" : "=&v"(r0), "=&v"(r1) : "v"(a0_), "v"(a1_) : "memory"); } while (0)
__device__ __forceinline__ bf16x8 tr_join(u32x2 r0, u32x2 r1) { const u32x4 v = {r0.x, r0.y, r1.x, r1.y}; return __builtin_bit_cast(bf16x8, v); }

#define LDS_RD128(dst, addr) asm volatile("ds_read_b128 %0, %1" : "=&v"(dst) : "v"((unsigned)(addr)) : "memory")
#define LDS_WAIT4(a, b, c, d) asm volatile("s_waitcnt lgkmcnt(0)" : "+v"(a), "+v"(b), "+v"(c), "+v"(d) :: "memory")
#define LDS_WAIT8(a, b, c, d, e, f, g, h) asm volatile("s_waitcnt lgkmcnt(0)" : "+v"(a), "+v"(b), "+v"(c), "+v"(d), "+v"(e), "+v"(f), "+v"(g), "+v"(h) :: "memory")
#define LDS_RD128_O(dst, base, OFF) asm volatile("ds_read_b128 %0, %1 offset:%2" : "=&v"(dst) : "v"((unsigned)(base)), "n"(OFF) : "memory")
#define LDS_RD4(arr, base, STRIDE) do { LDS_RD128_O((arr)[0], base, 0); LDS_RD128_O((arr)[1], base, (STRIDE)); LDS_RD128_O((arr)[2], base, 2 * (STRIDE)); LDS_RD128_O((arr)[3], base, 3 * (STRIDE)); } while (0)
#define LDS_RD8(arr, base, STRIDE) do { LDS_RD4(arr, base, STRIDE); LDS_RD128_O((arr)[4], base, 4 * (STRIDE)); LDS_RD128_O((arr)[5], base, 5 * (STRIDE)); LDS_RD128_O((arr)[6], base, 6 * (STRIDE)); LDS_RD128_O((arr)[7], base, 7 * (STRIDE)); } while (0)

namespace pg8 {
constexpr int BM = 256, BK = 64, HALF = 128, HTB = HALF * BK * 2, STAGE_BYTES = 8 * HTB, NXCD = 8, WGM = 8;
__device__ __forceinline__ int lds_byte(int r, int c) { const int st = (r >> 4) * 2 + (c >> 5), rr = r & 15, cc = c & 31, ob = rr * 64 + cc * 2; return st * 1024 + (ob ^ (((ob >> 9) & 1) << 5)); }
__device__ __forceinline__ void stage_rc(int b, int& R, int& C) { const int st = b / 1024, sb = b % 1024, swz = sb ^ (((sb >> 9) & 1) << 5); R = (st >> 1) * 16 + swz / 64; C = (st & 1) * 32 + (swz % 64) / 2; }
__device__ __forceinline__ int perm32(int rho) { const int n = rho >> 4, i = rho & 15; return 8 * (i >> 2) + 4 * n + (i & 3); }

struct Unit { int pm, pn; };
struct Gemm { const bf16_t* A; const bf16_t* Bt; int M, N, K, lda; };

struct StaticOrder {
    int nM, nN, nwg, G, c;
    __device__ void init(int M, int N, int G_, int c_) { nM = M / BM; nN = N / BM; nwg = nM * nN; G = G_; c = c_; }
    __device__ bool next(int i, Unit& u) const {
        const long L = (long)i * G + c; if (L >= nwg) return false;
        int wgid = (int)L; { const int q = nwg / NXCD, r = nwg % NXCD, xcd = wgid % NXCD, off = wgid / NXCD; wgid = (xcd < r ? xcd * (q + 1) : r * (q + 1) + (xcd - r) * q) + off; }
        const int nig = WGM * nN, gid = wgid / nig, fm = gid * WGM, gsz = (nM - fm) < WGM ? (nM - fm) : WGM;
        u.pm = fm + ((wgid % nig) % gsz); u.pn = (wgid % nig) / gsz; return true;
    }
};

struct ProbeOrder : StaticOrder { __device__ bool next(int i, Unit& u) const { const bool r = StaticOrder::next(i, u); u.pm = 0; u.pn = 0; return r; } };

typedef int i32x8 __attribute__((ext_vector_type(8)));
typedef int i32x4 __attribute__((ext_vector_type(4)));
__device__ __forceinline__ i32x8 cat8(const bf16x8 a, const bf16x8 b) { const i32x4 x = __builtin_bit_cast(i32x4, a), y = __builtin_bit_cast(i32x4, b); return __builtin_shufflevector(x, y, 0, 1, 2, 3, 4, 5, 6, 7); }
template <class Epi, class Sched, bool F8 = false>
__device__ __forceinline__ void gemm_phase(ldsp_t lds, const Gemm g, const Sched& S, const Epi& E) {
    const int tid = threadIdx.x, wid = __builtin_amdgcn_readfirstlane(tid >> 6), lane = tid & 63, wr = wid >> 2, wc = wid & 3, fr = lane & 15, fq = lane >> 4;
    const int K = g.K, nt = F8 ? K / 128 : K / BK, rowA = F8 ? g.lda : g.lda * 2, rowB = F8 ? K : K * 2;
    unsigned voffA[2], voffB[2];
#pragma unroll
    for (int i = 0; i < 2; ++i) { int R, C; stage_rc(tid * 16 + i * 8192, R, C); const int Rb = Epi::PERM ? ((R & ~31) + perm32(R & 31)) : R;
        voffA[i] = (unsigned)(R * rowA + C * 2); voffB[i] = (unsigned)(Rb * rowB + C * 2); }
    const size_t kstep = (size_t)(BK * 2);
    const size_t hstepA = (size_t)HALF * rowA, hstepB = (size_t)HALF * rowB;
    const size_t tstepA = 2 * hstepA, tstepB = 2 * hstepB;
    const unsigned ldsw = (unsigned)wid * 1024u;
    const int aoff = lds_byte(wr * 64 + fr, fq * 8), boff = lds_byte(wc * 32 + fr, fq * 8);
#define PG8_SA(b, h) (((b) * 2 + (h)) * HTB)
#define PG8_SB(b, h) ((4 + (b) * 2 + (h)) * HTB)
#define PG8_STAGE(bufoff, gbase, voff) do { _Pragma("unroll") for (int _i = 0; _i < 2; ++_i) \
        __builtin_amdgcn_global_load_lds((const unsigned*)((const char*)(gbase) + (voff)[_i]), (LAS unsigned*)(lds + (bufoff) + ldsw + _i * 8192), 16, 0, 0); } while (0)
#define PG8_LDA(dst, b, h) do { _Pragma("unroll") for (int m = 0; m < 4; ++m) _Pragma("unroll") for (int k = 0; k < 2; ++k) dst[m][k] = *(const LAS bf16x8*)(lds + PG8_SA(b, h) + aoff + m * 2048 + k * 1024); } while (0)
#define PG8_LDB(dst, b, h) do { _Pragma("unroll") for (int n = 0; n < 2; ++n) _Pragma("unroll") for (int k = 0; k < 2; ++k) dst[n][k] = *(const LAS bf16x8*)(lds + PG8_SB(b, h) + boff + n * 2048 + k * 1024); } while (0)
#define PG8_MMA(ai, bj, At, Bt) do { __builtin_amdgcn_s_setprio(1); _Pragma("unroll") for (int m = 0; m < 4; ++m) _Pragma("unroll") for (int n = 0; n < 2; ++n) { \
        if (F8) { const i32x8 b8_ = cat8(Bt[n][0], Bt[n][1]), a8_ = cat8(At[m][0], At[m][1]); asm volatile("v_mfma_f32_16x16x128_f8f6f4 %0, %1, %2, %0" : "+v"(acc[ai][bj][m][n]) : "v"(b8_), "v"(a8_)); } \
        else { _Pragma("unroll") for (int k = 0; k < 2; ++k) acc[ai][bj][m][n] = __builtin_amdgcn_mfma_f32_16x16x32_bf16(Bt[n][k], At[m][k], acc[ai][bj][m][n], 0, 0, 0); } } \
        __builtin_amdgcn_s_setprio(0); } while (0)
#define PG8_WAIT_V(n) asm volatile("s_waitcnt vmcnt(" #n ")" ::: "memory")
#define PG8_WAIT_L(n) asm volatile("s_waitcnt lgkmcnt(" #n ")" ::: "memory")
#define PG8_BAR __builtin_amdgcn_s_barrier()
#define PG8_SCHED __builtin_amdgcn_sched_barrier(0)
    Unit cur, nxt; int ui = 0;
    if (!S.next(0, cur)) return;
    f32x4 acc[2][2][4][2];
#pragma unroll
    for (int a = 0; a < 2; ++a)
#pragma unroll
        for (int b = 0; b < 2; ++b)
#pragma unroll
            for (int m = 0; m < 4; ++m)
#pragma unroll
                for (int n = 0; n < 2; ++n) acc[a][b][m][n] = (f32x4){0.f, 0.f, 0.f, 0.f};
    bf16x8 At[4][2], B0[2][2], B1[2][2];
    const char* cA = (const char*)g.A + (size_t)cur.pm * tstepA; const char* cB = (const char*)g.Bt + (size_t)cur.pn * tstepB;
    PG8_STAGE(PG8_SB(0, 0), cB, voffB); PG8_STAGE(PG8_SA(0, 0), cA, voffA); PG8_STAGE(PG8_SB(0, 1), cB + hstepB, voffB); PG8_STAGE(PG8_SA(0, 1), cA + hstepA, voffA);
    if (wr == 1) PG8_BAR;
    PG8_WAIT_V(4); PG8_BAR;
    PG8_STAGE(PG8_SB(1, 0), cB + kstep, voffB); PG8_STAGE(PG8_SA(1, 0), cA + kstep, voffA); PG8_STAGE(PG8_SB(1, 1), cB + hstepB + kstep, voffB);
    PG8_WAIT_V(6); PG8_BAR;
    for (;;) {
        const bool has_next = S.next(ui + 1, nxt);
        const char* nA = has_next ? (const char*)g.A + (size_t)nxt.pm * tstepA : cA; const char* nB = has_next ? (const char*)g.Bt + (size_t)nxt.pn * tstepB : cB;
        for (int t = 0; t < nt; t += 2) {
            const bool last = (t == nt - 2);
            const char* a1 = cA + (size_t)(t + 1) * kstep;
            const char* a2 = last ? nA : cA + (size_t)(t + 2) * kstep; const char* b2 = last ? nB : cB + (size_t)(t + 2) * kstep;
            const char* a3 = a2 + kstep; const char* b3 = b2 + kstep;
            PG8_LDB(B0, 0, 0); PG8_SCHED; PG8_LDA(At, 0, 0); PG8_STAGE(PG8_SA(1, 1), a1 + hstepA, voffA);
            PG8_WAIT_L(8); PG8_BAR; PG8_WAIT_L(0); PG8_MMA(0, 0, At, B0); PG8_BAR; PG8_SCHED;
            PG8_LDB(B1, 0, 1); PG8_STAGE(PG8_SB(0, 0), b2, voffB);
            PG8_BAR; PG8_WAIT_L(0); PG8_MMA(0, 1, At, B1); PG8_BAR;
            PG8_LDA(At, 0, 1); PG8_STAGE(PG8_SA(0, 0), a2, voffA);
            PG8_BAR; PG8_WAIT_L(0); PG8_MMA(1, 0, At, B0); PG8_BAR; PG8_SCHED;
            PG8_STAGE(PG8_SB(0, 1), b2 + hstepB, voffB);
            PG8_WAIT_V(6); PG8_BAR; PG8_MMA(1, 1, At, B1); PG8_BAR;
            PG8_LDB(B0, 1, 0); PG8_SCHED; PG8_LDA(At, 1, 0); PG8_STAGE(PG8_SA(0, 1), a2 + hstepA, voffA);
            PG8_WAIT_L(8); PG8_BAR; PG8_WAIT_L(0); PG8_MMA(0, 0, At, B0); PG8_BAR; PG8_SCHED;
            PG8_LDB(B1, 1, 1); PG8_STAGE(PG8_SB(1, 0), b3, voffB);
            PG8_BAR; PG8_WAIT_L(0); PG8_MMA(0, 1, At, B1); PG8_BAR;
            PG8_LDA(At, 1, 1); PG8_STAGE(PG8_SA(1, 0), a3, voffA);
            PG8_BAR; PG8_WAIT_L(0); PG8_MMA(1, 0, At, B0); PG8_BAR; PG8_SCHED;
            PG8_STAGE(PG8_SB(1, 1), b3 + hstepB, voffB);
            PG8_WAIT_V(6); PG8_BAR; PG8_MMA(1, 1, At, B1); PG8_BAR;
        }
        if (F8) { asm volatile("s_nop 15\n\ts_nop 15" ::: "memory"); PG8_SCHED; }
        E(acc, cur, wr, wc, fr, fq);
        if (!has_next) break;
#pragma unroll
        for (int a = 0; a < 2; ++a)
#pragma unroll
            for (int b = 0; b < 2; ++b)
#pragma unroll
                for (int m = 0; m < 4; ++m)
#pragma unroll
                    for (int n = 0; n < 2; ++n) acc[a][b][m][n] = (f32x4){0.f, 0.f, 0.f, 0.f};
        cur = nxt; cA = nA; cB = nB; ++ui;
    }
    PG8_WAIT_V(0);
    if (wr == 0) PG8_BAR;
    PG8_BAR;
#undef PG8_SA
#undef PG8_SB
#undef PG8_STAGE
#undef PG8_LDA
#undef PG8_LDB
#undef PG8_MMA
#undef PG8_WAIT_V
#undef PG8_WAIT_L
#undef PG8_BAR
#undef PG8_SCHED
}

struct EpiIn {
    static constexpr bool PERM = true;
    bf16_t* P; int pn0; float sc; const LAS unsigned char* lut;
    __device__ __forceinline__ void operator()(const f32x4 (&acc)[2][2][4][2], const Unit& u, int wr, int wc, int fr, int fq) const {
        const int pn = u.pn + pn0;
        const int row0 = u.pm * BM + wr * 64 + fr, col0 = pn * BM + wc * 32 + 8 * fq;
        const bool sg = (pn >= 16 && pn < 32);
#pragma unroll
        for (int ai = 0; ai < 2; ++ai)
#pragma unroll
            for (int m = 0; m < 4; ++m) { bf16_t* rowp = P + (size_t)(row0 + ai * HALF + m * 16) * PW + col0;
#pragma unroll
                for (int bj = 0; bj < 2; ++bj) { f32x4 v0 = acc[ai][bj][m][0] * sc, v1 = acc[ai][bj][m][1] * sc;
                    if (sg) {
                        unsigned b0 = 0u, b1 = 0u;
#pragma unroll
                        for (int j = 0; j < 4; ++j) {
                            const int i0 = min(max((int)(v0[j] * 64.0f + 512.0f), 0), 1023), i1 = min(max((int)(v1[j] * 64.0f + 512.0f), 0), 1023);
                            b0 |= (unsigned)lut[i0] << (8 * j); b1 |= (unsigned)lut[i1] << (8 * j); }
                        *(u32x2*)((unsigned char*)(P + (size_t)(row0 + ai * HALF + m * 16) * PW) + 8192 + (col0 - 4096) + bj * HALF) = (u32x2){b0, b1};
                    } else {
                        u32x4 w; w.x = pk2(v0[0], v0[1]); w.y = pk2(v0[2], v0[3]); w.z = pk2(v1[0], v1[1]); w.w = pk2(v1[2], v1[3]);
                        *(u32x4*)(rowp + bj * HALF) = w; } } }
    }
};
template <int MODE, bool OUT8 = false> struct EpiGate {
    static constexpr bool PERM = true;
    bf16_t* O; int ldo; const unsigned char* G; int ldg; float sc; unsigned char* O8;
    __device__ __forceinline__ void operator()(const f32x4 (&acc)[2][2][4][2], const Unit& u, int wr, int wc, int fr, int fq) const {
        const int row0 = u.pm * BM + wr * 64 + fr, col0 = u.pn * BM + wc * 32 + 8 * fq;
#pragma unroll
        for (int ai = 0; ai < 2; ++ai) {
            u32x2 gw[4][2]; u32x4 ow[4][2];
            if (MODE != 2) {
#pragma unroll
                for (int m = 0; m < 4; ++m)
#pragma unroll
                    for (int bj = 0; bj < 2; ++bj) { const size_t row = (size_t)(row0 + ai * HALF + m * 16);
                        gw[m][bj] = *(const u32x2*)(G + row * ldg + col0 + bj * HALF);
                        if (MODE == 1) ow[m][bj] = *(const u32x4*)(O + row * ldo + col0 + bj * HALF); }
                __builtin_amdgcn_sched_barrier(0);
            }
#pragma unroll
            for (int m = 0; m < 4; ++m) { const size_t row = (size_t)(row0 + ai * HALF + m * 16);
#pragma unroll
                for (int bj = 0; bj < 2; ++bj) { const f32x4 v0 = acc[ai][bj][m][0], v1 = acc[ai][bj][m][1];
                    float r[8] = {v0[0], v0[1], v0[2], v0[3], v1[0], v1[1], v1[2], v1[3]};
                    if (MODE != 2) { const unsigned gws[2] = {gw[m][bj].x, gw[m][bj].y};
#pragma unroll
                        for (int j = 0; j < 8; ++j) r[j] *= (float)((gws[j >> 2] >> (8 * (j & 3))) & 255u) * (sc * (1.0f / 255.0f)); }
                    if (MODE == 1) { const unsigned ows[4] = {ow[m][bj].x, ow[m][bj].y, ow[m][bj].z, ow[m][bj].w};
#pragma unroll
                        for (int j = 0; j < 4; ++j) { r[2 * j] += bflo(ows[j]); r[2 * j + 1] += bfhi(ows[j]); } }
                    if (OUT8) *(u32x2*)(O8 + row * ldo + col0 + bj * HALF) = (u32x2){(unsigned)pack_fp8x4(r[0], r[1], r[2], r[3]), (unsigned)pack_fp8x4(r[4], r[5], r[6], r[7])};
                    else { u32x4 w; w.x = pk2(r[0], r[1]); w.y = pk2(r[2], r[3]); w.z = pk2(r[4], r[5]); w.w = pk2(r[6], r[7]);
                        *(u32x4*)(O + row * ldo + col0 + bj * HALF) = w; } } }
        }
    }
};
struct EpiRes {
    static constexpr bool PERM = false;
    const float* X; const float* gmod; bf16_t* H; float sc;
    __device__ __forceinline__ void operator()(const f32x4 (&acc)[2][2][4][2], const Unit& u, int wr, int wc, int fr, int fq) const {
        const int row0 = u.pm * BM + wr * 64 + fr, col0 = u.pn * BM + wc * 32 + 4 * fq;
        const float* gm = gmod + (size_t)((u.pm * BM) >> 14) * 12288;
        f32x4 gv[2][2];
#pragma unroll
        for (int bj = 0; bj < 2; ++bj)
#pragma unroll
            for (int n = 0; n < 2; ++n) gv[bj][n] = *(const f32x4*)(gm + col0 + bj * HALF + n * 16) * sc;
#pragma unroll
        for (int ai = 0; ai < 2; ++ai)
#pragma unroll
          for (int mh = 0; mh < 2; ++mh) {
            f32x4 xs[2][2][2];
#pragma unroll
            for (int mm = 0; mm < 2; ++mm) { const size_t off = (size_t)(row0 + ai * HALF + (2 * mh + mm) * 16) * 2048 + col0;
#pragma unroll
                for (int bj = 0; bj < 2; ++bj)
#pragma unroll
                    for (int n = 0; n < 2; ++n) xs[mm][bj][n] = *(const f32x4*)(X + off + bj * HALF + n * 16); }
            __builtin_amdgcn_sched_barrier(0);
#pragma unroll
            for (int mm = 0; mm < 2; ++mm) { const int m = 2 * mh + mm; const size_t off = (size_t)(row0 + ai * HALF + m * 16) * 2048 + col0;
#pragma unroll
                for (int bj = 0; bj < 2; ++bj)
#pragma unroll
                    for (int n = 0; n < 2; ++n) { const f32x4 hv = xs[mm][bj][n] + gv[bj][n] * acc[ai][bj][m][n];
                        *(u32x2*)(H + off + bj * HALF + n * 16) = (u32x2){pk2(hv[0], hv[1]), pk2(hv[2], hv[3])}; } }
          }
    }
};
struct EpiNull {
    static constexpr bool PERM = true;
    float* sink;
    __device__ __forceinline__ void operator()(const f32x4 (&acc)[2][2][4][2], const Unit& u, int wr, int wc, int fr, int fq) const {
        float s = 0.f;
#pragma unroll
        for (int ai = 0; ai < 2; ++ai)
#pragma unroll
            for (int bj = 0; bj < 2; ++bj)
#pragma unroll
                for (int m = 0; m < 4; ++m)
#pragma unroll
                    for (int n = 0; n < 2; ++n) s += acc[ai][bj][m][n][0] + acc[ai][bj][m][n][1] + acc[ai][bj][m][n][2] + acc[ai][bj][m][n][3];
        if (s == 123.456f) sink[fr + 16 * fq + 64 * (wr * 4 + wc)] = s;
    }
};
}

__device__ void gemv_task(const Args& a, int task, ldsp_t lds) {
    const int tid = threadIdx.x, cq = tid & 15, rl = tid >> 4;
    const float* W = a.in[I_WADA] + 64 * task + 4 * cq;
    const float* c = a.in[I_C];
    LAS float* sl = (LAS float*)(lds + 16384);
    __syncthreads();
#pragma unroll
    for (int i = 0; i < 8; ++i) { const float cv = c[tid + 512 * i]; sl[tid + 512 * i] = cv * sigmoidf_(cv); }
    __syncthreads();
    f32x4 acc0 = {0.f, 0.f, 0.f, 0.f}, acc1 = {0.f, 0.f, 0.f, 0.f};
#pragma unroll 1
    for (int r0 = rl; r0 < 2048; r0 += 256) {
        f32x4 w[8];
#pragma unroll
        for (int u = 0; u < 8; ++u) w[u] = *(const f32x4*)(W + (size_t)(r0 + 32 * u) * 12288);
#pragma unroll
        for (int u = 0; u < 8; ++u) { const float s0 = sl[r0 + 32 * u], s1 = sl[2048 + r0 + 32 * u]; acc0 += s0 * w[u]; acc1 += s1 * w[u]; }
    }
    LAS float* red = (LAS float*)lds;
    __syncthreads();
#pragma unroll
    for (int j = 0; j < 4; ++j) { red[(rl * 16 + cq) * 8 + j] = acc0[j]; red[(rl * 16 + cq) * 8 + 4 + j] = acc1[j]; }
    __syncthreads();
    if (tid < 128) {
        const int b = tid >> 6, col = tid & 63; float s = 0.f;
        for (int r = 0; r < 32; ++r) s += red[(r * 16 + (col >> 2)) * 8 + b * 4 + (col & 3)];
        float* mod = (float*)(a.ws + WS_MOD);
        mod[b * 12288 + 64 * task + col] = s + a.in[I_BADA][64 * task + col];
    }
    __syncthreads();
}

template <class CMap>
__device__ __forceinline__ void tr_tile(const Args& a, const float* src, int src_ld, int r0, int c0, CMap cmap, bf16_t* dst, int dst_ld, ldsp_t lds, float qs = 0.f) {
    LAS float* tile = (LAS float*)lds;
    const int tid = threadIdx.x, cc = tid & 63, rr0 = tid >> 6;
    int c1, c2; float sg; cmap(c0 + cc, c1, c2, sg);
#pragma unroll
    for (int i = 0; i < 8; ++i) { const int r = rr0 + 8 * i; const float* sp = src + (size_t)(r0 + r) * src_ld;
        float v = c1 >= 0 ? sp[c1] : 0.f; if (c2 >= 0) v += sg * sp[c2];
        tile[cc * 65 + r] = v; }
    __syncthreads();
    if (qs > 0.f) {
        const int rp = (tid & 15) * 4, cq = tid >> 4;
#pragma unroll
        for (int i = 0; i < 2; ++i) { const int c = cq + 32 * i; const LAS float* tp = tile + c * 65 + rp;
            *(int*)((unsigned char*)dst + (size_t)(c0 + c) * dst_ld + r0 + rp) = pack_fp8x4(tp[0] * qs, tp[1] * qs, tp[2] * qs, tp[3] * qs); }
    } else {
    const int rp = (tid & 31) * 2, cq = tid >> 5;
#pragma unroll
    for (int i = 0; i < 4; ++i) { const int c = cq + 16 * i; *(unsigned*)(dst + (size_t)(c0 + c) * dst_ld + r0 + rp) = pk2(tile[c * 65 + rp], tile[c * 65 + rp + 1]); }
    }
    __syncthreads();
}
struct MapId { __device__ void operator()(int c, int& c1, int& c2, float& sg) const { c1 = c; c2 = -1; sg = 0.f; } };
struct MapWin { __device__ void operator()(int c, int& c1, int& c2, float& sg) const {
    c2 = -1; sg = 0.f;
    if (c < 1024) { const int gb = c & ~255, cp = c & 255;
        if (cp == 0 || cp == 128) c1 = gb + cp;
        else if (cp < 128) { c1 = gb + cp; c2 = gb + 256 - cp; sg = 1.f; }
        else { const int cc = cp - 128; c1 = gb + cc; c2 = gb + 256 - cc; sg = -1.f; } }
    else c1 = c < 4096 ? c : (c < 8192 ? c + 32 : (c < 8224 ? c - 4096 : -1)); } };

__device__ void fold_tile(const Args& a, int tile, ldsp_t lds) {
    LAS float* wl = (LAS float*)lds;
    LAS float* ct = (LAS float*)(lds + 65536);
    const int tid = threadIdx.x;
    const int nb = tile & 31, kb = tile >> 5;
    const int g = kb >> 2, c0 = (kb & 3) * 64, n0 = nb * 64;
    const float* wf = a.in[I_WFNET] + (size_t)(g * 256) * 2048 + n0;
    __syncthreads();
#pragma unroll
    for (int j = 0; j < 8; ++j) { const int row = (tid >> 4) + 32 * j, c4 = (tid & 15) * 4;
        const f32x4 v = *(const f32x4*)(wf + (size_t)row * 2048 + c4);
        wl[row * 64 + c4] = v[0]; wl[row * 64 + c4 + 1] = v[1]; wl[row * 64 + c4 + 2] = v[2]; wl[row * 64 + c4 + 3] = v[3]; }
    if (tid < 256) ct[tid] = cospif((float)tid * (1.0f / 128.0f));
    __syncthreads();
    const int kk = tid & 63, nn0 = tid >> 6, cp = c0 + kk;
    const bool isin = cp > 128; const int cf = isin ? cp - 128 : cp;
    float acc[8];
#pragma unroll
    for (int i = 0; i < 8; ++i) acc[i] = 0.f;
    for (int m = 0; m < 256; ++m) {
        const int idx = (m * cf) & 255;
        const float cs = isin ? ct[(idx + 192) & 255] : ct[idx];
#pragma unroll
        for (int i = 0; i < 8; ++i) acc[i] += wl[m * 64 + nn0 + 8 * i] * cs;
    }
    if (F8_FNET) { unsigned char* dst8 = a.ws + WS_WFN;
#pragma unroll
        for (int i = 0; i < 8; ++i) dst8[(size_t)(n0 + nn0 + 8 * i) * 1024 + g * 256 + cp] = (unsigned char)fp8_byte(acc[i] * (WFN8_SCALE / 2048.0f));
    } else {
    bf16_t* dst = (bf16_t*)(a.ws + WS_WFN);
#pragma unroll
    for (int i = 0; i < 8; ++i) dst[(size_t)(n0 + nn0 + 8 * i) * 1024 + g * 256 + cp] = (bf16_t)f2bf(acc[i] * (1.0f / 2048.0f));
    }
    __syncthreads();
}

__device__ void tables_task(const Args& a, int task) {
    const int tid = threadIdx.x;
    bf16_t* F1 = (bf16_t*)(a.ws + WS_F1); bf16_t* F2 = (bf16_t*)(a.ws + WS_F2); float* TW = (float*)(a.ws + WS_TW);
    {
        const int e = task * 512 + tid, R = e >> 7, sh = e & 127, w = R >> 5, mt = (R >> 4) & 1, r = R & 15, kf = 16 * w + r;
        float s, c; sincospif((float)((kf * sh) & 127) * (1.0f / 64.0f), &s, &c);
        F1[e] = (bf16_t)f2bf(mt ? -s : c);
    }
#pragma unroll
    for (int q = 0; q < 2; ++q) {
        const int e = task * 1024 + q * 512 + tid, R = e >> 8, K = e & 255, sl = K >> 1, ri = K & 1, w = R >> 5, mt = (R >> 4) & 1, r = R & 15, kf = 16 * w + r;
        float s, c; sincospif((float)((kf * sl) & 127) * (1.0f / 64.0f), &s, &c);
        const float v = mt ? (ri ? c : -s) : (ri ? s : c);
        F2[e] = (bf16_t)f2bf(v);
    }
    if (task < 32) {
        const int e = task * 512 + tid, kl = e >> 7, sl = e & 127;
        float s, c; sincospif((float)(kl * sl) * (1.0f / 8192.0f), &s, &c);
        TW[2 * e] = c; TW[2 * e + 1] = s;
    }
}

__device__ void cvt_flat(const Args& a, const float* src, bf16_t* dst, size_t n) {
    const size_t gt = (size_t)blockIdx.x * 512 + threadIdx.x, gs = (size_t)gridDim.x * 512;
    for (size_t i = gt * 8; i < n; i += gs * 8) {
        const f32x4 v0 = *(const f32x4*)(src + i), v1 = *(const f32x4*)(src + i + 4);
        u32x4 w; w.x = pk2(v0[0], v0[1]); w.y = pk2(v0[2], v0[3]); w.z = pk2(v1[0], v1[1]); w.w = pk2(v1[2], v1[3]);
        *(u32x4*)(dst + i) = w;
    }
}

constexpr int TR_N0 = 129 * 32, TR_N1 = TR_N0 + 32 * 16, TR_N2 = TR_N1 + 32 * 32, TR_N3 = TR_N2 + 32 * 32;
__device__ void tr_all(const Args& a, ldsp_t lds) {
    LAS float* tile = (LAS float*)lds;
    const int tid = threadIdx.x, cc = tid & 63, rr0 = tid >> 6, G = gridDim.x;
    float va[8], vb[8], sg = 0.f;
    bf16_t* dst = nullptr; int dst_ld = 0, r0 = 0, c0 = 0; float qs = 0.f;
#define TR_LOAD(T) do { const int t_ = (T); const float* src_; int sld_; int c1_, c2_ = -1; sg = 0.f; qs = 0.f; \
        if (t_ < TR_N0) { src_ = a.in[I_WIN]; sld_ = 8224; r0 = (t_ & 31) * 64; c0 = (t_ >> 5) * 64; const bool f8_ = in_f8(t_ >> 7) || (F8_MASK != 0u && (t_ >> 5) == 128);     \
            dst = f8_ ? (bf16_t*)(a.ws + WS_WIN8) : (bf16_t*)(a.ws + WS_WIN); dst_ld = 2048; qs = f8_ ? WIN8_SCALE : 0.f; MapWin()(c0 + cc, c1_, c2_, sg); } \
        else if (t_ < TR_N1) { const int u_ = t_ - TR_N0; src_ = a.in[I_WGLA]; sld_ = 2048; r0 = (u_ & 15) * 64; c0 = (u_ >> 4) * 64; dst = (bf16_t*)(a.ws + WS_WGLA); dst_ld = 1024; c1_ = c0 + cc; if (F8_GLA) qs = WIN8_SCALE; } \
        else if (t_ < TR_N2) { const int u_ = t_ - TR_N1; src_ = a.in[I_WOUT]; sld_ = 2048; r0 = (u_ & 31) * 64; c0 = (u_ >> 5) * 64; dst = (bf16_t*)(a.ws + WS_WOUT); dst_ld = 2048; c1_ = c0 + cc; if (F8_OUT) qs = WIN8_SCALE; } \
        else { const int u_ = t_ - TR_N2; src_ = a.in[I_WQ]; sld_ = 2048; r0 = (u_ & 31) * 64; c0 = (u_ >> 5) * 64; dst = (bf16_t*)(a.ws + WS_WQ); dst_ld = 2048; c1_ = c0 + cc; } \
        _Pragma("unroll") for (int i = 0; i < 8; ++i) { const float* sp_ = src_ + (size_t)(r0 + rr0 + 8 * i) * sld_; \
            va[i] = c1_ >= 0 ? sp_[c1_] : 0.f; vb[i] = c2_ >= 0 ? sp_[c2_] : 0.f; } } while (0)
    int t = blockIdx.x;
    if (t < TR_N3) TR_LOAD(t);
    for (; t < TR_N3; t += G) {
#pragma unroll
        for (int i = 0; i < 8; ++i) tile[cc * 65 + rr0 + 8 * i] = va[i] + sg * vb[i];
        __syncthreads();
        bf16_t* const dstc = dst; const int ldc = dst_ld, r0c = r0, c0c = c0; const float qsc = qs;
        if (t + G < TR_N3) TR_LOAD(t + G);
        if (qsc > 0.f) {
            const int rp = (tid & 15) * 4, cq = tid >> 4;
#pragma unroll
            for (int i = 0; i < 2; ++i) { const int c = cq + 32 * i; const LAS float* tp = tile + c * 65 + rp;
                *(int*)((unsigned char*)dstc + (size_t)(c0c + c) * ldc + r0c + rp) = pack_fp8x4(tp[0] * qsc, tp[1] * qsc, tp[2] * qsc, tp[3] * qsc); }
        } else {
            const int rp = (tid & 31) * 2, cq = tid >> 5;
#pragma unroll
            for (int i = 0; i < 4; ++i) { const int c = cq + 16 * i; *(unsigned*)(dstc + (size_t)(c0c + c) * ldc + r0c + rp) = pk2(tile[c * 65 + rp], tile[c * 65 + rp + 1]); }
        }
        __syncthreads();
    }
#undef TR_LOAD
}

__device__ void phase0(const Args& a, ldsp_t lds) {
    const int G = gridDim.x, bx = blockIdx.x;
    for (int t = bx; t < 192; t += G) gemv_task(a, t, lds);
    for (int t = bx; t < 64; t += G) tables_task(a, t);
    cvt_flat(a, a.in[I_KEYS], (bf16_t*)(a.ws + WS_KEYS), (size_t)8 * 2 * 128 * 128);
    tr_all(a, lds);
    for (int t = bx; t < 512; t += G) fold_tile(a, t, lds);
}

template <bool WITH_A1, bool XBF = false>
__device__ void norm_phase(const Args& a, const float* X, const float* gvec, const float* mod_sh, const float* mod_sc, bf16_t* out, const bf16_t* Wa1t, bf16_t* P, ldsp_t lds) {
    const int lane = threadIdx.x & 63, wave = threadIdx.x >> 6;
    const int W = gridDim.x * 8;
    const int row_first = blockIdx.x * 8 + wave;
    f32x4 Av[8], Bv[8], v[8];
    int bcur = -1;
#define NORM_LOAD_ROW(DST, ROW) do { _Pragma("unroll") for (int j = 0; j < 8; ++j) { \
        if (XBF) { const u32x2 hw_ = *(const u32x2*)((const bf16_t*)X + (size_t)(ROW) * 2048 + (j * 64 + lane) * 4); DST[j] = (f32x4){bflo(hw_.x), bfhi(hw_.x), bflo(hw_.y), bfhi(hw_.y)}; } \
        else DST[j] = *(const f32x4*)(X + (size_t)(ROW) * 2048 + (j * 64 + lane) * 4); } } while (0)
    if (row_first < T_) NORM_LOAD_ROW(v, row_first);
    for (int row = row_first; row < T_; row += W) {
        const int b = row >> 14;
        if (b != bcur) { bcur = b;
#pragma unroll
            for (int j = 0; j < 8; ++j) { const int d = (j * 64 + lane) * 4;
                const f32x4 gg = *(const f32x4*)(gvec + d), sc = *(const f32x4*)(mod_sc + b * 12288 + d);
                Av[j] = gg * (1.0f + sc); Bv[j] = *(const f32x4*)(mod_sh + b * 12288 + d); } }
        f32x4 vn[8];
        { const int rn = row + W < T_ ? row + W : row; NORM_LOAD_ROW(vn, rn); }
        float ss = 0.f;
#pragma unroll
        for (int j = 0; j < 8; ++j) ss += v[j][0] * v[j][0] + v[j][1] * v[j][1] + v[j][2] * v[j][2] + v[j][3] * v[j][3];
        ss = wave_sum(ss);
        const float rstd = rsqrtf(ss * (1.0f / 2048.0f) + EPS);
#pragma unroll
        for (int j = 0; j < 8; ++j) { const int d = (j * 64 + lane) * 4;
            const f32x4 y = v[j] * rstd * Av[j] + Bv[j];
            if (WITH_A1 && F8_MASK != 0u) *(int*)((unsigned char*)a.out + (size_t)row * 2048 + d) = pack_fp8x4(y[0], y[1], y[2], y[3]);
            if (out) { u32x2 w; w.x = pk2(y[0], y[1]); w.y = pk2(y[2], y[3]);
                *(u32x2*)(out + (size_t)row * 2048 + d) = w; } }
#pragma unroll
        for (int j = 0; j < 8; ++j) v[j] = vn[j];
    }
#undef NORM_LOAD_ROW
    if (WITH_A1) {
        constexpr int WS_ = 2064;
        const unsigned char* W8 = (const unsigned char*)Wa1t;
        __syncthreads();
#pragma unroll
        for (int p = 0; p < 8; ++p) { const int pc = threadIdx.x + 512 * p, rw = pc >> 7, c16 = pc & 127;
            *(LAS u32x4*)(lds + rw * WS_ + c16 * 16) = *(const u32x4*)(W8 + (size_t)rw * 2048 + c16 * 16); }
        asm volatile("s_waitcnt vmcnt(0)" ::: "memory");
        __syncthreads();
        const int l15 = lane & 15, g = lane >> 4;
        const int nrows = (T_ - row_first + W - 1) / W;
        const int myrow = row_first + W * (l15 < nrows ? l15 : 0);
        f32x4 acc[2] = {{0.f, 0.f, 0.f, 0.f}, {0.f, 0.f, 0.f, 0.f}};
        const unsigned char* ap = (const unsigned char*)a.out + (size_t)myrow * 2048 + 16 * g;
        LAS const unsigned char* bp = lds + l15 * WS_ + 16 * g;
#pragma unroll 4
        for (int kb = 0; kb < 16; ++kb) {
            const u32x4 a0 = *(const u32x4*)(ap + 128 * kb), a1v = *(const u32x4*)(ap + 128 * kb + 64);
            const u32x4 b00 = *(LAS const u32x4*)(bp + 128 * kb), b01 = *(LAS const u32x4*)(bp + 128 * kb + 64);
            const u32x4 b10 = *(LAS const u32x4*)(bp + 16 * WS_ + 128 * kb), b11 = *(LAS const u32x4*)(bp + 16 * WS_ + 128 * kb + 64);
            typedef int v8i_ __attribute__((ext_vector_type(8)));
            const v8i_ av = {(int)a0.x, (int)a0.y, (int)a0.z, (int)a0.w, (int)a1v.x, (int)a1v.y, (int)a1v.z, (int)a1v.w};
            const v8i_ bv0 = {(int)b00.x, (int)b00.y, (int)b00.z, (int)b00.w, (int)b01.x, (int)b01.y, (int)b01.z, (int)b01.w};
            const v8i_ bv1 = {(int)b10.x, (int)b10.y, (int)b10.z, (int)b10.w, (int)b11.x, (int)b11.y, (int)b11.z, (int)b11.w};
            acc[0] = __builtin_amdgcn_mfma_scale_f32_16x16x128_f8f6f4(av, bv0, acc[0], 0, 0, 0, 0, 0, 0);
            acc[1] = __builtin_amdgcn_mfma_scale_f32_16x16x128_f8f6f4(av, bv1, acc[1], 0, 0, 0, 0, 0, 0);
        }
        acc[0] *= (1.0f / WIN8_SCALE); acc[1] *= (1.0f / WIN8_SCALE);
#pragma unroll
        for (int r = 0; r < 4; ++r) { const int i = 4 * g + r; if (i < nrows) { const size_t rr = (size_t)(row_first + W * i);
            P[rr * PW + PC_A1 + l15] = (bf16_t)f2bf(acc[0][r]); P[rr * PW + PC_A1 + 16 + l15] = (bf16_t)f2bf(acc[1][r]); } }
    }
}

__device__ void fft1_phase(const Args& a, ldsp_t lds) {
    const int tid = threadIdx.x, lane = tid & 63, w = tid >> 6, g = lane >> 4, l15 = lane & 15;
    const bf16_t* F1 = (const bf16_t*)(a.ws + WS_F1);
    const float* TW = (const float*)(a.ws + WS_TW);
    const bf16_t* P = (const bf16_t*)(a.ws + WS_P);
    bf16_t* T1 = (bf16_t*)a.out;
    bf16x8 Af[2][4];
#pragma unroll
    for (int mt = 0; mt < 2; ++mt)
#pragma unroll
        for (int ks = 0; ks < 4; ++ks) Af[mt][ks] = *(const bf16x8*)(F1 + (32 * w + 16 * mt + l15) * 128 + 32 * ks + 8 * g);
    constexpr int OS = 272, OFF_OUT = 128 * 256;
    const unsigned ldsb = (unsigned)(size_t)lds;
    const int c16 = tid & 15, r32 = tid >> 4;
    u32x4 buf[4];
    int tile = blockIdx.x;
    if (tile < 2048) { const int cb = tile & 7, s_lo = (tile >> 3) & 127, b = tile >> 10;
        const bf16_t* src = P + (size_t)(b * S_ + s_lo) * PW + PC_Z + cb * 128 + 8 * c16;
#pragma unroll
        for (int i = 0; i < 4; ++i) buf[i] = *(const u32x4*)(src + (size_t)(r32 + 32 * i) * 128 * PW); }
    for (; tile < 2048; tile += gridDim.x) {
        const int cb = tile & 7, s_lo = (tile >> 3) & 127, b = tile >> 10;
        __syncthreads();
#pragma unroll
        for (int i = 0; i < 4; ++i) *(LAS u32x4*)(lds + tr_off(r32 + 32 * i, c16)) = buf[i];
        __syncthreads();
        { const int nt_ = tile + gridDim.x;
          if (nt_ < 2048) { const int cb2 = nt_ & 7, s2 = (nt_ >> 3) & 127, b2 = nt_ >> 10;
            const bf16_t* src = P + (size_t)(b2 * S_ + s2) * PW + PC_Z + cb2 * 128 + 8 * c16;
#pragma unroll
            for (int i = 0; i < 4; ++i) buf[i] = *(const u32x4*)(src + (size_t)(r32 + 32 * i) * 128 * PW); } }
        f32x4 acc[2][8];
#pragma unroll
        for (int mt = 0; mt < 2; ++mt)
#pragma unroll
            for (int nt = 0; nt < 8; ++nt) acc[mt][nt] = (f32x4){0.f, 0.f, 0.f, 0.f};
#pragma unroll
        for (int nt = 0; nt < 8; ++nt) { u32x2 t0[4], t1[4];
            unsigned lv = (unsigned)lane; asm volatile("" : "+v"(lv));
#pragma unroll
            for (int ks = 0; ks < 4; ++ks) TR_FRAG_ISSUE(t0[ks], t1[ks], ldsb, lv, nt, ks);
            asm volatile("s_waitcnt lgkmcnt(0)" : "+v"(t0[0]), "+v"(t1[0]), "+v"(t0[1]), "+v"(t1[1]), "+v"(t0[2]), "+v"(t1[2]), "+v"(t0[3]), "+v"(t1[3]) :: "memory");
#pragma unroll
            for (int ks = 0; ks < 4; ++ks) { const bf16x8 bfr = tr_join(t0[ks], t1[ks]);
                acc[0][nt] = __builtin_amdgcn_mfma_f32_16x16x32_bf16(Af[0][ks], bfr, acc[0][nt], 0, 0, 0);
                acc[1][nt] = __builtin_amdgcn_mfma_f32_16x16x32_bf16(Af[1][ks], bfr, acc[1][nt], 0, 0, 0); } }
#pragma unroll
        for (int r = 0; r < 4; ++r) { const int k_lo = 16 * w + 4 * g + r;
            const f32x2 cs = *(const f32x2*)(TW + 2 * (k_lo * 128 + s_lo));
#pragma unroll
            for (int nt = 0; nt < 8; ++nt) { const float tr = acc[0][nt][r], ti = acc[1][nt][r];
                *(LAS unsigned short*)(lds + OFF_OUT + (2 * k_lo) * OS + (16 * nt + l15) * 2) = (unsigned short)f2bf(tr * cs.x + ti * cs.y);
                *(LAS unsigned short*)(lds + OFF_OUT + (2 * k_lo + 1) * OS + (16 * nt + l15) * 2) = (unsigned short)f2bf(ti * cs.x - tr * cs.y); } }
        __syncthreads();
#pragma unroll
        for (int i = 0; i < 8; ++i) { const int row = r32 + 32 * i;
            const u32x4 v = *(const LAS u32x4*)(lds + OFF_OUT + row * OS + c16 * 16);
            *(u32x4*)(T1 + ((size_t)((b * 128 + (row >> 1)) * 128 + s_lo) * 2 + (row & 1)) * 1024 + cb * 128 + c16 * 8) = v; }
    }
}

__device__ void fft2_phase(const Args& a, ldsp_t lds) {
    const int tid = threadIdx.x, lane = tid & 63, w = tid >> 6, g = lane >> 4, l15 = lane & 15;
    const bf16_t* F2 = (const bf16_t*)(a.ws + WS_F2);
    const bf16_t* T1 = (const bf16_t*)a.out;
    bf16_t* ZA = (bf16_t*)a.out + (size_t)T_ * 2048;
    bf16x8 Af[2][8];
#pragma unroll
    for (int mt = 0; mt < 2; ++mt)
#pragma unroll
        for (int ks = 0; ks < 8; ++ks) Af[mt][ks] = *(const bf16x8*)(F2 + (32 * w + 16 * mt + l15) * 256 + 32 * ks + 8 * g);
    constexpr int OS = 272, OFF_OUT = 256 * 256;
    const unsigned ldsb = (unsigned)(size_t)lds;
    static_assert(OFF_OUT + 128 * OS <= LDS_BYTES - 16, "FFT2 LDS");
    const int c16 = tid & 15, r32 = tid >> 4;
    u32x4 buf[8];
    int tile = blockIdx.x;
    if (tile < 2048) { const int cb = tile & 7, k_lo = (tile >> 3) & 127, b = tile >> 10;
        const bf16_t* src = T1 + ((size_t)(b * 128 + k_lo) * 256) * 1024 + cb * 128 + 8 * c16;
#pragma unroll
        for (int i = 0; i < 8; ++i) buf[i] = *(const u32x4*)(src + (size_t)(r32 + 32 * i) * 1024); }
    for (; tile < 2048; tile += gridDim.x) {
        const int cb = tile & 7, k_lo = (tile >> 3) & 127, b = tile >> 10;
        const bool odd = (cb & 1) != 0;
        __syncthreads();
#pragma unroll
        for (int i = 0; i < 8; ++i) *(LAS u32x4*)(lds + tr_off(r32 + 32 * i, c16)) = buf[i];
        __syncthreads();
        { const int nt_ = tile + gridDim.x;
          if (nt_ < 2048) { const int cb2 = nt_ & 7, k2 = (nt_ >> 3) & 127, b2 = nt_ >> 10;
            const bf16_t* src = T1 + ((size_t)(b2 * 128 + k2) * 256) * 1024 + cb2 * 128 + 8 * c16;
#pragma unroll
            for (int i = 0; i < 8; ++i) buf[i] = *(const u32x4*)(src + (size_t)(r32 + 32 * i) * 1024); } }
        f32x4 acc[2][8];
#pragma unroll
        for (int mt = 0; mt < 2; ++mt)
#pragma unroll
            for (int nt = 0; nt < 8; ++nt) acc[mt][nt] = (f32x4){0.f, 0.f, 0.f, 0.f};
#pragma unroll
        for (int nt = 0; nt < 8; ++nt)
#pragma unroll
            for (int kh = 0; kh < 2; ++kh) { u32x2 t0[4], t1[4];
                unsigned lv = (unsigned)lane; asm volatile("" : "+v"(lv));
#pragma unroll
                for (int ks = 0; ks < 4; ++ks) TR_FRAG_ISSUE(t0[ks], t1[ks], ldsb, lv, nt, 4 * kh + ks);
                asm volatile("s_waitcnt lgkmcnt(0)" : "+v"(t0[0]), "+v"(t1[0]), "+v"(t0[1]), "+v"(t1[1]), "+v"(t0[2]), "+v"(t1[2]), "+v"(t0[3]), "+v"(t1[3]) :: "memory");
#pragma unroll
                for (int ks = 0; ks < 4; ++ks) { const bf16x8 bfr = tr_join(t0[ks], t1[ks]);
                    acc[0][nt] = __builtin_amdgcn_mfma_f32_16x16x32_bf16(Af[0][4 * kh + ks], bfr, acc[0][nt], 0, 0, 0);
                    if (odd) acc[1][nt] = __builtin_amdgcn_mfma_f32_16x16x32_bf16(Af[1][4 * kh + ks], bfr, acc[1][nt], 0, 0, 0); } }
#pragma unroll
        for (int r = 0; r < 4; ++r) { const int k_hi = 16 * w + 4 * g + r;
#pragma unroll
            for (int nt = 0; nt < 8; ++nt) { const float v = (odd && !(nt == 0 && l15 == 0)) ? acc[1][nt][r] : acc[0][nt][r];
                if (F8_FNET) *(LAS unsigned char*)(lds + OFF_OUT + k_hi * OS + (16 * nt + l15)) = (unsigned char)fp8_byte(v * ZA8_SCALE);
                else *(LAS unsigned short*)(lds + OFF_OUT + k_hi * OS + (16 * nt + l15) * 2) = (unsigned short)f2bf(v); } }
        __syncthreads();
        if (F8_FNET) {
#pragma unroll
            for (int i = 0; i < 2; ++i) { const int pc = tid + 512 * i, row = pc >> 3, c8 = pc & 7;
                const u32x4 v = *(const LAS u32x4*)(lds + OFF_OUT + row * OS + c8 * 16);
                *(u32x4*)((unsigned char*)ZA + (size_t)(b * S_ + 128 * row + k_lo) * 1024 + cb * 128 + c8 * 16) = v; }
        } else {
#pragma unroll
        for (int i = 0; i < 4; ++i) { const int row = r32 + 32 * i;
            const u32x4 v = *(const LAS u32x4*)(lds + OFF_OUT + row * OS + c16 * 16);
            *(u32x4*)(ZA + (size_t)(b * S_ + 128 * row + k_lo) * 1024 + cb * 128 + c16 * 8) = v; }
        }
    }
}

constexpr size_t WS_MIX8 = WS_XN + (size_t)64 * 1024 * 1024;
constexpr size_t WS_QT  = WS_XN;
constexpr size_t WS_AS  = WS_QT + (size_t)4096 * 64 * 128 * 2;
constexpr size_t WS_KDT = WS_END;
constexpr size_t WS_BL  = WS_KDT + (size_t)4096 * 128 * 64 * 2;
constexpr size_t WS_END2 = WS_BL + (size_t)4096 * 128 * 4;
static_assert(WS_AS + (size_t)4096 * 64 * 64 * 2 <= WS_O, "GLA pre-pass buffers must fit in the XN region");
static_assert(WS_END2 <= WS_WIN8 && WS_END3 <= (size_t)1060 * 1000 * 1000, "workspace budget");

__device__ __forceinline__ float fast_logsigmoid(float z) {
    const float e = __builtin_amdgcn_exp2f(-fabsf(z) * 1.4426950408889634f);
    return fminf(z, 0.f) - __builtin_amdgcn_logf(1.0f + e) * 0.6931471805599453f;
}

__device__ void gla_pre_phase(const Args& a, ldsp_t lds) {
    const int tid = threadIdx.x, lane = tid & 63, w = tid >> 6, g = lane >> 4, l15 = lane & 15;
    const int d = tid & 127, tg = tid >> 7;
    const bf16_t* P = (const bf16_t*)(a.ws + WS_P);
    bf16_t* QT = (bf16_t*)(a.ws + WS_QT); bf16_t* AS = (bf16_t*)(a.ws + WS_AS); bf16_t* KDT = (bf16_t*)(a.ws + WS_KDT); float* BL = (float*)(a.ws + WS_BL);
    constexpr int QS = 272, JS = 144;
    constexpr int GZS = 132;
    constexpr int OFF_QS = 0, OFF_KS = OFF_QS + 64 * QS, OFF_AS = OFF_KS + 64 * QS, OFF_A1 = OFF_AS + 64 * JS, OFF_TOT = OFF_A1 + 2048, OFF_GZ = OFF_TOT + 2048;
    static_assert(OFF_GZ + 64 * GZS * 4 <= LDS_BYTES - 16, "GLA pre LDS");
    LAS float* tot = (LAS float*)(lds + OFF_TOT);
    LAS float* Gz = (LAS float*)(lds + OFF_GZ);
    unsigned short qk[32];
    u32x4 a1v = {0u, 0u, 0u, 0u};
    const int task_base = (blockIdx.x >> 4) * 256 + (blockIdx.x & 15) * 16;
    int task = task_base;
#define GLA_PRE_LOADS(T) do { const int stream_ = (T) >> 8, chunk_ = (T) & 255, dir_ = stream_ & 1, h_ = (stream_ >> 1) & 3, b_ = stream_ >> 3; \
        if (tid < 128) { const int i_ = tid >> 1, hf_ = tid & 1, tau_ = chunk_ * 64 + i_, t_ = dir_ ? (S_ - 1 - tau_) : tau_; \
            a1v = *(const u32x4*)(P + (size_t)(b_ * S_ + t_) * PW + PC_A1 + dir_ * 16 + hf_ * 8); } \
        _Pragma("unroll") for (int ii = 0; ii < 16; ++ii) { const int tau_ = chunk_ * 64 + 16 * tg + ii, t_ = dir_ ? (S_ - 1 - tau_) : tau_; \
            const bf16_t* prow_ = P + (size_t)(b_ * S_ + t_) * PW; qk[2 * ii] = prow_[PC_Q + h_ * 128 + d]; qk[2 * ii + 1] = prow_[PC_K + h_ * 128 + d]; } } while (0)
    GLA_PRE_LOADS(task);
    float ba; bf16x8 bw2 = {0, 0, 0, 0, 0, 0, 0, 0};
    { const int stream = task_base >> 8, dir = stream & 1, h = (stream >> 1) & 3;
      if (g < 2) {
#pragma unroll
          for (int r = 0; r < 8; ++r) bw2[r] = (short)f2bf(a.in[I_WA2][(size_t)(dir * 16 + 8 * g + r) * 512 + h * 128 + 16 * w + l15]); }
      ba = a.in[I_BA][dir * 512 + h * 128 + d]; }
    for (; task < task_base + 16; ++task) {
        if (tid < 128) *(LAS u32x4*)(lds + OFF_A1 + (tid >> 1) * 32 + (tid & 1) * 16) = a1v;
        __syncthreads();
#pragma unroll
        for (int mt = 0; mt < 4; ++mt) {
            bf16x8 af = {0, 0, 0, 0, 0, 0, 0, 0};
            if (g < 2) af = *(const LAS bf16x8*)(lds + OFF_A1 + (16 * mt + l15) * 32 + g * 16);
            const f32x4 zacc = __builtin_amdgcn_mfma_f32_16x16x32_bf16(af, bw2, (f32x4){0.f, 0.f, 0.f, 0.f}, 0, 0, 0);
#pragma unroll
            for (int r = 0; r < 4; ++r) Gz[(16 * mt + 4 * g + r) * GZS + 16 * w + l15] = zacc[r]; }
        __syncthreads();
        float wv[16]; float run = 0.f;
#pragma unroll
        for (int ii = 0; ii < 16; ++ii) { const float z = ba + Gz[(16 * tg + ii) * GZS + d];
            run += fast_logsigmoid(z) * (1.0f / 16.0f); wv[ii] = run; }
        tot[tg * 128 + d] = run;
        __syncthreads();
        float pre = 0.f, blast = 0.f;
#pragma unroll
        for (int q = 0; q < 4; ++q) { const float tq = tot[q * 128 + d]; blast += tq; pre += (q < tg) ? tq : 0.f; }
        if (tg == 0) BL[(size_t)task * 128 + d] = blast;
        unsigned kd[8];
        const float eblast = __expf(blast);
#pragma unroll
        for (int ii = 0; ii < 16; ii += 2) { float kdv[2];
#pragma unroll
            for (int e = 0; e < 2; ++e) { const int i = 16 * tg + ii + e; const float bi = pre + wv[ii + e];
                const float qv = bf2f(qk[2 * (ii + e)]), kv = bf2f(qk[2 * (ii + e) + 1]);
                const float kt = kv * __expf(-bi);
                *(LAS unsigned short*)(lds + OFF_QS + i * QS + d * 2) = (unsigned short)f2bf(qv * 0.08838834764831845f * __expf(bi));
                *(LAS unsigned short*)(lds + OFF_KS + i * QS + d * 2) = (unsigned short)f2bf(kt);
                kdv[e] = kt * eblast; }
            kd[ii >> 1] = pk2(kdv[0], kdv[1]); }
        { bf16_t* kp = KDT + ((size_t)task * 128 + d) * 64 + 16 * tg;
          *(u32x4*)kp = (u32x4){kd[0], kd[1], kd[2], kd[3]}; *(u32x4*)(kp + 8) = (u32x4){kd[4], kd[5], kd[6], kd[7]}; }
        __syncthreads();
        { const int nt_ = task + 1; if (nt_ < task_base + 16) GLA_PRE_LOADS(nt_); }
#pragma unroll
        for (int q = 0; q < 2; ++q) { const int mt = w >> 1, nt = 2 * (w & 1) + q;
            f32x4 sacc = {0.f, 0.f, 0.f, 0.f};
#pragma unroll
            for (int ks = 0; ks < 4; ++ks) { const bf16x8 af = *(const LAS bf16x8*)(lds + OFF_QS + (16 * mt + l15) * QS + (32 * ks + 8 * g) * 2);
                const bf16x8 bf = *(const LAS bf16x8*)(lds + OFF_KS + (16 * nt + l15) * QS + (32 * ks + 8 * g) * 2);
                sacc = __builtin_amdgcn_mfma_f32_16x16x32_bf16(af, bf, sacc, 0, 0, 0); }
#pragma unroll
            for (int r = 0; r < 4; ++r) { const int i = 16 * mt + 4 * g + r, j = 16 * nt + l15;
                *(LAS unsigned short*)(lds + OFF_AS + i * JS + j * 2) = (unsigned short)f2bf(j <= i ? sacc[r] : 0.f); } }
        __syncthreads();
#pragma unroll
        for (int p = 0; p < 2; ++p) { const int pc = tid + 512 * p, row = pc >> 4, c16 = pc & 15;
            *(u32x4*)(QT + ((size_t)task * 64 + row) * 128 + c16 * 8) = *(const LAS u32x4*)(lds + OFF_QS + row * QS + c16 * 16); }
        { const int row = tid >> 3, c8 = tid & 7;
          *(u32x4*)(AS + ((size_t)task * 64 + row) * 64 + c8 * 8) = *(const LAS u32x4*)(lds + OFF_AS + row * JS + c8 * 16); }
    }
#undef GLA_PRE_LOADS
    __threadfence();
    __syncthreads();
}

__device__ __forceinline__ void gla_task_decode(int task, int& stream, int& eh, int& sg) {
    const int u = task & 255, i = task >> 8; stream = u >> 4; eh = i; sg = i ? 15 - (u & 15) : (u & 15);
}
__device__ __forceinline__ int gla_lidx(int stream, int eh, int sg) { return (stream * 2 + eh) * 16 + sg; }

#ifndef GLA_DEPTH_B
#define GLA_DEPTH_B 2
#endif
#ifndef GLA_DEPTH_A
#define GLA_DEPTH_A 2
#endif
template <bool PB>
__device__ void gla_scan_phase(const Args& a, ldsp_t lds) {
    const int tid = threadIdx.x, lane = tid & 63, w = tid >> 6, g = lane >> 4, l15 = lane & 15;
    const bf16_t* P = (const bf16_t*)(a.ws + WS_P);
    const bf16_t* QT = (const bf16_t*)(a.ws + WS_QT); const bf16_t* AS = (const bf16_t*)(a.ws + WS_AS); const bf16_t* KDT = (const bf16_t*)(a.ws + WS_KDT); const float* BL = (const float*)(a.ws + WS_BL);
    float* Lbuf = (float*)(a.ws + WS_L);
    float* DSEG = (float*)(a.ws + WS_DSEG);
    bf16_t* O = (bf16_t*)(a.ws + WS_O);
    constexpr int QS = 272, JS = 144;
    constexpr int OFF_QS = 0, OFF_AS = OFF_QS + 64 * QS, OFF_KDT = OFF_AS + 64 * JS, OFF_VT = OFF_KDT + 128 * JS, OFF_SB = OFF_VT + 128 * JS, OFF_OB = OFF_SB + 128 * QS,
                  OFF_DS = OFF_OB + 64 * QS, OFF_END = OFF_DS + 512;
    static_assert(OFF_END <= LDS_BYTES - 16, "GLA LDS");
    const int c16 = tid & 15, r32 = tid >> 4, c8 = tid & 7, r64 = tid >> 3;
    const unsigned ldsb = (unsigned)(size_t)lds;

    for (int it = 0; it < 2; ++it) {
        int stream, eh, sg;
        if (PB) gla_task_decode(blockIdx.x + 256 * it, stream, eh, sg);
        else { stream = blockIdx.x >> 4; sg = blockIdx.x & 15; eh = it; }
        const int dir = stream & 1, h = (stream >> 1) & 3, b = stream >> 3;
        f32x4 Sst[8];
#pragma unroll
        for (int mt = 0; mt < 8; ++mt) Sst[mt] = (f32x4){0.f, 0.f, 0.f, 0.f};
        if (PB) {
            for (int sp = 0; sp < sg; ++sp) {
                const float* Lp = Lbuf + (size_t)gla_lidx(stream, eh, sp) * 16384;
                const float* Dp = DSEG + (stream * 16 + sp) * 128;
#pragma unroll
                for (int mt = 0; mt < 8; ++mt) { const f32x4 dl = *(const f32x4*)(Dp + 16 * mt + 4 * g);
#pragma unroll
                    for (int r = 0; r < 4; ++r) Sst[mt][r] = Sst[mt][r] * __expf(dl[r]) + Lp[(mt * 4 + r) * 512 + tid]; }
            }
            __syncthreads();
#pragma unroll
            for (int mt = 0; mt < 8; ++mt) { u32x2 pw; pw.x = pk2(Sst[mt][0], Sst[mt][1]); pw.y = pk2(Sst[mt][2], Sst[mt][3]);
                *(LAS u32x2*)(lds + OFF_SB + (16 * w + l15) * QS + (16 * mt + 4 * g) * 2) = pw; }
        }
        float logD = 0.f;
        constexpr int DEPTH = PB ? GLA_DEPTH_B : GLA_DEPTH_A;
        u32x4 pk_[DEPTH][2], pv_[DEPTH][2], pq_[DEPTH][2], pa_[DEPTH]; float pbl[DEPTH];
#define GLA_SCAN_LOADS(SET, CI) do { const int ct_ = stream * 256 + sg * 16 + (CI); \
        _Pragma("unroll") for (int p_ = 0; p_ < 2; ++p_) { const int pc_ = tid + 512 * p_; \
            pk_[SET][p_] = *(const u32x4*)(KDT + ((size_t)ct_ * 128 + (pc_ >> 3)) * 64 + (pc_ & 7) * 8); \
            { const int j_ = pc_ >> 4, tau_ = (sg * 16 + (CI)) * 64 + j_, t_ = dir ? (S_ - 1 - tau_) : tau_; \
              pv_[SET][p_] = *(const u32x4*)(P + (size_t)(b * S_ + t_) * PW + PC_V + h * 256 + eh * 128 + (pc_ & 15) * 8); } \
            if (PB) pq_[SET][p_] = *(const u32x4*)(QT + ((size_t)ct_ * 64 + (pc_ >> 4)) * 128 + (pc_ & 15) * 8); } \
        if (PB) pa_[SET] = *(const u32x4*)(AS + ((size_t)ct_ * 64 + r64) * 64 + c8 * 8); \
        pbl[SET] = (tid < 128) ? BL[(size_t)ct_ * 128 + tid] : 0.f; } while (0)
#pragma unroll
        for (int s_ = 0; s_ < DEPTH; ++s_) GLA_SCAN_LOADS(s_, s_);
        for (int ci0 = 0; ci0 < 16; ci0 += DEPTH) {
#pragma unroll
          for (int s_ = 0; s_ < DEPTH; ++s_) {
            const int ci = ci0 + s_;
            if (ci >= 16) break;
            const int tau0 = (sg * 16 + ci) * 64;
#pragma unroll
            for (int p = 0; p < 2; ++p) { const int pc = tid + 512 * p;
                *(LAS u32x4*)(lds + OFF_KDT + (pc >> 3) * JS + (pc & 7) * 16) = pk_[s_][p];
                *(LAS u32x4*)(lds + OFF_VT + tr_off(pc >> 4, pc & 15)) = pv_[s_][p];
                if (PB) *(LAS u32x4*)(lds + OFF_QS + (pc >> 4) * QS + (pc & 15) * 16) = pq_[s_][p]; }
            if (PB) *(LAS u32x4*)(lds + OFF_AS + r64 * JS + c8 * 16) = pa_[s_];
            if (tid < 128) { *(LAS float*)(lds + OFF_DS + tid * 4) = __expf(pbl[s_]); logD += pbl[s_]; }
            __syncthreads();
            if (ci + DEPTH < 16) GLA_SCAN_LOADS(s_, ci + DEPTH);
            bf16x8 vfr[2];
            { u32x2 t0[2], t1[2];
              TR_FRAG_ISSUE(t0[0], t1[0], ldsb + OFF_VT, lane, w, 0); TR_FRAG_ISSUE(t0[1], t1[1], ldsb + OFF_VT, lane, w, 1);
              asm volatile("s_waitcnt lgkmcnt(0)" : "+v"(t0[0]), "+v"(t1[0]), "+v"(t0[1]), "+v"(t1[1]) :: "memory");
              vfr[0] = tr_join(t0[0], t1[0]); vfr[1] = tr_join(t0[1], t1[1]); }
            f32x4 oacc[4];
            if (PB) {
#pragma unroll
                for (int mt = 0; mt < 4; ++mt) oacc[mt] = (f32x4){0.f, 0.f, 0.f, 0.f};
                const unsigned qb = ldsb + OFF_QS + l15 * QS + g * 16, sbb = ldsb + OFF_SB + (16 * w + l15) * QS + g * 16;
#pragma unroll
                for (int ks = 0; ks < 4; ++ks) { bf16x8 sf, qf[4];
                    LDS_RD128_O(sf, sbb + ks * 64, 0); LDS_RD4(qf, qb + ks * 64, 16 * QS);
                    LDS_WAIT4(qf[0], qf[1], qf[2], qf[3]); asm volatile("" : "+v"(sf));
#pragma unroll
                    for (int mt = 0; mt < 4; ++mt) oacc[mt] = __builtin_amdgcn_mfma_f32_16x16x32_bf16(qf[mt], sf, oacc[mt], 0, 0, 0); }
                { const unsigned ab = ldsb + OFF_AS + l15 * JS + g * 16;
#pragma unroll
                  for (int ks = 0; ks < 2; ++ks) { bf16x8 af[4];
                      LDS_RD4(af, ab + ks * 64, 16 * JS);
                      LDS_WAIT4(af[0], af[1], af[2], af[3]);
#pragma unroll
                      for (int mt = 0; mt < 4; ++mt) oacc[mt] = __builtin_amdgcn_mfma_f32_16x16x32_bf16(af[mt], vfr[ks], oacc[mt], 0, 0, 0); } }
            }
#pragma unroll
            for (int mt = 0; mt < 8; ++mt) { const f32x4 dsc = *(const LAS f32x4*)(lds + OFF_DS + (16 * mt + 4 * g) * 4);
                Sst[mt] = Sst[mt] * dsc; }
            { const unsigned kb = ldsb + OFF_KDT + l15 * JS + g * 16;
#pragma unroll
              for (int ks = 0; ks < 2; ++ks) { bf16x8 kf[8];
                  LDS_RD8(kf, kb + ks * 64, 16 * JS);
                  LDS_WAIT8(kf[0], kf[1], kf[2], kf[3], kf[4], kf[5], kf[6], kf[7]);
#pragma unroll
                  for (int mt = 0; mt < 8; ++mt) Sst[mt] = __builtin_amdgcn_mfma_f32_16x16x32_bf16(kf[mt], vfr[ks], Sst[mt], 0, 0, 0); } }
            __syncthreads();
            if (PB) {
#pragma unroll
                for (int mt = 0; mt < 8; ++mt) { u32x2 pw; pw.x = pk2(Sst[mt][0], Sst[mt][1]); pw.y = pk2(Sst[mt][2], Sst[mt][3]);
                    *(LAS u32x2*)(lds + OFF_SB + (16 * w + l15) * QS + (16 * mt + 4 * g) * 2) = pw; }
#pragma unroll
                for (int mt = 0; mt < 4; ++mt)
#pragma unroll
                    for (int r = 0; r < 4; ++r) *(LAS unsigned short*)(lds + OFF_OB + (16 * mt + 4 * g + r) * QS + (16 * w + l15) * 2) = (unsigned short)f2bf(oacc[mt][r]);
                __syncthreads();
#pragma unroll
                for (int p = 0; p < 2; ++p) { const int pc = tid + 512 * p, i = pc >> 4, tau = tau0 + i, t = dir ? (S_ - 1 - tau) : tau;
                    *(u32x4*)(O + ((size_t)dir * T_ + (size_t)(b * S_ + t)) * 1024 + h * 256 + eh * 128 + (pc & 15) * 8) = *(const LAS u32x4*)(lds + OFF_OB + i * QS + (pc & 15) * 16); }
            }
          }
        }
#undef GLA_SCAN_LOADS
        if (!PB) {
            float* Lp = Lbuf + (size_t)gla_lidx(stream, eh, sg) * 16384;
#pragma unroll
            for (int mt = 0; mt < 8; ++mt)
#pragma unroll
                for (int r = 0; r < 4; ++r) Lp[(mt * 4 + r) * 512 + tid] = Sst[mt][r];
            if (tid < 128 && eh == 0) DSEG[(stream * 16 + sg) * 128 + tid] = logD;
        }
        __syncthreads();
    }
}

__device__ void gla_post_phase(const Args& a) {
    const int lane = threadIdx.x & 63, wave = threadIdx.x >> 6, W = gridDim.x * 8;
    const bf16_t* O = (const bf16_t*)(a.ws + WS_O);
    const bf16_t* P = (const bf16_t*)(a.ws + WS_P);
    bf16_t* GO = (bf16_t*)(a.ws + WS_XN);
    const float* ng = a.in[I_GNG];
    const int e0 = lane * 16;
    float ngv[16];
#pragma unroll
    for (int j = 0; j < 16; ++j) ngv[j] = ng[(e0 + j) & 255];
    const int row_first = blockIdx.x * 8 + wave;
    u32x4 f[2], bk[2], rr[2];
#define GLA_POST_LOAD(F, B, R, ROW) do { _Pragma("unroll") for (int q = 0; q < 2; ++q) { F[q] = *(const u32x4*)(O + (size_t)(ROW) * 1024 + e0 + 8 * q); \
        B[q] = *(const u32x4*)(O + ((size_t)T_ + (ROW)) * 1024 + e0 + 8 * q); R[q] = *(const u32x4*)(P + (size_t)(ROW) * PW + PC_R + e0 + 8 * q); } } while (0)
    if (row_first < T_) GLA_POST_LOAD(f, bk, rr, row_first);
    for (int row = row_first; row < T_; row += W) {
        u32x4 fn[2], bn[2], rn[2];
        { const int rnx = row + W < T_ ? row + W : row; GLA_POST_LOAD(fn, bn, rn, rnx); }
        float v[16]; float ss = 0.f;
#pragma unroll
        for (int q = 0; q < 2; ++q) {
            const unsigned fw[4] = {f[q].x, f[q].y, f[q].z, f[q].w}, bw[4] = {bk[q].x, bk[q].y, bk[q].z, bk[q].w};
#pragma unroll
            for (int j = 0; j < 4; ++j) { v[8 * q + 2 * j] = bflo(fw[j]) + bflo(bw[j]); v[8 * q + 2 * j + 1] = bfhi(fw[j]) + bfhi(bw[j]); } }
#pragma unroll
        for (int j = 0; j < 16; ++j) ss += v[j] * v[j];
#pragma unroll
        for (int o = 8; o >= 1; o >>= 1) ss += __shfl_xor(ss, o);
        const float rstd = rsqrtf(ss * (1.0f / 256.0f) + EPS);
        unsigned ow[8];
#pragma unroll
        for (int q = 0; q < 2; ++q) { const unsigned rw[4] = {rr[q].x, rr[q].y, rr[q].z, rr[q].w};
#pragma unroll
            for (int j = 0; j < 4; ++j) {
                const float r0 = bflo(rw[j]), r1 = bfhi(rw[j]);
                const float y0 = v[8 * q + 2 * j] * rstd * ngv[8 * q + 2 * j] * (r0 * sigmoidf_(r0)), y1 = v[8 * q + 2 * j + 1] * rstd * ngv[8 * q + 2 * j + 1] * (r1 * sigmoidf_(r1));
                ow[4 * q + j] = pk2(y0, y1); } }
        if (F8_GLA) {
            u32x4 o8;
#pragma unroll
            for (int q4 = 0; q4 < 4; ++q4) o8[q4] = (unsigned)pack_fp8x4(bflo(ow[2 * q4]), bfhi(ow[2 * q4]), bflo(ow[2 * q4 + 1]), bfhi(ow[2 * q4 + 1]));
            *(u32x4*)((unsigned char*)GO + (size_t)row * 1024 + e0) = o8;
        } else {
        *(u32x4*)(GO + (size_t)row * 1024 + e0) = (u32x4){ow[0], ow[1], ow[2], ow[3]};
        *(u32x4*)(GO + (size_t)row * 1024 + e0 + 8) = (u32x4){ow[4], ow[5], ow[6], ow[7]};
        }
#pragma unroll
        for (int q = 0; q < 2; ++q) { f[q] = fn[q]; bk[q] = bn[q]; rr[q] = rn[q]; }
    }
#undef GLA_POST_LOAD
}

__device__ __forceinline__ unsigned f2ord(float f) { const unsigned u = __float_as_uint(f); return (u & 0x80000000u) ? ~u : (u | 0x80000000u); }
__device__ __forceinline__ float ord2f(unsigned o) { return __uint_as_float((o & 0x80000000u) ? (o & 0x7fffffffu) : ~o); }
#define CE_DESC(x, y) do { const unsigned _hi = max((x), (y)), _lo = min((x), (y)); (x) = _hi; (y) = _lo; } while (0)
#define CE_ASC(x, y) do { const unsigned _hi = max((x), (y)), _lo = min((x), (y)); (x) = _lo; (y) = _hi; } while (0)
template <int N> __device__ __forceinline__ void bitonic_sort_desc(unsigned (&k)[N]) {
#pragma unroll
    for (int sz = 2; sz <= N; sz <<= 1)
#pragma unroll
        for (int j = sz >> 1; j > 0; j >>= 1)
#pragma unroll
            for (int i = 0; i < N; ++i) { const int l = i ^ j; if (l > i) { if ((i & sz) == 0) CE_DESC(k[i], k[l]); else CE_ASC(k[i], k[l]); } }
}
template <int N> __device__ __forceinline__ void bitonic_merge_desc(unsigned (&k)[N]) {
#pragma unroll
    for (int j = N >> 1; j > 0; j >>= 1)
#pragma unroll
        for (int i = 0; i < N; ++i) { const int l = i ^ j; if (l > i) CE_DESC(k[i], k[l]); }
}
#define CE2_DESC(kx, px, ky, py) do { const bool _sw = (ky) > (kx); const unsigned _k0 = _sw ? (ky) : (kx), _k1 = _sw ? (kx) : (ky), _p0 = _sw ? (py) : (px), _p1 = _sw ? (px) : (py); \
        (kx) = _k0; (ky) = _k1; (px) = _p0; (py) = _p1; } while (0)
template <int N> __device__ __forceinline__ void bitonic_sort_desc2(unsigned (&k)[N], unsigned (&p)[N]) {
#pragma unroll
    for (int sz = 2; sz <= N; sz <<= 1)
#pragma unroll
        for (int j = sz >> 1; j > 0; j >>= 1)
#pragma unroll
            for (int i = 0; i < N; ++i) { const int l = i ^ j; if (l > i) { if ((i & sz) == 0) CE2_DESC(k[i], p[i], k[l], p[l]); else CE2_DESC(k[l], p[l], k[i], p[i]); } }
}
template <int N> __device__ __forceinline__ void bitonic_merge_desc2(unsigned (&k)[N], unsigned (&p)[N]) {
#pragma unroll
    for (int j = N >> 1; j > 0; j >>= 1)
#pragma unroll
        for (int i = 0; i < N; ++i) { const int l = i ^ j; if (l > i) CE2_DESC(k[i], p[i], k[l], p[l]); }
}
__device__ __forceinline__ void lane_merge16(unsigned (&k)[16], int xm) {
    unsigned o[16];
#pragma unroll
    for (int i = 0; i < 16; ++i) o[i] = (unsigned)__shfl_xor((int)k[i], xm);
#pragma unroll
    for (int i = 0; i < 16; ++i) k[i] = max(k[i], o[15 - i]);
    bitonic_merge_desc<16>(k);
}
__device__ __forceinline__ void lane_merge16_2(unsigned (&k)[16], unsigned (&p)[16], int xm) {
    unsigned ok[16], op[16];
#pragma unroll
    for (int i = 0; i < 16; ++i) { ok[i] = (unsigned)__shfl_xor((int)k[i], xm); op[i] = (unsigned)__shfl_xor((int)p[i], xm); }
#pragma unroll
    for (int i = 0; i < 16; ++i) { const bool sw = ok[15 - i] > k[i]; k[i] = sw ? ok[15 - i] : k[i]; p[i] = sw ? op[15 - i] : p[i]; }
    bitonic_merge_desc2<16>(k, p);
}

__device__ void peer_select_phase(const Args& a, ldsp_t lds) {
    const int tid = threadIdx.x, lane = tid & 63, wave = tid >> 6, g = lane >> 4, l15 = lane & 15, W = gridDim.x * 8;
    const bf16_t* QP = (const bf16_t*)(a.ws + WS_QP);
    const bf16_t* KB = (const bf16_t*)(a.ws + WS_KEYS);
    int* IDX = (int*)(a.ws + WS_IDX); float* GW = (float*)(a.ws + WS_G);
    constexpr int KS = 272, OFF_TL = 2 * 128 * KS;
    static_assert(OFF_TL + 8 * 8192 <= LDS_BYTES - 16, "select LDS");
    const unsigned ldsb = (unsigned)(size_t)lds;
    LAS unsigned* tl = (LAS unsigned*)(lds + OFF_TL + wave * 8192);
    for (int h = 0; h < 8; ++h) {
        __syncthreads();
#pragma unroll
        for (int p = 0; p < 8; ++p) { const int pc = tid + 512 * p, row = pc >> 4, c16 = pc & 15;
            *(LAS u32x4*)(lds + row * KS + c16 * 16) = *(const u32x4*)(KB + (size_t)(h * 256 + row) * 128 + c16 * 8); }
        __syncthreads();
      for (int grp = blockIdx.x * 8 + wave; grp < 2048; grp += W) {
        const int tok0 = grp * 16, tok = tok0 + l15;
        bf16x8 bq[2][4];
#pragma unroll
        for (int hf = 0; hf < 2; ++hf)
#pragma unroll
            for (int ks = 0; ks < 4; ++ks) bq[hf][ks] = *(const bf16x8*)(QP + (size_t)tok * 2048 + h * 256 + hf * 128 + 32 * ks + 8 * g);
#pragma unroll 1
        for (int hf = 0; hf < 2; ++hf) {
            f32x4 acc[8];
#pragma unroll
            for (int mt = 0; mt < 8; ++mt) acc[mt] = (f32x4){0.f, 0.f, 0.f, 0.f};
            const unsigned kbase = ldsb + (unsigned)((hf * 128 + l15) * KS + g * 16);
#pragma unroll
            for (int ks = 0; ks < 4; ++ks) { bf16x8 af[8];
                LDS_RD8(af, kbase + ks * 64, 16 * KS);
                LDS_WAIT8(af[0], af[1], af[2], af[3], af[4], af[5], af[6], af[7]);
                const bf16x8 bfr = hf ? bq[1][ks] : bq[0][ks];
#pragma unroll
                for (int mt = 0; mt < 8; ++mt) acc[mt] = __builtin_amdgcn_mfma_f32_16x16x32_bf16(af[mt], bfr, acc[mt], 0, 0, 0); }
            unsigned key[32];
#pragma unroll
            for (int mt = 0; mt < 8; ++mt)
#pragma unroll
                for (int r = 0; r < 4; ++r) { const int n = 16 * mt + 4 * g + r; key[4 * mt + r] = (f2ord(acc[mt][r]) & ~127u) | (unsigned)(127 - n); }
            unsigned lo[16], hi[16];
#pragma unroll
            for (int i = 0; i < 16; ++i) { lo[i] = key[i]; hi[i] = key[16 + i]; }
            bitonic_sort_desc<16>(lo); bitonic_sort_desc<16>(hi);
#pragma unroll
            for (int i = 0; i < 16; ++i) lo[i] = max(lo[i], hi[15 - i]);
            bitonic_merge_desc<16>(lo);
            lane_merge16(lo, 16); lane_merge16(lo, 32);
#pragma unroll
            for (int i = 0; i < 16; ++i) tl[(hf * 16 + i) * 64 + lane] = lo[i];
        }
        unsigned top[2][16];
#pragma unroll
        for (int i = 0; i < 16; ++i) { top[0][i] = tl[i * 64 + lane]; top[1][i] = tl[(16 + i) * 64 + lane]; }
        unsigned ck[16], cp[16];
#pragma unroll
        for (int i = 0; i < 16; ++i) { ck[i] = 0u; cp[i] = 0u; }
#define PEER_CAND(slot, I, J) do { const float _s = ord2f(top[0][I] & ~127u) + ord2f(top[1][J] & ~127u); ck[slot] = f2ord(_s); cp[slot] = ((127u - (top[0][I] & 127u)) << 7) | (127u - (top[1][J] & 127u)); } while (0)
        if (g == 0) { PEER_CAND(0, 0, 0); PEER_CAND(1, 0, 1); PEER_CAND(2, 0, 2); PEER_CAND(3, 0, 3); PEER_CAND(4, 0, 4); PEER_CAND(5, 0, 5); PEER_CAND(6, 0, 6); PEER_CAND(7, 0, 7);
            PEER_CAND(8, 0, 8); PEER_CAND(9, 0, 9); PEER_CAND(10, 0, 10); PEER_CAND(11, 0, 11); PEER_CAND(12, 0, 12); PEER_CAND(13, 0, 13); PEER_CAND(14, 0, 14); PEER_CAND(15, 0, 15); }
        else if (g == 1) { PEER_CAND(0, 1, 0); PEER_CAND(1, 1, 1); PEER_CAND(2, 1, 2); PEER_CAND(3, 1, 3); PEER_CAND(4, 1, 4); PEER_CAND(5, 1, 5); PEER_CAND(6, 1, 6); PEER_CAND(7, 1, 7);
            PEER_CAND(8, 2, 0); PEER_CAND(9, 2, 1); PEER_CAND(10, 2, 2); PEER_CAND(11, 2, 3); PEER_CAND(12, 2, 4); PEER_CAND(13, 3, 0); PEER_CAND(14, 3, 1); PEER_CAND(15, 3, 2); }
        else if (g == 2) { PEER_CAND(0, 3, 3); PEER_CAND(1, 4, 0); PEER_CAND(2, 4, 1); PEER_CAND(3, 4, 2); PEER_CAND(4, 5, 0); PEER_CAND(5, 5, 1); PEER_CAND(6, 6, 0); PEER_CAND(7, 6, 1);
            PEER_CAND(8, 7, 0); PEER_CAND(9, 7, 1); PEER_CAND(10, 8, 0); PEER_CAND(11, 9, 0); PEER_CAND(12, 10, 0); PEER_CAND(13, 11, 0); PEER_CAND(14, 12, 0); PEER_CAND(15, 13, 0); }
        else { PEER_CAND(0, 14, 0); PEER_CAND(1, 15, 0); }
#undef PEER_CAND
        bitonic_sort_desc2<16>(ck, cp);
        lane_merge16_2(ck, cp, 16); lane_merge16_2(ck, cp, 32);
        float ev[16]; float sum = 0.f; const float mx = ord2f(ck[0]);
#pragma unroll
        for (int i = 0; i < 16; ++i) { ev[i] = __expf(ord2f(ck[i]) - mx); sum += ev[i]; }
        const float inv = 1.0f / sum;
#pragma unroll
        for (int i = 0; i < 16; ++i) if ((i >> 2) == g) { IDX[(size_t)tok * 128 + h * 16 + i] = (int)cp[i]; GW[(size_t)tok * 128 + h * 16 + i] = ev[i] * inv; }
      }
    }
}

typedef float f32x16 __attribute__((ext_vector_type(16)));
typedef float f32x32 __attribute__((ext_vector_type(32)));
typedef unsigned u32x6 __attribute__((ext_vector_type(6)));
typedef _Float16 h16x2 __attribute__((ext_vector_type(2)));
typedef _Float16 h16x32 __attribute__((ext_vector_type(32)));
__device__ __forceinline__ float group8_sum(float d) {
    d += __builtin_bit_cast(float, __builtin_amdgcn_update_dpp(0, __builtin_bit_cast(int, d), 0xB1, 0xF, 0xF, true));
    d += __builtin_bit_cast(float, __builtin_amdgcn_update_dpp(0, __builtin_bit_cast(int, d), 0x4E, 0xF, 0xF, true));
    d += __builtin_bit_cast(float, __builtin_amdgcn_update_dpp(0, __builtin_bit_cast(int, d), 0x141, 0xF, 0xF, true));
    return d;
}
constexpr float U_SCALE = 48.0f, V_SCALE = 2.5f;
constexpr size_t WS_PART = WS_QP;
constexpr size_t WS_CF   = WS_VB + (size_t)32 * 1024 * 1024;
constexpr size_t WS_SSP  = WS_CF + (size_t)T_ * 128 * 4;
constexpr size_t WS_H2   = WS_O;
static_assert(WS_SSP + (size_t)T_ * 8 * 4 <= WS_END, "PEER buffers must fit in the P region");
constexpr int PEER_Q1 = 3 * XCD_BAR_WORDS, PEER_Q2 = 3 * XCD_BAR_WORDS + 1024;
constexpr int PEER_CHUNK = 16, PEER_NCHUNK = T_ / PEER_CHUNK;

__device__ void cvt_rows_fp6_sliced(const Args& a, const float* src, unsigned char* dst, int nrows, float scale) {
    const size_t gt = (size_t)blockIdx.x * 512 + threadIdx.x, gs = (size_t)gridDim.x * 512;
    for (size_t idx = gt; idx < (size_t)nrows * 64; idx += gs) {
        const size_t row = idx >> 6; const int l = (int)(idx & 63), sl = l >> 3, q = l & 7;
        const float* sp = src + row * 2048 + 32 * l;
        f32x16 a, b;
#pragma unroll
        for (int i = 0; i < 8; ++i) { const f32x4 vv = *(const f32x4*)(sp + 4 * i);
            a[2 * i] = fminf(fmaxf(vv[0] * scale, -7.5f), 7.5f); b[2 * i] = fminf(fmaxf(vv[1] * scale, -7.5f), 7.5f);
            a[2 * i + 1] = fminf(fmaxf(vv[2] * scale, -7.5f), 7.5f); b[2 * i + 1] = fminf(fmaxf(vv[3] * scale, -7.5f), 7.5f); }
        const u32x6 pk = __builtin_amdgcn_cvt_scalef32_2xpk16_fp6_f32(a, b, 1.0f);
        unsigned char* dp = dst + ((size_t)sl * 16384 + row) * 192;
        *(u32x4*)(dp + 16 * q) = (u32x4){pk[0], pk[1], pk[2], pk[3]};
        *(u32x2*)(dp + 128 + 8 * q) = (u32x2){pk[4], pk[5]};
    }
}
__device__ __forceinline__ float gelu_erf(float x) { return 0.5f * x * (1.0f + erff(x * 0.70710678118654752f)); }

#define PEER_PULL_BEGIN(QBASE) { unsigned* qh_ = (unsigned*)(a.ws + WS_CTL) + (QBASE) + a.li; int s = (int)(xb_xcc_id() & 7u), tried_ = 0; \
        while (tried_ < 8) { unsigned c_ = 0u; if (lane == 0) c_ = __hip_atomic_fetch_add(qh_ + 64 * s, 1u, __ATOMIC_RELAXED, __HIP_MEMORY_SCOPE_AGENT); \
            const int chunk = (int)__builtin_amdgcn_readfirstlane(c_); \
            if (chunk >= PEER_NCHUNK) { s = (s + 1) & 7; ++tried_; continue; } \
            tried_ = 0;
#define PEER_PULL_END } }

__device__ void peer_stage1_phase(const Args& a) {
    const int lane = threadIdx.x & 63, p = lane >> 3, q = lane & 7, gl = lane & ~7;
    const bf16_t* XN = (const bf16_t*)(a.ws + WS_XN);
    const unsigned char* UB = a.ws + WS_UB;
    const int* IDX = (const int*)(a.ws + WS_IDX);
    bf16_t* PART = (bf16_t*)(a.ws + WS_PART);
    PEER_PULL_BEGIN(PEER_Q1)
        const unsigned char* ubase = UB + (size_t)s * 16384 * 192;
        for (int th = 0; th < PEER_CHUNK / 8; ++th) { const int tok = chunk * PEER_CHUNK + 8 * th + p;
            h16x2 xh[16];
#pragma unroll
            for (int i = 0; i < 4; ++i) { const u32x4 xv = *(const u32x4*)(XN + (size_t)tok * 2048 + s * 256 + 32 * q + 8 * i); const unsigned xs[4] = {xv.x, xv.y, xv.z, xv.w};
#pragma unroll
                for (int j = 0; j < 4; ++j) xh[4 * i + j] = (h16x2){(_Float16)bflo(xs[j]), (_Float16)bfhi(xs[j])}; }
            bf16_t* prow = PART + ((size_t)s * T_ + tok) * 128;
            const int* idp = IDX + (size_t)tok * 128 + q;
            u32x4 faA[8]; u32x2 fbA[8];
            const unsigned qo4 = 16u * q, qo2 = 8u * q; const unsigned char* ubase2 = ubase + 128;
#define PEER_S1_LOAD(FA, FB, IDV) do { _Pragma("unroll") for (int kq = 0; kq < 8; ++kq) { const unsigned ro_ = __umul24((unsigned)__shfl(IDV, gl + kq), 192u);     \
                FA[kq] = *(const u32x4*)(ubase + (ro_ + qo4)); FB[kq] = *(const u32x2*)(ubase2 + (ro_ + qo2)); } } while (0)
#define PEER_S1_USE(FA, FB, J) do { float mine_ = 0.f; _Pragma("unroll") for (int kq = 0; kq < 8; ++kq) { const u32x6 pk_ = {FA[kq].x, FA[kq].y, FA[kq].z, FA[kq].w, FB[kq].x, FB[kq].y}; \
                const h16x32 uf_ = __builtin_amdgcn_cvt_scalef32_pk32_f16_fp6(pk_, 1.0f); \
                float dd_ = 0.f; \
                _Pragma("unroll") for (int jj = 0; jj < 16; ++jj) dd_ = __builtin_amdgcn_fdot2((h16x2){uf_[2 * jj], uf_[2 * jj + 1]}, xh[jj], dd_, false); \
                const float d_ = group8_sum(dd_); \
                mine_ = (q == kq) ? d_ : mine_; } \
                prow[8 * (J) + q] = (bf16_t)f2bf(mine_); } while (0)
            int idn = idp[0];
#pragma unroll 1
            for (int j = 0; j < 16; ++j) {
                const int idj = idn; if (j < 15) idn = idp[8 * (j + 1)];
                PEER_S1_LOAD(faA, fbA, idj);
                PEER_S1_USE(faA, fbA, j);
            }
#undef PEER_S1_LOAD
#undef PEER_S1_USE
        }
    PEER_PULL_END
}

__device__ void peer_cf_phase(const Args& a) {
    const bf16_t* PART = (const bf16_t*)(a.ws + WS_PART); const float* GW = (const float*)(a.ws + WS_G); float* CF = (float*)(a.ws + WS_CF);
    const size_t n = (size_t)T_ * 128;
    for (size_t i = ((size_t)blockIdx.x * 512 + threadIdx.x) * 4; i < n; i += (size_t)gridDim.x * 512 * 4) {
        u32x2 pw[8];
#pragma unroll
        for (int s = 0; s < 8; ++s) pw[s] = *(const u32x2*)(PART + (size_t)s * n + i);
        const f32x4 gw = *(const f32x4*)(GW + i);
        f32x4 d = {0.f, 0.f, 0.f, 0.f};
#pragma unroll
        for (int s = 0; s < 8; ++s) { d[0] += bflo(pw[s].x); d[1] += bfhi(pw[s].x); d[2] += bflo(pw[s].y); d[3] += bfhi(pw[s].y); }
        f32x4 r;
#pragma unroll
        for (int j = 0; j < 4; ++j) r[j] = gw[j] * gelu_erf(d[j] * (1.0f / U_SCALE)) * (1.0f / V_SCALE);
        *(f32x4*)(CF + i) = r;
    }
}

__device__ __forceinline__ unsigned cf_h2(float c) { const h16x2 h = {(_Float16)c, (_Float16)c}; return __builtin_bit_cast(unsigned, h); }
template <bool DRY> __device__ void peer_stage2_phase(const Args& a) {
    const int lane = threadIdx.x & 63, p = lane >> 3, q = lane & 7, gl = lane & ~7;
    const unsigned char* VB = a.ws + WS_VB;
    const int* IDX = (const int*)(a.ws + WS_IDX); const float* CF = (const float*)(a.ws + WS_CF);
    bf16_t* O2 = (bf16_t*)(a.ws + WS_H2);
    PEER_PULL_BEGIN(PEER_Q2)
        const unsigned char* vbase = VB + (size_t)s * 16384 * 192;
        for (int th = 0; th < PEER_CHUNK / 8; ++th) { const int tok = chunk * PEER_CHUNK + 8 * th + p;
            h16x2 o[16];
#pragma unroll
            for (int j = 0; j < 16; ++j) o[j] = (h16x2){(_Float16)0.f, (_Float16)0.f};
            u32x4 faA[4], faB[4]; u32x2 fbA[4], fbB[4];
            const unsigned qo4 = 16u * q, qo2 = 8u * q; const unsigned char* vbase2 = vbase + 128;
            int idj = IDX[(size_t)tok * 128 + q]; unsigned cfj = cf_h2(CF[(size_t)tok * 128 + q]);
#define PEER_S2_LOAD(FA, FB, IDV, K0) do { _Pragma("unroll") for (int kq = 0; kq < 4; ++kq) { const unsigned ro_ = __umul24((unsigned)__shfl(IDV, gl + (K0) + kq), 192u);     \
                FA[kq] = *(const u32x4*)(vbase + (ro_ + qo4)); FB[kq] = *(const u32x2*)(vbase2 + (ro_ + qo2)); } } while (0)
#define PEER_S2_USE(FA, FB, CFV, K0) do { _Pragma("unroll") for (int kq = 0; kq < 4; ++kq) { const h16x2 cf_ = __builtin_bit_cast(h16x2, (unsigned)__shfl((int)(CFV), gl + (K0) + kq)); \
                const u32x6 pk_ = {FA[kq].x, FA[kq].y, FA[kq].z, FA[kq].w, FB[kq].x, FB[kq].y}; \
                const h16x32 vf_ = __builtin_amdgcn_cvt_scalef32_pk32_f16_fp6(pk_, 1.0f); \
                _Pragma("unroll") for (int jj = 0; jj < 16; ++jj) o[jj] = (h16x2){vf_[2 * jj], vf_[2 * jj + 1]} * cf_ + o[jj]; } } while (0)
            PEER_S2_LOAD(faA, fbA, idj, 0);
#pragma unroll 1
            for (int j = 0; j < 16; ++j) {
                const int jn = j < 15 ? j + 1 : 15;
                const int idn = IDX[(size_t)tok * 128 + 8 * jn + q]; const unsigned cfn = cf_h2(CF[(size_t)tok * 128 + 8 * jn + q]);
                PEER_S2_LOAD(faB, fbB, idj, 4);
                PEER_S2_USE(faA, fbA, cfj, 0);
                PEER_S2_LOAD(faA, fbA, idn, 0);
                PEER_S2_USE(faB, fbB, cfj, 4);
                idj = idn; cfj = cfn;
            }
#undef PEER_S2_LOAD
#undef PEER_S2_USE
            { const int d0 = s * 256 + 32 * q;
#pragma unroll
              for (int i = 0; i < 4; ++i) { const u32x4 w = {pk2((float)o[4 * i].x, (float)o[4 * i].y), pk2((float)o[4 * i + 1].x, (float)o[4 * i + 1].y), pk2((float)o[4 * i + 2].x, (float)o[4 * i + 2].y), pk2((float)o[4 * i + 3].x, (float)o[4 * i + 3].y)};
                  if (!DRY || (float)o[0].x == 123.456f) *(u32x4*)(O2 + (size_t)tok * 2048 + d0 + 8 * i) = w; } }
        }
    PEER_PULL_END
}

__device__ void peer_final_phase(const Args& a) {
    const int lane = threadIdx.x & 63, wave = threadIdx.x >> 6, W = gridDim.x * 8;
    const bf16_t* O2 = (const bf16_t*)(a.ws + WS_H2); const float* fg = a.in[I_FNG]; const float* mod = (const float*)(a.ws + WS_MOD);
    float* H = a.out; const bf16_t* HB = (const bf16_t*)(a.ws + WS_HB);
    f32x4 F[8], G2[8]; int bcur = -1;
#pragma unroll
    for (int i = 0; i < 4; ++i) { const int d0 = (i * 64 + lane) * 8; F[2 * i] = *(const f32x4*)(fg + d0); F[2 * i + 1] = *(const f32x4*)(fg + d0 + 4); }
    const int tok_first = blockIdx.x * 8 + wave;
    u32x4 hw[4], ow[4];
    if (tok_first < T_) {
#pragma unroll
        for (int i = 0; i < 4; ++i) { const int d0 = (i * 64 + lane) * 8; hw[i] = *(const u32x4*)(HB + (size_t)tok_first * 2048 + d0); ow[i] = *(const u32x4*)(O2 + (size_t)tok_first * 2048 + d0); } }
    for (int tok = tok_first; tok < T_; tok += W) {
        const int b = tok >> 14;
        if (b != bcur) { bcur = b;
#pragma unroll
            for (int i = 0; i < 4; ++i) { const int d0 = (i * 64 + lane) * 8; G2[2 * i] = *(const f32x4*)(mod + b * 12288 + 5 * 2048 + d0); G2[2 * i + 1] = *(const f32x4*)(mod + b * 12288 + 5 * 2048 + d0 + 4); } }
        u32x4 hn[4], on[4];
        { const int tn = tok + W < T_ ? tok + W : tok;
#pragma unroll
          for (int i = 0; i < 4; ++i) { const int d0 = (i * 64 + lane) * 8; hn[i] = *(const u32x4*)(HB + (size_t)tn * 2048 + d0); on[i] = *(const u32x4*)(O2 + (size_t)tn * 2048 + d0); } }
        float hv[32]; float ss = 0.f;
#pragma unroll
        for (int i = 0; i < 4; ++i) {
            const unsigned os[4] = {ow[i].x, ow[i].y, ow[i].z, ow[i].w}, hs[4] = {hw[i].x, hw[i].y, hw[i].z, hw[i].w};
#pragma unroll
            for (int j = 0; j < 4; ++j) { const f32x4 gq = G2[2 * i + (j >> 1)];
                hv[8 * i + 2 * j] = bflo(hs[j]) + gq[2 * (j & 1)] * bflo(os[j]); hv[8 * i + 2 * j + 1] = bfhi(hs[j]) + gq[2 * (j & 1) + 1] * bfhi(os[j]); }
#pragma unroll
            for (int j = 0; j < 8; ++j) ss += hv[8 * i + j] * hv[8 * i + j]; }
        ss = wave_sum(ss);
        const float rstd = rsqrtf(ss * (1.0f / 2048.0f) + EPS);
#pragma unroll
        for (int i = 0; i < 4; ++i) { const int d0 = (i * 64 + lane) * 8;
            f32x4 r0, r1;
#pragma unroll
            for (int j = 0; j < 4; ++j) { r0[j] = hv[8 * i + j] * rstd * F[2 * i][j]; r1[j] = hv[8 * i + 4 + j] * rstd * F[2 * i + 1][j]; }
            *(f32x4*)(H + (size_t)tok * 2048 + d0) = r0; *(f32x4*)(H + (size_t)tok * 2048 + d0 + 4) = r1; }
#pragma unroll
        for (int i = 0; i < 4; ++i) { hw[i] = hn[i]; ow[i] = on[i]; }
    }
}

__global__ void __launch_bounds__(512, 2) mega(Args a) {
    extern __shared__ __attribute__((aligned(16))) unsigned char lds_raw[];
    ldsp_t lds = (ldsp_t)lds_raw;
    cg::grid_group grid = cg::this_grid();
    const int lo = a.ph_lo, hi = a.ph_hi;
    unsigned char* ws = a.ws;
    const float* mod = (const float*)(ws + WS_MOD);
#ifdef ONLY_PHASE
#define IN(k) ((k) == ONLY_PHASE && lo <= (k) && (k) < hi)
#elif defined(SKIP_PHASE)
#define IN(k) ((k) != SKIP_PHASE && (k) != SKIP_PHASE2 && lo <= (k) && (k) < hi)
#else
#define IN(k) (lo <= (k) && (k) < hi)
#endif
    volatile LAS unsigned* bst = (volatile LAS unsigned*)(lds + LDS_BYTES - 16);
    if (threadIdx.x == 0) { bst[0] = 0u; bst[1] = 0u; }
    __syncthreads();
    XcdBarrier xbar = xcd_barrier_post((unsigned*)(ws + WS_CTL) + a.li * XCD_BAR_WORDS, bst, (int)(threadIdx.x >> 6));
#define SEAM(k) do { if (IN(k) && IN((k) + 1)) { if ((k) == 0) grid.sync(); else xcd_barrier(xbar); } } while (0)
#ifndef DUP_PHASE
#define DUP_PHASE (-1)
#endif
#define REP(k)

    if (IN(0)) phase0(a, lds);
    SEAM(0);
    if (IN(1)) norm_phase<true>(a, a.in[I_X], a.in[I_N1G], mod, mod + 2048, F8_MASK == 0xFFFFFFFFu ? nullptr : (bf16_t*)(ws + WS_XN), (const bf16_t*)(ws + WS_WIN8 + (size_t)8192 * 2048), (bf16_t*)(ws + WS_P), lds);
    SEAM(1);
    if (IN(2)) {
        {
            LAS unsigned char* lut = lds + 131072;
            for (int i = threadIdx.x; i < 1024; i += 512) lut[i] = (unsigned char)(sigmoidf_(((float)i - 511.5f) * (1.0f / 64.0f)) * 255.0f + 0.5f);
            __syncthreads();
        }
#define PROJ_SEG(T0, T1, F8) do { if ((T1) > (T0)) { \
        pg8::Gemm g{(F8) ? (const bf16_t*)a.out : (const bf16_t*)(ws + WS_XN), (F8) ? (const bf16_t*)(ws + WS_WIN8 + (size_t)(T0) * 256 * 2048) : (const bf16_t*)(ws + WS_WIN) + (size_t)(T0) * 256 * 2048, T_, ((T1) - (T0)) * 256, 2048, 2048}; \
        pg8::StaticOrder S; S.init(T_, ((T1) - (T0)) * 256, gridDim.x, blockIdx.x); \
        pg8::EpiIn E{(bf16_t*)(ws + WS_P), (T0), (F8) ? 1.0f / WIN8_SCALE : 1.0f, (const LAS unsigned char*)(lds + 131072)}; \
        pg8::gemm_phase<pg8::EpiIn, pg8::StaticOrder, F8>(lds, g, S, E); } } while (0)
#if F8_MASK == 0xFFFFFFFFu
        PROJ_SEG(0, 32, true);
#elif F8_MASK == 0xFFFF0000u
        PROJ_SEG(0, 16, false); PROJ_SEG(16, 32, true);
#elif F8_MASK == 0xFFFF000Fu
        PROJ_SEG(0, 4, true); PROJ_SEG(4, 16, false); PROJ_SEG(16, 32, true);
#elif F8_MASK == 0xFFFFFF0Fu
        PROJ_SEG(0, 4, true); PROJ_SEG(4, 8, false); PROJ_SEG(8, 32, true);
#elif F8_MASK == 0u
        PROJ_SEG(0, 32, false);
#else
#error "unsupported F8_MASK"
#endif
#undef PROJ_SEG
    }
    SEAM(2);
    if (IN(3)) { fft1_phase(a, lds); __syncthreads(); }
    if (IN(4)) gla_pre_phase(a, lds);
    if (IN(5)) gla_scan_phase<false>(a, lds);
    SEAM(5);
    if (IN(6)) { fft2_phase(a, lds); __syncthreads(); }
    if (IN(7)) gla_scan_phase<true>(a, lds);
    SEAM(7);
    if (IN(8)) gla_post_phase(a);
    SEAM(8);
    if (IN(9)) {
        {
            pg8::Gemm g{(const bf16_t*)a.out + (size_t)T_ * 2048, (const bf16_t*)(ws + WS_WFN), T_, 2048, 1024, 1024};
            pg8::StaticOrder S; S.init(T_, 2048, gridDim.x, blockIdx.x);
            pg8::EpiGate<0> E{(bf16_t*)(ws + WS_O), 2048, ws + WS_P + 8192, PW * 2, F8_FNET ? 1.0f / (ZA8_SCALE * WFN8_SCALE) : 1.0f, nullptr};
            pg8::gemm_phase<pg8::EpiGate<0>, pg8::StaticOrder, F8_FNET != 0>(lds, g, S, E);
        }
        {
            pg8::Gemm g{(const bf16_t*)(ws + WS_XN), (const bf16_t*)(ws + WS_WGLA), T_, 2048, 1024, 1024};
            pg8::StaticOrder S; S.init(T_, 2048, gridDim.x, blockIdx.x);
            pg8::EpiGate<1, F8_OUT != 0> E{(bf16_t*)(ws + WS_O), 2048, ws + WS_P + 8192 + 2048, PW * 2, F8_GLA ? 1.0f / WIN8_SCALE : 1.0f, ws + WS_MIX8};
            pg8::gemm_phase<pg8::EpiGate<1, F8_OUT != 0>, pg8::StaticOrder, F8_GLA != 0>(lds, g, S, E);
        }
    }
    SEAM(9);
    if (IN(10)) {
        pg8::Gemm g{F8_OUT ? (const bf16_t*)(ws + WS_MIX8) : (const bf16_t*)(ws + WS_O), (const bf16_t*)(ws + WS_WOUT), T_, 2048, 2048, 2048};
        pg8::StaticOrder S; S.init(T_, 2048, gridDim.x, blockIdx.x);
        pg8::EpiRes E{a.in[I_X], mod + 2 * 2048, (bf16_t*)(ws + WS_HB), F8_OUT ? 1.0f / WIN8_SCALE : 1.0f};
        pg8::gemm_phase<pg8::EpiRes, pg8::StaticOrder, F8_OUT != 0>(lds, g, S, E);
    }
    SEAM(10);
    if (IN(11)) {
        norm_phase<false, true>(a, (const float*)(ws + WS_HB), a.in[I_N2G], mod + 3 * 2048, mod + 4 * 2048, (bf16_t*)(ws + WS_XN), nullptr, nullptr, lds);
        cvt_rows_fp6_sliced(a, a.in[I_U], ws + WS_UB, 16384, U_SCALE);
        cvt_rows_fp6_sliced(a, a.in[I_V], ws + WS_VB, 16384, V_SCALE);
    }
    SEAM(11);
    if (IN(12)) {
#ifdef CLKPROBE
        unsigned long long c0 = __builtin_amdgcn_s_memtime(), r0 = __builtin_amdgcn_s_memrealtime();
#endif
        pg8::Gemm g{(const bf16_t*)(ws + WS_XN), (const bf16_t*)(ws + WS_WQ), T_, 2048, 2048, 2048};
        pg8::StaticOrder S; S.init(T_, 2048, gridDim.x, blockIdx.x);
        pg8::EpiGate<2> E{(bf16_t*)(ws + WS_QP), 2048, nullptr, 0, 1.0f, nullptr};
        pg8::gemm_phase(lds, g, S, E);
#ifdef CLKPROBE
        unsigned long long c1 = __builtin_amdgcn_s_memtime(), r1 = __builtin_amdgcn_s_memrealtime();
        if (blockIdx.x == 7 && threadIdx.x == 0) { float* pr = (float*)(ws + WS_CTL + 40960); pr[0] = (float)(c1 - c0) / (float)(r1 - r0) * 100.0f; pr[1] = (float)(r1 - r0) * 0.01f; }
#endif
    }
    SEAM(12);
    if (IN(13)) peer_select_phase(a, lds);
    SEAM(13);
    if (IN(14)) peer_stage1_phase(a);
    SEAM(14);
    if (IN(15)) peer_cf_phase(a);
    SEAM(15);
    if (IN(16)) peer_stage2_phase<false>(a);
    SEAM(16);
    if (IN(17)) peer_final_phase(a);
#ifdef PROBE_CVT
    if (IN(22)) {
        unsigned s0 = threadIdx.x * 2654435761u + blockIdx.x;
        float ac0 = 0.f, ac1 = 0.f, ac2 = 0.f, ac3 = 0.f; const h16x2 x1 = {(_Float16)1.f, (_Float16)0.5f};
#pragma unroll 1
        for (int it = 0; it < 2048; ++it) {
#if PROBE_CVT == 1
            const u32x6 pk = {s0, s0 ^ 0x1234567u, s0 + (unsigned)it, s0 * 3u, s0 ^ (unsigned)it, s0 + 77u};
            const h16x32 u = __builtin_amdgcn_cvt_scalef32_pk32_f16_fp6(pk, 1.0f);
#pragma unroll
            for (int jj = 0; jj < 4; ++jj) {
                ac0 = __builtin_amdgcn_fdot2((h16x2){u[8 * jj], u[8 * jj + 1]}, x1, ac0, false); ac1 = __builtin_amdgcn_fdot2((h16x2){u[8 * jj + 2], u[8 * jj + 3]}, x1, ac1, false);
                ac2 = __builtin_amdgcn_fdot2((h16x2){u[8 * jj + 4], u[8 * jj + 5]}, x1, ac2, false); ac3 = __builtin_amdgcn_fdot2((h16x2){u[8 * jj + 6], u[8 * jj + 7]}, x1, ac3, false); }
#elif PROBE_CVT == 2
            const unsigned w[8] = {s0, s0 ^ 0x1234567u, s0 + (unsigned)it, s0 * 3u, s0 ^ (unsigned)it, s0 + 77u, s0 * 5u, s0 ^ 0x55aa55u};
#pragma unroll
            for (int jj = 0; jj < 4; ++jj) {
                ac0 = __builtin_amdgcn_fdot2(__builtin_amdgcn_cvt_scalef32_pk_f16_fp8(w[2 * jj] & 0x77777777u, 1.0f, false), x1, ac0, false); ac1 = __builtin_amdgcn_fdot2(__builtin_amdgcn_cvt_scalef32_pk_f16_fp8(w[2 * jj] & 0x77777777u, 1.0f, true), x1, ac1, false);
                ac2 = __builtin_amdgcn_fdot2(__builtin_amdgcn_cvt_scalef32_pk_f16_fp8(w[2 * jj + 1] & 0x77777777u, 1.0f, false), x1, ac2, false); ac3 = __builtin_amdgcn_fdot2(__builtin_amdgcn_cvt_scalef32_pk_f16_fp8(w[2 * jj + 1] & 0x77777777u, 1.0f, true), x1, ac3, false); }
#else
            const unsigned w[8] = {s0, s0 ^ 0x1234567u, s0 + (unsigned)it, s0 * 3u, s0 ^ (unsigned)it, s0 + 77u, s0 * 5u, s0 ^ 0x55aa55u};
#pragma unroll
            for (int jj = 0; jj < 4; ++jj) {
                ac0 = __builtin_amdgcn_fdot2(__builtin_bit_cast(h16x2, w[2 * jj] & 0x3fff3fffu), x1, ac0, false); ac1 = __builtin_amdgcn_fdot2(__builtin_bit_cast(h16x2, (w[2 * jj] >> 2) & 0x3fff3fffu), x1, ac1, false);
                ac2 = __builtin_amdgcn_fdot2(__builtin_bit_cast(h16x2, w[2 * jj + 1] & 0x3fff3fffu), x1, ac2, false); ac3 = __builtin_amdgcn_fdot2(__builtin_bit_cast(h16x2, (w[2 * jj + 1] >> 2) & 0x3fff3fffu), x1, ac3, false); }
#endif
            s0 = s0 * 1664525u + 1013904223u;
        }
        const float acc = (ac0 + ac1) + (ac2 + ac3);
        if (acc == 123.456f) ((float*)(ws + WS_CTL + 40960))[threadIdx.x] = acc;
    }
#endif
#ifdef PROBE_GEMM
    if (IN(20)) {
        pg8::Gemm g{(const bf16_t*)(ws + WS_XN), (const bf16_t*)(ws + WS_WQ), T_, 2048, 2048, 2048};
        pg8::ProbeOrder S; S.init(T_, 2048, gridDim.x, blockIdx.x);
        pg8::EpiNull E{(float*)(ws + WS_CTL + 32768)};
        pg8::gemm_phase(lds, g, S, E);
    }
#endif
#undef IN
#undef SEAM
}

constexpr int N_PHASES = 18;

extern "C" void kernel_launch(void* const* d_in, const int* in_sizes, int n_in, void* d_out, int out_size, void* d_ws, size_t ws_size, hipStream_t stream) {
    static int grid = 0;
    if (grid == 0) {
        int dev = 0, cus = 0, per_cu = 0;
        (void)hipGetDevice(&dev);
        (void)hipDeviceGetAttribute(&cus, hipDeviceAttributeMultiprocessorCount, dev);
        (void)hipFuncSetAttribute((const void*)mega, hipFuncAttributeMaxDynamicSharedMemorySize, LDS_BYTES);
        (void)hipOccupancyMaxActiveBlocksPerMultiprocessor(&per_cu, (const void*)mega, 512, LDS_BYTES);
        if (per_cu < 1 || n_in != 18 || ws_size < WS_END4 || cus != 256) { fprintf(stderr, "kernel_launch: unexpected configuration (per_cu %d, n_in %d, ws %zu)\n", per_cu, n_in, ws_size); grid = -1; return; }
        grid = cus;
    }
    if (grid < 0) return;
    (void)hipMemsetAsync((char*)d_ws + WS_CTL, 0, 4 * XCD_BAR_WORDS * 4, stream);
    Args a{};
    for (int i = 0; i < 18; ++i) a.in[i] = (const float*)d_in[i];
    a.out = (float*)d_out; a.ws = (unsigned char*)d_ws; a.li = 0; a.pad = 0;
#if DUP_PHASE >= 0
#if DUP_PHASE == 116
    const int lo_[3] = {0, 20, 13}, hi_[3] = {13, 21, N_PHASES};
#elif DUP_PHASE == 122
    const int lo_[3] = {0, 22, 0}, hi_[3] = {N_PHASES, 23, 0};
#elif defined(DUP_FIRST)
    const int lo_[3] = {0, DUP_PHASE, DUP_PHASE}, hi_[3] = {DUP_PHASE, DUP_PHASE + 1, N_PHASES};
#else
    const int lo_[3] = {0, DUP_PHASE, DUP_PHASE + 1}, hi_[3] = {DUP_PHASE + 1, DUP_PHASE + 1, N_PHASES};
#endif
    for (int li = 0; li < 3; ++li) { a.ph_lo = lo_[li]; a.ph_hi = hi_[li]; a.li = li; a.pad = (li == 1) ? 1 : 0;
#ifdef DUP_SKIP
        if (li == 1) continue;
#endif
        if (DUP_PHASE == 100 && li == 1) continue;
        if (a.ph_lo >= a.ph_hi) continue;
        void* args[] = {&a};
        hipError_t e = hipLaunchCooperativeKernel((void*)mega, dim3(grid), dim3(512), args, LDS_BYTES, stream);
        if (e != hipSuccess) fprintf(stderr, "launch %d failed: %s\n", li, hipGetErrorString(e)); }
#else
    a.ph_lo = 0; a.ph_hi = N_PHASES;
    void* args[] = {&a};
    hipError_t e = hipLaunchCooperativeKernel((void*)mega, dim3(grid), dim3(512), args, LDS_BYTES, stream);
    if (e != hipSuccess) fprintf(stderr, "cooperative launch failed: %s (grid %d)\n", hipGetErrorString(e), grid);
#endif
}
```

```cpp
#include <hip/hip_runtime.h>
#include <hip/hip_cooperative_groups.h>
#include <cstdio>
namespace cg = cooperative_groups;

#define LAS __attribute__((address_space(3)))
typedef unsigned short bf16_t;
typedef short bf16x8 __attribute__((ext_vector_type(8)));
typedef float f32x4 __attribute__((ext_vector_type(4)));
typedef float f32x2 __attribute__((ext_vector_type(2)));
typedef unsigned u32x4 __attribute__((ext_vector_type(4)));
typedef unsigned u32x2 __attribute__((ext_vector_type(2)));
typedef LAS unsigned char* ldsp_t;

#ifndef N_PHASE_LAUNCH
#define N_PHASE_LAUNCH 0
#endif

constexpr int T_ = 32768, D_ = 2048, S_ = 16384;
constexpr float EPS = 1e-6f;
constexpr int PW = 8448;
constexpr int PC_Z = 0, PC_Q = 1024, PC_K = 1536, PC_V = 2048, PC_R = 3072, PC_GF = 4096, PC_GG = 6144, PC_A1 = 8192;
constexpr int LDS_BYTES = 147456;

constexpr size_t WS_CTL  = 0;
constexpr size_t WS_MOD  = 65536;
constexpr size_t WS_TW   = WS_MOD + 98304;
constexpr size_t WS_F1   = WS_TW + 131072;
constexpr size_t WS_F2   = WS_F1 + 65536;
constexpr size_t WS_DSEG = WS_F2 + 131072;
constexpr size_t WS_WIN  = WS_DSEG + 131072;
constexpr size_t WS_WFN  = WS_WIN + (size_t)8448 * 2048 * 2;
constexpr size_t WS_WGLA = WS_WFN + (size_t)2048 * 2048 * 2;
constexpr size_t WS_WOUT = WS_WGLA + (size_t)2048 * 1024 * 2;
constexpr size_t WS_WQ   = WS_WOUT + (size_t)2048 * 2048 * 2;
constexpr size_t WS_KEYS = WS_WQ + (size_t)2048 * 2048 * 2;
constexpr size_t WS_L    = WS_KEYS + (size_t)8 * 2 * 128 * 128 * 2;
constexpr size_t WS_XN   = WS_L + (size_t)512 * 16384 * 4;
constexpr size_t WS_O    = WS_XN + (size_t)T_ * 2048 * 2;
constexpr size_t WS_P    = WS_O + (size_t)T_ * 2048 * 2;
constexpr size_t WS_QP   = WS_P;
constexpr size_t WS_IDX  = WS_QP + (size_t)T_ * 2048 * 2;
constexpr size_t WS_G    = WS_IDX + (size_t)T_ * 128 * 4;
constexpr size_t WS_UB   = WS_G + (size_t)T_ * 128 * 4;
constexpr size_t WS_VB   = WS_UB + (size_t)16384 * 2048 * 2;
constexpr size_t WS_END  = WS_P + (size_t)T_ * PW * 2;
static_assert(WS_VB + (size_t)16384 * 2048 * 2 <= WS_END, "late buffers must fit in the P region");
static_assert(WS_END <= (size_t)1000 * 1000 * 1000, "workspace budget");

struct Args { const float* in[18]; float* out; unsigned char* ws; int ph_lo, ph_hi, li, pad; };
enum { I_X = 0, I_C, I_WADA, I_BADA, I_N1G, I_WIN, I_WFNET, I_WA2, I_BA, I_GNG, I_WGLA, I_WOUT, I_N2G, I_WQ, I_KEYS, I_U, I_V, I_FNG };

typedef __bf16 hwbf16x2 __attribute__((ext_vector_type(2)));
__device__ __forceinline__ unsigned f2bf(float f) { const __bf16 b = (__bf16)f; return (unsigned)__builtin_bit_cast(unsigned short, b); }
__device__ __forceinline__ float bf2f(unsigned h) { return __uint_as_float(h << 16); }
__device__ __forceinline__ unsigned pk2(float lo, float hi) { const f32x2 v = {lo, hi}; const hwbf16x2 b = __builtin_convertvector(v, hwbf16x2); return __builtin_bit_cast(unsigned, b); }
__device__ __forceinline__ float bflo(unsigned w) { return __uint_as_float(w << 16); }
__device__ __forceinline__ float bfhi(unsigned w) { return __uint_as_float(w & 0xffff0000u); }
__device__ __forceinline__ int lane_hw() { int l; asm volatile("v_mbcnt_lo_u32_b32 %0, -1, 0\n\tv_mbcnt_hi_u32_b32 %0, -1, %0" : "=v"(l)); return l; }
#define TID_A(a) ((((a).pad) << 6) | lane_hw())
constexpr float WIN8_SCALE = 32.0f;
constexpr size_t WS_WIN8 = (WS_END + (size_t)4096 * 128 * 64 * 2 + (size_t)4096 * 128 * 4 + 255) & ~(size_t)255;
constexpr size_t WS_END3 = WS_WIN8 + (size_t)8448 * 2048;
constexpr size_t WS_XQ8  = WS_O;
constexpr size_t WS_XS   = WS_O + (size_t)T_ * 2048;
constexpr size_t WS_HB   = WS_END;
constexpr size_t WS_END4 = (WS_HB + (size_t)T_ * 2048 * 2) > WS_END3 ? (WS_HB + (size_t)T_ * 2048 * 2) : WS_END3;
static_assert(WS_END4 <= (size_t)1073741824, "workspace budget");
#ifndef F8_MASK
#define F8_MASK 0xFFFFFFFFu
#endif
__device__ __forceinline__ bool in_f8(int ct) { return ct < 32 && ((F8_MASK >> ct) & 1u); }
#ifndef F8_FNET
#define F8_FNET 1
#endif
constexpr float ZA8_SCALE = 1.0f / 256.0f, WFN8_SCALE = 4096.0f;
#ifndef F8_GLA
#define F8_GLA 1
#endif
#ifndef F8_OUT
#define F8_OUT 1
#endif
__device__ __forceinline__ unsigned fp8_byte(float v) { v = fminf(fmaxf(v, -448.0f), 448.0f); return (unsigned)__builtin_amdgcn_cvt_pk_fp8_f32(v, v, 0, false) & 0xFFu; }
constexpr float WINI8_SCALE = 1024.0f;
__device__ __forceinline__ int pack_i8x4(float a, float b, float c, float d) {
    const int q0 = __float2int_rn(fminf(fmaxf(a, -127.f), 127.f)), q1 = __float2int_rn(fminf(fmaxf(b, -127.f), 127.f)), q2 = __float2int_rn(fminf(fmaxf(c, -127.f), 127.f)), q3 = __float2int_rn(fminf(fmaxf(d, -127.f), 127.f));
    return (int)((unsigned)(q0 & 255) | ((unsigned)(q1 & 255) << 8) | ((unsigned)(q2 & 255) << 16) | ((unsigned)q3 << 24));
}
__device__ __forceinline__ int pack_fp8x4(float a, float b, float c, float d) { int p = __builtin_amdgcn_cvt_pk_fp8_f32(a, b, 0, false); return __builtin_amdgcn_cvt_pk_fp8_f32(c, d, p, true); }
__device__ __forceinline__ float q8rt(float x) { const int p = __builtin_amdgcn_cvt_pk_fp8_f32(x, x, 0, false); return __builtin_amdgcn_cvt_f32_fp8(p, 0); }
__device__ __forceinline__ float wave_sum(float v) {
#pragma unroll
    for (int o = 32; o >= 1; o >>= 1) v += __shfl_xor(v, o);
    return v;
}
__device__ __forceinline__ float sigmoidf_(float v) { return __builtin_amdgcn_rcpf(1.0f + __expf(-v)); }


#define XB_TMO      128
#define XB_XCNT(j)  (256  + 64 * (j))
#define XB_XSUB(j)  (1280 + 64 * (j))
#define XB_XGEN(j)  (2304 + 64 * (j))
#define XB_TOP      3328
#define XB_TOPGEN   3392
#define XCD_BAR_WORDS 3456
#define XB_SPIN_CAP (1u << 22)
__device__ __forceinline__ unsigned xb_ld(unsigned* p)              { return __hip_atomic_load(p, __ATOMIC_RELAXED, __HIP_MEMORY_SCOPE_AGENT); }
__device__ __forceinline__ unsigned xb_add(unsigned* p, unsigned v) { return __hip_atomic_fetch_add(p, v, __ATOMIC_RELAXED, __HIP_MEMORY_SCOPE_AGENT); }
__device__ __forceinline__ unsigned xb_xcc_id() { return (unsigned)__builtin_amdgcn_s_getreg((3 << 11) | 20) & 0xFu; }
#define XB_SPIN(cond, bar) do { unsigned _sp = 0; while (cond) { __builtin_amdgcn_s_sleep(1); \
    if ((++_sp & 255u) == 0u) { if (xb_ld(&(bar)[XB_TMO])) break; if (_sp > XB_SPIN_CAP) { atomicAdd(&(bar)[XB_TMO], 1u); break; } } } } while (0)
struct XcdBarrier { unsigned* bar; unsigned x; volatile LAS unsigned* st; int wv; };
__device__ __forceinline__ XcdBarrier xcd_barrier_post(unsigned* bar, volatile LAS unsigned* st, int wv) {
    XcdBarrier b; b.bar = bar; b.x = xb_xcc_id(); b.st = st; b.wv = wv;
    if (threadIdx.x == 0) (void)xb_add(&bar[XB_XCNT(b.x)], 1u);
    return b;
}
__device__ __forceinline__ void xcd_barrier_complete(unsigned* bar, unsigned x, unsigned& nloc, unsigned& nx) {
    const unsigned G = gridDim.x * gridDim.y * gridDim.z;
    unsigned sum, cnt, mine, sp = 0u;
    for (;;) {
        sum = 0u; cnt = 0u; mine = 0u;
#pragma unroll
        for (unsigned j = 0; j < 16; ++j) { const unsigned c = xb_ld(&bar[XB_XCNT(j)]); sum += c; cnt += (c > 0u) ? 1u : 0u; mine = (j == x) ? c : mine; }
        if (sum == G) break;
        __builtin_amdgcn_s_sleep(1);
        if ((++sp & 255u) == 0u) { if (xb_ld(&bar[XB_TMO])) break; if (sp > XB_SPIN_CAP) { atomicAdd(&bar[XB_TMO], 1u); break; } }
    }
    nloc = mine > 0u ? mine : 1u; nx = cnt > 0u ? cnt : 1u;
}
__device__ __forceinline__ void xcd_barrier(const XcdBarrier& b) {
    asm volatile("s_waitcnt vmcnt(0)" ::: "memory");
    __syncthreads();
    if (threadIdx.x == 0) {
        unsigned* bar = b.bar;
        __builtin_amdgcn_s_waitcnt(0);
        unsigned nloc = b.st[0], nx = b.st[1];
        if (nloc == 0u) { xcd_barrier_complete(bar, b.x, nloc, nx); b.st[0] = nloc; b.st[1] = nx; }
        const unsigned old = xb_add(&bar[XB_XSUB(b.x)], 1u);
        const unsigned gen = old / nloc;
        if (old + 1u == (gen + 1u) * nloc) {
            __builtin_amdgcn_fence(__ATOMIC_RELEASE, "agent");
            asm volatile("s_waitcnt vmcnt(0)" ::: "memory");
            const unsigned og = xb_add(&bar[XB_TOP], 1u);
            const unsigned tg = og / nx;
            if (og + 1u == (tg + 1u) * nx) xb_add(&bar[XB_TOPGEN], 1u);
            else XB_SPIN(xb_ld(&bar[XB_TOPGEN]) == tg, bar);
            __builtin_amdgcn_fence(__ATOMIC_ACQUIRE, "agent");
            xb_add(&bar[XB_XGEN(b.x)], 1u);
            asm volatile("s_waitcnt vmcnt(0)" ::: "memory");
        } else {
            XB_SPIN(xb_ld(&bar[XB_XGEN(b.x)]) == gen, bar);
            __builtin_amdgcn_fence(__ATOMIC_ACQUIRE, "agent");
            asm volatile("s_waitcnt vmcnt(0)" ::: "memory");
        }
    }
    __syncthreads();
}

__device__ __forceinline__ unsigned tr_off(unsigned row, unsigned ch) { return 256u * row + 16u * (ch ^ (((row & 3u) << 2) | ((row >> 2) & 3u))); }
#define TR_FRAG_ISSUE(r0, r1, base, lane, c, ks) do { const unsigned g_ = (lane) >> 4, q_ = ((lane) & 15) >> 2, p_ = (lane) & 3; \
    const unsigned a0_ = (base) + tr_off(32u * (ks) + 8u * g_ + q_, 2u * (c) + (p_ >> 1)) + 8u * (p_ & 1u); \
    const unsigned a1_ = (base) + tr_off(32u * (ks) + 8u * g_ + 4u + q_, 2u * (c) + (p_ >> 1)) + 8u * (p_ & 1u); \
    asm volatile("ds_read_b64_tr_b16 %0, %2\n\tds_read_b64_tr_b16 %1, %3" : "=&v"(r0), "=&v"(r1) : "v"(a0_), "v"(a1_) : "memory"); } while (0)
__device__ __forceinline__ bf16x8 tr_join(u32x2 r0, u32x2 r1) { const u32x4 v = {r0.x, r0.y, r1.x, r1.y}; return __builtin_bit_cast(bf16x8, v); }

#define LDS_RD128(dst, addr) asm volatile("ds_read_b128 %0, %1" : "=&v"(dst) : "v"((unsigned)(addr)) : "memory")
#define LDS_WAIT4(a, b, c, d) asm volatile("s_waitcnt lgkmcnt(0)" : "+v"(a), "+v"(b), "+v"(c), "+v"(d) :: "memory")
#define LDS_WAIT8(a, b, c, d, e, f, g, h) asm volatile("s_waitcnt lgkmcnt(0)" : "+v"(a), "+v"(b), "+v"(c), "+v"(d), "+v"(e), "+v"(f), "+v"(g), "+v"(h) :: "memory")
#define LDS_RD128_O(dst, base, OFF) asm volatile("ds_read_b128 %0, %1 offset:%2" : "=&v"(dst) : "v"((unsigned)(base)), "n"(OFF) : "memory")
#define LDS_RD4(arr, base, STRIDE) do { LDS_RD128_O((arr)[0], base, 0); LDS_RD128_O((arr)[1], base, (STRIDE)); LDS_RD128_O((arr)[2], base, 2 * (STRIDE)); LDS_RD128_O((arr)[3], base, 3 * (STRIDE)); } while (0)
#define LDS_RD8(arr, base, STRIDE) do { LDS_RD4(arr, base, STRIDE); LDS_RD128_O((arr)[4], base, 4 * (STRIDE)); LDS_RD128_O((arr)[5], base, 5 * (STRIDE)); LDS_RD128_O((arr)[6], base, 6 * (STRIDE)); LDS_RD128_O((arr)[7], base, 7 * (STRIDE)); } while (0)

namespace pg8 {
constexpr int BM = 256, BK = 64, HALF = 128, HTB = HALF * BK * 2, STAGE_BYTES = 8 * HTB, NXCD = 8, WGM = 8;
__device__ __forceinline__ int lds_byte(int r, int c) { const int st = (r >> 4) * 2 + (c >> 5), rr = r & 15, cc = c & 31, ob = rr * 64 + cc * 2; return st * 1024 + (ob ^ (((ob >> 9) & 1) << 5)); }
__device__ __forceinline__ void stage_rc(int b, int& R, int& C) { const int st = b / 1024, sb = b % 1024, swz = sb ^ (((sb >> 9) & 1) << 5); R = (st >> 1) * 16 + swz / 64; C = (st & 1) * 32 + (swz % 64) / 2; }
__device__ __forceinline__ int perm32(int rho) { const int n = rho >> 4, i = rho & 15; return 8 * (i >> 2) + 4 * n + (i & 3); }

struct Unit { int pm, pn; };
struct Gemm { const bf16_t* A; const bf16_t* Bt; int M, N, K, lda; };

struct StaticOrder {
    int nM, nN, nwg, G, c;
    __device__ void init(int M, int N, int G_, int c_) { nM = M / BM; nN = N / BM; nwg = nM * nN; G = G_; c = c_; }
    __device__ bool next(int i, Unit& u) const {
        const long L = (long)i * G + c; if (L >= nwg) return false;
        int wgid = (int)L; { const int q = nwg / NXCD, r = nwg % NXCD, xcd = wgid % NXCD, off = wgid / NXCD; wgid = (xcd < r ? xcd * (q + 1) : r * (q + 1) + (xcd - r) * q) + off; }
        const int nig = WGM * nN, gid = wgid / nig, fm = gid * WGM, gsz = (nM - fm) < WGM ? (nM - fm) : WGM;
        u.pm = fm + ((wgid % nig) % gsz); u.pn = (wgid % nig) / gsz; return true;
    }
};

struct ProbeOrder : StaticOrder { __device__ bool next(int i, Unit& u) const { const bool r = StaticOrder::next(i, u); u.pm = 0; u.pn = 0; return r; } };

typedef int i32x8 __attribute__((ext_vector_type(8)));
typedef int i32x4 __attribute__((ext_vector_type(4)));
__device__ __forceinline__ i32x8 cat8(const bf16x8 a, const bf16x8 b) { const i32x4 x = __builtin_bit_cast(i32x4, a), y = __builtin_bit_cast(i32x4, b); return __builtin_shufflevector(x, y, 0, 1, 2, 3, 4, 5, 6, 7); }
template <class Epi, class Sched, bool F8 = false, bool I8 = false>
__device__ __forceinline__ void gemm_phase(ldsp_t lds, const Gemm g, const Sched& S, const Epi& E) {
    const int tid = threadIdx.x, wid = __builtin_amdgcn_readfirstlane(tid >> 6), lane = tid & 63, wr = wid >> 2, wc = wid & 3, fr = lane & 15, fq = lane >> 4;
    const int K = g.K, nt = F8 ? K / 128 : K / BK, rowA = F8 ? g.lda : g.lda * 2, rowB = F8 ? K : K * 2;
    unsigned voffA[2], voffB[2];
#pragma unroll
    for (int i = 0; i < 2; ++i) { int R, C; stage_rc(tid * 16 + i * 8192, R, C); const int Rb = Epi::PERM ? ((R & ~31) + perm32(R & 31)) : R;
        voffA[i] = (unsigned)(R * rowA + C * 2); voffB[i] = (unsigned)(Rb * rowB + C * 2); }
    const size_t kstep = (size_t)(BK * 2);
    const size_t hstepA = (size_t)HALF * rowA, hstepB = (size_t)HALF * rowB;
    const size_t tstepA = 2 * hstepA, tstepB = 2 * hstepB;
    const unsigned ldsw = (unsigned)wid * 1024u;
    const int aoff = lds_byte(wr * 64 + fr, fq * 8), boff = lds_byte(wc * 32 + fr, fq * 8);
#define PG8_SA(b, h) (((b) * 2 + (h)) * HTB)
#define PG8_SB(b, h) ((4 + (b) * 2 + (h)) * HTB)
#define PG8_STAGE(bufoff, gbase, voff) do { _Pragma("unroll") for (int _i = 0; _i < 2; ++_i) \
        __builtin_amdgcn_global_load_lds((const unsigned*)((const char*)(gbase) + (voff)[_i]), (LAS unsigned*)(lds + (bufoff) + ldsw + _i * 8192), 16, 0, 0); } while (0)
#define PG8_LDA(dst, b, h) do { _Pragma("unroll") for (int m = 0; m < 4; ++m) _Pragma("unroll") for (int k = 0; k < 2; ++k) dst[m][k] = *(const LAS bf16x8*)(lds + PG8_SA(b, h) + aoff + m * 2048 + k * 1024); } while (0)
#define PG8_LDB(dst, b, h) do { _Pragma("unroll") for (int n = 0; n < 2; ++n) _Pragma("unroll") for (int k = 0; k < 2; ++k) dst[n][k] = *(const LAS bf16x8*)(lds + PG8_SB(b, h) + boff + n * 2048 + k * 1024); } while (0)
#define PG8_MMA(ai, bj, At, Bt) do { __builtin_amdgcn_s_setprio(1); _Pragma("unroll") for (int m = 0; m < 4; ++m) _Pragma("unroll") for (int n = 0; n < 2; ++n) { \
        if (F8 && I8) { _Pragma("unroll") for (int k = 0; k < 2; ++k) { i32x4 c_ = __builtin_bit_cast(i32x4, acc[ai][bj][m][n]); \
            c_ = __builtin_amdgcn_mfma_i32_16x16x64_i8(__builtin_bit_cast(i32x4, Bt[n][k]), __builtin_bit_cast(i32x4, At[m][k]), c_, 0, 0, 0); acc[ai][bj][m][n] = __builtin_bit_cast(f32x4, c_); } } \
        else if (F8) { const i32x8 b8_ = cat8(Bt[n][0], Bt[n][1]), a8_ = cat8(At[m][0], At[m][1]); asm volatile("v_mfma_f32_16x16x128_f8f6f4 %0, %1, %2, %0" : "+v"(acc[ai][bj][m][n]) : "v"(b8_), "v"(a8_)); } \
        else { _Pragma("unroll") for (int k = 0; k < 2; ++k) acc[ai][bj][m][n] = __builtin_amdgcn_mfma_f32_16x16x32_bf16(Bt[n][k], At[m][k], acc[ai][bj][m][n], 0, 0, 0); } } \
        __builtin_amdgcn_s_setprio(0); } while (0)
#define PG8_WAIT_V(n) asm volatile("s_waitcnt vmcnt(" #n ")" ::: "memory")
#define PG8_WAIT_L(n) asm volatile("s_waitcnt lgkmcnt(" #n ")" ::: "memory")
#define PG8_BAR __builtin_amdgcn_s_barrier()
#define PG8_SCHED __builtin_amdgcn_sched_barrier(0)
    Unit cur, nxt; int ui = 0;
    if (!S.next(0, cur)) return;
    f32x4 acc[2][2][4][2];
#pragma unroll
    for (int a = 0; a < 2; ++a)
#pragma unroll
        for (int b = 0; b < 2; ++b)
#pragma unroll
            for (int m = 0; m < 4; ++m)
#pragma unroll
                for (int n = 0; n < 2; ++n) acc[a][b][m][n] = (f32x4){0.f, 0.f, 0.f, 0.f};
    bf16x8 At[4][2], B0[2][2], B1[2][2];
    const char* cA = (const char*)g.A + (size_t)cur.pm * tstepA; const char* cB = (const char*)g.Bt + (size_t)cur.pn * tstepB;
    PG8_STAGE(PG8_SB(0, 0), cB, voffB); PG8_STAGE(PG8_SA(0, 0), cA, voffA); PG8_STAGE(PG8_SB(0, 1), cB + hstepB, voffB); PG8_STAGE(PG8_SA(0, 1), cA + hstepA, voffA);
    if (wr == 1) PG8_BAR;
    PG8_WAIT_V(4); PG8_BAR;
    PG8_STAGE(PG8_SB(1, 0), cB + kstep, voffB); PG8_STAGE(PG8_SA(1, 0), cA + kstep, voffA); PG8_STAGE(PG8_SB(1, 1), cB + hstepB + kstep, voffB);
    PG8_WAIT_V(6); PG8_BAR;
    for (;;) {
        const bool has_next = S.next(ui + 1, nxt);
        const char* nA = has_next ? (const char*)g.A + (size_t)nxt.pm * tstepA : cA; const char* nB = has_next ? (const char*)g.Bt + (size_t)nxt.pn * tstepB : cB;
        for (int t = 0; t < nt; t += 2) {
            const bool last = (t == nt - 2);
            const char* a1 = cA + (size_t)(t + 1) * kstep;
            const char* a2 = last ? nA : cA + (size_t)(t + 2) * kstep; const char* b2 = last ? nB : cB + (size_t)(t + 2) * kstep;
            const char* a3 = a2 + kstep; const char* b3 = b2 + kstep;
            PG8_LDB(B0, 0, 0); PG8_SCHED; PG8_LDA(At, 0, 0); PG8_STAGE(PG8_SA(1, 1), a1 + hstepA, voffA);
            PG8_WAIT_L(8); PG8_BAR; PG8_WAIT_L(0); PG8_MMA(0, 0, At, B0); PG8_BAR; PG8_SCHED;
            PG8_LDB(B1, 0, 1); PG8_STAGE(PG8_SB(0, 0), b2, voffB);
            PG8_BAR; PG8_WAIT_L(0); PG8_MMA(0, 1, At, B1); PG8_BAR;
            PG8_LDA(At, 0, 1); PG8_STAGE(PG8_SA(0, 0), a2, voffA);
            PG8_BAR; PG8_WAIT_L(0); PG8_MMA(1, 0, At, B0); PG8_BAR; PG8_SCHED;
            PG8_STAGE(PG8_SB(0, 1), b2 + hstepB, voffB);
            PG8_WAIT_V(6); PG8_BAR; PG8_MMA(1, 1, At, B1); PG8_BAR;
            PG8_LDB(B0, 1, 0); PG8_SCHED; PG8_LDA(At, 1, 0); PG8_STAGE(PG8_SA(0, 1), a2 + hstepA, voffA);
            PG8_WAIT_L(8); PG8_BAR; PG8_WAIT_L(0); PG8_MMA(0, 0, At, B0); PG8_BAR; PG8_SCHED;
            PG8_LDB(B1, 1, 1); PG8_STAGE(PG8_SB(1, 0), b3, voffB);
            PG8_BAR; PG8_WAIT_L(0); PG8_MMA(0, 1, At, B1); PG8_BAR;
            PG8_LDA(At, 1, 1); PG8_STAGE(PG8_SA(1, 0), a3, voffA);
            PG8_BAR; PG8_WAIT_L(0); PG8_MMA(1, 0, At, B0); PG8_BAR; PG8_SCHED;
            PG8_STAGE(PG8_SB(1, 1), b3 + hstepB, voffB);
            PG8_WAIT_V(6); PG8_BAR; PG8_MMA(1, 1, At, B1); PG8_BAR;
        }
        if (F8 && I8) {
#pragma unroll
            for (int a_ = 0; a_ < 2; ++a_)
#pragma unroll
                for (int b_ = 0; b_ < 2; ++b_)
#pragma unroll
                    for (int m_ = 0; m_ < 4; ++m_)
#pragma unroll
                        for (int n_ = 0; n_ < 2; ++n_) { const i32x4 c_ = __builtin_bit_cast(i32x4, acc[a_][b_][m_][n_]); acc[a_][b_][m_][n_] = (f32x4){(float)c_[0], (float)c_[1], (float)c_[2], (float)c_[3]}; }
        } else if (F8) { asm volatile("s_nop 15\n\ts_nop 15" ::: "memory"); PG8_SCHED; }
        E(acc, cur, wr, wc, fr, fq);
        if (!has_next) break;
#pragma unroll
        for (int a = 0; a < 2; ++a)
#pragma unroll
            for (int b = 0; b < 2; ++b)
#pragma unroll
                for (int m = 0; m < 4; ++m)
#pragma unroll
                    for (int n = 0; n < 2; ++n) acc[a][b][m][n] = (f32x4){0.f, 0.f, 0.f, 0.f};
        cur = nxt; cA = nA; cB = nB; ++ui;
    }
    PG8_WAIT_V(0);
    if (wr == 0) PG8_BAR;
    PG8_BAR;
#undef PG8_SA
#undef PG8_SB
#undef PG8_STAGE
#undef PG8_LDA
#undef PG8_LDB
#undef PG8_MMA
#undef PG8_WAIT_V
#undef PG8_WAIT_L
#undef PG8_BAR
#undef PG8_SCHED
}

struct EpiIn {
    static constexpr bool PERM = true;
    bf16_t* P; int pn0; float sc; const float* xs;
    __device__ __forceinline__ void operator()(const f32x4 (&acc)[2][2][4][2], const Unit& u, int wr, int wc, int fr, int fq) const {
        const int pn = u.pn + pn0;
        const int row0 = u.pm * BM + wr * 64 + fr, col0 = pn * BM + wc * 32 + 8 * fq;
        const bool sg = (pn >= 16 && pn < 32);
        float rs[2][4];
#pragma unroll
        for (int ai = 0; ai < 2; ++ai)
#pragma unroll
            for (int m = 0; m < 4; ++m) rs[ai][m] = xs ? xs[row0 + ai * HALF + m * 16] * sc : sc;
        __builtin_amdgcn_sched_barrier(0);
#pragma unroll
        for (int ai = 0; ai < 2; ++ai)
#pragma unroll
            for (int m = 0; m < 4; ++m) { bf16_t* rowp = P + (size_t)(row0 + ai * HALF + m * 16) * PW + col0;
                const float rsc = rs[ai][m];
#pragma unroll
                for (int bj = 0; bj < 2; ++bj) { f32x4 v0 = acc[ai][bj][m][0] * rsc, v1 = acc[ai][bj][m][1] * rsc;
                    if (sg) {
                        unsigned b0 = 0u, b1 = 0u;
#pragma unroll
                        for (int j = 0; j < 4; ++j) { b0 |= (unsigned)(sigmoidf_(v0[j]) * 255.0f + 0.5f) << (8 * j); b1 |= (unsigned)(sigmoidf_(v1[j]) * 255.0f + 0.5f) << (8 * j); }
                        *(u32x2*)((unsigned char*)(P + (size_t)(row0 + ai * HALF + m * 16) * PW) + 8192 + (col0 - 4096) + bj * HALF) = (u32x2){b0, b1};
                    } else {
                        u32x4 w; w.x = pk2(v0[0], v0[1]); w.y = pk2(v0[2], v0[3]); w.z = pk2(v1[0], v1[1]); w.w = pk2(v1[2], v1[3]);
                        *(u32x4*)(rowp + bj * HALF) = w; } } }
    }
};
template <int MODE, bool OUT8 = false> struct EpiGate {
    static constexpr bool PERM = true;
    bf16_t* O; int ldo; const unsigned char* G; int ldg; float sc; unsigned char* O8;
    __device__ __forceinline__ void operator()(const f32x4 (&acc)[2][2][4][2], const Unit& u, int wr, int wc, int fr, int fq) const {
        const int row0 = u.pm * BM + wr * 64 + fr, col0 = u.pn * BM + wc * 32 + 8 * fq;
#pragma unroll
        for (int ai = 0; ai < 2; ++ai) {
            u32x2 gw[4][2]; u32x4 ow[4][2];
            if (MODE != 2) {
#pragma unroll
                for (int m = 0; m < 4; ++m)
#pragma unroll
                    for (int bj = 0; bj < 2; ++bj) { const size_t row = (size_t)(row0 + ai * HALF + m * 16);
                        gw[m][bj] = *(const u32x2*)(G + row * ldg + col0 + bj * HALF);
                        if (MODE == 1) ow[m][bj] = *(const u32x4*)(O + row * ldo + col0 + bj * HALF); }
                __builtin_amdgcn_sched_barrier(0);
            }
#pragma unroll
            for (int m = 0; m < 4; ++m) { const size_t row = (size_t)(row0 + ai * HALF + m * 16);
#pragma unroll
                for (int bj = 0; bj < 2; ++bj) { const f32x4 v0 = acc[ai][bj][m][0], v1 = acc[ai][bj][m][1];
                    float r[8] = {v0[0], v0[1], v0[2], v0[3], v1[0], v1[1], v1[2], v1[3]};
                    if (MODE != 2) { const unsigned gws[2] = {gw[m][bj].x, gw[m][bj].y};
#pragma unroll
                        for (int j = 0; j < 8; ++j) r[j] *= (float)((gws[j >> 2] >> (8 * (j & 3))) & 255u) * (sc * (1.0f / 255.0f)); }
                    if (MODE == 1) { const unsigned ows[4] = {ow[m][bj].x, ow[m][bj].y, ow[m][bj].z, ow[m][bj].w};
#pragma unroll
                        for (int j = 0; j < 4; ++j) { r[2 * j] += bflo(ows[j]); r[2 * j + 1] += bfhi(ows[j]); } }
                    if (OUT8) *(u32x2*)(O8 + row * ldo + col0 + bj * HALF) = (u32x2){(unsigned)pack_fp8x4(r[0], r[1], r[2], r[3]), (unsigned)pack_fp8x4(r[4], r[5], r[6], r[7])};
                    else { u32x4 w; w.x = pk2(r[0], r[1]); w.y = pk2(r[2], r[3]); w.z = pk2(r[4], r[5]); w.w = pk2(r[6], r[7]);
                        *(u32x4*)(O + row * ldo + col0 + bj * HALF) = w; } } }
        }
    }
};
struct EpiRes {
    static constexpr bool PERM = false;
    const float* X; const float* gmod; bf16_t* H; float sc;
    __device__ __forceinline__ void operator()(const f32x4 (&acc)[2][2][4][2], const Unit& u, int wr, int wc, int fr, int fq) const {
        const int row0 = u.pm * BM + wr * 64 + fr, col0 = u.pn * BM + wc * 32 + 4 * fq;
        const float* gm = gmod + (size_t)((u.pm * BM) >> 14) * 12288;
        f32x4 gv[2][2];
#pragma unroll
        for (int bj = 0; bj < 2; ++bj)
#pragma unroll
            for (int n = 0; n < 2; ++n) gv[bj][n] = *(const f32x4*)(gm + col0 + bj * HALF + n * 16) * sc;
#pragma unroll
        for (int ai = 0; ai < 2; ++ai)
#pragma unroll
          for (int mh = 0; mh < 2; ++mh) {
            f32x4 xs[2][2][2];
#pragma unroll
            for (int mm = 0; mm < 2; ++mm) { const size_t off = (size_t)(row0 + ai * HALF + (2 * mh + mm) * 16) * 2048 + col0;
#pragma unroll
                for (int bj = 0; bj < 2; ++bj)
#pragma unroll
                    for (int n = 0; n < 2; ++n) xs[mm][bj][n] = *(const f32x4*)(X + off + bj * HALF + n * 16); }
            __builtin_amdgcn_sched_barrier(0);
#pragma unroll
            for (int mm = 0; mm < 2; ++mm) { const int m = 2 * mh + mm; const size_t off = (size_t)(row0 + ai * HALF + m * 16) * 2048 + col0;
#pragma unroll
                for (int bj = 0; bj < 2; ++bj)
#pragma unroll
                    for (int n = 0; n < 2; ++n) { const f32x4 hv = xs[mm][bj][n] + gv[bj][n] * acc[ai][bj][m][n];
                        *(u32x2*)(H + off + bj * HALF + n * 16) = (u32x2){pk2(hv[0], hv[1]), pk2(hv[2], hv[3])}; } }
          }
    }
};
struct EpiNull {
    static constexpr bool PERM = true;
    float* sink;
    __device__ __forceinline__ void operator()(const f32x4 (&acc)[2][2][4][2], const Unit& u, int wr, int wc, int fr, int fq) const {
        float s = 0.f;
#pragma unroll
        for (int ai = 0; ai < 2; ++ai)
#pragma unroll
            for (int bj = 0; bj < 2; ++bj)
#pragma unroll
                for (int m = 0; m < 4; ++m)
#pragma unroll
                    for (int n = 0; n < 2; ++n) s += acc[ai][bj][m][n][0] + acc[ai][bj][m][n][1] + acc[ai][bj][m][n][2] + acc[ai][bj][m][n][3];
        if (s == 123.456f) sink[fr + 16 * fq + 64 * (wr * 4 + wc)] = s;
    }
};
}

__device__ void gemv_task(const Args& a, int task, ldsp_t lds) {
    const int tid = threadIdx.x, cq = tid & 15, rl = tid >> 4;
    const float* W = a.in[I_WADA] + 64 * task + 4 * cq;
    const float* c = a.in[I_C];
    LAS float* sl = (LAS float*)(lds + 16384);
    __syncthreads();
#pragma unroll
    for (int i = 0; i < 8; ++i) { const float cv = c[tid + 512 * i]; sl[tid + 512 * i] = cv * sigmoidf_(cv); }
    __syncthreads();
    f32x4 acc0 = {0.f, 0.f, 0.f, 0.f}, acc1 = {0.f, 0.f, 0.f, 0.f};
#pragma unroll 1
    for (int r0 = rl; r0 < 2048; r0 += 256) {
        f32x4 w[8];
#pragma unroll
        for (int u = 0; u < 8; ++u) w[u] = *(const f32x4*)(W + (size_t)(r0 + 32 * u) * 12288);
#pragma unroll
        for (int u = 0; u < 8; ++u) { const float s0 = sl[r0 + 32 * u], s1 = sl[2048 + r0 + 32 * u]; acc0 += s0 * w[u]; acc1 += s1 * w[u]; }
    }
    LAS float* red = (LAS float*)lds;
    __syncthreads();
#pragma unroll
    for (int j = 0; j < 4; ++j) { red[(rl * 16 + cq) * 8 + j] = acc0[j]; red[(rl * 16 + cq) * 8 + 4 + j] = acc1[j]; }
    __syncthreads();
    if (tid < 128) {
        const int b = tid >> 6, col = tid & 63; float s = 0.f;
        for (int r = 0; r < 32; ++r) s += red[(r * 16 + (col >> 2)) * 8 + b * 4 + (col & 3)];
        float* mod = (float*)(a.ws + WS_MOD);
        mod[b * 12288 + 64 * task + col] = s + a.in[I_BADA][64 * task + col];
    }
    __syncthreads();
}

template <class CMap>
__device__ __forceinline__ void tr_tile(const Args& a, const float* src, int src_ld, int r0, int c0, CMap cmap, bf16_t* dst, int dst_ld, ldsp_t lds, float qs = 0.f) {
    LAS float* tile = (LAS float*)lds;
    const int tid = threadIdx.x, cc = tid & 63, rr0 = tid >> 6;
    int c1, c2; float sg; cmap(c0 + cc, c1, c2, sg);
#pragma unroll
    for (int i = 0; i < 8; ++i) { const int r = rr0 + 8 * i; const float* sp = src + (size_t)(r0 + r) * src_ld;
        float v = c1 >= 0 ? sp[c1] : 0.f; if (c2 >= 0) v += sg * sp[c2];
        tile[cc * 65 + r] = v; }
    __syncthreads();
    if (qs > 0.f) {
        const int rp = (tid & 15) * 4, cq = tid >> 4;
#pragma unroll
        for (int i = 0; i < 2; ++i) { const int c = cq + 32 * i; const LAS float* tp = tile + c * 65 + rp;
            *(int*)((unsigned char*)dst + (size_t)(c0 + c) * dst_ld + r0 + rp) = pack_fp8x4(tp[0] * qs, tp[1] * qs, tp[2] * qs, tp[3] * qs); }
    } else {
    const int rp = (tid & 31) * 2, cq = tid >> 5;
#pragma unroll
    for (int i = 0; i < 4; ++i) { const int c = cq + 16 * i; *(unsigned*)(dst + (size_t)(c0 + c) * dst_ld + r0 + rp) = pk2(tile[c * 65 + rp], tile[c * 65 + rp + 1]); }
    }
    __syncthreads();
}
struct MapId { __device__ void operator()(int c, int& c1, int& c2, float& sg) const { c1 = c; c2 = -1; sg = 0.f; } };
struct MapWin { __device__ void operator()(int c, int& c1, int& c2, float& sg) const {
    c2 = -1; sg = 0.f;
    if (c < 1024) { const int gb = c & ~255, cp = c & 255;
        if (cp == 0 || cp == 128) c1 = gb + cp;
        else if (cp < 128) { c1 = gb + cp; c2 = gb + 256 - cp; sg = 1.f; }
        else { const int cc = cp - 128; c1 = gb + cc; c2 = gb + 256 - cc; sg = -1.f; } }
    else c1 = c < 4096 ? c : (c < 8192 ? c + 32 : (c < 8224 ? c - 4096 : -1)); } };

__device__ void fold_tile(const Args& a, int tile, ldsp_t lds) {
    LAS float* wl = (LAS float*)lds;
    LAS float* ct = (LAS float*)(lds + 65536);
    const int tid = threadIdx.x;
    const int nb = tile & 31, kb = tile >> 5;
    const int g = kb >> 2, c0 = (kb & 3) * 64, n0 = nb * 64;
    const float* wf = a.in[I_WFNET] + (size_t)(g * 256) * 2048 + n0;
    __syncthreads();
#pragma unroll
    for (int j = 0; j < 8; ++j) { const int row = (tid >> 4) + 32 * j, c4 = (tid & 15) * 4;
        const f32x4 v = *(const f32x4*)(wf + (size_t)row * 2048 + c4);
        wl[row * 64 + c4] = v[0]; wl[row * 64 + c4 + 1] = v[1]; wl[row * 64 + c4 + 2] = v[2]; wl[row * 64 + c4 + 3] = v[3]; }
    if (tid < 256) ct[tid] = cospif((float)tid * (1.0f / 128.0f));
    __syncthreads();
    const int kk = tid & 63, nn0 = tid >> 6, cp = c0 + kk;
    const bool isin = cp > 128; const int cf = isin ? cp - 128 : cp;
    float acc[8];
#pragma unroll
    for (int i = 0; i < 8; ++i) acc[i] = 0.f;
    for (int m = 0; m < 256; ++m) {
        const int idx = (m * cf) & 255;
        const float cs = isin ? ct[(idx + 192) & 255] : ct[idx];
#pragma unroll
        for (int i = 0; i < 8; ++i) acc[i] += wl[m * 64 + nn0 + 8 * i] * cs;
    }
    if (F8_FNET) { unsigned char* dst8 = a.ws + WS_WFN;
#pragma unroll
        for (int i = 0; i < 8; ++i) dst8[(size_t)(n0 + nn0 + 8 * i) * 1024 + g * 256 + cp] = (unsigned char)fp8_byte(acc[i] * (WFN8_SCALE / 2048.0f));
    } else {
    bf16_t* dst = (bf16_t*)(a.ws + WS_WFN);
#pragma unroll
    for (int i = 0; i < 8; ++i) dst[(size_t)(n0 + nn0 + 8 * i) * 1024 + g * 256 + cp] = (bf16_t)f2bf(acc[i] * (1.0f / 2048.0f));
    }
    __syncthreads();
}

__device__ void tables_task(const Args& a, int task) {
    const int tid = threadIdx.x;
    bf16_t* F1 = (bf16_t*)(a.ws + WS_F1); bf16_t* F2 = (bf16_t*)(a.ws + WS_F2); float* TW = (float*)(a.ws + WS_TW);
    {
        const int e = task * 512 + tid, R = e >> 7, sh = e & 127, w = R >> 5, mt = (R >> 4) & 1, r = R & 15, kf = 16 * w + r;
        float s, c; sincospif((float)((kf * sh) & 127) * (1.0f / 64.0f), &s, &c);
        F1[e] = (bf16_t)f2bf(mt ? -s : c);
    }
#pragma unroll
    for (int q = 0; q < 2; ++q) {
        const int e = task * 1024 + q * 512 + tid, R = e >> 8, K = e & 255, sl = K >> 1, ri = K & 1, w = R >> 5, mt = (R >> 4) & 1, r = R & 15, kf = 16 * w + r;
        float s, c; sincospif((float)((kf * sl) & 127) * (1.0f / 64.0f), &s, &c);
        const float v = mt ? (ri ? c : -s) : (ri ? s : c);
        F2[e] = (bf16_t)f2bf(v);
    }
    if (task < 32) {
        const int e = task * 512 + tid, kl = e >> 7, sl = e & 127;
        float s, c; sincospif((float)(kl * sl) * (1.0f / 8192.0f), &s, &c);
        TW[2 * e] = c; TW[2 * e + 1] = s;
    }
}

__device__ void cvt_flat(const Args& a, const float* src, bf16_t* dst, size_t n) {
    const size_t gt = (size_t)blockIdx.x * 512 + threadIdx.x, gs = (size_t)gridDim.x * 512;
    for (size_t i = gt * 8; i < n; i += gs * 8) {
        const f32x4 v0 = *(const f32x4*)(src + i), v1 = *(const f32x4*)(src + i + 4);
        u32x4 w; w.x = pk2(v0[0], v0[1]); w.y = pk2(v0[2], v0[3]); w.z = pk2(v1[0], v1[1]); w.w = pk2(v1[2], v1[3]);
        *(u32x4*)(dst + i) = w;
    }
}

constexpr int TR_N0 = 129 * 32, TR_N1 = TR_N0 + 32 * 16, TR_N2 = TR_N1 + 32 * 32, TR_N3 = TR_N2 + 32 * 32;
__device__ void tr_all(const Args& a, ldsp_t lds) {
    LAS float* tile = (LAS float*)lds;
    const int tid = threadIdx.x, cc = tid & 63, rr0 = tid >> 6, G = gridDim.x;
    float va[8], vb[8], sg = 0.f; bool wide = false, i8t = false;
    bf16_t* dst = nullptr; int dst_ld = 0, r0 = 0, c0 = 0; float qs = 0.f;
#define TR_LOAD(T) do { const int t_ = (T); const float* src_; int sld_; int c1_, c2_ = -1; sg = 0.f; qs = 0.f; i8t = t_ < TR_N0;     \
        if (t_ < TR_N0) { src_ = a.in[I_WIN]; sld_ = 8224; r0 = (t_ & 31) * 64; c0 = (t_ >> 5) * 64; const bool f8_ = in_f8(t_ >> 7) || (F8_MASK != 0u && (t_ >> 5) == 128);     \
            dst = f8_ ? (bf16_t*)(a.ws + WS_WIN8) : (bf16_t*)(a.ws + WS_WIN); dst_ld = 2048; qs = f8_ ? WINI8_SCALE : 0.f; MapWin()(c0 + cc, c1_, c2_, sg); } \
        else if (t_ < TR_N1) { const int u_ = t_ - TR_N0; src_ = a.in[I_WGLA]; sld_ = 2048; r0 = (u_ & 15) * 64; c0 = (u_ >> 4) * 64; dst = (bf16_t*)(a.ws + WS_WGLA); dst_ld = 1024; c1_ = c0 + cc; if (F8_GLA) qs = WIN8_SCALE; } \
        else if (t_ < TR_N2) { const int u_ = t_ - TR_N1; src_ = a.in[I_WOUT]; sld_ = 2048; r0 = (u_ & 31) * 64; c0 = (u_ >> 5) * 64; dst = (bf16_t*)(a.ws + WS_WOUT); dst_ld = 2048; c1_ = c0 + cc; if (F8_OUT) qs = WIN8_SCALE; } \
        else { const int u_ = t_ - TR_N2; src_ = a.in[I_WQ]; sld_ = 2048; r0 = (u_ & 31) * 64; c0 = (u_ >> 5) * 64; dst = (bf16_t*)(a.ws + WS_WQ); dst_ld = 2048; c1_ = c0 + cc; } \
        wide = !(t_ < TR_N0 && c0 < 1024);     \
        if (wide) { int w1_ = c0 + 4 * (tid & 15), w2_; float wsg_; if (t_ < TR_N0) MapWin()(w1_, w1_, w2_, wsg_); \
            _Pragma("unroll") for (int i = 0; i < 2; ++i) { f32x4 v_ = {0.f, 0.f, 0.f, 0.f}; if (w1_ >= 0) v_ = *(const f32x4*)(src_ + (size_t)(r0 + (tid >> 4) + 32 * i) * sld_ + w1_); \
                va[4 * i] = v_[0]; va[4 * i + 1] = v_[1]; va[4 * i + 2] = v_[2]; va[4 * i + 3] = v_[3]; vb[4 * i] = 0.f; vb[4 * i + 1] = 0.f; vb[4 * i + 2] = 0.f; vb[4 * i + 3] = 0.f; } } \
        else { _Pragma("unroll") for (int i = 0; i < 8; ++i) { const float* sp_ = src_ + (size_t)(r0 + rr0 + 8 * i) * sld_; \
            va[i] = c1_ >= 0 ? sp_[c1_] : 0.f; vb[i] = c2_ >= 0 ? sp_[c2_] : 0.f; } } } while (0)
    int t = blockIdx.x;
    if (t < TR_N3) TR_LOAD(t);
    for (; t < TR_N3; t += G) {
        if (wide) {
#pragma unroll
            for (int i = 0; i < 2; ++i)
#pragma unroll
                for (int k = 0; k < 4; ++k) tile[(4 * (tid & 15) + k) * 65 + (tid >> 4) + 32 * i] = va[4 * i + k];
        } else {
#pragma unroll
            for (int i = 0; i < 8; ++i) tile[cc * 65 + rr0 + 8 * i] = va[i] + sg * vb[i];
        }
        __syncthreads();
        bf16_t* const dstc = dst; const int ldc = dst_ld, r0c = r0, c0c = c0; const float qsc = qs; const bool i8c = i8t;
        if (t + G < TR_N3) TR_LOAD(t + G);
        if (qsc > 0.f) {
            const int rp = (tid & 15) * 4, cq = tid >> 4;
#pragma unroll
            for (int i = 0; i < 2; ++i) { const int c = cq + 32 * i; const LAS float* tp = tile + c * 65 + rp;
                *(int*)((unsigned char*)dstc + (size_t)(c0c + c) * ldc + r0c + rp) = i8c ? pack_i8x4(tp[0] * qsc, tp[1] * qsc, tp[2] * qsc, tp[3] * qsc) : pack_fp8x4(tp[0] * qsc, tp[1] * qsc, tp[2] * qsc, tp[3] * qsc); }
        } else {
            const int rp = (tid & 31) * 2, cq = tid >> 5;
#pragma unroll
            for (int i = 0; i < 4; ++i) { const int c = cq + 16 * i; *(unsigned*)(dstc + (size_t)(c0c + c) * ldc + r0c + rp) = pk2(tile[c * 65 + rp], tile[c * 65 + rp + 1]); }
        }
        __syncthreads();
    }
#undef TR_LOAD
}

__device__ void phase0(const Args& a, ldsp_t lds) {
    const int G = gridDim.x, bx = blockIdx.x;
    for (int t = bx; t < 192; t += G) gemv_task(a, t, lds);
    for (int t = bx; t < 64; t += G) tables_task(a, t);
    cvt_flat(a, a.in[I_KEYS], (bf16_t*)(a.ws + WS_KEYS), (size_t)8 * 2 * 128 * 128);
    tr_all(a, lds);
    for (int t = bx; t < 512; t += G) fold_tile(a, t, lds);
}

template <bool WITH_A1, bool XBF = false>
__device__ void norm_phase(const Args& a, const float* X, const float* gvec, const float* mod_sh, const float* mod_sc, bf16_t* out, const bf16_t* Wa1t, bf16_t* P, ldsp_t lds) {
    const int lane = threadIdx.x & 63, wave = threadIdx.x >> 6;
    const int W = gridDim.x * 8;
    const int row_first = blockIdx.x * 8 + wave;
    f32x4 Av[8], Bv[8], v[8];
    int bcur = -1;
#define NORM_LOAD_ROW(DST, ROW) do { _Pragma("unroll") for (int j = 0; j < 8; ++j) { \
        if (XBF) { const u32x2 hw_ = *(const u32x2*)((const bf16_t*)X + (size_t)(ROW) * 2048 + (j * 64 + lane) * 4); DST[j] = (f32x4){bflo(hw_.x), bfhi(hw_.x), bflo(hw_.y), bfhi(hw_.y)}; } \
        else DST[j] = *(const f32x4*)(X + (size_t)(ROW) * 2048 + (j * 64 + lane) * 4); } } while (0)
    if (row_first < T_) NORM_LOAD_ROW(v, row_first);
    for (int row = row_first; row < T_; row += W) {
        const int b = row >> 14;
        if (b != bcur) { bcur = b;
#pragma unroll
            for (int j = 0; j < 8; ++j) { const int d = (j * 64 + lane) * 4;
                const f32x4 gg = *(const f32x4*)(gvec + d), sc = *(const f32x4*)(mod_sc + b * 12288 + d);
                Av[j] = gg * (1.0f + sc); Bv[j] = *(const f32x4*)(mod_sh + b * 12288 + d); } }
        f32x4 vn[8];
        { const int rn = row + W < T_ ? row + W : row; NORM_LOAD_ROW(vn, rn); }
        float ss = 0.f;
#pragma unroll
        for (int j = 0; j < 8; ++j) ss += v[j][0] * v[j][0] + v[j][1] * v[j][1] + v[j][2] * v[j][2] + v[j][3] * v[j][3];
        ss = wave_sum(ss);
        const float rstd = rsqrtf(ss * (1.0f / 2048.0f) + EPS);
        if (XBF) {
            f32x4 y[8]; float mx = 0.f;
#pragma unroll
            for (int j = 0; j < 8; ++j) { y[j] = v[j] * rstd * Av[j] + Bv[j];
                mx = fmaxf(mx, fmaxf(fmaxf(fabsf(y[j][0]), fabsf(y[j][1])), fmaxf(fabsf(y[j][2]), fabsf(y[j][3])))); }
#pragma unroll
            for (int o = 32; o >= 1; o >>= 1) mx = fmaxf(mx, __shfl_xor(mx, o));
            const float qs = 127.0f / fmaxf(mx, 1e-20f);
            if (lane == 0) ((float*)(a.ws + WS_XS))[row] = mx * (1.0f / 127.0f);
#pragma unroll
            for (int j = 0; j < 8; ++j) { const int d = (j * 64 + lane) * 4;
                u32x2 w; w.x = pk2(y[j][0], y[j][1]); w.y = pk2(y[j][2], y[j][3]);
                *(u32x2*)(out + (size_t)row * 2048 + d) = w;
                const int q0 = __float2int_rn(y[j][0] * qs), q1 = __float2int_rn(y[j][1] * qs), q2 = __float2int_rn(y[j][2] * qs), q3 = __float2int_rn(y[j][3] * qs);
                *(unsigned*)(a.ws + WS_XQ8 + (size_t)row * 2048 + d) = (unsigned)(q0 & 255) | ((unsigned)(q1 & 255) << 8) | ((unsigned)(q2 & 255) << 16) | ((unsigned)q3 << 24); }
        } else {
            f32x4 y[8]; float mx = 0.f;
#pragma unroll
            for (int j = 0; j < 8; ++j) { y[j] = v[j] * rstd * Av[j] + Bv[j];
                mx = fmaxf(mx, fmaxf(fmaxf(fabsf(y[j][0]), fabsf(y[j][1])), fmaxf(fabsf(y[j][2]), fabsf(y[j][3])))); }
#pragma unroll
            for (int o = 32; o >= 1; o >>= 1) mx = fmaxf(mx, __shfl_xor(mx, o));
            const float qs = 127.0f / fmaxf(mx, 1e-20f);
            if (lane == 0) ((float*)(a.ws + WS_XS))[row] = mx * (1.0f / 127.0f);
#pragma unroll
            for (int j = 0; j < 8; ++j) { const int d = (j * 64 + lane) * 4;
                *(int*)((unsigned char*)a.out + (size_t)row * 2048 + d) = pack_i8x4(y[j][0] * qs, y[j][1] * qs, y[j][2] * qs, y[j][3] * qs);
                if (out) { u32x2 w; w.x = pk2(y[j][0], y[j][1]); w.y = pk2(y[j][2], y[j][3]);
                    *(u32x2*)(out + (size_t)row * 2048 + d) = w; } }
        }
#pragma unroll
        for (int j = 0; j < 8; ++j) v[j] = vn[j];
    }
#undef NORM_LOAD_ROW
    if (WITH_A1) {
        constexpr int WS_ = 2064;
        const unsigned char* W8 = (const unsigned char*)Wa1t;
        __syncthreads();
#pragma unroll
        for (int p = 0; p < 8; ++p) { const int pc = threadIdx.x + 512 * p, rw = pc >> 7, c16 = pc & 127;
            *(LAS u32x4*)(lds + rw * WS_ + c16 * 16) = *(const u32x4*)(W8 + (size_t)rw * 2048 + c16 * 16); }
        asm volatile("s_waitcnt vmcnt(0)" ::: "memory");
        __syncthreads();
        const int l15 = lane & 15, g = lane >> 4;
        const int nrows = (T_ - row_first + W - 1) / W;
        const int myrow = row_first + W * (l15 < nrows ? l15 : 0);
        f32x4 acc[2] = {{0.f, 0.f, 0.f, 0.f}, {0.f, 0.f, 0.f, 0.f}};
        typedef int v4ia_ __attribute__((ext_vector_type(4))); v4ia_ ia[2] = {{0, 0, 0, 0}, {0, 0, 0, 0}};
        const unsigned char* ap = (const unsigned char*)a.out + (size_t)myrow * 2048 + 16 * g;
        LAS const unsigned char* bp = lds + l15 * WS_ + 16 * g;
#pragma unroll 4
        for (int kb = 0; kb < 16; ++kb) {
            const u32x4 a0 = *(const u32x4*)(ap + 128 * kb), a1v = *(const u32x4*)(ap + 128 * kb + 64);
            const u32x4 b00 = *(LAS const u32x4*)(bp + 128 * kb), b01 = *(LAS const u32x4*)(bp + 128 * kb + 64);
            const u32x4 b10 = *(LAS const u32x4*)(bp + 16 * WS_ + 128 * kb), b11 = *(LAS const u32x4*)(bp + 16 * WS_ + 128 * kb + 64);
            typedef int v8i_ __attribute__((ext_vector_type(8)));
            const v8i_ av = {(int)a0.x, (int)a0.y, (int)a0.z, (int)a0.w, (int)a1v.x, (int)a1v.y, (int)a1v.z, (int)a1v.w};
            const v8i_ bv0 = {(int)b00.x, (int)b00.y, (int)b00.z, (int)b00.w, (int)b01.x, (int)b01.y, (int)b01.z, (int)b01.w};
            const v8i_ bv1 = {(int)b10.x, (int)b10.y, (int)b10.z, (int)b10.w, (int)b11.x, (int)b11.y, (int)b11.z, (int)b11.w};
            (void)av; (void)bv0; (void)bv1;
            typedef int v4i_ __attribute__((ext_vector_type(4)));
            ia[0] = __builtin_amdgcn_mfma_i32_16x16x64_i8(__builtin_bit_cast(v4i_, a0), __builtin_bit_cast(v4i_, b00), ia[0], 0, 0, 0);
            ia[0] = __builtin_amdgcn_mfma_i32_16x16x64_i8(__builtin_bit_cast(v4i_, a1v), __builtin_bit_cast(v4i_, b01), ia[0], 0, 0, 0);
            ia[1] = __builtin_amdgcn_mfma_i32_16x16x64_i8(__builtin_bit_cast(v4i_, a0), __builtin_bit_cast(v4i_, b10), ia[1], 0, 0, 0);
            ia[1] = __builtin_amdgcn_mfma_i32_16x16x64_i8(__builtin_bit_cast(v4i_, a1v), __builtin_bit_cast(v4i_, b11), ia[1], 0, 0, 0);
        }
#pragma unroll
        for (int r = 0; r < 4; ++r) { const int i_ = 4 * g + r; const float rs_ = (i_ < nrows) ? ((const float*)(a.ws + WS_XS))[row_first + W * i_] * (1.0f / WINI8_SCALE) : 0.f;
            acc[0][r] = (float)ia[0][r] * rs_; acc[1][r] = (float)ia[1][r] * rs_; }
#pragma unroll
        for (int r = 0; r < 4; ++r) { const int i = 4 * g + r; if (i < nrows) { const size_t rr = (size_t)(row_first + W * i);
            P[rr * PW + PC_A1 + l15] = (bf16_t)f2bf(acc[0][r]); P[rr * PW + PC_A1 + 16 + l15] = (bf16_t)f2bf(acc[1][r]); } }
    }
}

__device__ void fft1_phase(const Args& a, ldsp_t lds) {
    const int tid = threadIdx.x, lane = tid & 63, w = tid >> 6, g = lane >> 4, l15 = lane & 15;
    const bf16_t* F1 = (const bf16_t*)(a.ws + WS_F1);
    const float* TW = (const float*)(a.ws + WS_TW);
    const bf16_t* P = (const bf16_t*)(a.ws + WS_P);
    bf16_t* T1 = (bf16_t*)a.out;
    bf16x8 Af[2][4];
#pragma unroll
    for (int mt = 0; mt < 2; ++mt)
#pragma unroll
        for (int ks = 0; ks < 4; ++ks) Af[mt][ks] = *(const bf16x8*)(F1 + (32 * w + 16 * mt + l15) * 128 + 32 * ks + 8 * g);
    constexpr int OS = 272, OFF_OUT = 128 * 256;
    const unsigned ldsb = (unsigned)(size_t)lds;
    const int c16 = tid & 15, r32 = tid >> 4;
    u32x4 buf[4];
    int tile = blockIdx.x;
    if (tile < 2048) { const int cb = tile & 7, s_lo = (tile >> 3) & 127, b = tile >> 10;
        const bf16_t* src = P + (size_t)(b * S_ + s_lo) * PW + PC_Z + cb * 128 + 8 * c16;
#pragma unroll
        for (int i = 0; i < 4; ++i) buf[i] = *(const u32x4*)(src + (size_t)(r32 + 32 * i) * 128 * PW); }
    for (; tile < 2048; tile += gridDim.x) {
        const int cb = tile & 7, s_lo = (tile >> 3) & 127, b = tile >> 10;
        __syncthreads();
#pragma unroll
        for (int i = 0; i < 4; ++i) *(LAS u32x4*)(lds + tr_off(r32 + 32 * i, c16)) = buf[i];
        __syncthreads();
        { const int nt_ = tile + gridDim.x;
          if (nt_ < 2048) { const int cb2 = nt_ & 7, s2 = (nt_ >> 3) & 127, b2 = nt_ >> 10;
            const bf16_t* src = P + (size_t)(b2 * S_ + s2) * PW + PC_Z + cb2 * 128 + 8 * c16;
#pragma unroll
            for (int i = 0; i < 4; ++i) buf[i] = *(const u32x4*)(src + (size_t)(r32 + 32 * i) * 128 * PW); } }
        f32x4 acc[2][8];
#pragma unroll
        for (int mt = 0; mt < 2; ++mt)
#pragma unroll
            for (int nt = 0; nt < 8; ++nt) acc[mt][nt] = (f32x4){0.f, 0.f, 0.f, 0.f};
#pragma unroll
        for (int nt = 0; nt < 8; ++nt) { u32x2 t0[4], t1[4];
            unsigned lv = (unsigned)lane; asm volatile("" : "+v"(lv));
#pragma unroll
            for (int ks = 0; ks < 4; ++ks) TR_FRAG_ISSUE(t0[ks], t1[ks], ldsb, lv, nt, ks);
            asm volatile("s_waitcnt lgkmcnt(0)" : "+v"(t0[0]), "+v"(t1[0]), "+v"(t0[1]), "+v"(t1[1]), "+v"(t0[2]), "+v"(t1[2]), "+v"(t0[3]), "+v"(t1[3]) :: "memory");
#pragma unroll
            for (int ks = 0; ks < 4; ++ks) { const bf16x8 bfr = tr_join(t0[ks], t1[ks]);
                acc[0][nt] = __builtin_amdgcn_mfma_f32_16x16x32_bf16(Af[0][ks], bfr, acc[0][nt], 0, 0, 0);
                acc[1][nt] = __builtin_amdgcn_mfma_f32_16x16x32_bf16(Af[1][ks], bfr, acc[1][nt], 0, 0, 0); } }
#pragma unroll
        for (int r = 0; r < 4; ++r) { const int k_lo = 16 * w + 4 * g + r;
            const f32x2 cs = *(const f32x2*)(TW + 2 * (k_lo * 128 + s_lo));
#pragma unroll
            for (int nt = 0; nt < 8; ++nt) { const float tr = acc[0][nt][r], ti = acc[1][nt][r];
                *(LAS unsigned short*)(lds + OFF_OUT + (2 * k_lo) * OS + (16 * nt + l15) * 2) = (unsigned short)f2bf(tr * cs.x + ti * cs.y);
                *(LAS unsigned short*)(lds + OFF_OUT + (2 * k_lo + 1) * OS + (16 * nt + l15) * 2) = (unsigned short)f2bf(ti * cs.x - tr * cs.y); } }
        __syncthreads();
#pragma unroll
        for (int i = 0; i < 8; ++i) { const int row = r32 + 32 * i;
            const u32x4 v = *(const LAS u32x4*)(lds + OFF_OUT + row * OS + c16 * 16);
            *(u32x4*)(T1 + ((size_t)((b * 128 + (row >> 1)) * 128 + s_lo) * 2 + (row & 1)) * 1024 + cb * 128 + c16 * 8) = v; }
    }
}

__device__ void fft2_phase(const Args& a, ldsp_t lds) {
    const int tid = threadIdx.x, lane = tid & 63, w = tid >> 6, g = lane >> 4, l15 = lane & 15;
    const bf16_t* F2 = (const bf16_t*)(a.ws + WS_F2);
    const bf16_t* T1 = (const bf16_t*)a.out;
    bf16_t* ZA = (bf16_t*)a.out + (size_t)T_ * 2048;
    bf16x8 Af[2][8];
#pragma unroll
    for (int mt = 0; mt < 2; ++mt)
#pragma unroll
        for (int ks = 0; ks < 8; ++ks) Af[mt][ks] = *(const bf16x8*)(F2 + (32 * w + 16 * mt + l15) * 256 + 32 * ks + 8 * g);
    constexpr int OS = 272, OFF_OUT = 256 * 256;
    const unsigned ldsb = (unsigned)(size_t)lds;
    static_assert(OFF_OUT + 128 * OS <= LDS_BYTES - 16, "FFT2 LDS");
    const int c16 = tid & 15, r32 = tid >> 4;
    u32x4 buf[8];
    int tile = blockIdx.x;
    if (tile < 2048) { const int cb = tile & 7, k_lo = (tile >> 3) & 127, b = tile >> 10;
        const bf16_t* src = T1 + ((size_t)(b * 128 + k_lo) * 256) * 1024 + cb * 128 + 8 * c16;
#pragma unroll
        for (int i = 0; i < 8; ++i) buf[i] = *(const u32x4*)(src + (size_t)(r32 + 32 * i) * 1024); }
    for (; tile < 2048; tile += gridDim.x) {
        const int cb = tile & 7, k_lo = (tile >> 3) & 127, b = tile >> 10;
        const bool odd = (cb & 1) != 0;
        __syncthreads();
#pragma unroll
        for (int i = 0; i < 8; ++i) *(LAS u32x4*)(lds + tr_off(r32 + 32 * i, c16)) = buf[i];
        __syncthreads();
        { const int nt_ = tile + gridDim.x;
          if (nt_ < 2048) { const int cb2 = nt_ & 7, k2 = (nt_ >> 3) & 127, b2 = nt_ >> 10;
            const bf16_t* src = T1 + ((size_t)(b2 * 128 + k2) * 256) * 1024 + cb2 * 128 + 8 * c16;
#pragma unroll
            for (int i = 0; i < 8; ++i) buf[i] = *(const u32x4*)(src + (size_t)(r32 + 32 * i) * 1024); } }
        f32x4 acc[2][8];
#pragma unroll
        for (int mt = 0; mt < 2; ++mt)
#pragma unroll
            for (int nt = 0; nt < 8; ++nt) acc[mt][nt] = (f32x4){0.f, 0.f, 0.f, 0.f};
#pragma unroll
        for (int nt = 0; nt < 8; ++nt)
#pragma unroll
            for (int kh = 0; kh < 2; ++kh) { u32x2 t0[4], t1[4];
                unsigned lv = (unsigned)lane; asm volatile("" : "+v"(lv));
#pragma unroll
                for (int ks = 0; ks < 4; ++ks) TR_FRAG_ISSUE(t0[ks], t1[ks], ldsb, lv, nt, 4 * kh + ks);
                asm volatile("s_waitcnt lgkmcnt(0)" : "+v"(t0[0]), "+v"(t1[0]), "+v"(t0[1]), "+v"(t1[1]), "+v"(t0[2]), "+v"(t1[2]), "+v"(t0[3]), "+v"(t1[3]) :: "memory");
#pragma unroll
                for (int ks = 0; ks < 4; ++ks) { const bf16x8 bfr = tr_join(t0[ks], t1[ks]);
                    acc[0][nt] = __builtin_amdgcn_mfma_f32_16x16x32_bf16(Af[0][4 * kh + ks], bfr, acc[0][nt], 0, 0, 0);
                    if (odd) acc[1][nt] = __builtin_amdgcn_mfma_f32_16x16x32_bf16(Af[1][4 * kh + ks], bfr, acc[1][nt], 0, 0, 0); } }
#pragma unroll
        for (int r = 0; r < 4; ++r) { const int k_hi = 16 * w + 4 * g + r;
#pragma unroll
            for (int nt = 0; nt < 8; ++nt) { const float v = (odd && !(nt == 0 && l15 == 0)) ? acc[1][nt][r] : acc[0][nt][r];
                if (F8_FNET) *(LAS unsigned char*)(lds + OFF_OUT + k_hi * OS + (16 * nt + l15)) = (unsigned char)fp8_byte(v * ZA8_SCALE);
                else *(LAS unsigned short*)(lds + OFF_OUT + k_hi * OS + (16 * nt + l15) * 2) = (unsigned short)f2bf(v); } }
        __syncthreads();
        if (F8_FNET) {
#pragma unroll
            for (int i = 0; i < 2; ++i) { const int pc = tid + 512 * i, row = pc >> 3, c8 = pc & 7;
                const u32x4 v = *(const LAS u32x4*)(lds + OFF_OUT + row * OS + c8 * 16);
                *(u32x4*)((unsigned char*)ZA + (size_t)(b * S_ + 128 * row + k_lo) * 1024 + cb * 128 + c8 * 16) = v; }
        } else {
#pragma unroll
        for (int i = 0; i < 4; ++i) { const int row = r32 + 32 * i;
            const u32x4 v = *(const LAS u32x4*)(lds + OFF_OUT + row * OS + c16 * 16);
            *(u32x4*)(ZA + (size_t)(b * S_ + 128 * row + k_lo) * 1024 + cb * 128 + c16 * 8) = v; }
        }
    }
}

constexpr size_t WS_MIX8 = WS_XN + (size_t)64 * 1024 * 1024;
constexpr size_t WS_QT  = WS_XN;
constexpr size_t WS_AS  = WS_QT + (size_t)4096 * 64 * 128 * 2;
constexpr size_t WS_KDT = WS_END;
constexpr size_t WS_BL  = WS_KDT + (size_t)4096 * 128 * 64 * 2;
constexpr size_t WS_END2 = WS_BL + (size_t)4096 * 128 * 4;
static_assert(WS_AS + (size_t)4096 * 64 * 64 * 2 <= WS_O, "GLA pre-pass buffers must fit in the XN region");
static_assert(WS_END2 <= WS_WIN8 && WS_END3 <= (size_t)1060 * 1000 * 1000, "workspace budget");

__device__ __forceinline__ float fast_logsigmoid(float z) {
    const float e = __builtin_amdgcn_exp2f(-fabsf(z) * 1.4426950408889634f);
    return fminf(z, 0.f) - __builtin_amdgcn_logf(1.0f + e) * 0.6931471805599453f;
}

__device__ void gla_pre_phase(const Args& a, ldsp_t lds) {
    const int tid = threadIdx.x, lane = tid & 63, w = tid >> 6, g = lane >> 4, l15 = lane & 15;
    const int d = tid & 127, tg = tid >> 7;
    const bf16_t* P = (const bf16_t*)(a.ws + WS_P);
    bf16_t* QT = (bf16_t*)(a.ws + WS_QT); bf16_t* AS = (bf16_t*)(a.ws + WS_AS); bf16_t* KDT = (bf16_t*)(a.ws + WS_KDT); float* BL = (float*)(a.ws + WS_BL);
    constexpr int QS = 272, JS = 144;
    constexpr int GZS = 132;
    constexpr int OFF_QS = 0, OFF_KS = OFF_QS + 64 * QS, OFF_AS = OFF_KS + 64 * QS, OFF_A1 = OFF_AS + 64 * JS, OFF_TOT = OFF_A1 + 2048, OFF_GZ = OFF_TOT + 2048, OFF_RQ = OFF_GZ + 64 * GZS * 4, OFF_RK = OFF_RQ + 64 * 256;
    static_assert(OFF_RK + 64 * 256 <= LDS_BYTES - 16, "GLA pre LDS");
    LAS float* tot = (LAS float*)(lds + OFF_TOT);
    LAS float* Gz = (LAS float*)(lds + OFF_GZ);
    u32x4 pq[2], pkk[2];
    u32x4 a1v = {0u, 0u, 0u, 0u};
    const int task_base = (blockIdx.x >> 4) * 256 + (blockIdx.x & 15) * 16;
    int task = task_base;
#define GLA_PRE_LOADS(T) do { const int stream_ = (T) >> 8, chunk_ = (T) & 255, dir_ = stream_ & 1, h_ = (stream_ >> 1) & 3, b_ = stream_ >> 3; \
        if (tid < 128) { const int i_ = tid >> 1, hf_ = tid & 1, tau_ = chunk_ * 64 + i_, t_ = dir_ ? (S_ - 1 - tau_) : tau_; \
            a1v = *(const u32x4*)(P + (size_t)(b_ * S_ + t_) * PW + PC_A1 + dir_ * 16 + hf_ * 8); } \
        _Pragma("unroll") for (int p_ = 0; p_ < 2; ++p_) { const int pc_ = tid + 512 * p_, i_ = pc_ >> 4, c_ = pc_ & 15, tau_ = chunk_ * 64 + i_, t_ = dir_ ? (S_ - 1 - tau_) : tau_; \
            const bf16_t* prow_ = P + (size_t)(b_ * S_ + t_) * PW + h_ * 128 + c_ * 8; pq[p_] = *(const u32x4*)(prow_ + PC_Q); pkk[p_] = *(const u32x4*)(prow_ + PC_K); } } while (0)
    GLA_PRE_LOADS(task);
    float ba; bf16x8 bw2 = {0, 0, 0, 0, 0, 0, 0, 0};
    { const int stream = task_base >> 8, dir = stream & 1, h = (stream >> 1) & 3;
      if (g < 2) {
#pragma unroll
          for (int r = 0; r < 8; ++r) bw2[r] = (short)f2bf(a.in[I_WA2][(size_t)(dir * 16 + 8 * g + r) * 512 + h * 128 + 16 * w + l15]); }
      ba = a.in[I_BA][dir * 512 + h * 128 + d]; }
    for (; task < task_base + 16; ++task) {
        if (tid < 128) *(LAS u32x4*)(lds + OFF_A1 + (tid >> 1) * 32 + (tid & 1) * 16) = a1v;
#pragma unroll
        for (int p = 0; p < 2; ++p) { const int pc = tid + 512 * p;
            *(LAS u32x4*)(lds + OFF_RQ + (pc >> 4) * 256 + (pc & 15) * 16) = pq[p]; *(LAS u32x4*)(lds + OFF_RK + (pc >> 4) * 256 + (pc & 15) * 16) = pkk[p]; }
        __syncthreads();
#pragma unroll
        for (int mt = 0; mt < 4; ++mt) {
            bf16x8 af = {0, 0, 0, 0, 0, 0, 0, 0};
            if (g < 2) af = *(const LAS bf16x8*)(lds + OFF_A1 + (16 * mt + l15) * 32 + g * 16);
            const f32x4 zacc = __builtin_amdgcn_mfma_f32_16x16x32_bf16(af, bw2, (f32x4){0.f, 0.f, 0.f, 0.f}, 0, 0, 0);
#pragma unroll
            for (int r = 0; r < 4; ++r) Gz[(16 * mt + 4 * g + r) * GZS + 16 * w + l15] = zacc[r]; }
        __syncthreads();
        float wv[16]; float run = 0.f;
#pragma unroll
        for (int ii = 0; ii < 16; ++ii) { const float z = ba + Gz[(16 * tg + ii) * GZS + d];
            run += fast_logsigmoid(z) * (1.0f / 16.0f); wv[ii] = run; }
        tot[tg * 128 + d] = run;
        __syncthreads();
        float pre = 0.f, blast = 0.f;
#pragma unroll
        for (int q = 0; q < 4; ++q) { const float tq = tot[q * 128 + d]; blast += tq; pre += (q < tg) ? tq : 0.f; }
        if (tg == 0) BL[(size_t)task * 128 + d] = blast;
        unsigned kd[8];
        const float eblast = __expf(blast);
#pragma unroll
        for (int ii = 0; ii < 16; ii += 2) { float kdv[2];
#pragma unroll
            for (int e = 0; e < 2; ++e) { const int i = 16 * tg + ii + e; const float bi = pre + wv[ii + e];
                const float qv = bf2f(*(const LAS unsigned short*)(lds + OFF_RQ + i * 256 + d * 2)), kv = bf2f(*(const LAS unsigned short*)(lds + OFF_RK + i * 256 + d * 2));
                const float kt = kv * __expf(-bi);
                *(LAS unsigned short*)(lds + OFF_QS + i * QS + d * 2) = (unsigned short)f2bf(qv * 0.08838834764831845f * __expf(bi));
                *(LAS unsigned short*)(lds + OFF_KS + i * QS + d * 2) = (unsigned short)f2bf(kt);
                kdv[e] = kt * eblast; }
            kd[ii >> 1] = pk2(kdv[0], kdv[1]); }
        { bf16_t* kp = KDT + ((size_t)task * 128 + d) * 64 + 16 * tg;
          *(u32x4*)kp = (u32x4){kd[0], kd[1], kd[2], kd[3]}; *(u32x4*)(kp + 8) = (u32x4){kd[4], kd[5], kd[6], kd[7]}; }
        __syncthreads();
        { const int nt_ = task + 1; if (nt_ < task_base + 16) GLA_PRE_LOADS(nt_); }
#pragma unroll
        for (int q = 0; q < 2; ++q) { const int mt = w >> 1, nt = 2 * (w & 1) + q;
            f32x4 sacc = {0.f, 0.f, 0.f, 0.f};
#pragma unroll
            for (int ks = 0; ks < 4; ++ks) { const bf16x8 af = *(const LAS bf16x8*)(lds + OFF_QS + (16 * mt + l15) * QS + (32 * ks + 8 * g) * 2);
                const bf16x8 bf = *(const LAS bf16x8*)(lds + OFF_KS + (16 * nt + l15) * QS + (32 * ks + 8 * g) * 2);
                sacc = __builtin_amdgcn_mfma_f32_16x16x32_bf16(af, bf, sacc, 0, 0, 0); }
#pragma unroll
            for (int r = 0; r < 4; ++r) { const int i = 16 * mt + 4 * g + r, j = 16 * nt + l15;
                *(LAS unsigned short*)(lds + OFF_AS + i * JS + j * 2) = (unsigned short)f2bf(j <= i ? sacc[r] : 0.f); } }
        __syncthreads();
#pragma unroll
        for (int p = 0; p < 2; ++p) { const int pc = tid + 512 * p, row = pc >> 4, c16 = pc & 15;
            *(u32x4*)(QT + ((size_t)task * 64 + row) * 128 + c16 * 8) = *(const LAS u32x4*)(lds + OFF_QS + row * QS + c16 * 16); }
        { const int row = tid >> 3, c8 = tid & 7;
          *(u32x4*)(AS + ((size_t)task * 64 + row) * 64 + c8 * 8) = *(const LAS u32x4*)(lds + OFF_AS + row * JS + c8 * 16); }
    }
#undef GLA_PRE_LOADS
    __threadfence();
    __syncthreads();
}

__device__ __forceinline__ void gla_task_decode(int task, int& stream, int& eh, int& sg) {
    const int u = task & 255, i = task >> 8; stream = u >> 4; eh = i; sg = i ? 15 - (u & 15) : (u & 15);
}
__device__ __forceinline__ int gla_lidx(int stream, int eh, int sg) { return (stream * 2 + eh) * 16 + sg; }

#ifndef GLA_DEPTH_B
#define GLA_DEPTH_B 2
#endif
#ifndef GLA_DEPTH_A
#define GLA_DEPTH_A 2
#endif
template <bool PB>
__device__ void gla_scan_phase(const Args& a, ldsp_t lds) {
    const int tid = threadIdx.x, lane = tid & 63, w = tid >> 6, g = lane >> 4, l15 = lane & 15;
    const bf16_t* P = (const bf16_t*)(a.ws + WS_P);
    const bf16_t* QT = (const bf16_t*)(a.ws + WS_QT); const bf16_t* AS = (const bf16_t*)(a.ws + WS_AS); const bf16_t* KDT = (const bf16_t*)(a.ws + WS_KDT); const float* BL = (const float*)(a.ws + WS_BL);
    float* Lbuf = (float*)(a.ws + WS_L);
    float* DSEG = (float*)(a.ws + WS_DSEG);
    bf16_t* O = (bf16_t*)(a.ws + WS_O);
    constexpr int QS = 272, JS = 144;
    constexpr int OFF_QS = 0, OFF_AS = OFF_QS + 64 * QS, OFF_KDT = OFF_AS + 64 * JS, OFF_VT = OFF_KDT + 128 * JS, OFF_SB = OFF_VT + 128 * JS, OFF_OB = OFF_SB + 128 * QS,
                  OFF_DS = OFF_OB + 64 * QS, OFF_END = OFF_DS + 512;
    static_assert(OFF_END <= LDS_BYTES - 16, "GLA LDS");
    const int c16 = tid & 15, r32 = tid >> 4, c8 = tid & 7, r64 = tid >> 3;
    const unsigned ldsb = (unsigned)(size_t)lds;

    for (int it = 0; it < 2; ++it) {
        int stream, eh, sg;
        if (PB) gla_task_decode(blockIdx.x + 256 * it, stream, eh, sg);
        else { stream = blockIdx.x >> 4; sg = blockIdx.x & 15; eh = it; }
        const int dir = stream & 1, h = (stream >> 1) & 3, b = stream >> 3;
        f32x4 Sst[8];
#pragma unroll
        for (int mt = 0; mt < 8; ++mt) Sst[mt] = (f32x4){0.f, 0.f, 0.f, 0.f};
        if (PB) {
            for (int sp = 0; sp < sg; ++sp) {
                const float* Lp = Lbuf + (size_t)gla_lidx(stream, eh, sp) * 16384;
                const float* Dp = DSEG + (stream * 16 + sp) * 128;
#pragma unroll
                for (int mt = 0; mt < 8; ++mt) { const f32x4 dl = *(const f32x4*)(Dp + 16 * mt + 4 * g);
#pragma unroll
                    for (int r = 0; r < 4; ++r) Sst[mt][r] = Sst[mt][r] * __expf(dl[r]) + Lp[(mt * 4 + r) * 512 + tid]; }
            }
            __syncthreads();
#pragma unroll
            for (int mt = 0; mt < 8; ++mt) { u32x2 pw; pw.x = pk2(Sst[mt][0], Sst[mt][1]); pw.y = pk2(Sst[mt][2], Sst[mt][3]);
                *(LAS u32x2*)(lds + OFF_SB + (16 * w + l15) * QS + (16 * mt + 4 * g) * 2) = pw; }
        }
        float logD = 0.f;
        constexpr int DEPTH = PB ? GLA_DEPTH_B : GLA_DEPTH_A;
        u32x4 pk_[DEPTH][2], pv_[DEPTH][2], pq_[DEPTH][2], pa_[DEPTH]; float pbl[DEPTH];
#define GLA_SCAN_LOADS(SET, CI) do { const int ct_ = stream * 256 + sg * 16 + (CI); \
        _Pragma("unroll") for (int p_ = 0; p_ < 2; ++p_) { const int pc_ = tid + 512 * p_; \
            pk_[SET][p_] = *(const u32x4*)(KDT + ((size_t)ct_ * 128 + (pc_ >> 3)) * 64 + (pc_ & 7) * 8); \
            { const int j_ = pc_ >> 4, tau_ = (sg * 16 + (CI)) * 64 + j_, t_ = dir ? (S_ - 1 - tau_) : tau_; \
              pv_[SET][p_] = *(const u32x4*)(P + (size_t)(b * S_ + t_) * PW + PC_V + h * 256 + eh * 128 + (pc_ & 15) * 8); } \
            if (PB) pq_[SET][p_] = *(const u32x4*)(QT + ((size_t)ct_ * 64 + (pc_ >> 4)) * 128 + (pc_ & 15) * 8); } \
        if (PB) pa_[SET] = *(const u32x4*)(AS + ((size_t)ct_ * 64 + r64) * 64 + c8 * 8); \
        pbl[SET] = (tid < 128) ? BL[(size_t)ct_ * 128 + tid] : 0.f; } while (0)
#pragma unroll
        for (int s_ = 0; s_ < DEPTH; ++s_) GLA_SCAN_LOADS(s_, s_);
        for (int ci0 = 0; ci0 < 16; ci0 += DEPTH) {
#pragma unroll
          for (int s_ = 0; s_ < DEPTH; ++s_) {
            const int ci = ci0 + s_;
            if (ci >= 16) break;
            const int tau0 = (sg * 16 + ci) * 64;
#pragma unroll
            for (int p = 0; p < 2; ++p) { const int pc = tid + 512 * p;
                *(LAS u32x4*)(lds + OFF_KDT + (pc >> 3) * JS + (pc & 7) * 16) = pk_[s_][p];
                *(LAS u32x4*)(lds + OFF_VT + tr_off(pc >> 4, pc & 15)) = pv_[s_][p];
                if (PB) *(LAS u32x4*)(lds + OFF_QS + (pc >> 4) * QS + (pc & 15) * 16) = pq_[s_][p]; }
            if (PB) *(LAS u32x4*)(lds + OFF_AS + r64 * JS + c8 * 16) = pa_[s_];
            if (tid < 128) { *(LAS float*)(lds + OFF_DS + tid * 4) = __expf(pbl[s_]); logD += pbl[s_]; }
            __syncthreads();
            if (ci + DEPTH < 16) GLA_SCAN_LOADS(s_, ci + DEPTH);
            bf16x8 vfr[2];
            { u32x2 t0[2], t1[2];
              TR_FRAG_ISSUE(t0[0], t1[0], ldsb + OFF_VT, lane, w, 0); TR_FRAG_ISSUE(t0[1], t1[1], ldsb + OFF_VT, lane, w, 1);
              asm volatile("s_waitcnt lgkmcnt(0)" : "+v"(t0[0]), "+v"(t1[0]), "+v"(t0[1]), "+v"(t1[1]) :: "memory");
              vfr[0] = tr_join(t0[0], t1[0]); vfr[1] = tr_join(t0[1], t1[1]); }
            f32x4 oacc[4];
            if (PB) {
#pragma unroll
                for (int mt = 0; mt < 4; ++mt) oacc[mt] = (f32x4){0.f, 0.f, 0.f, 0.f};
                const unsigned qb = ldsb + OFF_QS + l15 * QS + g * 16, sbb = ldsb + OFF_SB + (16 * w + l15) * QS + g * 16;
#pragma unroll
                for (int ks = 0; ks < 4; ++ks) { bf16x8 sf, qf[4];
                    LDS_RD128_O(sf, sbb + ks * 64, 0); LDS_RD4(qf, qb + ks * 64, 16 * QS);
                    LDS_WAIT4(qf[0], qf[1], qf[2], qf[3]); asm volatile("" : "+v"(sf));
#pragma unroll
                    for (int mt = 0; mt < 4; ++mt) oacc[mt] = __builtin_amdgcn_mfma_f32_16x16x32_bf16(qf[mt], sf, oacc[mt], 0, 0, 0); }
                { const unsigned ab = ldsb + OFF_AS + l15 * JS + g * 16;
#pragma unroll
                  for (int ks = 0; ks < 2; ++ks) { bf16x8 af[4];
                      LDS_RD4(af, ab + ks * 64, 16 * JS);
                      LDS_WAIT4(af[0], af[1], af[2], af[3]);
#pragma unroll
                      for (int mt = 0; mt < 4; ++mt) oacc[mt] = __builtin_amdgcn_mfma_f32_16x16x32_bf16(af[mt], vfr[ks], oacc[mt], 0, 0, 0); } }
            }
#pragma unroll
            for (int mt = 0; mt < 8; ++mt) { const f32x4 dsc = *(const LAS f32x4*)(lds + OFF_DS + (16 * mt + 4 * g) * 4);
                Sst[mt] = Sst[mt] * dsc; }
            { const unsigned kb = ldsb + OFF_KDT + l15 * JS + g * 16;
#pragma unroll
              for (int ks = 0; ks < 2; ++ks) { bf16x8 kf[8];
                  LDS_RD8(kf, kb + ks * 64, 16 * JS);
                  LDS_WAIT8(kf[0], kf[1], kf[2], kf[3], kf[4], kf[5], kf[6], kf[7]);
#pragma unroll
                  for (int mt = 0; mt < 8; ++mt) Sst[mt] = __builtin_amdgcn_mfma_f32_16x16x32_bf16(kf[mt], vfr[ks], Sst[mt], 0, 0, 0); } }
            __syncthreads();
            if (PB) {
#pragma unroll
                for (int mt = 0; mt < 8; ++mt) { u32x2 pw; pw.x = pk2(Sst[mt][0], Sst[mt][1]); pw.y = pk2(Sst[mt][2], Sst[mt][3]);
                    *(LAS u32x2*)(lds + OFF_SB + (16 * w + l15) * QS + (16 * mt + 4 * g) * 2) = pw; }
#pragma unroll
                for (int mt = 0; mt < 4; ++mt)
#pragma unroll
                    for (int r = 0; r < 4; ++r) *(LAS unsigned short*)(lds + OFF_OB + (16 * mt + 4 * g + r) * QS + (16 * w + l15) * 2) = (unsigned short)f2bf(oacc[mt][r]);
                __syncthreads();
#pragma unroll
                for (int p = 0; p < 2; ++p) { const int pc = tid + 512 * p, i = pc >> 4, tau = tau0 + i, t = dir ? (S_ - 1 - tau) : tau;
                    *(u32x4*)(O + ((size_t)dir * T_ + (size_t)(b * S_ + t)) * 1024 + h * 256 + eh * 128 + (pc & 15) * 8) = *(const LAS u32x4*)(lds + OFF_OB + i * QS + (pc & 15) * 16); }
            }
          }
        }
#undef GLA_SCAN_LOADS
        if (!PB) {
            float* Lp = Lbuf + (size_t)gla_lidx(stream, eh, sg) * 16384;
#pragma unroll
            for (int mt = 0; mt < 8; ++mt)
#pragma unroll
                for (int r = 0; r < 4; ++r) Lp[(mt * 4 + r) * 512 + tid] = Sst[mt][r];
            if (tid < 128 && eh == 0) DSEG[(stream * 16 + sg) * 128 + tid] = logD;
        }
        __syncthreads();
    }
}

__device__ void gla_post_phase(const Args& a) {
    const int lane = threadIdx.x & 63, wave = threadIdx.x >> 6, W = gridDim.x * 8;
    const bf16_t* O = (const bf16_t*)(a.ws + WS_O);
    const bf16_t* P = (const bf16_t*)(a.ws + WS_P);
    bf16_t* GO = (bf16_t*)(a.ws + WS_XN);
    const float* ng = a.in[I_GNG];
    const int e0 = lane * 16;
    float ngv[16];
#pragma unroll
    for (int j = 0; j < 16; ++j) ngv[j] = ng[(e0 + j) & 255];
    const int row_first = blockIdx.x * 8 + wave;
    u32x4 f[2], bk[2], rr[2];
#define GLA_POST_LOAD(F, B, R, ROW) do { _Pragma("unroll") for (int q = 0; q < 2; ++q) { F[q] = *(const u32x4*)(O + (size_t)(ROW) * 1024 + e0 + 8 * q); \
        B[q] = *(const u32x4*)(O + ((size_t)T_ + (ROW)) * 1024 + e0 + 8 * q); R[q] = *(const u32x4*)(P + (size_t)(ROW) * PW + PC_R + e0 + 8 * q); } } while (0)
    if (row_first < T_) GLA_POST_LOAD(f, bk, rr, row_first);
    for (int row = row_first; row < T_; row += W) {
        u32x4 fn[2], bn[2], rn[2];
        { const int rnx = row + W < T_ ? row + W : row; GLA_POST_LOAD(fn, bn, rn, rnx); }
        float v[16]; float ss = 0.f;
#pragma unroll
        for (int q = 0; q < 2; ++q) {
            const unsigned fw[4] = {f[q].x, f[q].y, f[q].z, f[q].w}, bw[4] = {bk[q].x, bk[q].y, bk[q].z, bk[q].w};
#pragma unroll
            for (int j = 0; j < 4; ++j) { v[8 * q + 2 * j] = bflo(fw[j]) + bflo(bw[j]); v[8 * q + 2 * j + 1] = bfhi(fw[j]) + bfhi(bw[j]); } }
#pragma unroll
        for (int j = 0; j < 16; ++j) ss += v[j] * v[j];
#pragma unroll
        for (int o = 8; o >= 1; o >>= 1) ss += __shfl_xor(ss, o);
        const float rstd = rsqrtf(ss * (1.0f / 256.0f) + EPS);
        unsigned ow[8];
#pragma unroll
        for (int q = 0; q < 2; ++q) { const unsigned rw[4] = {rr[q].x, rr[q].y, rr[q].z, rr[q].w};
#pragma unroll
            for (int j = 0; j < 4; ++j) {
                const float r0 = bflo(rw[j]), r1 = bfhi(rw[j]);
                const float y0 = v[8 * q + 2 * j] * rstd * ngv[8 * q + 2 * j] * (r0 * sigmoidf_(r0)), y1 = v[8 * q + 2 * j + 1] * rstd * ngv[8 * q + 2 * j + 1] * (r1 * sigmoidf_(r1));
                ow[4 * q + j] = pk2(y0, y1); } }
        if (F8_GLA) {
            u32x4 o8;
#pragma unroll
            for (int q4 = 0; q4 < 4; ++q4) o8[q4] = (unsigned)pack_fp8x4(bflo(ow[2 * q4]), bfhi(ow[2 * q4]), bflo(ow[2 * q4 + 1]), bfhi(ow[2 * q4 + 1]));
            *(u32x4*)((unsigned char*)GO + (size_t)row * 1024 + e0) = o8;
        } else {
        *(u32x4*)(GO + (size_t)row * 1024 + e0) = (u32x4){ow[0], ow[1], ow[2], ow[3]};
        *(u32x4*)(GO + (size_t)row * 1024 + e0 + 8) = (u32x4){ow[4], ow[5], ow[6], ow[7]};
        }
#pragma unroll
        for (int q = 0; q < 2; ++q) { f[q] = fn[q]; bk[q] = bn[q]; rr[q] = rn[q]; }
    }
#undef GLA_POST_LOAD
}

__device__ __forceinline__ unsigned f2ord(float f) { const unsigned u = __float_as_uint(f); return (u & 0x80000000u) ? ~u : (u | 0x80000000u); }
__device__ __forceinline__ float ord2f(unsigned o) { return __uint_as_float((o & 0x80000000u) ? (o & 0x7fffffffu) : ~o); }
#define CE_DESC(x, y) do { const unsigned _hi = max((x), (y)), _lo = min((x), (y)); (x) = _hi; (y) = _lo; } while (0)
#define CE_ASC(x, y) do { const unsigned _hi = max((x), (y)), _lo = min((x), (y)); (x) = _lo; (y) = _hi; } while (0)
template <int N> __device__ __forceinline__ void bitonic_sort_desc(unsigned (&k)[N]) {
#pragma unroll
    for (int sz = 2; sz <= N; sz <<= 1)
#pragma unroll
        for (int j = sz >> 1; j > 0; j >>= 1)
#pragma unroll
            for (int i = 0; i < N; ++i) { const int l = i ^ j; if (l > i) { if ((i & sz) == 0) CE_DESC(k[i], k[l]); else CE_ASC(k[i], k[l]); } }
}
template <int N> __device__ __forceinline__ void bitonic_merge_desc(unsigned (&k)[N]) {
#pragma unroll
    for (int j = N >> 1; j > 0; j >>= 1)
#pragma unroll
        for (int i = 0; i < N; ++i) { const int l = i ^ j; if (l > i) CE_DESC(k[i], k[l]); }
}
#define CE2_DESC(kx, px, ky, py) do { const bool _sw = (ky) > (kx); const unsigned _k0 = _sw ? (ky) : (kx), _k1 = _sw ? (kx) : (ky), _p0 = _sw ? (py) : (px), _p1 = _sw ? (px) : (py); \
        (kx) = _k0; (ky) = _k1; (px) = _p0; (py) = _p1; } while (0)
template <int N> __device__ __forceinline__ void bitonic_sort_desc2(unsigned (&k)[N], unsigned (&p)[N]) {
#pragma unroll
    for (int sz = 2; sz <= N; sz <<= 1)
#pragma unroll
        for (int j = sz >> 1; j > 0; j >>= 1)
#pragma unroll
            for (int i = 0; i < N; ++i) { const int l = i ^ j; if (l > i) { if ((i & sz) == 0) CE2_DESC(k[i], p[i], k[l], p[l]); else CE2_DESC(k[l], p[l], k[i], p[i]); } }
}
template <int N> __device__ __forceinline__ void bitonic_merge_desc2(unsigned (&k)[N], unsigned (&p)[N]) {
#pragma unroll
    for (int j = N >> 1; j > 0; j >>= 1)
#pragma unroll
        for (int i = 0; i < N; ++i) { const int l = i ^ j; if (l > i) CE2_DESC(k[i], p[i], k[l], p[l]); }
}
__device__ __forceinline__ void lane_merge16(unsigned (&k)[16], int xm) {
    unsigned o[16];
#pragma unroll
    for (int i = 0; i < 16; ++i) o[i] = (unsigned)__shfl_xor((int)k[i], xm);
#pragma unroll
    for (int i = 0; i < 16; ++i) k[i] = max(k[i], o[15 - i]);
    bitonic_merge_desc<16>(k);
}
__device__ __forceinline__ void lane_merge16_2(unsigned (&k)[16], unsigned (&p)[16], int xm) {
    unsigned ok[16], op[16];
#pragma unroll
    for (int i = 0; i < 16; ++i) { ok[i] = (unsigned)__shfl_xor((int)k[i], xm); op[i] = (unsigned)__shfl_xor((int)p[i], xm); }
#pragma unroll
    for (int i = 0; i < 16; ++i) { const bool sw = ok[15 - i] > k[i]; k[i] = sw ? ok[15 - i] : k[i]; p[i] = sw ? op[15 - i] : p[i]; }
    bitonic_merge_desc2<16>(k, p);
}

__device__ void peer_select_phase(const Args& a, ldsp_t lds) {
    const int tid = threadIdx.x, lane = tid & 63, wave = tid >> 6, g = lane >> 4, l15 = lane & 15, W = gridDim.x * 8;
    const bf16_t* QP = (const bf16_t*)(a.ws + WS_QP);
    const bf16_t* KB = (const bf16_t*)(a.ws + WS_KEYS);
    int* IDX = (int*)(a.ws + WS_IDX); float* GW = (float*)(a.ws + WS_G);
    constexpr int KS = 272, OFF_TL = 2 * 128 * KS;
    static_assert(OFF_TL + 8 * 8192 <= LDS_BYTES - 16, "select LDS");
    const unsigned ldsb = (unsigned)(size_t)lds;
    LAS unsigned* tl = (LAS unsigned*)(lds + OFF_TL + wave * 8192);
    for (int h = 0; h < 8; ++h) {
        __syncthreads();
#pragma unroll
        for (int p = 0; p < 8; ++p) { const int pc = tid + 512 * p, row = pc >> 4, c16 = pc & 15;
            *(LAS u32x4*)(lds + row * KS + c16 * 16) = *(const u32x4*)(KB + (size_t)(h * 256 + row) * 128 + c16 * 8); }
        __syncthreads();
      for (int grp = blockIdx.x * 8 + wave; grp < 2048; grp += W) {
        const int tok0 = grp * 16, tok = tok0 + l15;
        bf16x8 bq[2][4];
#pragma unroll
        for (int hf = 0; hf < 2; ++hf)
#pragma unroll
            for (int ks = 0; ks < 4; ++ks) bq[hf][ks] = *(const bf16x8*)(QP + (size_t)tok * 2048 + h * 256 + hf * 128 + 32 * ks + 8 * g);
#pragma unroll 1
        for (int hf = 0; hf < 2; ++hf) {
            f32x4 acc[8];
#pragma unroll
            for (int mt = 0; mt < 8; ++mt) acc[mt] = (f32x4){0.f, 0.f, 0.f, 0.f};
            const unsigned kbase = ldsb + (unsigned)((hf * 128 + l15) * KS + g * 16);
#pragma unroll
            for (int ks = 0; ks < 4; ++ks) { bf16x8 af[8];
                LDS_RD8(af, kbase + ks * 64, 16 * KS);
                LDS_WAIT8(af[0], af[1], af[2], af[3], af[4], af[5], af[6], af[7]);
                const bf16x8 bfr = hf ? bq[1][ks] : bq[0][ks];
#pragma unroll
                for (int mt = 0; mt < 8; ++mt) acc[mt] = __builtin_amdgcn_mfma_f32_16x16x32_bf16(af[mt], bfr, acc[mt], 0, 0, 0); }
            unsigned key[32];
#pragma unroll
            for (int mt = 0; mt < 8; ++mt)
#pragma unroll
                for (int r = 0; r < 4; ++r) { const int n = 16 * mt + 4 * g + r; key[4 * mt + r] = (f2ord(acc[mt][r]) & ~127u) | (unsigned)(127 - n); }
            unsigned lo[16], hi[16];
#pragma unroll
            for (int i = 0; i < 16; ++i) { lo[i] = key[i]; hi[i] = key[16 + i]; }
            bitonic_sort_desc<16>(lo); bitonic_sort_desc<16>(hi);
#pragma unroll
            for (int i = 0; i < 16; ++i) lo[i] = max(lo[i], hi[15 - i]);
            bitonic_merge_desc<16>(lo);
            lane_merge16(lo, 16); lane_merge16(lo, 32);
#pragma unroll
            for (int i = 0; i < 16; ++i) tl[(hf * 16 + i) * 64 + lane] = lo[i];
        }
        unsigned top[2][16];
#pragma unroll
        for (int i = 0; i < 16; ++i) { top[0][i] = tl[i * 64 + lane]; top[1][i] = tl[(16 + i) * 64 + lane]; }
        unsigned ck[16], cp[16];
#pragma unroll
        for (int i = 0; i < 16; ++i) { ck[i] = 0u; cp[i] = 0u; }
#define PEER_CAND(slot, I, J) do { const float _s = ord2f(top[0][I] & ~127u) + ord2f(top[1][J] & ~127u); ck[slot] = f2ord(_s); cp[slot] = ((127u - (top[0][I] & 127u)) << 7) | (127u - (top[1][J] & 127u)); } while (0)
        if (g == 0) { PEER_CAND(0, 0, 0); PEER_CAND(1, 0, 1); PEER_CAND(2, 0, 2); PEER_CAND(3, 0, 3); PEER_CAND(4, 0, 4); PEER_CAND(5, 0, 5); PEER_CAND(6, 0, 6); PEER_CAND(7, 0, 7);
            PEER_CAND(8, 0, 8); PEER_CAND(9, 0, 9); PEER_CAND(10, 0, 10); PEER_CAND(11, 0, 11); PEER_CAND(12, 0, 12); PEER_CAND(13, 0, 13); PEER_CAND(14, 0, 14); PEER_CAND(15, 0, 15); }
        else if (g == 1) { PEER_CAND(0, 1, 0); PEER_CAND(1, 1, 1); PEER_CAND(2, 1, 2); PEER_CAND(3, 1, 3); PEER_CAND(4, 1, 4); PEER_CAND(5, 1, 5); PEER_CAND(6, 1, 6); PEER_CAND(7, 1, 7);
            PEER_CAND(8, 2, 0); PEER_CAND(9, 2, 1); PEER_CAND(10, 2, 2); PEER_CAND(11, 2, 3); PEER_CAND(12, 2, 4); PEER_CAND(13, 3, 0); PEER_CAND(14, 3, 1); PEER_CAND(15, 3, 2); }
        else if (g == 2) { PEER_CAND(0, 3, 3); PEER_CAND(1, 4, 0); PEER_CAND(2, 4, 1); PEER_CAND(3, 4, 2); PEER_CAND(4, 5, 0); PEER_CAND(5, 5, 1); PEER_CAND(6, 6, 0); PEER_CAND(7, 6, 1);
            PEER_CAND(8, 7, 0); PEER_CAND(9, 7, 1); PEER_CAND(10, 8, 0); PEER_CAND(11, 9, 0); PEER_CAND(12, 10, 0); PEER_CAND(13, 11, 0); PEER_CAND(14, 12, 0); PEER_CAND(15, 13, 0); }
        else { PEER_CAND(0, 14, 0); PEER_CAND(1, 15, 0); }
#undef PEER_CAND
        bitonic_sort_desc2<16>(ck, cp);
        lane_merge16_2(ck, cp, 16); lane_merge16_2(ck, cp, 32);
        float ev[16]; float sum = 0.f; const float mx = ord2f(ck[0]);
#pragma unroll
        for (int i = 0; i < 16; ++i) { ev[i] = __expf(ord2f(ck[i]) - mx); sum += ev[i]; }
        const float inv = 1.0f / sum;
#pragma unroll
        for (int i = 0; i < 16; ++i) if ((i >> 2) == g) { IDX[(size_t)tok * 128 + h * 16 + i] = (int)cp[i]; GW[(size_t)tok * 128 + h * 16 + i] = ev[i] * inv; }
      }
    }
}

typedef float f32x16 __attribute__((ext_vector_type(16)));
typedef float f32x32 __attribute__((ext_vector_type(32)));
typedef unsigned u32x6 __attribute__((ext_vector_type(6)));
typedef _Float16 h16x2 __attribute__((ext_vector_type(2)));
typedef _Float16 h16x32 __attribute__((ext_vector_type(32)));
__device__ __forceinline__ float group8_sum(float d) {
    d += __builtin_bit_cast(float, __builtin_amdgcn_update_dpp(0, __builtin_bit_cast(int, d), 0xB1, 0xF, 0xF, true));
    d += __builtin_bit_cast(float, __builtin_amdgcn_update_dpp(0, __builtin_bit_cast(int, d), 0x4E, 0xF, 0xF, true));
    d += __builtin_bit_cast(float, __builtin_amdgcn_update_dpp(0, __builtin_bit_cast(int, d), 0x141, 0xF, 0xF, true));
    return d;
}
constexpr float U_SCALE = 48.0f, V_SCALE = 4.0f;
constexpr size_t WS_PART = WS_QP;
constexpr size_t WS_CF   = WS_VB + (size_t)32 * 1024 * 1024;
constexpr size_t WS_SSP  = WS_CF + (size_t)T_ * 128 * 4;
constexpr size_t WS_H2   = WS_O;
static_assert(WS_SSP + (size_t)T_ * 8 * 4 <= WS_END, "PEER buffers must fit in the P region");
constexpr int PEER_Q1 = 3 * XCD_BAR_WORDS, PEER_Q2 = 3 * XCD_BAR_WORDS + 1024;
constexpr int PEER_CHUNK = 16, PEER_NCHUNK = T_ / PEER_CHUNK;

__device__ void cvt_rows_fp6_sliced(const Args& a, const float* src, unsigned char* dst, int nrows, float scale) {
    const size_t gt = (size_t)blockIdx.x * 512 + threadIdx.x, gs = (size_t)gridDim.x * 512;
    for (size_t idx = gt; idx < (size_t)nrows * 64; idx += gs) {
        const size_t row = idx >> 6; const int l = (int)(idx & 63), sl = l >> 3, q = l & 7;
        const float* sp = src + row * 2048 + 32 * l;
        f32x16 a, b;
#pragma unroll
        for (int i = 0; i < 8; ++i) { const f32x4 vv = *(const f32x4*)(sp + 4 * i);
            a[2 * i] = fminf(fmaxf(vv[0] * scale, -7.5f), 7.5f); b[2 * i] = fminf(fmaxf(vv[1] * scale, -7.5f), 7.5f);
            a[2 * i + 1] = fminf(fmaxf(vv[2] * scale, -7.5f), 7.5f); b[2 * i + 1] = fminf(fmaxf(vv[3] * scale, -7.5f), 7.5f); }
        const u32x6 pk = __builtin_amdgcn_cvt_scalef32_2xpk16_fp6_f32(a, b, 1.0f);
        unsigned char* dp = dst + ((size_t)sl * 16384 + row) * 192;
        *(u32x4*)(dp + 16 * q) = (u32x4){pk[0], pk[1], pk[2], pk[3]};
        *(u32x2*)(dp + 128 + 8 * q) = (u32x2){pk[4], pk[5]};
    }
}
constexpr float U4_SCALE = 128.0f;
__device__ void cvt_rows_i4_sliced(const Args& a, const float* src, unsigned char* dst, int nrows, float scale) {
    const size_t gt = (size_t)blockIdx.x * 512 + threadIdx.x, gs = (size_t)gridDim.x * 512;
    for (size_t idx = gt; idx < (size_t)nrows * 64; idx += gs) {
        const size_t row = idx >> 6; const int l = (int)(idx & 63), sl = l >> 3, q = l & 7;
        const float* sa = src + row * 2048 + 256 * sl + 16 * q; const float* sb = sa + 128;
        unsigned w[4];
#pragma unroll
        for (int i = 0; i < 4; ++i) { const f32x4 va = *(const f32x4*)(sa + 4 * i), vb = *(const f32x4*)(sb + 4 * i); unsigned pk = 0u;
#pragma unroll
            for (int e = 0; e < 4; ++e) { const int qa = __float2int_rn(fminf(fmaxf(va[e] * scale, -7.0f), 7.0f)) + 8, qb = __float2int_rn(fminf(fmaxf(vb[e] * scale, -7.0f), 7.0f)) + 8;
                pk |= ((unsigned)qa | ((unsigned)qb << 4)) << (8 * e); }
            w[i] = pk; }
        *(u32x4*)(dst + ((size_t)sl * 16384 + row) * 128 + 16 * q) = (u32x4){w[0], w[1], w[2], w[3]};
    }
}
__device__ void cvt_rows_fp4_sliced(const Args& a, const float* src, unsigned char* dst, int nrows, float scale) {
    const size_t gt = (size_t)blockIdx.x * 512 + threadIdx.x, gs = (size_t)gridDim.x * 512;
    for (size_t idx = gt; idx < (size_t)nrows * 64; idx += gs) {
        const size_t row = idx >> 6; const int l = (int)(idx & 63), sl = l >> 3, q = l & 7;
        const float* sp = src + row * 2048 + 32 * l;
        unsigned w[4];
#pragma unroll
        for (int d = 0; d < 4; ++d) { const f32x4 v0 = *(const f32x4*)(sp + 8 * d), v1 = *(const f32x4*)(sp + 8 * d + 4); unsigned pw = 0u;
            float e[8] = {v0[0], v0[1], v0[2], v0[3], v1[0], v1[1], v1[2], v1[3]};
#pragma unroll
            for (int i = 0; i < 8; ++i) e[i] = fminf(fmaxf(e[i] * scale, -6.0f), 6.0f);
            pw = __builtin_amdgcn_cvt_scalef32_pk_fp4_f32(pw, e[0], e[1], 1.0f, 0); pw = __builtin_amdgcn_cvt_scalef32_pk_fp4_f32(pw, e[2], e[3], 1.0f, 1);
            pw = __builtin_amdgcn_cvt_scalef32_pk_fp4_f32(pw, e[4], e[5], 1.0f, 2); pw = __builtin_amdgcn_cvt_scalef32_pk_fp4_f32(pw, e[6], e[7], 1.0f, 3);
            w[d] = pw; }
        *(u32x4*)(dst + ((size_t)sl * 16384 + row) * 128 + 16 * q) = (u32x4){w[0], w[1], w[2], w[3]};
    }
}
__device__ __forceinline__ float gelu_erf(float x) { return 0.5f * x * (1.0f + erff(x * 0.70710678118654752f)); }

#define PEER_PULL_BEGIN(QBASE) { unsigned* qh_ = (unsigned*)(a.ws + WS_CTL) + (QBASE) + a.li; int s = (int)(xb_xcc_id() & 7u), tried_ = 0; \
        while (tried_ < 8) { unsigned c_ = 0u; if (lane == 0) c_ = __hip_atomic_fetch_add(qh_ + 64 * s, 1u, __ATOMIC_RELAXED, __HIP_MEMORY_SCOPE_AGENT); \
            const int chunk = (int)__builtin_amdgcn_readfirstlane(c_); \
            if (chunk >= PEER_NCHUNK) { s = (s + 1) & 7; ++tried_; continue; } \
            tried_ = 0;
#define PEER_PULL_END } }

__device__ void peer_stage1_phase(const Args& a) {
    const int lane = threadIdx.x & 63, p = lane >> 3, q = lane & 7, gl = lane & ~7;
    const unsigned char* XQ = a.ws + WS_XQ8; const float* XS = (const float*)(a.ws + WS_XS);
    const unsigned char* UB = a.ws + WS_UB;
    const int* IDX = (const int*)(a.ws + WS_IDX);
    bf16_t* PART = (bf16_t*)(a.ws + WS_PART);
    PEER_PULL_BEGIN(PEER_Q1)
        const unsigned char* ubase = UB + (size_t)s * 16384 * 128;
        for (int th = 0; th < PEER_CHUNK / 8; ++th) { const int tok = chunk * PEER_CHUNK + 8 * th + p;
            const u32x4 xa = *(const u32x4*)(XQ + (size_t)tok * 2048 + s * 256 + 16 * q), xb = *(const u32x4*)(XQ + (size_t)tok * 2048 + s * 256 + 128 + 16 * q);
            const float psc = XS[tok] * (U_SCALE / U4_SCALE);
            int sx8 = 0;
            { const unsigned xw[8] = {xa.x, xa.y, xa.z, xa.w, xb.x, xb.y, xb.z, xb.w};
#pragma unroll
              for (int i = 0; i < 8; ++i) sx8 = __builtin_amdgcn_sdot4((int)xw[i], 0x01010101, sx8, false);
              sx8 *= -8; }
            bf16_t* prow = PART + ((size_t)s * T_ + tok) * 128;
            const int* idp = IDX + (size_t)tok * 128 + q;
            const unsigned qo = 16u * q;
            u32x4 faA[8];
#define PEER_S1_LOAD(FA, IDV) do { _Pragma("unroll") for (int kq = 0; kq < 8; ++kq) { const unsigned ro_ = ((unsigned)__shfl(IDV, gl + kq) << 7) + qo;     \
                FA[kq] = *(const u32x4*)(ubase + ro_); } } while (0)
#define PEER_S1_DOT(W, XA, XB) do { ac_ = __builtin_amdgcn_sdot4((int)((W) & 0x0F0F0F0Fu), (int)(XA), ac_, false); ac_ = __builtin_amdgcn_sdot4((int)(((W) >> 4) & 0x0F0F0F0Fu), (int)(XB), ac_, false); } while (0)
#define PEER_S1_USE(FA, J) do { float mine_ = 0.f; _Pragma("unroll") for (int kq = 0; kq < 8; ++kq) { int ac_ = sx8; \
                PEER_S1_DOT(FA[kq].x, xa.x, xb.x); PEER_S1_DOT(FA[kq].y, xa.y, xb.y); PEER_S1_DOT(FA[kq].z, xa.z, xb.z); PEER_S1_DOT(FA[kq].w, xa.w, xb.w); \
                const float d_ = group8_sum((float)ac_); \
                mine_ = (q == kq) ? d_ : mine_; } \
                prow[8 * (J) + q] = (bf16_t)f2bf(mine_ * psc); } while (0)
            int idn = idp[0];
#pragma unroll 1
            for (int j = 0; j < 16; ++j) {
                const int idj = idn; if (j < 15) idn = idp[8 * (j + 1)];
                PEER_S1_LOAD(faA, idj);
                PEER_S1_USE(faA, j);
            }
#undef PEER_S1_LOAD
#undef PEER_S1_USE
#undef PEER_S1_DOT
        }
    PEER_PULL_END
}

__device__ void peer_cf_phase(const Args& a) {
    const bf16_t* PART = (const bf16_t*)(a.ws + WS_PART); const float* GW = (const float*)(a.ws + WS_G); float* CF = (float*)(a.ws + WS_CF);
    const size_t n = (size_t)T_ * 128;
    for (size_t i = ((size_t)blockIdx.x * 512 + threadIdx.x) * 4; i < n; i += (size_t)gridDim.x * 512 * 4) {
        u32x2 pw[8];
#pragma unroll
        for (int s = 0; s < 8; ++s) pw[s] = *(const u32x2*)(PART + (size_t)s * n + i);
        const f32x4 gw = *(const f32x4*)(GW + i);
        f32x4 d = {0.f, 0.f, 0.f, 0.f};
#pragma unroll
        for (int s = 0; s < 8; ++s) { d[0] += bflo(pw[s].x); d[1] += bfhi(pw[s].x); d[2] += bflo(pw[s].y); d[3] += bfhi(pw[s].y); }
        f32x4 r;
#pragma unroll
        for (int j = 0; j < 4; ++j) r[j] = gw[j] * gelu_erf(d[j] * (1.0f / U_SCALE)) * (1.0f / V_SCALE);
        *(f32x4*)(CF + i) = r;
    }
}

__device__ __forceinline__ unsigned cf_h2(float c) { const h16x2 h = {(_Float16)c, (_Float16)c}; return __builtin_bit_cast(unsigned, h); }
template <bool DRY> __device__ void peer_stage2_phase(const Args& a) {
    const int lane = threadIdx.x & 63, p = lane >> 3, q = lane & 7, gl = lane & ~7;
    const unsigned char* VB = a.ws + WS_VB;
    const int* IDX = (const int*)(a.ws + WS_IDX); const float* CF = (const float*)(a.ws + WS_CF);
    bf16_t* O2 = (bf16_t*)(a.ws + WS_H2);
    PEER_PULL_BEGIN(PEER_Q2)
        const unsigned char* vbase = VB + (size_t)s * 16384 * 128;
        for (int th = 0; th < PEER_CHUNK / 8; ++th) { const int tok = chunk * PEER_CHUNK + 8 * th + p;
            h16x2 o[16];
#pragma unroll
            for (int j = 0; j < 16; ++j) o[j] = (h16x2){(_Float16)0.f, (_Float16)0.f};
            u32x4 faA[4], faB[4];
            const unsigned qo4 = 16u * q;
            int idj = IDX[(size_t)tok * 128 + q]; unsigned cfj = cf_h2(CF[(size_t)tok * 128 + q]);
#define PEER_S2_LOAD(FA, IDV, K0) do { _Pragma("unroll") for (int kq = 0; kq < 4; ++kq) { const unsigned ro_ = ((unsigned)__shfl(IDV, gl + (K0) + kq) << 7) + qo4;     \
                FA[kq] = *(const u32x4*)(vbase + ro_); } } while (0)
#define PEER_S2_USE(FA, CFV, K0) do { _Pragma("unroll") for (int kq = 0; kq < 4; ++kq) { const h16x2 cf_ = __builtin_bit_cast(h16x2, (unsigned)__shfl((int)(CFV), gl + (K0) + kq)); \
                const unsigned vw_[4] = {FA[kq].x, FA[kq].y, FA[kq].z, FA[kq].w}; \
                _Pragma("unroll") for (int d = 0; d < 4; ++d) { \
                    o[4 * d + 0] = __builtin_amdgcn_cvt_scalef32_pk_f16_fp4(vw_[d], 1.0f, 0) * cf_ + o[4 * d + 0]; o[4 * d + 1] = __builtin_amdgcn_cvt_scalef32_pk_f16_fp4(vw_[d], 1.0f, 1) * cf_ + o[4 * d + 1]; \
                    o[4 * d + 2] = __builtin_amdgcn_cvt_scalef32_pk_f16_fp4(vw_[d], 1.0f, 2) * cf_ + o[4 * d + 2]; o[4 * d + 3] = __builtin_amdgcn_cvt_scalef32_pk_f16_fp4(vw_[d], 1.0f, 3) * cf_ + o[4 * d + 3]; } } } while (0)
            PEER_S2_LOAD(faA, idj, 0);
#pragma unroll 1
            for (int j = 0; j < 16; ++j) {
                const int jn = j < 15 ? j + 1 : 15;
                const int idn = IDX[(size_t)tok * 128 + 8 * jn + q]; const unsigned cfn = cf_h2(CF[(size_t)tok * 128 + 8 * jn + q]);
                PEER_S2_LOAD(faB, idj, 4);
                PEER_S2_USE(faA, cfj, 0);
                PEER_S2_LOAD(faA, idn, 0);
                PEER_S2_USE(faB, cfj, 4);
                idj = idn; cfj = cfn;
            }
#undef PEER_S2_LOAD
#undef PEER_S2_USE
            { const int d0 = s * 256 + 32 * q;
#pragma unroll
              for (int i = 0; i < 4; ++i) { const u32x4 w = {pk2((float)o[4 * i].x, (float)o[4 * i].y), pk2((float)o[4 * i + 1].x, (float)o[4 * i + 1].y), pk2((float)o[4 * i + 2].x, (float)o[4 * i + 2].y), pk2((float)o[4 * i + 3].x, (float)o[4 * i + 3].y)};
                  if (!DRY || (float)o[0].x == 123.456f) *(u32x4*)(O2 + (size_t)tok * 2048 + d0 + 8 * i) = w; } }
        }
    PEER_PULL_END
}

__device__ void peer_final_phase(const Args& a) {
    const int lane = threadIdx.x & 63, wave = threadIdx.x >> 6, W = gridDim.x * 8;
    const bf16_t* O2 = (const bf16_t*)(a.ws + WS_H2); const float* fg = a.in[I_FNG]; const float* mod = (const float*)(a.ws + WS_MOD);
    float* H = a.out; const bf16_t* HB = (const bf16_t*)(a.ws + WS_HB);
    f32x4 F[8], G2[8]; int bcur = -1;
#pragma unroll
    for (int i = 0; i < 4; ++i) { const int d0 = (i * 64 + lane) * 8; F[2 * i] = *(const f32x4*)(fg + d0); F[2 * i + 1] = *(const f32x4*)(fg + d0 + 4); }
    const int tok_first = blockIdx.x * 8 + wave;
    u32x4 hw[4], ow[4];
    if (tok_first < T_) {
#pragma unroll
        for (int i = 0; i < 4; ++i) { const int d0 = (i * 64 + lane) * 8; hw[i] = *(const u32x4*)(HB + (size_t)tok_first * 2048 + d0); ow[i] = *(const u32x4*)(O2 + (size_t)tok_first * 2048 + d0); } }
    for (int tok = tok_first; tok < T_; tok += W) {
        const int b = tok >> 14;
        if (b != bcur) { bcur = b;
#pragma unroll
            for (int i = 0; i < 4; ++i) { const int d0 = (i * 64 + lane) * 8; G2[2 * i] = *(const f32x4*)(mod + b * 12288 + 5 * 2048 + d0); G2[2 * i + 1] = *(const f32x4*)(mod + b * 12288 + 5 * 2048 + d0 + 4); } }
        u32x4 hn[4], on[4];
        { const int tn = tok + W < T_ ? tok + W : tok;
#pragma unroll
          for (int i = 0; i < 4; ++i) { const int d0 = (i * 64 + lane) * 8; hn[i] = *(const u32x4*)(HB + (size_t)tn * 2048 + d0); on[i] = *(const u32x4*)(O2 + (size_t)tn * 2048 + d0); } }
        float hv[32]; float ss = 0.f;
#pragma unroll
        for (int i = 0; i < 4; ++i) {
            const unsigned os[4] = {ow[i].x, ow[i].y, ow[i].z, ow[i].w}, hs[4] = {hw[i].x, hw[i].y, hw[i].z, hw[i].w};
#pragma unroll
            for (int j = 0; j < 4; ++j) { const f32x4 gq = G2[2 * i + (j >> 1)];
                hv[8 * i + 2 * j] = bflo(hs[j]) + gq[2 * (j & 1)] * bflo(os[j]); hv[8 * i + 2 * j + 1] = bfhi(hs[j]) + gq[2 * (j & 1) + 1] * bfhi(os[j]); }
#pragma unroll
            for (int j = 0; j < 8; ++j) ss += hv[8 * i + j] * hv[8 * i + j]; }
        ss = wave_sum(ss);
        const float rstd = rsqrtf(ss * (1.0f / 2048.0f) + EPS);
#pragma unroll
        for (int i = 0; i < 4; ++i) { const int d0 = (i * 64 + lane) * 8;
            f32x4 r0, r1;
#pragma unroll
            for (int j = 0; j < 4; ++j) { r0[j] = hv[8 * i + j] * rstd * F[2 * i][j]; r1[j] = hv[8 * i + 4 + j] * rstd * F[2 * i + 1][j]; }
            *(f32x4*)(H + (size_t)tok * 2048 + d0) = r0; *(f32x4*)(H + (size_t)tok * 2048 + d0 + 4) = r1; }
#pragma unroll
        for (int i = 0; i < 4; ++i) { hw[i] = hn[i]; ow[i] = on[i]; }
    }
}

__global__ void __launch_bounds__(512, 2) mega(Args a) {
    extern __shared__ __attribute__((aligned(16))) unsigned char lds_raw[];
    ldsp_t lds = (ldsp_t)lds_raw;
    cg::grid_group grid = cg::this_grid();
    const int lo = a.ph_lo, hi = a.ph_hi;
    unsigned char* ws = a.ws;
    const float* mod = (const float*)(ws + WS_MOD);
#ifdef ONLY_PHASE
#define IN(k) ((k) == ONLY_PHASE && lo <= (k) && (k) < hi)
#elif defined(SKIP_PHASE)
#define IN(k) ((k) != SKIP_PHASE && (k) != SKIP_PHASE2 && lo <= (k) && (k) < hi)
#else
#define IN(k) (lo <= (k) && (k) < hi)
#endif
    volatile LAS unsigned* bst = (volatile LAS unsigned*)(lds + LDS_BYTES - 16);
    if (threadIdx.x == 0) { bst[0] = 0u; bst[1] = 0u; }
    __syncthreads();
    XcdBarrier xbar = xcd_barrier_post((unsigned*)(ws + WS_CTL) + a.li * XCD_BAR_WORDS, bst, (int)(threadIdx.x >> 6));
#define SEAM(k) do { if (IN(k) && IN((k) + 1)) { if ((k) == 0) grid.sync(); else xcd_barrier(xbar); } } while (0)
#ifndef DUP_PHASE
#define DUP_PHASE (-1)
#endif
#define REP(k)

    if (IN(0)) phase0(a, lds);
    SEAM(0);
    if (IN(1)) norm_phase<true>(a, a.in[I_X], a.in[I_N1G], mod, mod + 2048, F8_MASK == 0xFFFFFFFFu ? nullptr : (bf16_t*)(ws + WS_XN), (const bf16_t*)(ws + WS_WIN8 + (size_t)8192 * 2048), (bf16_t*)(ws + WS_P), lds);
    SEAM(1);
    if (IN(2)) {
#define PROJ_SEG(T0, T1, F8) do { if ((T1) > (T0)) { \
        pg8::Gemm g{(F8) ? (const bf16_t*)a.out : (const bf16_t*)(ws + WS_XN), (F8) ? (const bf16_t*)(ws + WS_WIN8 + (size_t)(T0) * 256 * 2048) : (const bf16_t*)(ws + WS_WIN) + (size_t)(T0) * 256 * 2048, T_, ((T1) - (T0)) * 256, 2048, 2048}; \
        pg8::StaticOrder S; S.init(T_, ((T1) - (T0)) * 256, gridDim.x, blockIdx.x); \
        pg8::EpiIn E{(bf16_t*)(ws + WS_P), (T0), (F8) ? 1.0f / WINI8_SCALE : 1.0f, (F8) ? (const float*)(ws + WS_XS) : nullptr}; \
        pg8::gemm_phase<pg8::EpiIn, pg8::StaticOrder, F8, F8>(lds, g, S, E); } } while (0)
#if F8_MASK == 0xFFFFFFFFu
        PROJ_SEG(0, 32, true);
#elif F8_MASK == 0xFFFF0000u
        PROJ_SEG(0, 16, false); PROJ_SEG(16, 32, true);
#elif F8_MASK == 0xFFFF000Fu
        PROJ_SEG(0, 4, true); PROJ_SEG(4, 16, false); PROJ_SEG(16, 32, true);
#elif F8_MASK == 0xFFFFFF0Fu
        PROJ_SEG(0, 4, true); PROJ_SEG(4, 8, false); PROJ_SEG(8, 32, true);
#elif F8_MASK == 0u
        PROJ_SEG(0, 32, false);
#else
#error "unsupported F8_MASK"
#endif
#undef PROJ_SEG
    }
    SEAM(2);
    if (IN(3)) { fft1_phase(a, lds); __syncthreads(); }
    if (IN(4)) gla_pre_phase(a, lds);
    if (IN(5)) gla_scan_phase<false>(a, lds);
    SEAM(5);
    if (IN(6)) { fft2_phase(a, lds); __syncthreads(); }
    if (IN(7)) gla_scan_phase<true>(a, lds);
    SEAM(7);
    if (IN(8)) gla_post_phase(a);
    SEAM(8);
    if (IN(9)) {
        {
            pg8::Gemm g{(const bf16_t*)a.out + (size_t)T_ * 2048, (const bf16_t*)(ws + WS_WFN), T_, 2048, 1024, 1024};
            pg8::StaticOrder S; S.init(T_, 2048, gridDim.x, blockIdx.x);
            pg8::EpiGate<0> E{(bf16_t*)(ws + WS_O), 2048, ws + WS_P + 8192, PW * 2, F8_FNET ? 1.0f / (ZA8_SCALE * WFN8_SCALE) : 1.0f, nullptr};
            pg8::gemm_phase<pg8::EpiGate<0>, pg8::StaticOrder, F8_FNET != 0>(lds, g, S, E);
        }
        {
            pg8::Gemm g{(const bf16_t*)(ws + WS_XN), (const bf16_t*)(ws + WS_WGLA), T_, 2048, 1024, 1024};
            pg8::StaticOrder S; S.init(T_, 2048, gridDim.x, blockIdx.x);
            pg8::EpiGate<1, F8_OUT != 0> E{(bf16_t*)(ws + WS_O), 2048, ws + WS_P + 8192 + 2048, PW * 2, F8_GLA ? 1.0f / WIN8_SCALE : 1.0f, ws + WS_MIX8};
            pg8::gemm_phase<pg8::EpiGate<1, F8_OUT != 0>, pg8::StaticOrder, F8_GLA != 0>(lds, g, S, E);
        }
    }
    SEAM(9);
    if (IN(10)) {
        pg8::Gemm g{F8_OUT ? (const bf16_t*)(ws + WS_MIX8) : (const bf16_t*)(ws + WS_O), (const bf16_t*)(ws + WS_WOUT), T_, 2048, 2048, 2048};
        pg8::StaticOrder S; S.init(T_, 2048, gridDim.x, blockIdx.x);
        pg8::EpiRes E{a.in[I_X], mod + 2 * 2048, (bf16_t*)(ws + WS_HB), F8_OUT ? 1.0f / WIN8_SCALE : 1.0f};
        pg8::gemm_phase<pg8::EpiRes, pg8::StaticOrder, F8_OUT != 0>(lds, g, S, E);
    }
    SEAM(10);
    if (IN(11)) {
        norm_phase<false, true>(a, (const float*)(ws + WS_HB), a.in[I_N2G], mod + 3 * 2048, mod + 4 * 2048, (bf16_t*)(ws + WS_XN), nullptr, nullptr, lds);
        cvt_rows_i4_sliced(a, a.in[I_U], ws + WS_UB, 16384, U4_SCALE);
        cvt_rows_fp4_sliced(a, a.in[I_V], ws + WS_VB, 16384, V_SCALE);
    }
    SEAM(11);
    if (IN(12)) {
#ifdef CLKPROBE
        unsigned long long c0 = __builtin_amdgcn_s_memtime(), r0 = __builtin_amdgcn_s_memrealtime();
#endif
        pg8::Gemm g{(const bf16_t*)(ws + WS_XN), (const bf16_t*)(ws + WS_WQ), T_, 2048, 2048, 2048};
        pg8::StaticOrder S; S.init(T_, 2048, gridDim.x, blockIdx.x);
        pg8::EpiGate<2> E{(bf16_t*)(ws + WS_QP), 2048, nullptr, 0, 1.0f, nullptr};
        pg8::gemm_phase(lds, g, S, E);
#ifdef CLKPROBE
        unsigned long long c1 = __builtin_amdgcn_s_memtime(), r1 = __builtin_amdgcn_s_memrealtime();
        if (blockIdx.x == 7 && threadIdx.x == 0) { float* pr = (float*)(ws + WS_CTL + 40960); pr[0] = (float)(c1 - c0) / (float)(r1 - r0) * 100.0f; pr[1] = (float)(r1 - r0) * 0.01f; }
#endif
    }
    SEAM(12);
    if (IN(13)) peer_select_phase(a, lds);
    SEAM(13);
    if (IN(14)) peer_stage1_phase(a);
    SEAM(14);
    if (IN(15)) peer_cf_phase(a);
    SEAM(15);
    if (IN(16)) peer_stage2_phase<false>(a);
    SEAM(16);
    if (IN(17)) peer_final_phase(a);
#ifdef PROBE_CVT
    if (IN(22)) {
        unsigned s0 = threadIdx.x * 2654435761u + blockIdx.x;
        float ac0 = 0.f, ac1 = 0.f, ac2 = 0.f, ac3 = 0.f; const h16x2 x1 = {(_Float16)1.f, (_Float16)0.5f};
#pragma unroll 1
        for (int it = 0; it < 2048; ++it) {
#if PROBE_CVT == 1
            const u32x6 pk = {s0, s0 ^ 0x1234567u, s0 + (unsigned)it, s0 * 3u, s0 ^ (unsigned)it, s0 + 77u};
            const h16x32 u = __builtin_amdgcn_cvt_scalef32_pk32_f16_fp6(pk, 1.0f);
#pragma unroll
            for (int jj = 0; jj < 4; ++jj) {
                ac0 = __builtin_amdgcn_fdot2((h16x2){u[8 * jj], u[8 * jj + 1]}, x1, ac0, false); ac1 = __builtin_amdgcn_fdot2((h16x2){u[8 * jj + 2], u[8 * jj + 3]}, x1, ac1, false);
                ac2 = __builtin_amdgcn_fdot2((h16x2){u[8 * jj + 4], u[8 * jj + 5]}, x1, ac2, false); ac3 = __builtin_amdgcn_fdot2((h16x2){u[8 * jj + 6], u[8 * jj + 7]}, x1, ac3, false); }
#elif PROBE_CVT == 2
            const unsigned w[8] = {s0, s0 ^ 0x1234567u, s0 + (unsigned)it, s0 * 3u, s0 ^ (unsigned)it, s0 + 77u, s0 * 5u, s0 ^ 0x55aa55u};
#pragma unroll
            for (int jj = 0; jj < 4; ++jj) {
                ac0 = __builtin_amdgcn_fdot2(__builtin_amdgcn_cvt_scalef32_pk_f16_fp8(w[2 * jj] & 0x77777777u, 1.0f, false), x1, ac0, false); ac1 = __builtin_amdgcn_fdot2(__builtin_amdgcn_cvt_scalef32_pk_f16_fp8(w[2 * jj] & 0x77777777u, 1.0f, true), x1, ac1, false);
                ac2 = __builtin_amdgcn_fdot2(__builtin_amdgcn_cvt_scalef32_pk_f16_fp8(w[2 * jj + 1] & 0x77777777u, 1.0f, false), x1, ac2, false); ac3 = __builtin_amdgcn_fdot2(__builtin_amdgcn_cvt_scalef32_pk_f16_fp8(w[2 * jj + 1] & 0x77777777u, 1.0f, true), x1, ac3, false); }
#else
            const unsigned w[8] = {s0, s0 ^ 0x1234567u, s0 + (unsigned)it, s0 * 3u, s0 ^ (unsigned)it, s0 + 77u, s0 * 5u, s0 ^ 0x55aa55u};
#pragma unroll
            for (int jj = 0; jj < 4; ++jj) {
                ac0 = __builtin_amdgcn_fdot2(__builtin_bit_cast(h16x2, w[2 * jj] & 0x3fff3fffu), x1, ac0, false); ac1 = __builtin_amdgcn_fdot2(__builtin_bit_cast(h16x2, (w[2 * jj] >> 2) & 0x3fff3fffu), x1, ac1, false);
                ac2 = __builtin_amdgcn_fdot2(__builtin_bit_cast(h16x2, w[2 * jj + 1] & 0x3fff3fffu), x1, ac2, false); ac3 = __builtin_amdgcn_fdot2(__builtin_bit_cast(h16x2, (w[2 * jj + 1] >> 2) & 0x3fff3fffu), x1, ac3, false); }
#endif
            s0 = s0 * 1664525u + 1013904223u;
        }
        const float acc = (ac0 + ac1) + (ac2 + ac3);
        if (acc == 123.456f) ((float*)(ws + WS_CTL + 40960))[threadIdx.x] = acc;
    }
#endif
#ifdef PROBE_GEMM
    if (IN(20)) {
        pg8::Gemm g{(const bf16_t*)(ws + WS_XN), (const bf16_t*)(ws + WS_WQ), T_, 2048, 2048, 2048};
        pg8::ProbeOrder S; S.init(T_, 2048, gridDim.x, blockIdx.x);
        pg8::EpiNull E{(float*)(ws + WS_CTL + 32768)};
        pg8::gemm_phase(lds, g, S, E);
    }
#endif
#undef IN
#undef SEAM
}

constexpr int N_PHASES = 18;

extern "C" void kernel_launch(void* const* d_in, const int* in_sizes, int n_in, void* d_out, int out_size, void* d_ws, size_t ws_size, hipStream_t stream) {
    static int grid = 0;
    if (grid == 0) {
        int dev = 0, cus = 0, per_cu = 0;
        (void)hipGetDevice(&dev);
        (void)hipDeviceGetAttribute(&cus, hipDeviceAttributeMultiprocessorCount, dev);
        (void)hipFuncSetAttribute((const void*)mega, hipFuncAttributeMaxDynamicSharedMemorySize, LDS_BYTES);
        (void)hipOccupancyMaxActiveBlocksPerMultiprocessor(&per_cu, (const void*)mega, 512, LDS_BYTES);
        if (per_cu < 1 || n_in != 18 || ws_size < WS_END4 || cus != 256) { fprintf(stderr, "kernel_launch: unexpected configuration (per_cu %d, n_in %d, ws %zu)\n", per_cu, n_in, ws_size); grid = -1; return; }
        grid = cus;
    }
    if (grid < 0) return;
    (void)hipMemsetAsync((char*)d_ws + WS_CTL, 0, 4 * XCD_BAR_WORDS * 4, stream);
    Args a{};
    for (int i = 0; i < 18; ++i) a.in[i] = (const float*)d_in[i];
    a.out = (float*)d_out; a.ws = (unsigned char*)d_ws; a.li = 0; a.pad = 0;
#if DUP_PHASE >= 0
#if DUP_PHASE == 116
    const int lo_[3] = {0, 20, 13}, hi_[3] = {13, 21, N_PHASES};
#elif DUP_PHASE == 122
    const int lo_[3] = {0, 22, 0}, hi_[3] = {N_PHASES, 23, 0};
#elif defined(DUP_FIRST)
    const int lo_[3] = {0, DUP_PHASE, DUP_PHASE}, hi_[3] = {DUP_PHASE, DUP_PHASE + 1, N_PHASES};
#else
    const int lo_[3] = {0, DUP_PHASE, DUP_PHASE + 1}, hi_[3] = {DUP_PHASE + 1, DUP_PHASE + 1, N_PHASES};
#endif
    for (int li = 0; li < 3; ++li) { a.ph_lo = lo_[li]; a.ph_hi = hi_[li]; a.li = li; a.pad = (li == 1) ? 1 : 0;
#ifdef DUP_SKIP
        if (li == 1) continue;
#endif
        if (DUP_PHASE == 100 && li == 1) continue;
        if (a.ph_lo >= a.ph_hi) continue;
        void* args[] = {&a};
        hipError_t e = hipLaunchCooperativeKernel((void*)mega, dim3(grid), dim3(512), args, LDS_BYTES, stream);
        if (e != hipSuccess) fprintf(stderr, "launch %d failed: %s\n", li, hipGetErrorString(e)); }
#else
    a.ph_lo = 0; a.ph_hi = N_PHASES;
    void* args[] = {&a};
    hipError_t e = hipLaunchCooperativeKernel((void*)mega, dim3(grid), dim3(512), args, LDS_BYTES, stream);
    if (e != hipSuccess) fprintf(stderr, "cooperative launch failed: %s (grid %d)\n", hipGetErrorString(e), grid);
#endif
}
```
